# Optimizing an MI355X kernel written in HIP

```python
import math
import jax, jax.numpy as jnp
from jax import lax
import numpy as np

D_MODEL = 2048
BATCH = 4
SEQ = 2048
DEPTH = 2

CHUNK = 64
QBLOCK = 128
N_MIXERS = 2
N_SB_LAYERS = (DEPTH + 1) // 2
N_ML_LAYERS = DEPTH // 2
EPS = 1e-6

SB_HEADS = 16
SB_HEAD_DIM = D_MODEL // SB_HEADS
SB_WIDTH = SB_HEADS * SB_HEAD_DIM

ML_HEADS = 8
ML_QK_DIM = (D_MODEL // 2) // ML_HEADS
ML_V_DIM = D_MODEL // ML_HEADS
ML_QK_WIDTH = ML_HEADS * ML_QK_DIM
ML_V_WIDTH = ML_HEADS * ML_V_DIM
ML_IN_WIDTH = 2 * ML_QK_WIDTH + 2 * ML_V_WIDTH + 2 * ML_HEADS

N_GROUPS = 4
EXPERTS_PER_GROUP = 8
N_EXPERTS = N_GROUPS * EXPERTS_PER_GROUP
TOP_K = 2
EXPERT_FF = D_MODEL // 8

kernel_name = "hybrid_stickbreaking_mlstm_hmoe"


def rmsnorm(x, g):
    xf = x.astype(jnp.float32)
    y = xf * lax.rsqrt(jnp.mean(xf * xf, axis=-1, keepdims=True) + EPS)
    return (y * g.astype(jnp.float32)).astype(x.dtype)


def stick_breaking_mixer(h, w_in, w_out):
    B, S, _ = h.shape
    qkv = h @ w_in
    q, k, v = jnp.split(qkv, 3, axis=-1)
    to_heads = lambda a: a.reshape(B, S, SB_HEADS, SB_HEAD_DIM).transpose(0, 2, 1, 3).astype(jnp.float32)
    q = to_heads(q) * (SB_HEAD_DIM ** -0.5)
    k, v = to_heads(k), to_heads(v)
    outs = []
    for blk in range(S // QBLOCK):
        t0 = blk * QBLOCK
        kn = t0 + QBLOCK
        qb, kb, vb = q[:, :, t0:kn], k[:, :, :kn], v[:, :, :kn]
        z = jnp.einsum('bhqd,bhkd->bhqk', qb, kb)
        t_idx = t0 + jnp.arange(QBLOCK)[:, None]
        s_idx = jnp.arange(kn)[None, :]
        mask = s_idx < t_idx
        log_1m = jnp.where(mask, jax.nn.log_sigmoid(-z), 0.0)
        suffix = lax.cumsum(log_1m, axis=3, reverse=True) - log_1m
        A = jnp.where(mask, jnp.exp(jax.nn.log_sigmoid(z) + suffix), 0.0)
        outs.append(jnp.einsum('bhqk,bhkd->bhqd', A, vb))
    o = jnp.concatenate(outs, axis=2)
    o = o.transpose(0, 2, 1, 3).reshape(B, S, SB_WIDTH).astype(h.dtype)
    return o @ w_out


def _mlstm_chunk_step(carry, inp):
    C, n, m = carry
    qc, kc, vc, ic, fc = inp
    L = qc.shape[2]
    b = jnp.cumsum(fc, axis=-1)
    bL = b[..., -1]
    causal = jnp.tril(jnp.ones((L, L), dtype=bool))
    D = b[..., :, None] - b[..., None, :] + ic[..., None, :]
    D = jnp.where(causal, D, -1e30)
    m_inter = b + m[..., None]
    m_t = jnp.maximum(m_inter, jnp.max(D, axis=-1))
    W = jnp.einsum('bhtd,bhsd->bhts', qc, kc) * jnp.where(causal, jnp.exp(D - m_t[..., None]), 0.0)
    inter = jnp.exp(m_inter - m_t)
    num = inter[..., None] * jnp.einsum('bhtd,bhde->bhte', qc, C) + jnp.einsum('bhts,bhse->bhte', W, vc)
    den = inter * jnp.einsum('bhtd,bhd->bht', qc, n) + jnp.sum(W, axis=-1)
    h = num / jnp.maximum(jnp.abs(den), jnp.exp(-m_t))[..., None]
    key_log = bL[..., None] - b + ic
    m_new = jnp.maximum(bL + m, jnp.max(key_log, axis=-1))
    decay = jnp.exp(key_log - m_new[..., None])
    carry_scale = jnp.exp(bL + m - m_new)
    C_new = carry_scale[..., None, None] * C + jnp.einsum('bhs,bhsd,bhse->bhde', decay, kc, vc)
    n_new = carry_scale[..., None] * n + jnp.einsum('bhs,bhsd->bhd', decay, kc)
    return (C_new, n_new, m_new), h


def mlstm_mixer(h, w_in, b_i, b_f, g_head, w_out):
    B, S, _ = h.shape
    NC = S // CHUNK
    proj = (h @ w_in).astype(jnp.float32)
    q, k, v, o, i_raw, f_raw = jnp.split(
        proj, np.cumsum([ML_QK_WIDTH, ML_QK_WIDTH, ML_V_WIDTH, ML_V_WIDTH, ML_HEADS]).tolist(), axis=-1)
    i_log = i_raw + b_i.astype(jnp.float32)
    f_log = jax.nn.log_sigmoid(f_raw + b_f.astype(jnp.float32))
    def chunked(a, d):
        return a.reshape(B, NC, CHUNK, ML_HEADS, d).transpose(1, 0, 3, 2, 4)
    qc = chunked(q, ML_QK_DIM) * (ML_QK_DIM ** -0.5)
    kc = chunked(k, ML_QK_DIM)
    vc = chunked(v, ML_V_DIM)
    ic = i_log.reshape(B, NC, CHUNK, ML_HEADS).transpose(1, 0, 3, 2)
    fc = f_log.reshape(B, NC, CHUNK, ML_HEADS).transpose(1, 0, 3, 2)
    init = (jnp.zeros((B, ML_HEADS, ML_QK_DIM, ML_V_DIM), jnp.float32),
            jnp.zeros((B, ML_HEADS, ML_QK_DIM), jnp.float32),
            jnp.zeros((B, ML_HEADS), jnp.float32))
    _, hs = lax.scan(_mlstm_chunk_step, init, (qc, kc, vc, ic, fc))
    hs = hs.transpose(1, 0, 3, 2, 4).reshape(B, S, ML_HEADS, ML_V_DIM)
    hs = hs * lax.rsqrt(jnp.mean(hs * hs, axis=-1, keepdims=True) + EPS)
    hs = hs.reshape(B, S, ML_V_WIDTH) * g_head.astype(jnp.float32)
    out = (jax.nn.sigmoid(o) * hs).astype(h.dtype)
    return out @ w_out


def hierarchical_moe(h, w_group, b_group, w_expert, b_expert, w1, w3, w2):
    B, S, D = h.shape
    t = h.reshape(B * S, D)
    g_logits = (t @ w_group + b_group).astype(jnp.float32)
    p_group = jax.nn.softmax(g_logits, axis=-1)
    g_sel = jnp.argmax(g_logits, axis=-1)
    p_sel = jnp.take_along_axis(p_group, g_sel[:, None], axis=-1)
    e_logits = (t @ w_expert + b_expert).astype(jnp.float32).reshape(-1, N_GROUPS, EXPERTS_PER_GROUP)
    e_sel = jnp.take_along_axis(e_logits, g_sel[:, None, None], axis=1)[:, 0]
    top_v, top_i = lax.top_k(e_sel, TOP_K)
    w = jax.nn.softmax(top_v, axis=-1) * p_sel
    e_idx = g_sel[:, None] * EXPERTS_PER_GROUP + top_i
    gates = jnp.sum(jax.nn.one_hot(e_idx, N_EXPERTS, dtype=jnp.float32) * w[..., None], axis=1)
    hid = jax.nn.silu(jnp.einsum('td,edf->tef', t, w1)) * jnp.einsum('td,edf->tef', t, w3)
    hid = hid * gates[..., None].astype(hid.dtype)
    out = jnp.einsum('tef,efd->td', hid, w2)
    return out.reshape(B, S, D)


def setup_inputs(seed: int = 0) -> dict:
    key = jax.random.key(seed)
    ks = jax.random.split(key, 20)
    f32 = jnp.float32
    nrm = lambda k, shape, scale: jax.random.normal(k, shape, f32) * scale
    x = nrm(ks[0], (BATCH, SEQ, D_MODEL), 1.0)
    norm_mix = 1.0 + nrm(ks[1], (DEPTH, D_MODEL), 0.01)
    norm_ffn = 1.0 + nrm(ks[2], (DEPTH, D_MODEL), 0.01)
    norm_final = 1.0 + nrm(ks[3], (D_MODEL,), 0.01)
    sb_w_in = nrm(ks[4], (N_SB_LAYERS, D_MODEL, 3 * SB_WIDTH), D_MODEL ** -0.5)
    sb_w_out = nrm(ks[5], (N_SB_LAYERS, SB_WIDTH, D_MODEL), SB_WIDTH ** -0.5)
    ml_w_in = nrm(ks[6], (N_ML_LAYERS, D_MODEL, ML_IN_WIDTH), D_MODEL ** -0.5)
    ml_b_i = nrm(ks[7], (N_ML_LAYERS, ML_HEADS), 0.1)
    ml_b_f = jnp.linspace(3.0, 6.0, ML_HEADS, dtype=f32)[None, :] + nrm(ks[8], (N_ML_LAYERS, ML_HEADS), 0.1)
    ml_g_head = 1.0 + nrm(ks[9], (N_ML_LAYERS, ML_V_WIDTH), 0.01)
    ml_w_out = nrm(ks[10], (N_ML_LAYERS, ML_V_WIDTH, D_MODEL), ML_V_WIDTH ** -0.5)
    moe_w_group = nrm(ks[11], (DEPTH, D_MODEL, N_GROUPS), D_MODEL ** -0.5)
    moe_b_group = nrm(ks[12], (DEPTH, N_GROUPS), 0.01)
    moe_w_expert = nrm(ks[13], (DEPTH, D_MODEL, N_EXPERTS), D_MODEL ** -0.5)
    moe_b_expert = nrm(ks[14], (DEPTH, N_EXPERTS), 0.01)
    moe_w1 = nrm(ks[15], (DEPTH, N_EXPERTS, D_MODEL, EXPERT_FF), D_MODEL ** -0.5)
    moe_w3 = nrm(ks[16], (DEPTH, N_EXPERTS, D_MODEL, EXPERT_FF), D_MODEL ** -0.5)
    moe_w2 = nrm(ks[17], (DEPTH, N_EXPERTS, EXPERT_FF, D_MODEL), EXPERT_FF ** -0.5)
    return {"x": x, "norm_mix": norm_mix, "norm_ffn": norm_ffn, "norm_final": norm_final,
            "sb_w_in": sb_w_in, "sb_w_out": sb_w_out,
            "ml_w_in": ml_w_in, "ml_b_i": ml_b_i, "ml_b_f": ml_b_f, "ml_g_head": ml_g_head,
            "ml_w_out": ml_w_out,
            "moe_w_group": moe_w_group, "moe_b_group": moe_b_group,
            "moe_w_expert": moe_w_expert, "moe_b_expert": moe_b_expert,
            "moe_w1": moe_w1, "moe_w3": moe_w3, "moe_w2": moe_w2}


def reference(x, norm_mix, norm_ffn, norm_final, sb_w_in, sb_w_out,
              ml_w_in, ml_b_i, ml_b_f, ml_g_head, ml_w_out,
              moe_w_group, moe_b_group, moe_w_expert, moe_b_expert, moe_w1, moe_w3, moe_w2):
    for i in range(DEPTH):
        h = rmsnorm(x, norm_mix[i])
        j = i // N_MIXERS
        if i % N_MIXERS == 0:
            x = x + stick_breaking_mixer(h, sb_w_in[j], sb_w_out[j])
        else:
            x = x + mlstm_mixer(h, ml_w_in[j], ml_b_i[j], ml_b_f[j], ml_g_head[j], ml_w_out[j])
        h = rmsnorm(x, norm_ffn[i])
        x = x + hierarchical_moe(h, moe_w_group[i], moe_b_group[i], moe_w_expert[i], moe_b_expert[i],
                                 moe_w1[i], moe_w3[i], moe_w2[i])
    return rmsnorm(x, norm_final)
```

```cpp
#include <hip/hip_runtime.h>
#include <cstdio>
#include <cstdint>

#define GAS __attribute__((address_space(1)))
#define LAS __attribute__((address_space(3)))
#define DI __device__ __forceinline__
typedef unsigned short bf16_t;
typedef short bf16x8 __attribute__((ext_vector_type(8)));
typedef short s16x4 __attribute__((ext_vector_type(4)));
typedef float f32x4 __attribute__((ext_vector_type(4)));
typedef unsigned u32x4 __attribute__((ext_vector_type(4)));
typedef unsigned u32x2 __attribute__((ext_vector_type(2)));

#ifndef MK_MULTI
#define MK_MULTI 1
#endif

constexpr int T = 8192, D = 2048, SEQ = 2048;
constexpr int SBH = 16;
constexpr int MLH = 8, ML_IN = 6160;
constexpr int NE = 32, FF = 256;
constexpr float EPS = 1e-6f;
constexpr int NPHASE = 15;
constexpr int NTHREADS = 512;
constexpr int LDS_BYTES = 147456;

constexpr size_t MiB = 1u << 20;
constexpr size_t WS_CTL = 0, CTL_BYTES = 1 * MiB;
constexpr size_t WS_WSBIN = 1 * MiB, WS_WSBOUT = 25 * MiB, WS_WMLIN = 33 * MiB, WS_WMLOUT = 57 * MiB;
constexpr size_t WS_W13 = 65 * MiB, WS_W2 = 193 * MiB;
constexpr size_t WS_X = 257 * MiB, WS_H = 321 * MiB, WS_ACT = 353 * MiB;
constexpr size_t A_Q = 0, A_K = 32 * MiB, A_VT = 64 * MiB, A_O = 96 * MiB;
constexpr size_t A_Q1 = 0, A_K1 = 16 * MiB, A_KT = 32 * MiB, A_VT1 = 48 * MiB, A_OG = 80 * MiB, A_HS = 112 * MiB, A_G = 144 * MiB;
constexpr size_t A_HID = 0, A_LIST = 9 * MiB, A_LISTW = 10 * MiB, A_Y = 16 * MiB;
constexpr size_t WS_END = WS_ACT + 145 * MiB;
constexpr int CW_BAR = 4096;
constexpr int CW_CNT = 16384;

typedef __bf16 bf16x2_t __attribute__((ext_vector_type(2)));
typedef float f32x2 __attribute__((ext_vector_type(2)));
DI unsigned pk2(float lo, float hi) { const f32x2 v = {lo, hi}; return __builtin_bit_cast(unsigned, __builtin_convertvector(v, bf16x2_t)); }
DI unsigned f2bf(float f) { return pk2(f, 0.f) & 0xffffu; }
DI float bf2f(unsigned short b) { return __builtin_bit_cast(float, ((unsigned)b) << 16); }
DI float wave_sum(float v) {
#pragma unroll
    for (int o = 1; o < 64; o <<= 1) v += __shfl_xor(v, o);
    return v;
}
#define LDS_WAIT() asm volatile("s_waitcnt lgkmcnt(0)" ::: "memory")
#define VM_WAIT() asm volatile("s_waitcnt vmcnt(0)" ::: "memory")
#define MFMA16(a, b, c) __builtin_amdgcn_mfma_f32_16x16x32_bf16((a), (b), (c), 0, 0, 0)

#define XB_TMO      128
#define XB_XCNT(j)  (256  + 64 * (j))
#define XB_XSUB(j)  (1280 + 64 * (j))
#define XB_XGEN(j)  (2304 + 64 * (j))
#define XB_TOP      3328
#define XB_TOPGEN   3392
#define XCD_BAR_WORDS 3456
#define XB_SPIN_CAP (1u << 18)
DI unsigned xb_ld(unsigned* p)              { return __hip_atomic_load(p, __ATOMIC_RELAXED, __HIP_MEMORY_SCOPE_AGENT); }
DI unsigned xb_add(unsigned* p, unsigned v) { return __hip_atomic_fetch_add(p, v, __ATOMIC_RELAXED, __HIP_MEMORY_SCOPE_AGENT); }
DI unsigned xb_xcc_id() { return (unsigned)__builtin_amdgcn_s_getreg((3 << 11) | 20) & 0xFu; }
#define XB_SPIN(cond, bar) do { unsigned _sp = 0; while (cond) { __builtin_amdgcn_s_sleep(1); \
    if ((++_sp & 255u) == 0u) { if (xb_ld(&(bar)[XB_TMO])) break; if (_sp > XB_SPIN_CAP) { atomicAdd(&(bar)[XB_TMO], 1u); break; } } } } while (0)
struct XcdBarrier { unsigned* bar; unsigned x; volatile LAS unsigned* st; };
DI XcdBarrier xcd_barrier_post(unsigned* bar, volatile LAS unsigned* st) {
    XcdBarrier b; b.bar = bar; b.x = xb_xcc_id(); b.st = st;
    if (threadIdx.x == 0) (void)xb_add(&bar[XB_XCNT(b.x)], 1u);
    return b;
}
DI void xcd_barrier_complete(unsigned* bar, unsigned x, unsigned& nloc, unsigned& nx) {
    const unsigned G = gridDim.x * gridDim.y * gridDim.z;
    unsigned sum, cnt, mine, sp = 0u;
    for (;;) {
        sum = 0u; cnt = 0u; mine = 0u;
#pragma unroll
        for (unsigned j = 0; j < 16; ++j) { const unsigned c = xb_ld(&bar[XB_XCNT(j)]); sum += c; cnt += (c > 0u) ? 1u : 0u; mine = (j == x) ? c : mine; }
        if (sum == G) break;
        __builtin_amdgcn_s_sleep(1);
        if ((++sp & 255u) == 0u) { if (xb_ld(&bar[XB_TMO])) break; if (sp > XB_SPIN_CAP) { atomicAdd(&bar[XB_TMO], 1u); break; } }
    }
    nloc = mine > 0u ? mine : 1u; nx = cnt > 0u ? cnt : 1u;
}
DI void xcd_barrier(const XcdBarrier& b) {
    asm volatile("s_waitcnt vmcnt(0)" ::: "memory");
    __syncthreads();
    if (threadIdx.x == 0) {
        unsigned* bar = b.bar;
        __builtin_amdgcn_s_waitcnt(0);
        unsigned nloc = b.st[0], nx = b.st[1];
        if (nloc == 0u) { xcd_barrier_complete(bar, b.x, nloc, nx); b.st[0] = nloc; b.st[1] = nx; }
        const unsigned old = xb_add(&bar[XB_XSUB(b.x)], 1u);
        const unsigned gen = old / nloc;
        if (old + 1u == (gen + 1u) * nloc) {
            __builtin_amdgcn_fence(__ATOMIC_RELEASE, "agent");
            asm volatile("s_waitcnt vmcnt(0)" ::: "memory");
            const unsigned og = xb_add(&bar[XB_TOP], 1u);
            const unsigned tg = og / nx;
            if (og + 1u == (tg + 1u) * nx) xb_add(&bar[XB_TOPGEN], 1u);
            else XB_SPIN(xb_ld(&bar[XB_TOPGEN]) == tg, bar);
            __builtin_amdgcn_fence(__ATOMIC_ACQUIRE, "agent");
            xb_add(&bar[XB_XGEN(b.x)], 1u);
            asm volatile("s_waitcnt vmcnt(0)" ::: "memory");
        } else {
            XB_SPIN(xb_ld(&bar[XB_XGEN(b.x)]) == gen, bar);
            __builtin_amdgcn_fence(__ATOMIC_ACQUIRE, "agent");
            asm volatile("s_waitcnt vmcnt(0)" ::: "memory");
        }
    }
    __syncthreads();
}

struct Args {
    const float* in[18];
    float* out;
    unsigned char* ws;
    int ph_lo, ph_hi;
};

DI int perm13(int f, int which) { return (f >> 6) * 128 + ((f >> 4) & 3) * 32 + which * 16 + (f & 15); }
DI void transpose_item(const float* W, int ldw, bf16_t* WT, int ldt, int k0, int n0, int mode, LAS float* scr, int lane) {
#pragma unroll 8
    for (int i = 0; i < 32; ++i) { const int kk = 2 * i + (lane >> 5); scr[kk * 33 + (lane & 31)] = W[(size_t)(k0 + kk) * ldw + n0 + (lane & 31)]; }
    LDS_WAIT(); asm volatile("" ::: "memory");
    const int c = lane & 7;
#pragma unroll
    for (int j = 0; j < 4; ++j) {
        const int n = (lane >> 3) + 8 * j; const LAS float* s = scr + (8 * c) * 33 + n;
        u32x4 o; o.x = pk2(s[0 * 33], s[1 * 33]); o.y = pk2(s[2 * 33], s[3 * 33]); o.z = pk2(s[4 * 33], s[5 * 33]); o.w = pk2(s[6 * 33], s[7 * 33]);
        const int nn = n0 + n; const int row = (mode == 0) ? nn : perm13(nn, mode - 1);
        *(u32x4*)(WT + (size_t)row * ldt + k0 + 8 * c) = o;
    }
    LDS_WAIT(); asm volatile("" ::: "memory");
}

struct NormP {
    const float* src; float* X; const bf16_t* Y; bf16_t* H; float* outf; const float* g;
    const float* wg; const float* bg; const float* we; const float* be;
    unsigned* cnt; unsigned* list; float* listw;
    const float* wml; float* G;
};
template <int MODE>
DI void norm_phase(const NormP& p, LAS unsigned char* lds, int tid, int wid, int lane) {
    LAS float* rowbuf = (LAS float*)lds;
    LAS float* part = (LAS float*)(lds + 65536);
    LAS float* logit = (LAS float*)(lds + 65536 + 8 * 8 * 36 * 4);
    constexpr int NOUT = (MODE == 1) ? 36 : 16;
    for (int it = blockIdx.x; it < T / 8; it += gridDim.x) {
        const int row = it * 8 + wid;
        f32x4 v[8]; float ss = 0.f;
        const size_t ro = (size_t)row * D;
#pragma unroll
        for (int j = 0; j < 8; ++j) {
            const int c = 4 * lane + 256 * j;
            f32x4 x = *(const f32x4*)((MODE == 0 ? p.src : (const float*)p.X) + ro + c);
            if (MODE >= 2) {
                const u32x2 a = *(const u32x2*)(p.Y + ro + c), b = *(const u32x2*)(p.Y + (size_t)T * D + ro + c);
                x.x += bf2f(a.x & 0xffff) + bf2f(b.x & 0xffff); x.y += bf2f(a.x >> 16) + bf2f(b.x >> 16);
                x.z += bf2f(a.y & 0xffff) + bf2f(b.y & 0xffff); x.w += bf2f(a.y >> 16) + bf2f(b.y >> 16);
                if (MODE == 2) *(f32x4*)(p.X + ro + c) = x;
            }
            v[j] = x; ss += (x.x * x.x + x.y * x.y) + (x.z * x.z + x.w * x.w);
        }
        const float rstd = 1.0f / sqrtf(wave_sum(ss) * (1.0f / D) + EPS);
#pragma unroll
        for (int j = 0; j < 8; ++j) {
            const int c = 4 * lane + 256 * j;
            const f32x4 gg = *(const f32x4*)(p.g + c);
            f32x4 y; y.x = v[j].x * rstd * gg.x; y.y = v[j].y * rstd * gg.y; y.z = v[j].z * rstd * gg.z; y.w = v[j].w * rstd * gg.w;
            if (MODE == 3) *(f32x4*)(p.outf + ro + c) = y;
            else { u32x2 o; o.x = pk2(y.x, y.y); o.y = pk2(y.z, y.w); *(u32x2*)(p.H + ro + c) = o; }
            if (MODE == 1 || MODE == 2) *(LAS f32x4*)(rowbuf + wid * D + c) = y;
        }
        if (MODE == 1 || MODE == 2) {
            __syncthreads();
            const float* wp; int stride;
            if (MODE == 1) { if (lane < 4) { wp = p.wg + lane; stride = 4; } else { wp = p.we + ((lane - 4) & 31); stride = 32; } }
            else { wp = p.wml + (lane & 15); stride = ML_IN; }
            float acc[8];
#pragma unroll
            for (int r = 0; r < 8; ++r) acc[r] = 0.f;
            if (lane < NOUT) {
                for (int k4 = 0; k4 < 64; ++k4) {
                    const int k = 256 * wid + 4 * k4;
                    const float w0 = wp[(size_t)k * stride], w1 = wp[(size_t)(k + 1) * stride], w2 = wp[(size_t)(k + 2) * stride], w3 = wp[(size_t)(k + 3) * stride];
#pragma unroll
                    for (int r = 0; r < 8; ++r) {
                        const f32x4 h = *(LAS f32x4*)(rowbuf + r * D + k);
                        acc[r] += (h.x * w0 + h.y * w1) + (h.z * w2 + h.w * w3);
                    }
                }
#pragma unroll
                for (int r = 0; r < 8; ++r) part[(wid * 8 + r) * 36 + lane] = acc[r];
            }
            __syncthreads();
            if (tid < 8 * NOUT) {
                const int r = tid / NOUT, j = tid % NOUT;
                float s = 0.f;
#pragma unroll
                for (int w = 0; w < 8; ++w) s += part[(w * 8 + r) * 36 + j];
                if (MODE == 1) { s += (j < 4) ? p.bg[j] : p.be[j - 4]; logit[r * 36 + j] = s; }
                else p.G[(size_t)(it * 8 + r) * 16 + j] = s;
            }
            if (MODE == 1) {
                __syncthreads();
                if (tid < 8) {
                    const int tok = it * 8 + tid; const LAS float* lg = logit + tid * 36;
                    int gs = 0; float gm = lg[0];
#pragma unroll
                    for (int j = 1; j < 4; ++j) if (lg[j] > gm) { gm = lg[j]; gs = j; }
                    float den = 0.f;
#pragma unroll
                    for (int j = 0; j < 4; ++j) den += __expf(lg[j] - gm);
                    const float psel = 1.0f / den;
                    const LAS float* el = lg + 4 + gs * 8;
                    int i0 = 0; float v0 = el[0];
#pragma unroll
                    for (int j = 1; j < 8; ++j) if (el[j] > v0) { v0 = el[j]; i0 = j; }
                    int i1 = -1; float v1 = -3.0e38f;
#pragma unroll
                    for (int j = 0; j < 8; ++j) if (j != i0 && el[j] > v1) { v1 = el[j]; i1 = j; }
                    const float e10 = __expf(v1 - v0); const float w0 = psel / (1.0f + e10), w1 = psel * e10 / (1.0f + e10);
                    const int e0 = gs * 8 + i0, e1 = gs * 8 + i1;
                    const unsigned p0 = atomicAdd(p.cnt + e0, 1u); p.list[(size_t)e0 * T + p0] = (unsigned)tok * 2u; p.listw[(size_t)e0 * T + p0] = w0;
                    const unsigned p1 = atomicAdd(p.cnt + e1, 1u); p.list[(size_t)e1 * T + p1] = (unsigned)tok * 2u + 1u; p.listw[(size_t)e1 * T + p1] = w1;
                }
            }
            __syncthreads();
        }
    }
}

DI int lds_byte(int r, int c) { const int st = (r >> 4) * 2 + (c >> 5), rr = r & 15, cc = c & 31, ob = rr * 64 + cc * 2; return st * 1024 + (ob ^ (((ob >> 9) & 1) << 5)); }
DI void stage_rc(int b, int& R, int& C) { const int st = b / 1024, sb = b % 1024, swz = sb ^ (((sb >> 9) & 1) << 5); R = (st >> 1) * 16 + swz / 64; C = (st & 1) * 32 + (swz % 64) / 2; }

DI void gemm_tile128(LAS unsigned char* lds, const bf16_t* pa0, const bf16_t* pa1, const bf16_t* pb0, const bf16_t* pb1, int K, f32x4 (&acc)[4][2],
                     int wid, int wr, int wc, int fr, int fq) {
    const int nt = K / 64;
    const unsigned ldsw = (unsigned)wid * 1024u;
#define GT_STAGE(buf, t) do { \
        __builtin_amdgcn_global_load_lds((const GAS unsigned*)(pa0 + (t) * 64), (LAS unsigned*)(lds + (buf) * 32768 + ldsw), 16, 0, 0); \
        __builtin_amdgcn_global_load_lds((const GAS unsigned*)(pa1 + (t) * 64), (LAS unsigned*)(lds + (buf) * 32768 + 8192 + ldsw), 16, 0, 0); \
        __builtin_amdgcn_global_load_lds((const GAS unsigned*)(pb0 + (t) * 64), (LAS unsigned*)(lds + (buf) * 32768 + 16384 + ldsw), 16, 0, 0); \
        __builtin_amdgcn_global_load_lds((const GAS unsigned*)(pb1 + (t) * 64), (LAS unsigned*)(lds + (buf) * 32768 + 16384 + 8192 + ldsw), 16, 0, 0); } while (0)
#pragma unroll
    for (int m = 0; m < 4; ++m)
#pragma unroll
        for (int n = 0; n < 2; ++n) acc[m][n] = (f32x4){0.f, 0.f, 0.f, 0.f};
    const int aoff = lds_byte(wr * 64 + fr, fq * 8), boff = lds_byte(wc * 32 + fr, fq * 8);
    GT_STAGE(0, 0);
    for (int t = 0; t < nt; ++t) {
        asm volatile("s_waitcnt vmcnt(0) lgkmcnt(0)" ::: "memory");
        __builtin_amdgcn_s_barrier();
        asm volatile("" ::: "memory");
        if (t + 1 < nt) GT_STAGE((t + 1) & 1, t + 1);
        const LAS unsigned char* sa = lds + (t & 1) * 32768, * sb = sa + 16384;
        bf16x8 Af[4][2], Bf[2][2];
#pragma unroll
        for (int m = 0; m < 4; ++m)
#pragma unroll
            for (int k = 0; k < 2; ++k) Af[m][k] = *(const LAS bf16x8*)(sa + aoff + m * 2048 + k * 1024);
#pragma unroll
        for (int n = 0; n < 2; ++n)
#pragma unroll
            for (int k = 0; k < 2; ++k) Bf[n][k] = *(const LAS bf16x8*)(sb + boff + n * 2048 + k * 1024);
#pragma unroll
        for (int m = 0; m < 4; ++m)
#pragma unroll
            for (int n = 0; n < 2; ++n)
#pragma unroll
                for (int k = 0; k < 2; ++k) acc[m][n] = MFMA16(Bf[n][k], Af[m][k], acc[m][n]);
    }
    asm volatile("s_waitcnt vmcnt(0) lgkmcnt(0)" ::: "memory");
    __builtin_amdgcn_s_barrier();
    asm volatile("" ::: "memory");
#undef GT_STAGE
}

struct Job { const bf16_t* A; const bf16_t* Bt; void* out; const float* base; int M, N, K, lda, ldb, ldo, kind; float scale; };
constexpr int JOBS_LDS = 139264;
DI void run_jobs(int njobs, LAS unsigned char* lds, int tid, int wid, int lane) {
    const Job* jobs = (const Job*)((unsigned char*)lds + JOBS_LDS);
    __syncthreads();
    const int wr = wid >> 2, wc = wid & 3, fr = lane & 15, fq = lane >> 4;
    int R0, C0, R1, C1; stage_rc(tid * 16, R0, C0); stage_rc(tid * 16 + 8192, R1, C1);
    int total = 0;
    for (int j = 0; j < njobs; ++j) total += (jobs[j].M / 128) * (jobs[j].N / 128);
    for (int u = blockIdx.x; u < total; u += gridDim.x) {
        int j = 0, r = u;
        while (r >= (jobs[j].M / 128) * (jobs[j].N / 128)) { r -= (jobs[j].M / 128) * (jobs[j].N / 128); ++j; }
        const Job J = jobs[j];
        const int nN = J.N / 128, pm = r / nN, pn = r % nN;
        const bf16_t* A = J.A + (size_t)(pm * 128) * J.lda; const bf16_t* B = J.Bt + (size_t)(pn * 128) * J.ldb;
        f32x4 acc[4][2];
        gemm_tile128(lds, A + (size_t)R0 * J.lda + C0, A + (size_t)R1 * J.lda + C1, B + (size_t)R0 * J.ldb + C0, B + (size_t)R1 * J.ldb + C1, J.K, acc, wid, wr, wc, fr, fq);
#pragma unroll
        for (int m = 0; m < 4; ++m) {
            const int row = pm * 128 + wr * 64 + m * 16 + fr;
#pragma unroll
            for (int n = 0; n < 2; ++n) {
                const int col = pn * 128 + wc * 32 + n * 16 + fq * 4;
                const f32x4 a = acc[m][n];
                if (J.kind == 0) { u32x2 o; o.x = pk2(a.x * J.scale, a.y * J.scale); o.y = pk2(a.z * J.scale, a.w * J.scale); *(u32x2*)((bf16_t*)J.out + (size_t)row * J.ldo + col) = o; }
                else { const f32x4 b = *(const f32x4*)(J.base + (size_t)row * J.ldo + col); f32x4 o; o.x = a.x + b.x; o.y = a.y + b.y; o.z = a.z + b.z; o.w = a.w + b.w; *(f32x4*)((float*)J.out + (size_t)row * J.ldo + col) = o; }
            }
        }
    }
}

struct MoeP { const bf16_t* H; const bf16_t* W13; const bf16_t* W2; bf16_t* hid; bf16_t* Y; const unsigned* cnt; const unsigned* list; const float* listw; };
constexpr int MOE_LDS_CTL = 65536;
DI void moe_table(const MoeP& p, LAS unsigned char* lds, int tid) {
    LAS int* ctl = (LAS int*)(lds + MOE_LDS_CTL);
    if (tid == 0) {
        int b = 0, ts = 0;
        for (int e = 0; e < NE; ++e) { const int c = (int)__hip_atomic_load(p.cnt + e, __ATOMIC_RELAXED, __HIP_MEMORY_SCOPE_AGENT); ctl[e] = c; ctl[32 + e] = b; ctl[64 + e] = ts; b += c; ts += (c + 127) / 128; }
        ctl[64 + NE] = ts;
    }
    __syncthreads();
}
DI void moe_gemm1(const MoeP& p, LAS unsigned char* lds, int tid, int wid, int lane) {
    const int wr = wid >> 2, wc = wid & 3, fr = lane & 15, fq = lane >> 4;
    int R0, C0, R1, C1; stage_rc(tid * 16, R0, C0); stage_rc(tid * 16 + 8192, R1, C1);
    moe_table(p, lds, tid);
    const LAS int* ctl = (const LAS int*)(lds + MOE_LDS_CTL);
    const int total = ctl[64 + NE] * 4;
    for (int u = blockIdx.x; u < total; u += gridDim.x) {
        const int rt_g = u >> 2, ct = u & 3;
        int e = 0; while (e + 1 < NE && ctl[64 + e + 1] <= rt_g) ++e;
        const int rt = rt_g - ctl[64 + e], cnt = ctl[e], sbase = ctl[32 + e];
        const int ra = rt * 128 + R0, rb = rt * 128 + R1;
        const unsigned ta = p.list[(size_t)e * T + (ra < cnt ? ra : cnt - 1)] >> 1, tb = p.list[(size_t)e * T + (rb < cnt ? rb : cnt - 1)] >> 1;
        const bf16_t* B = p.W13 + ((size_t)e * 512 + ct * 128) * D;
        f32x4 acc[4][2];
        gemm_tile128(lds, p.H + (size_t)ta * D + C0, p.H + (size_t)tb * D + C1, B + (size_t)R0 * D + C0, B + (size_t)R1 * D + C1, D, acc, wid, wr, wc, fr, fq);
#pragma unroll
        for (int m = 0; m < 4; ++m) {
            const int r = rt * 128 + wr * 64 + m * 16 + fr;
            if (r < cnt) {
                const float gw = p.listw[(size_t)e * T + r];
                const f32x4 g = acc[m][0], uu = acc[m][1];
                float hv[4];
#pragma unroll
                for (int j = 0; j < 4; ++j) { const float gj = g[j]; hv[j] = gj / (1.0f + __expf(-gj)) * uu[j] * gw; }
                u32x2 o; o.x = pk2(hv[0], hv[1]); o.y = pk2(hv[2], hv[3]);
                *(u32x2*)(p.hid + (size_t)(sbase + r) * FF + ct * 64 + wc * 16 + fq * 4) = o;
            }
        }
    }
}
DI void moe_gemm2(const MoeP& p, LAS unsigned char* lds, int tid, int wid, int lane) {
    const int wr = wid >> 2, wc = wid & 3, fr = lane & 15, fq = lane >> 4;
    int R0, C0, R1, C1; stage_rc(tid * 16, R0, C0); stage_rc(tid * 16 + 8192, R1, C1);
    moe_table(p, lds, tid);
    const LAS int* ctl = (const LAS int*)(lds + MOE_LDS_CTL);
    const int total = ctl[64 + NE] * 16;
    for (int u = blockIdx.x; u < total; u += gridDim.x) {
        const int rt_g = u >> 4, ct = u & 15;
        int e = 0; while (e + 1 < NE && ctl[64 + e + 1] <= rt_g) ++e;
        const int rt = rt_g - ctl[64 + e], cnt = ctl[e], sbase = ctl[32 + e];
        const bf16_t* A = p.hid + (size_t)(sbase + rt * 128) * FF;
        const bf16_t* B = p.W2 + ((size_t)e * D + ct * 128) * FF;
        f32x4 acc[4][2];
        gemm_tile128(lds, A + (size_t)R0 * FF + C0, A + (size_t)R1 * FF + C1, B + (size_t)R0 * FF + C0, B + (size_t)R1 * FF + C1, FF, acc, wid, wr, wc, fr, fq);
#pragma unroll
        for (int m = 0; m < 4; ++m) {
            const int r = rt * 128 + wr * 64 + m * 16 + fr;
            if (r < cnt) {
                const unsigned ent = p.list[(size_t)e * T + r];
                bf16_t* yrow = p.Y + ((size_t)(ent & 1u) * T + (ent >> 1)) * D + ct * 128 + wc * 32 + fq * 4;
#pragma unroll
                for (int n = 0; n < 2; ++n) { const f32x4 a = acc[m][n]; u32x2 o; o.x = pk2(a.x, a.y); o.y = pk2(a.z, a.w); *(u32x2*)(yrow + n * 16) = o; }
            }
        }
    }
}

constexpr int AT_QS = 0, AT_KS = 34816, AT_VT = 52224, AT_SS = 70656, AT_AS = 105472;
DI void attn_phase(const bf16_t* Qb, const bf16_t* Kb, const bf16_t* Vt, bf16_t* O, LAS unsigned char* lds, int tid, int wid, int lane) {
    const int fr = lane & 15, fq = lane >> 4;
    for (int bx = blockIdx.x; bx < 1024; bx += gridDim.x) {
        const int rnd = bx >> 8, pos = bx & 255;
        const int qb = (rnd & 1) ? ((3 - rnd) * 4 + (pos >> 6)) : (15 - rnd * 4 - (pos >> 6));
        const int bh = pos & 63, b = bh >> 4, h = bh & 15;
        const int t0 = qb * 128;
#pragma unroll
        for (int c4 = 0; c4 < 4; ++c4) {
            const int c = tid + 512 * c4, row = c >> 4, c16 = c & 15;
            const u32x4 v = *(const u32x4*)(Qb + (size_t)(b * SEQ + t0 + row) * D + h * 128 + c16 * 8);
            *(LAS u32x4*)(lds + AT_QS + row * 272 + c16 * 16) = v;
        }
        f32x4 oacc[8];
#pragma unroll
        for (int n = 0; n < 8; ++n) oacc[n] = (f32x4){0.f, 0.f, 0.f, 0.f};
        float Rrun = 0.f;
        const int erow = 16 * wid + (lane >> 2), eseg = lane & 3;
        const int tq = t0 + erow;
        for (int s0 = t0 + 64; s0 >= 0; s0 -= 64) {
            __syncthreads();
#pragma unroll
            for (int c2 = 0; c2 < 2; ++c2) {
                const int c = tid + 512 * c2;
                { const int row = c >> 4, c16 = c & 15;
                  const u32x4 v = *(const u32x4*)(Kb + (size_t)(b * SEQ + s0 + row) * D + h * 128 + c16 * 8);
                  *(LAS u32x4*)(lds + AT_KS + row * 272 + c16 * 16) = v; }
                { const int row = c >> 3, c8 = c & 7;
                  const u32x4 v = *(const u32x4*)(Vt + (size_t)(h * 128 + row) * T + b * SEQ + s0 + c8 * 8);
                  *(LAS u32x4*)(lds + AT_VT + row * 144 + c8 * 16) = v; }
            }
            __syncthreads();
            f32x4 sacc[4];
#pragma unroll
            for (int n = 0; n < 4; ++n) sacc[n] = (f32x4){0.f, 0.f, 0.f, 0.f};
#pragma unroll
            for (int ks = 0; ks < 4; ++ks) {
                const bf16x8 qa = *(const LAS bf16x8*)(lds + AT_QS + (16 * wid + fr) * 272 + (ks * 32 + fq * 8) * 2);
#pragma unroll
                for (int n = 0; n < 4; ++n) {
                    const bf16x8 kb = *(const LAS bf16x8*)(lds + AT_KS + (16 * n + fr) * 272 + (ks * 32 + fq * 8) * 2);
                    sacc[n] = MFMA16(kb, qa, sacc[n]);
                }
            }
#pragma unroll
            for (int n = 0; n < 4; ++n) *(LAS f32x4*)(lds + AT_SS + (16 * wid + fr) * 272 + (16 * n + 4 * fq) * 4) = sacc[n];
            __syncthreads();
            {
                float z[16];
#pragma unroll
                for (int q4 = 0; q4 < 4; ++q4) { const f32x4 v = *(const LAS f32x4*)(lds + AT_SS + erow * 272 + (16 * eseg + 4 * q4) * 4); z[4 * q4] = v.x; z[4 * q4 + 1] = v.y; z[4 * q4 + 2] = v.z; z[4 * q4 + 3] = v.w; }
                float c[16]; float run = 0.f;
                const int sbase = s0 + 16 * eseg;
#pragma unroll
                for (int k = 15; k >= 0; --k) {
                    const bool ok = (sbase + k) < tq;
                    const float zz = z[k];
                    const float sp = fmaxf(zz, 0.f) + __logf(1.0f + __expf(-fabsf(zz)));
                    run -= ok ? sp : 0.f;
                    c[k] = run;
                }
                const int qbase = lane & ~3;
                const float t0s = __shfl(run, qbase), t1s = __shfl(run, qbase + 1), t2s = __shfl(run, qbase + 2), t3s = __shfl(run, qbase + 3);
                const float offs = Rrun + ((eseg < 1) ? t1s : 0.f) + ((eseg < 2) ? t2s : 0.f) + ((eseg < 3) ? t3s : 0.f);
                unsigned pk[8];
#pragma unroll
                for (int k = 0; k < 16; k += 2) {
                    const float a0 = ((sbase + k) < tq) ? __expf(z[k] + c[k] + offs) : 0.f;
                    const float a1 = ((sbase + k + 1) < tq) ? __expf(z[k + 1] + c[k + 1] + offs) : 0.f;
                    pk[k >> 1] = pk2(a0, a1);
                }
                Rrun += (t0s + t1s) + (t2s + t3s);
                *(LAS u32x4*)(lds + AT_AS + erow * 144 + eseg * 32) = (u32x4){pk[0], pk[1], pk[2], pk[3]};
                *(LAS u32x4*)(lds + AT_AS + erow * 144 + eseg * 32 + 16) = (u32x4){pk[4], pk[5], pk[6], pk[7]};
            }
            __syncthreads();
#pragma unroll
            for (int ks = 0; ks < 2; ++ks) {
                const bf16x8 aa = *(const LAS bf16x8*)(lds + AT_AS + (16 * wid + fr) * 144 + (ks * 32 + fq * 8) * 2);
#pragma unroll
                for (int n = 0; n < 8; ++n) {
                    const bf16x8 vb = *(const LAS bf16x8*)(lds + AT_VT + (16 * n + fr) * 144 + (ks * 32 + fq * 8) * 2);
                    oacc[n] = MFMA16(vb, aa, oacc[n]);
                }
            }
        }
        bf16_t* orow = O + (size_t)(b * SEQ + t0 + 16 * wid + fr) * D + h * 128 + 4 * fq;
#pragma unroll
        for (int n = 0; n < 8; ++n) { u32x2 o; o.x = pk2(oacc[n].x, oacc[n].y); o.y = pk2(oacc[n].z, oacc[n].w); *(u32x2*)(orow + 16 * n) = o; }
        __syncthreads();
    }
}

constexpr int ML_QS = 0, ML_KS = 17408, ML_KD = 34816, ML_VT = 53248, ML_WS = 90112, ML_HB = 99328, ML_SC = 133120;
DI float ml_tab(LAS float* tab, float gi, float gf, float mprev, int lane) {
    const float flog = fminf(gf, 0.f) - __logf(1.0f + __expf(-fabsf(gf)));
    float bb = flog;
#pragma unroll
    for (int o = 1; o < 64; o <<= 1) { const float v = __shfl_up(bb, o); if (lane >= o) bb += v; }
    const float a = gi - bb;
    float pm = a;
#pragma unroll
    for (int o = 1; o < 64; o <<= 1) { const float v = __shfl_up(pm, o); if (lane >= o) pm = fmaxf(pm, v); }
    const float amax = __shfl(pm, 63), bL = __shfl(bb, 63);
    const float Mx = fmaxf(mprev, amax);
    tab[lane] = a; tab[64 + lane] = bb; tab[128 + lane] = fmaxf(pm, mprev);
    if (lane == 0) { tab[192] = mprev; tab[193] = Mx; }
    return bL + Mx;
}
DI void mlstm_phase(const bf16_t* Q1, const bf16_t* K1, const bf16_t* KT, const bf16_t* VT, const bf16_t* OG, const float* G, const float* b_i, const float* b_f,
                    const float* g_head, bf16_t* HS, LAS unsigned char* lds, int tid, int wid, int lane) {
    const int fr = lane & 15, fq = lane >> 4;
    LAS float* sc = (LAS float*)(lds + ML_SC); LAS float* sssq = sc + 512; LAS float* srs = sc + 1024; LAS float* sden = sc + 1280; LAS float* sn = sc + 1344;
    LAS bf16_t* hb = (LAS bf16_t*)(lds + ML_HB);
    for (int unit = blockIdx.x; unit < 32; unit += gridDim.x) {
        const int b = unit >> 3, h = unit & 7;
        __syncthreads();
        float mcarry = 0.f, gi_n = 0.f, gf_n = 0.f;
        const float bi_h = b_i[h], bf_h = b_f[h];
        if (wid == 0) {
            const size_t g0 = (size_t)(b * SEQ + lane) * 16;
            mcarry = ml_tab(sc, G[g0 + h] + bi_h, G[g0 + 8 + h] + bf_h, 0.f, lane);
            gi_n = G[g0 + 64 * 16 + h] + bi_h; gf_n = G[g0 + 64 * 16 + 8 + h] + bf_h;
        }
        if (tid < 128) sn[tid] = 0.f;
        f32x4 C[8][2];
#pragma unroll
        for (int dt = 0; dt < 8; ++dt)
#pragma unroll
            for (int et = 0; et < 2; ++et) C[dt][et] = (f32x4){0.f, 0.f, 0.f, 0.f};
#pragma unroll 1
        for (int c = 0; c < 32; ++c) {
            const int tok0 = b * SEQ + c * 64;
            LAS float* tab = sc + (c & 1) * 256;
            __syncthreads();
            if (wid == 0 && c + 1 < 32) {
                mcarry = ml_tab(sc + ((c + 1) & 1) * 256, gi_n, gf_n, mcarry, lane);
                if (c + 2 < 32) { const size_t g0 = (size_t)(tok0 + 128 + lane) * 16; gi_n = G[g0 + h] + bi_h; gf_n = G[g0 + 8 + h] + bf_h; }
            }
            const float mprev = tab[192], M63 = tab[193];
#pragma unroll
            for (int c2 = 0; c2 < 2; ++c2) {
                const int ch = tid + 512 * c2;
                { const int row = ch >> 4, c16 = ch & 15;
                  *(LAS u32x4*)(lds + ML_QS + row * 272 + c16 * 16) = *(const u32x4*)(Q1 + (size_t)(tok0 + row) * 1024 + h * 128 + c16 * 8);
                  *(LAS u32x4*)(lds + ML_KS + row * 272 + c16 * 16) = *(const u32x4*)(K1 + (size_t)(tok0 + row) * 1024 + h * 128 + c16 * 8); }
                { const int row = ch >> 3, c8 = ch & 7;
                  const u32x4 v = *(const u32x4*)(KT + (size_t)(h * 128 + row) * T + tok0 + c8 * 8);
                  const unsigned w[4] = {v.x, v.y, v.z, v.w}; unsigned o[4];
#pragma unroll
                  for (int q = 0; q < 4; ++q) {
                      const int s = c8 * 8 + 2 * q;
                      const float d0 = __expf(tab[s] - M63), d1 = __expf(tab[s + 1] - M63);
                      o[q] = pk2(bf2f(w[q] & 0xffff) * d0, bf2f(w[q] >> 16) * d1);
                  }
                  *(LAS u32x4*)(lds + ML_KD + row * 144 + c8 * 16) = (u32x4){o[0], o[1], o[2], o[3]}; }
            }
#pragma unroll
            for (int c4 = 0; c4 < 4; ++c4) {
                const int ch = tid + 512 * c4, row = ch >> 3, c8 = ch & 7;
                *(LAS u32x4*)(lds + ML_VT + row * 144 + c8 * 16) = *(const u32x4*)(VT + (size_t)(h * 256 + row) * T + tok0 + c8 * 8);
            }
            __syncthreads();
            {
                const int tb = wid >> 1;
#pragma unroll
                for (int a2 = 0; a2 < 2; ++a2) {
                    const int sa_t = 2 * (wid & 1) + a2;
                    u32x2 o = (u32x2){0u, 0u}; float rsum = 0.f;
                    if (sa_t <= tb) {
                        f32x4 acc = (f32x4){0.f, 0.f, 0.f, 0.f};
#pragma unroll
                        for (int ks = 0; ks < 4; ++ks) {
                            const bf16x8 kf = *(const LAS bf16x8*)(lds + ML_KS + (16 * sa_t + fr) * 272 + (ks * 32 + fq * 8) * 2);
                            const bf16x8 qf = *(const LAS bf16x8*)(lds + ML_QS + (16 * tb + fr) * 272 + (ks * 32 + fq * 8) * 2);
                            acc = MFMA16(kf, qf, acc);
                        }
                        const int tl = 16 * tb + fr; const float Mt = tab[128 + tl];
                        float wv[4];
#pragma unroll
                        for (int j = 0; j < 4; ++j) { const int sl = 16 * sa_t + 4 * fq + j; wv[j] = (sl <= tl) ? acc[j] * __expf(tab[sl] - Mt) : 0.f; }
                        o.x = pk2(wv[0], wv[1]); o.y = pk2(wv[2], wv[3]);
                        rsum = (wv[0] + wv[1]) + (wv[2] + wv[3]);
                        rsum += __shfl_xor(rsum, 16); rsum += __shfl_xor(rsum, 32);
                    }
                    *(LAS u32x2*)(lds + ML_WS + (16 * tb + fr) * 144 + (16 * sa_t + 4 * fq) * 2) = o;
                    if (fq == 0) srs[sa_t * 64 + 16 * tb + fr] = rsum;
                }
            }
            __syncthreads();
            {
                const int tl = tid >> 3, sl = tid & 7;
                const u32x4 qa = *(const LAS u32x4*)(lds + ML_QS + tl * 272 + sl * 32), qb = *(const LAS u32x4*)(lds + ML_QS + tl * 272 + sl * 32 + 16);
                const unsigned qw[8] = {qa.x, qa.y, qa.z, qa.w, qb.x, qb.y, qb.z, qb.w};
                float p = 0.f;
#pragma unroll
                for (int k = 0; k < 8; ++k) p += bf2f(qw[k] & 0xffff) * sn[sl * 16 + 2 * k] + bf2f(qw[k] >> 16) * sn[sl * 16 + 2 * k + 1];
                p += __shfl_xor(p, 1); p += __shfl_xor(p, 2); p += __shfl_xor(p, 4);
                if (sl == 0) sden[tl] = __expf(mprev - tab[128 + tl]) * p + (srs[tl] + srs[64 + tl]) + (srs[128 + tl] + srs[192 + tl]);
            }
#pragma unroll 1
            for (int tt = 0; tt < 4; ++tt) {
                f32x4 num[2];
#pragma unroll
                for (int et = 0; et < 2; ++et) num[et] = (f32x4){0.f, 0.f, 0.f, 0.f};
#pragma unroll
                for (int u = 0; u < 4; ++u) {
                    const s16x4 qlo = *(const LAS s16x4*)(lds + ML_QS + (16 * tt + fr) * 272 + (32 * u + 4 * fq) * 2);
                    const s16x4 qhi = *(const LAS s16x4*)(lds + ML_QS + (16 * tt + fr) * 272 + (32 * u + 16 + 4 * fq) * 2);
                    const bf16x8 qf = __builtin_shufflevector(qlo, qhi, 0, 1, 2, 3, 4, 5, 6, 7);
#pragma unroll
                    for (int et = 0; et < 2; ++et) {
                        const f32x4 c0 = C[2 * u][et], c1 = C[2 * u + 1][et];
                        u32x4 pb; pb.x = pk2(c0.x, c0.y); pb.y = pk2(c0.z, c0.w); pb.z = pk2(c1.x, c1.y); pb.w = pk2(c1.z, c1.w);
                        num[et] = MFMA16(qf, __builtin_bit_cast(bf16x8, pb), num[et]);
                    }
                }
                float scv[4];
#pragma unroll
                for (int j = 0; j < 4; ++j) scv[j] = __expf(mprev - tab[128 + 16 * tt + 4 * fq + j]);
#pragma unroll
                for (int et = 0; et < 2; ++et) { num[et].x *= scv[0]; num[et].y *= scv[1]; num[et].z *= scv[2]; num[et].w *= scv[3]; }
                const int nks = (tt < 2) ? 1 : 2;
                for (int ks = 0; ks < nks; ++ks) {
                    const bf16x8 wf = *(const LAS bf16x8*)(lds + ML_WS + (16 * tt + fr) * 144 + (ks * 32 + fq * 8) * 2);
#pragma unroll
                    for (int et = 0; et < 2; ++et) {
                        const bf16x8 vf = *(const LAS bf16x8*)(lds + ML_VT + (32 * wid + 16 * et + fr) * 144 + (ks * 32 + fq * 8) * 2);
                        num[et] = MFMA16(wf, vf, num[et]);
                    }
                }
#pragma unroll
                for (int j = 0; j < 4; ++j) {
                    const int tl = 16 * tt + 4 * fq + j;
                    const float h0 = num[0][j], h1 = num[1][j];
                    hb[tl * 264 + 32 * wid + fr] = (bf16_t)f2bf(h0);
                    hb[tl * 264 + 32 * wid + 16 + fr] = (bf16_t)f2bf(h1);
                    float s = h0 * h0 + h1 * h1;
                    s += __shfl_xor(s, 1); s += __shfl_xor(s, 2); s += __shfl_xor(s, 4); s += __shfl_xor(s, 8);
                    if (fr == 0) sssq[wid * 64 + tl] = s;
                }
            }
            const float cs = __expf(mprev - M63);
            {
#pragma unroll
                for (int dt = 0; dt < 8; ++dt)
#pragma unroll
                    for (int et = 0; et < 2; ++et) { C[dt][et].x *= cs; C[dt][et].y *= cs; C[dt][et].z *= cs; C[dt][et].w *= cs; }
#pragma unroll
                for (int ks = 0; ks < 2; ++ks) {
                    bf16x8 vf[2];
#pragma unroll
                    for (int et = 0; et < 2; ++et) vf[et] = *(const LAS bf16x8*)(lds + ML_VT + (32 * wid + 16 * et + fr) * 144 + (ks * 32 + fq * 8) * 2);
#pragma unroll
                    for (int dt = 0; dt < 8; ++dt) {
                        const bf16x8 kf = *(const LAS bf16x8*)(lds + ML_KD + (16 * dt + fr) * 144 + (ks * 32 + fq * 8) * 2);
#pragma unroll
                        for (int et = 0; et < 2; ++et) C[dt][et] = MFMA16(kf, vf[et], C[dt][et]);
                    }
                }
            }
            __syncthreads();
            {
                const int dl = tid >> 2, sl = tid & 3;
                const u32x4 ka = *(const LAS u32x4*)(lds + ML_KD + dl * 144 + sl * 32), kb = *(const LAS u32x4*)(lds + ML_KD + dl * 144 + sl * 32 + 16);
                const unsigned kw[8] = {ka.x, ka.y, ka.z, ka.w, kb.x, kb.y, kb.z, kb.w};
                float p = 0.f;
#pragma unroll
                for (int k = 0; k < 8; ++k) p += bf2f(kw[k] & 0xffff) + bf2f(kw[k] >> 16);
                p += __shfl_xor(p, 1); p += __shfl_xor(p, 2);
                if (sl == 0) sn[dl] = cs * sn[dl] + p;
            }
            {
                const int tl = tid >> 3, part = tid & 7;
                float tot = 0.f;
#pragma unroll
                for (int w = 0; w < 8; ++w) tot += sssq[w * 64 + tl];
                const float dd = 1.0f / fmaxf(fabsf(sden[tl]), __expf(-(tab[64 + tl] + tab[128 + tl])));
                const float rinv = dd / sqrtf(tot * dd * dd * (1.0f / 256.0f) + EPS);
#pragma unroll
                for (int q = 0; q < 4; ++q) {
                    const int e0 = (part + 8 * q) * 8;
                    const u32x4 hv = *(const LAS u32x4*)(lds + ML_HB + tl * 528 + e0 * 2);
                    const size_t idx = (size_t)(tok0 + tl) * D + h * 256 + e0;
                    const u32x4 ov = *(const u32x4*)(OG + idx);
                    const f32x4 g0 = *(const f32x4*)(g_head + h * 256 + e0), g1 = *(const f32x4*)(g_head + h * 256 + e0 + 4);
                    const unsigned hw[4] = {hv.x, hv.y, hv.z, hv.w}, ow[4] = {ov.x, ov.y, ov.z, ov.w};
                    const float gg[8] = {g0.x, g0.y, g0.z, g0.w, g1.x, g1.y, g1.z, g1.w};
                    unsigned r[4];
#pragma unroll
                    for (int k = 0; k < 4; ++k) {
                        const float ha = bf2f(hw[k] & 0xffff), hbv = bf2f(hw[k] >> 16), oa = bf2f(ow[k] & 0xffff), ob = bf2f(ow[k] >> 16);
                        r[k] = pk2(ha * rinv * gg[2 * k] / (1.0f + __expf(-oa)), hbv * rinv * gg[2 * k + 1] / (1.0f + __expf(-ob)));
                    }
                    *(u32x4*)(HS + idx) = (u32x4){r[0], r[1], r[2], r[3]};
                }
            }
        }
    }
}

__global__ void __launch_bounds__(NTHREADS, 2) fwd_kernel(Args args) {
    extern __shared__ __attribute__((aligned(16))) unsigned char lds_raw[];
    LAS unsigned char* lds = (LAS unsigned char*)lds_raw;
    const int tid = threadIdx.x, lane = tid & 63, wid = __builtin_amdgcn_readfirstlane(tid >> 6);
    unsigned char* ws = args.ws;
    unsigned* ctl = (unsigned*)(ws + WS_CTL);
    volatile LAS unsigned* misc = (volatile LAS unsigned*)(lds + LDS_BYTES - 64);
    if (tid < 16) misc[tid] = 0u;
    __syncthreads();
    XcdBarrier bar; bar.bar = ctl + CW_BAR; bar.x = 0; bar.st = misc;
    const int lo = args.ph_lo, hi = args.ph_hi;
    if (hi - lo > 1) bar = xcd_barrier_post(ctl + CW_BAR, misc);
#ifndef PHMASK
#define PHMASK 0x7fff
#endif
#define IN(k) (((PHMASK >> (k)) & 1) && lo <= (k) && (k) < hi)
#define SEAM(k) do { if (IN(k) && IN((k) + 1)) xcd_barrier(bar); } while (0)

#define LZ(z) int z = 0; asm volatile("" : "+s"(z))
#define INP(k) (args.in[k] + z)
#define WSP(type, off) ((type*)(ws + (off) + z))
#define ACT(type, off) ((type*)(ws + WS_ACT + (off) + z))

    if (IN(0)) {
        LZ(z);
        const float* sb_w_in = INP(4); const float* sb_w_out = INP(5); const float* ml_w_in = INP(6); const float* ml_w_out = INP(10);
        const float* moe_w1 = INP(15); const float* moe_w3 = INP(16); const float* moe_w2 = INP(17);
        bf16_t* Wsbin = WSP(bf16_t, WS_WSBIN); bf16_t* Wsbout = WSP(bf16_t, WS_WSBOUT); bf16_t* Wmlin = WSP(bf16_t, WS_WMLIN); bf16_t* Wmlout = WSP(bf16_t, WS_WMLOUT);
        bf16_t* W13 = WSP(bf16_t, WS_W13); bf16_t* W2 = WSP(bf16_t, WS_W2);
        LAS float* scr = (LAS float*)(lds + wid * 16384);
        const int gw = blockIdx.x * 8 + wid, NGW = gridDim.x * 8;
        constexpr int I_SBIN = 32 * 192, I_SBOUT = 32 * 64, I_MLIN = 32 * 192, I_MLOUT = 32 * 64, I_W1 = 64 * 32 * 8, I_W2 = 64 * 4 * 64;
        constexpr int NITEMS = I_SBIN + I_SBOUT + I_MLIN + I_MLOUT + 2 * I_W1 + I_W2;
        for (int it = gw; it < NITEMS; it += NGW) {
            int r = it;
            if (r < I_SBIN) { transpose_item(sb_w_in, 6144, Wsbin, D, 64 * (r / 192), 32 * (r % 192), 0, scr, lane); continue; } r -= I_SBIN;
            if (r < I_SBOUT) { transpose_item(sb_w_out, D, Wsbout, D, 64 * (r / 64), 32 * (r % 64), 0, scr, lane); continue; } r -= I_SBOUT;
            if (r < I_MLIN) { transpose_item(ml_w_in, ML_IN, Wmlin, D, 64 * (r / 192), 32 * (r % 192), 0, scr, lane); continue; } r -= I_MLIN;
            if (r < I_MLOUT) { transpose_item(ml_w_out, D, Wmlout, D, 64 * (r / 64), 32 * (r % 64), 0, scr, lane); continue; } r -= I_MLOUT;
            if (r < 2 * I_W1) {
                const int which = r / I_W1; r %= I_W1;
                const int le = r / 256, q = r % 256;
                transpose_item((which ? moe_w3 : moe_w1) + (size_t)le * D * FF, FF, W13 + (size_t)le * 512 * D, D, 64 * (q / 8), 32 * (q % 8), 1 + which, scr, lane); continue; }
            r -= 2 * I_W1;
            { const int le = r / 256, q = r % 256;
              transpose_item(moe_w2 + (size_t)le * FF * D, D, W2 + (size_t)le * D * FF, FF, 64 * (q / 64), 32 * (q % 64), 0, scr, lane); }
        }
        __syncthreads();
        NormP p{}; p.src = INP(0); p.H = WSP(bf16_t, WS_H); p.g = INP(1);
        norm_phase<0>(p, lds, tid, wid, lane);
    }
    SEAM(0);
    if (IN(1)) {
        LZ(z);
        bf16_t* H = WSP(bf16_t, WS_H); bf16_t* Wsbin = WSP(bf16_t, WS_WSBIN);
        Job* jobs = (Job*)((unsigned char*)lds + JOBS_LDS);
        if (tid == 0) {
            jobs[0] = Job{H, Wsbin, ACT(bf16_t, A_Q), nullptr, T, D, D, D, D, D, 0, 0.08838834764831845f};
            jobs[1] = Job{H, Wsbin + (size_t)2048 * D, ACT(bf16_t, A_K), nullptr, T, D, D, D, D, D, 0, 1.0f};
            jobs[2] = Job{Wsbin + (size_t)4096 * D, H, ACT(bf16_t, A_VT), nullptr, D, T, D, D, D, T, 0, 1.0f};
        }
        run_jobs(3, lds, tid, wid, lane);
    }
    SEAM(1);
    if (IN(2)) { LZ(z); attn_phase(ACT(bf16_t, A_Q), ACT(bf16_t, A_K), ACT(bf16_t, A_VT), ACT(bf16_t, A_O), lds, tid, wid, lane); }
    SEAM(2);
    if (IN(3)) { LZ(z); Job* jobs = (Job*)((unsigned char*)lds + JOBS_LDS); if (tid == 0) jobs[0] = Job{ACT(bf16_t, A_O), WSP(bf16_t, WS_WSBOUT), WSP(float, WS_X), INP(0), T, D, D, D, D, D, 1, 1.0f}; run_jobs(1, lds, tid, wid, lane); }
    SEAM(3);
#define MOE_PHASES(l, pb) \
    if (IN(pb)) { LZ(z); NormP p{}; p.X = WSP(float, WS_X); p.H = WSP(bf16_t, WS_H); p.g = INP(2) + (l) * D; p.wg = INP(11) + (size_t)(l) * D * 4; p.bg = INP(12) + (l) * 4; \
        p.we = INP(13) + (size_t)(l) * D * 32; p.be = INP(14) + (l) * 32; p.cnt = ctl + CW_CNT + 64 * (l) + z; p.list = ACT(unsigned, A_LIST); p.listw = ACT(float, A_LISTW); \
        norm_phase<1>(p, lds, tid, wid, lane); } \
    SEAM(pb); \
    if (IN((pb) + 1)) { LZ(z); MoeP mp{WSP(bf16_t, WS_H), WSP(bf16_t, WS_W13) + (size_t)(l) * NE * 512 * D, WSP(bf16_t, WS_W2) + (size_t)(l) * NE * D * FF, ACT(bf16_t, A_HID), ACT(bf16_t, A_Y), \
        ctl + CW_CNT + 64 * (l) + z, ACT(unsigned, A_LIST), ACT(float, A_LISTW)}; moe_gemm1(mp, lds, tid, wid, lane); } \
    SEAM((pb) + 1); \
    if (IN((pb) + 2)) { LZ(z); MoeP mp{WSP(bf16_t, WS_H), WSP(bf16_t, WS_W13) + (size_t)(l) * NE * 512 * D, WSP(bf16_t, WS_W2) + (size_t)(l) * NE * D * FF, ACT(bf16_t, A_HID), ACT(bf16_t, A_Y), \
        ctl + CW_CNT + 64 * (l) + z, ACT(unsigned, A_LIST), ACT(float, A_LISTW)}; moe_gemm2(mp, lds, tid, wid, lane); } \
    SEAM((pb) + 2);
    MOE_PHASES(0, 4)
    if (IN(7)) { LZ(z); NormP p{}; p.X = WSP(float, WS_X); p.Y = ACT(bf16_t, A_Y); p.H = WSP(bf16_t, WS_H); p.g = INP(1) + D; p.wml = INP(6) + 6144; p.G = ACT(float, A_G); norm_phase<2>(p, lds, tid, wid, lane); }
    SEAM(7);
    if (IN(8)) {
        LZ(z);
        bf16_t* H = WSP(bf16_t, WS_H); bf16_t* Wmlin = WSP(bf16_t, WS_WMLIN);
        Job* jobs = (Job*)((unsigned char*)lds + JOBS_LDS);
        if (tid == 0) {
            jobs[0] = Job{H, Wmlin, ACT(bf16_t, A_Q1), nullptr, T, 1024, D, D, D, 1024, 0, 0.08838834764831845f};
            jobs[1] = Job{H, Wmlin + (size_t)1024 * D, ACT(bf16_t, A_K1), nullptr, T, 1024, D, D, D, 1024, 0, 1.0f};
            jobs[2] = Job{H, Wmlin + (size_t)4096 * D, ACT(bf16_t, A_OG), nullptr, T, D, D, D, D, D, 0, 1.0f};
            jobs[3] = Job{Wmlin + (size_t)1024 * D, H, ACT(bf16_t, A_KT), nullptr, 1024, T, D, D, D, T, 0, 1.0f};
            jobs[4] = Job{Wmlin + (size_t)2048 * D, H, ACT(bf16_t, A_VT1), nullptr, D, T, D, D, D, T, 0, 1.0f};
        }
        run_jobs(5, lds, tid, wid, lane);
    }
    SEAM(8);
    if (IN(9)) { LZ(z); mlstm_phase(ACT(bf16_t, A_Q1), ACT(bf16_t, A_K1), ACT(bf16_t, A_KT), ACT(bf16_t, A_VT1), ACT(bf16_t, A_OG), ACT(float, A_G), INP(7), INP(8), INP(9), ACT(bf16_t, A_HS), lds, tid, wid, lane); }
    SEAM(9);
    if (IN(10)) { LZ(z); Job* jobs = (Job*)((unsigned char*)lds + JOBS_LDS); if (tid == 0) jobs[0] = Job{ACT(bf16_t, A_HS), WSP(bf16_t, WS_WMLOUT), WSP(float, WS_X), WSP(float, WS_X), T, D, D, D, D, D, 1, 1.0f}; run_jobs(1, lds, tid, wid, lane); }
    SEAM(10);
    MOE_PHASES(1, 11)
    if (IN(14)) { LZ(z); NormP p{}; p.X = WSP(float, WS_X); p.Y = ACT(bf16_t, A_Y); p.outf = args.out + z; p.g = INP(3); norm_phase<3>(p, lds, tid, wid, lane); }
#undef IN
#undef SEAM
}

extern "C" void kernel_launch(void* const* d_in, const int* in_sizes, int n_in, void* d_out, int out_size, void* d_ws, size_t ws_size, hipStream_t stream) {
    static int grid = 0;
    if (grid == 0) {
        if (n_in != 18 || out_size != T * D || ws_size < WS_END) { fprintf(stderr, "kernel_launch: unexpected shapes (n_in %d out %d ws %zu need %zu)\n", n_in, out_size, ws_size, (size_t)WS_END); grid = -1; return; }
        int dev = 0, cus = 0, per_cu = 0;
        if (hipGetDevice(&dev) != hipSuccess || hipDeviceGetAttribute(&cus, hipDeviceAttributeMultiprocessorCount, dev) != hipSuccess) { grid = -1; return; }
        if (hipFuncSetAttribute((const void*)fwd_kernel, hipFuncAttributeMaxDynamicSharedMemorySize, LDS_BYTES) != hipSuccess) { fprintf(stderr, "kernel_launch: hipFuncSetAttribute failed\n"); grid = -1; return; }
        if (hipOccupancyMaxActiveBlocksPerMultiprocessor(&per_cu, (const void*)fwd_kernel, NTHREADS, LDS_BYTES) != hipSuccess || per_cu < 1) { fprintf(stderr, "kernel_launch: occupancy query says %d\n", per_cu); per_cu = 1; }
        (void)hipGetLastError();
        grid = cus;
    }
    if (grid < 0) return;
    (void)hipMemsetAsync((char*)d_ws + WS_CTL, 0, CTL_BYTES, stream);
    Args a{};
    for (int i = 0; i < 18; ++i) a.in[i] = (const float*)d_in[i];
    a.out = (float*)d_out; a.ws = (unsigned char*)d_ws;
#if MK_MULTI
    for (int ph = 0; ph < NPHASE; ++ph) { a.ph_lo = ph; a.ph_hi = ph + 1; hipLaunchKernelGGL(fwd_kernel, dim3(grid), dim3(NTHREADS), LDS_BYTES, stream, a); }
#else
    a.ph_lo = 0; a.ph_hi = NPHASE;
    void* kargs[] = {&a};
    hipError_t e = hipLaunchCooperativeKernel((const void*)fwd_kernel, dim3(grid), dim3(NTHREADS), kargs, LDS_BYTES, stream);
    if (e != hipSuccess) fprintf(stderr, "kernel_launch: cooperative launch failed: %s\n", hipGetErrorString(e));
#endif
}
```

```cpp
#include <hip/hip_runtime.h>
#include <cstdio>
#include <cstdint>

#define GAS __attribute__((address_space(1)))
#define LAS __attribute__((address_space(3)))
#define DI __device__ __forceinline__
typedef unsigned short bf16_t;
typedef short bf16x8 __attribute__((ext_vector_type(8)));
typedef short s16x4 __attribute__((ext_vector_type(4)));
typedef float f32x4 __attribute__((ext_vector_type(4)));
typedef unsigned u32x4 __attribute__((ext_vector_type(4)));
typedef unsigned u32x2 __attribute__((ext_vector_type(2)));

#ifndef MK_MULTI
#define MK_MULTI 0
#endif

constexpr int T = 8192, D = 2048, SEQ = 2048;
constexpr int SBH = 16;
constexpr int MLH = 8, ML_IN = 6160;
constexpr int NE = 32, FF = 256;
constexpr float EPS = 1e-6f;
constexpr int NPHASE = 15;
constexpr int NTHREADS = 512;
constexpr int LDS_BYTES = 147456;

constexpr size_t MiB = 1u << 20;
constexpr size_t WS_CTL = 0, CTL_BYTES = 1 * MiB;
constexpr size_t WS_WSBIN = 1 * MiB, WS_WSBOUT = 25 * MiB, WS_WMLIN = 33 * MiB, WS_WMLOUT = 57 * MiB;
constexpr size_t WS_W13 = 65 * MiB, WS_W2 = 193 * MiB;
constexpr size_t WS_X = 257 * MiB, WS_H = 321 * MiB, WS_ACT = 353 * MiB;
constexpr size_t A_Q = 0, A_K = 32 * MiB, A_VT = 64 * MiB, A_O = 96 * MiB;
constexpr size_t A_Q1 = 0, A_K1 = 16 * MiB, A_KT = 32 * MiB, A_VT1 = 48 * MiB, A_OG = 80 * MiB, A_HS = 112 * MiB, A_G = 144 * MiB;
constexpr size_t A_HID = 0, A_LIST = 9 * MiB, A_LISTW = 10 * MiB, A_Y = 16 * MiB;
constexpr size_t WS_END = WS_ACT + 145 * MiB;
constexpr int CW_BAR = 4096;
constexpr int CW_CNT = 16384;

typedef __bf16 bf16x2_t __attribute__((ext_vector_type(2)));
typedef float f32x2 __attribute__((ext_vector_type(2)));
DI unsigned pk2(float lo, float hi) { const f32x2 v = {lo, hi}; return __builtin_bit_cast(unsigned, __builtin_convertvector(v, bf16x2_t)); }
DI unsigned f2bf(float f) { return pk2(f, 0.f) & 0xffffu; }
DI float bf2f(unsigned short b) { return __builtin_bit_cast(float, ((unsigned)b) << 16); }
DI float wave_sum(float v) {
#pragma unroll
    for (int o = 1; o < 64; o <<= 1) v += __shfl_xor(v, o);
    return v;
}
#define LDS_WAIT() asm volatile("s_waitcnt lgkmcnt(0)" ::: "memory")
#define VM_WAIT() asm volatile("s_waitcnt vmcnt(0)" ::: "memory")
#define MFMA16(a, b, c) __builtin_amdgcn_mfma_f32_16x16x32_bf16((a), (b), (c), 0, 0, 0)

#define XB_TMO      128
#define XB_XCNT(j)  (256  + 64 * (j))
#define XB_XSUB(j)  (1280 + 64 * (j))
#define XB_XGEN(j)  (2304 + 64 * (j))
#define XB_TOP      3328
#define XB_TOPGEN   3392
#define XCD_BAR_WORDS 3456
#define XB_SPIN_CAP (1u << 18)
DI unsigned xb_ld(unsigned* p)              { return __hip_atomic_load(p, __ATOMIC_RELAXED, __HIP_MEMORY_SCOPE_AGENT); }
DI unsigned xb_add(unsigned* p, unsigned v) { return __hip_atomic_fetch_add(p, v, __ATOMIC_RELAXED, __HIP_MEMORY_SCOPE_AGENT); }
DI unsigned xb_xcc_id() { return (unsigned)__builtin_amdgcn_s_getreg((3 << 11) | 20) & 0xFu; }
#define XB_SPIN(cond, bar) do { unsigned _sp = 0; while (cond) { __builtin_amdgcn_s_sleep(1); \
    if ((++_sp & 255u) == 0u) { if (xb_ld(&(bar)[XB_TMO])) break; if (_sp > XB_SPIN_CAP) { atomicAdd(&(bar)[XB_TMO], 1u); break; } } } } while (0)
struct XcdBarrier { unsigned* bar; unsigned x; volatile LAS unsigned* st; };
DI XcdBarrier xcd_barrier_post(unsigned* bar, volatile LAS unsigned* st) {
    XcdBarrier b; b.bar = bar; b.x = xb_xcc_id(); b.st = st;
    if (threadIdx.x == 0) (void)xb_add(&bar[XB_XCNT(b.x)], 1u);
    return b;
}
DI void xcd_barrier_complete(unsigned* bar, unsigned x, unsigned& nloc, unsigned& nx) {
    const unsigned G = gridDim.x * gridDim.y * gridDim.z;
    unsigned sum, cnt, mine, sp = 0u;
    for (;;) {
        sum = 0u; cnt = 0u; mine = 0u;
#pragma unroll
        for (unsigned j = 0; j < 16; ++j) { const unsigned c = xb_ld(&bar[XB_XCNT(j)]); sum += c; cnt += (c > 0u) ? 1u : 0u; mine = (j == x) ? c : mine; }
        if (sum == G) break;
        __builtin_amdgcn_s_sleep(1);
        if ((++sp & 255u) == 0u) { if (xb_ld(&bar[XB_TMO])) break; if (sp > XB_SPIN_CAP) { atomicAdd(&bar[XB_TMO], 1u); break; } }
    }
    nloc = mine > 0u ? mine : 1u; nx = cnt > 0u ? cnt : 1u;
}
DI void xcd_barrier(const XcdBarrier& b) {
    asm volatile("s_waitcnt vmcnt(0)" ::: "memory");
    __syncthreads();
    if (threadIdx.x == 0) {
        unsigned* bar = b.bar;
        __builtin_amdgcn_s_waitcnt(0);
        unsigned nloc = b.st[0], nx = b.st[1];
        if (nloc == 0u) { xcd_barrier_complete(bar, b.x, nloc, nx); b.st[0] = nloc; b.st[1] = nx; }
        const unsigned old = xb_add(&bar[XB_XSUB(b.x)], 1u);
        const unsigned gen = old / nloc;
        if (old + 1u == (gen + 1u) * nloc) {
            __builtin_amdgcn_fence(__ATOMIC_RELEASE, "agent");
            asm volatile("s_waitcnt vmcnt(0)" ::: "memory");
            const unsigned og = xb_add(&bar[XB_TOP], 1u);
            const unsigned tg = og / nx;
            if (og + 1u == (tg + 1u) * nx) xb_add(&bar[XB_TOPGEN], 1u);
            else XB_SPIN(xb_ld(&bar[XB_TOPGEN]) == tg, bar);
            __builtin_amdgcn_fence(__ATOMIC_ACQUIRE, "agent");
            xb_add(&bar[XB_XGEN(b.x)], 1u);
            asm volatile("s_waitcnt vmcnt(0)" ::: "memory");
        } else {
            XB_SPIN(xb_ld(&bar[XB_XGEN(b.x)]) == gen, bar);
            __builtin_amdgcn_fence(__ATOMIC_ACQUIRE, "agent");
            asm volatile("s_waitcnt vmcnt(0)" ::: "memory");
        }
    }
    __syncthreads();
}

struct Args {
    const float* in[18];
    float* out;
    unsigned char* ws;
    int ph_lo, ph_hi;
};

DI int perm13(int f, int which) { return (f >> 6) * 128 + ((f >> 4) & 3) * 32 + which * 16 + (f & 15); }
DI void transpose_item(const float* W, int ldw, bf16_t* WT, int ldt, int k0, int n0, int mode, LAS float* scr, int lane) {
#pragma unroll 8
    for (int i = 0; i < 32; ++i) { const int kk = 2 * i + (lane >> 5); scr[kk * 33 + (lane & 31)] = W[(size_t)(k0 + kk) * ldw + n0 + (lane & 31)]; }
    LDS_WAIT(); asm volatile("" ::: "memory");
    const int c = lane & 7;
#pragma unroll
    for (int j = 0; j < 4; ++j) {
        const int n = (lane >> 3) + 8 * j; const LAS float* s = scr + (8 * c) * 33 + n;
        u32x4 o; o.x = pk2(s[0 * 33], s[1 * 33]); o.y = pk2(s[2 * 33], s[3 * 33]); o.z = pk2(s[4 * 33], s[5 * 33]); o.w = pk2(s[6 * 33], s[7 * 33]);
        const int nn = n0 + n; const int row = (mode == 0) ? nn : perm13(nn, mode - 1);
        *(u32x4*)(WT + (size_t)row * ldt + k0 + 8 * c) = o;
    }
    LDS_WAIT(); asm volatile("" ::: "memory");
}

struct NormP {
    const float* src; float* X; const bf16_t* Y; bf16_t* H; float* outf; const float* g;
    const float* wg; const float* bg; const float* we; const float* be;
    unsigned* cnt; unsigned* list; float* listw;
    const float* wml; float* G;
};
template <int MODE>
DI void norm_phase(const NormP& p, LAS unsigned char* lds, int tid, int wid, int lane) {
    LAS float* rowbuf = (LAS float*)lds;
    LAS float* part = (LAS float*)(lds + 65536);
    LAS float* logit = (LAS float*)(lds + 65536 + 8 * 8 * 36 * 4);
    constexpr int NOUT = (MODE == 1) ? 36 : 16;
    for (int it = blockIdx.x; it < T / 8; it += gridDim.x) {
        const int row = it * 8 + wid;
        f32x4 v[8]; float ss = 0.f;
        const size_t ro = (size_t)row * D;
#pragma unroll
        for (int j = 0; j < 8; ++j) {
            const int c = 4 * lane + 256 * j;
            f32x4 x = *(const f32x4*)((MODE == 0 ? p.src : (const float*)p.X) + ro + c);
            if (MODE >= 2) {
                const u32x2 a = *(const u32x2*)(p.Y + ro + c), b = *(const u32x2*)(p.Y + (size_t)T * D + ro + c);
                x.x += bf2f(a.x & 0xffff) + bf2f(b.x & 0xffff); x.y += bf2f(a.x >> 16) + bf2f(b.x >> 16);
                x.z += bf2f(a.y & 0xffff) + bf2f(b.y & 0xffff); x.w += bf2f(a.y >> 16) + bf2f(b.y >> 16);
                if (MODE == 2) *(f32x4*)(p.X + ro + c) = x;
            }
            v[j] = x; ss += (x.x * x.x + x.y * x.y) + (x.z * x.z + x.w * x.w);
        }
        const float rstd = 1.0f / sqrtf(wave_sum(ss) * (1.0f / D) + EPS);
#pragma unroll
        for (int j = 0; j < 8; ++j) {
            const int c = 4 * lane + 256 * j;
            const f32x4 gg = *(const f32x4*)(p.g + c);
            f32x4 y; y.x = v[j].x * rstd * gg.x; y.y = v[j].y * rstd * gg.y; y.z = v[j].z * rstd * gg.z; y.w = v[j].w * rstd * gg.w;
            if (MODE == 3) *(f32x4*)(p.outf + ro + c) = y;
            else { u32x2 o; o.x = pk2(y.x, y.y); o.y = pk2(y.z, y.w); *(u32x2*)(p.H + ro + c) = o; }
            if (MODE == 1 || MODE == 2) *(LAS f32x4*)(rowbuf + wid * D + c) = y;
        }
        if (MODE == 1 || MODE == 2) {
            __syncthreads();
            const float* wp; int stride;
            if (MODE == 1) { if (lane < 4) { wp = p.wg + lane; stride = 4; } else { wp = p.we + ((lane - 4) & 31); stride = 32; } }
            else { wp = p.wml + (lane & 15); stride = ML_IN; }
            float acc[8];
#pragma unroll
            for (int r = 0; r < 8; ++r) acc[r] = 0.f;
            if (lane < NOUT) {
                for (int k4 = 0; k4 < 64; ++k4) {
                    const int k = 256 * wid + 4 * k4;
                    const float w0 = wp[(size_t)k * stride], w1 = wp[(size_t)(k + 1) * stride], w2 = wp[(size_t)(k + 2) * stride], w3 = wp[(size_t)(k + 3) * stride];
#pragma unroll
                    for (int r = 0; r < 8; ++r) {
                        const f32x4 h = *(LAS f32x4*)(rowbuf + r * D + k);
                        acc[r] += (h.x * w0 + h.y * w1) + (h.z * w2 + h.w * w3);
                    }
                }
#pragma unroll
                for (int r = 0; r < 8; ++r) part[(wid * 8 + r) * 36 + lane] = acc[r];
            }
            __syncthreads();
            if (tid < 8 * NOUT) {
                const int r = tid / NOUT, j = tid % NOUT;
                float s = 0.f;
#pragma unroll
                for (int w = 0; w < 8; ++w) s += part[(w * 8 + r) * 36 + j];
                if (MODE == 1) { s += (j < 4) ? p.bg[j] : p.be[j - 4]; logit[r * 36 + j] = s; }
                else p.G[(size_t)(it * 8 + r) * 16 + j] = s;
            }
            if (MODE == 1) {
                __syncthreads();
                if (tid < 8) {
                    const int tok = it * 8 + tid; const LAS float* lg = logit + tid * 36;
                    int gs = 0; float gm = lg[0];
#pragma unroll
                    for (int j = 1; j < 4; ++j) if (lg[j] > gm) { gm = lg[j]; gs = j; }
                    float den = 0.f;
#pragma unroll
                    for (int j = 0; j < 4; ++j) den += __expf(lg[j] - gm);
                    const float psel = 1.0f / den;
                    const LAS float* el = lg + 4 + gs * 8;
                    int i0 = 0; float v0 = el[0];
#pragma unroll
                    for (int j = 1; j < 8; ++j) if (el[j] > v0) { v0 = el[j]; i0 = j; }
                    int i1 = -1; float v1 = -3.0e38f;
#pragma unroll
                    for (int j = 0; j < 8; ++j) if (j != i0 && el[j] > v1) { v1 = el[j]; i1 = j; }
                    const float e10 = __expf(v1 - v0); const float w0 = psel / (1.0f + e10), w1 = psel * e10 / (1.0f + e10);
                    const int e0 = gs * 8 + i0, e1 = gs * 8 + i1;
                    const unsigned p0 = atomicAdd(p.cnt + e0, 1u); p.list[(size_t)e0 * T + p0] = (unsigned)tok * 2u; p.listw[(size_t)e0 * T + p0] = w0;
                    const unsigned p1 = atomicAdd(p.cnt + e1, 1u); p.list[(size_t)e1 * T + p1] = (unsigned)tok * 2u + 1u; p.listw[(size_t)e1 * T + p1] = w1;
                }
            }
            __syncthreads();
        }
    }
}

DI int lds_byte(int r, int c) { const int st = (r >> 4) * 2 + (c >> 5), rr = r & 15, cc = c & 31, ob = rr * 64 + cc * 2; return st * 1024 + (ob ^ (((ob >> 9) & 1) << 5)); }
DI void stage_rc(int b, int& R, int& C) { const int st = b / 1024, sb = b % 1024, swz = sb ^ (((sb >> 9) & 1) << 5); R = (st >> 1) * 16 + swz / 64; C = (st & 1) * 32 + (swz % 64) / 2; }

DI void gemm_tile128(LAS unsigned char* lds, const bf16_t* pa0, const bf16_t* pa1, const bf16_t* pb0, const bf16_t* pb1, int K, f32x4 (&acc)[4][2],
                     int wid, int wr, int wc, int fr, int fq) {
    const int nt = K / 64;
    const unsigned ldsw = (unsigned)wid * 1024u;
#define GT_STAGE(buf, t) do { \
        __builtin_amdgcn_global_load_lds((const GAS unsigned*)(pa0 + (t) * 64), (LAS unsigned*)(lds + (buf) * 32768 + ldsw), 16, 0, 0); \
        __builtin_amdgcn_global_load_lds((const GAS unsigned*)(pa1 + (t) * 64), (LAS unsigned*)(lds + (buf) * 32768 + 8192 + ldsw), 16, 0, 0); \
        __builtin_amdgcn_global_load_lds((const GAS unsigned*)(pb0 + (t) * 64), (LAS unsigned*)(lds + (buf) * 32768 + 16384 + ldsw), 16, 0, 0); \
        __builtin_amdgcn_global_load_lds((const GAS unsigned*)(pb1 + (t) * 64), (LAS unsigned*)(lds + (buf) * 32768 + 16384 + 8192 + ldsw), 16, 0, 0); } while (0)
#pragma unroll
    for (int m = 0; m < 4; ++m)
#pragma unroll
        for (int n = 0; n < 2; ++n) acc[m][n] = (f32x4){0.f, 0.f, 0.f, 0.f};
    const int aoff = lds_byte(wr * 64 + fr, fq * 8), boff = lds_byte(wc * 32 + fr, fq * 8);
    GT_STAGE(0, 0);
    for (int t = 0; t < nt; ++t) {
        asm volatile("s_waitcnt vmcnt(0) lgkmcnt(0)" ::: "memory");
        __builtin_amdgcn_s_barrier();
        asm volatile("" ::: "memory");
        if (t + 1 < nt) GT_STAGE((t + 1) & 1, t + 1);
        const LAS unsigned char* sa = lds + (t & 1) * 32768, * sb = sa + 16384;
        bf16x8 Af[4][2], Bf[2][2];
#pragma unroll
        for (int m = 0; m < 4; ++m)
#pragma unroll
            for (int k = 0; k < 2; ++k) Af[m][k] = *(const LAS bf16x8*)(sa + aoff + m * 2048 + k * 1024);
#pragma unroll
        for (int n = 0; n < 2; ++n)
#pragma unroll
            for (int k = 0; k < 2; ++k) Bf[n][k] = *(const LAS bf16x8*)(sb + boff + n * 2048 + k * 1024);
#pragma unroll
        for (int m = 0; m < 4; ++m)
#pragma unroll
            for (int n = 0; n < 2; ++n)
#pragma unroll
                for (int k = 0; k < 2; ++k) acc[m][n] = MFMA16(Bf[n][k], Af[m][k], acc[m][n]);
    }
    asm volatile("s_waitcnt vmcnt(0) lgkmcnt(0)" ::: "memory");
    __builtin_amdgcn_s_barrier();
    asm volatile("" ::: "memory");
#undef GT_STAGE
}

struct Job { const bf16_t* A; const bf16_t* Bt; void* out; const float* base; int M, N, K, lda, ldb, ldo, kind; float scale; };
constexpr int JOBS_LDS = 139264;
DI void run_jobs(int njobs, LAS unsigned char* lds, int tid, int wid, int lane) {
    const Job* jobs = (const Job*)((unsigned char*)lds + JOBS_LDS);
    __syncthreads();
    const int wr = wid >> 2, wc = wid & 3, fr = lane & 15, fq = lane >> 4;
    int R0, C0, R1, C1; stage_rc(tid * 16, R0, C0); stage_rc(tid * 16 + 8192, R1, C1);
    int total = 0;
    for (int j = 0; j < njobs; ++j) total += (jobs[j].M / 128) * (jobs[j].N / 128);
    for (int u = blockIdx.x; u < total; u += gridDim.x) {
        int j = 0, r = u;
        while (r >= (jobs[j].M / 128) * (jobs[j].N / 128)) { r -= (jobs[j].M / 128) * (jobs[j].N / 128); ++j; }
        const Job J = jobs[j];
        const int nN = J.N / 128, pm = r / nN, pn = r % nN;
        const bf16_t* A = J.A + (size_t)(pm * 128) * J.lda; const bf16_t* B = J.Bt + (size_t)(pn * 128) * J.ldb;
        f32x4 acc[4][2];
        gemm_tile128(lds, A + (size_t)R0 * J.lda + C0, A + (size_t)R1 * J.lda + C1, B + (size_t)R0 * J.ldb + C0, B + (size_t)R1 * J.ldb + C1, J.K, acc, wid, wr, wc, fr, fq);
#pragma unroll
        for (int m = 0; m < 4; ++m) {
            const int row = pm * 128 + wr * 64 + m * 16 + fr;
#pragma unroll
            for (int n = 0; n < 2; ++n) {
                const int col = pn * 128 + wc * 32 + n * 16 + fq * 4;
                const f32x4 a = acc[m][n];
                if (J.kind == 0) { u32x2 o; o.x = pk2(a.x * J.scale, a.y * J.scale); o.y = pk2(a.z * J.scale, a.w * J.scale); *(u32x2*)((bf16_t*)J.out + (size_t)row * J.ldo + col) = o; }
                else { const f32x4 b = *(const f32x4*)(J.base + (size_t)row * J.ldo + col); f32x4 o; o.x = a.x + b.x; o.y = a.y + b.y; o.z = a.z + b.z; o.w = a.w + b.w; *(f32x4*)((float*)J.out + (size_t)row * J.ldo + col) = o; }
            }
        }
    }
}

struct MoeP { const bf16_t* H; const bf16_t* W13; const bf16_t* W2; bf16_t* hid; bf16_t* Y; const unsigned* cnt; const unsigned* list; const float* listw; };
constexpr int MOE_LDS_CTL = 65536;
DI void moe_table(const MoeP& p, LAS unsigned char* lds, int tid) {
    LAS int* ctl = (LAS int*)(lds + MOE_LDS_CTL);
    if (tid == 0) {
        int b = 0, ts = 0;
        for (int e = 0; e < NE; ++e) { const int c = (int)__hip_atomic_load(p.cnt + e, __ATOMIC_RELAXED, __HIP_MEMORY_SCOPE_AGENT); ctl[e] = c; ctl[32 + e] = b; ctl[64 + e] = ts; b += c; ts += (c + 127) / 128; }
        ctl[64 + NE] = ts;
    }
    __syncthreads();
}
DI void moe_gemm1(const MoeP& p, LAS unsigned char* lds, int tid, int wid, int lane) {
    const int wr = wid >> 2, wc = wid & 3, fr = lane & 15, fq = lane >> 4;
    int R0, C0, R1, C1; stage_rc(tid * 16, R0, C0); stage_rc(tid * 16 + 8192, R1, C1);
    moe_table(p, lds, tid);
    const LAS int* ctl = (const LAS int*)(lds + MOE_LDS_CTL);
    const int total = ctl[64 + NE] * 4;
    for (int u = blockIdx.x; u < total; u += gridDim.x) {
        const int rt_g = u >> 2, ct = u & 3;
        int e = 0; while (e + 1 < NE && ctl[64 + e + 1] <= rt_g) ++e;
        const int rt = rt_g - ctl[64 + e], cnt = ctl[e], sbase = ctl[32 + e];
        const int ra = rt * 128 + R0, rb = rt * 128 + R1;
        const unsigned ta = p.list[(size_t)e * T + (ra < cnt ? ra : cnt - 1)] >> 1, tb = p.list[(size_t)e * T + (rb < cnt ? rb : cnt - 1)] >> 1;
        const bf16_t* B = p.W13 + ((size_t)e * 512 + ct * 128) * D;
        f32x4 acc[4][2];
        gemm_tile128(lds, p.H + (size_t)ta * D + C0, p.H + (size_t)tb * D + C1, B + (size_t)R0 * D + C0, B + (size_t)R1 * D + C1, D, acc, wid, wr, wc, fr, fq);
#pragma unroll
        for (int m = 0; m < 4; ++m) {
            const int r = rt * 128 + wr * 64 + m * 16 + fr;
            if (r < cnt) {
                const float gw = p.listw[(size_t)e * T + r];
                const f32x4 g = acc[m][0], uu = acc[m][1];
                float hv[4];
#pragma unroll
                for (int j = 0; j < 4; ++j) { const float gj = g[j]; hv[j] = gj / (1.0f + __expf(-gj)) * uu[j] * gw; }
                u32x2 o; o.x = pk2(hv[0], hv[1]); o.y = pk2(hv[2], hv[3]);
                *(u32x2*)(p.hid + (size_t)(sbase + r) * FF + ct * 64 + wc * 16 + fq * 4) = o;
            }
        }
    }
}
DI void moe_gemm2(const MoeP& p, LAS unsigned char* lds, int tid, int wid, int lane) {
    const int wr = wid >> 2, wc = wid & 3, fr = lane & 15, fq = lane >> 4;
    int R0, C0, R1, C1; stage_rc(tid * 16, R0, C0); stage_rc(tid * 16 + 8192, R1, C1);
    moe_table(p, lds, tid);
    const LAS int* ctl = (const LAS int*)(lds + MOE_LDS_CTL);
    const int total = ctl[64 + NE] * 16;
    for (int u = blockIdx.x; u < total; u += gridDim.x) {
        const int rt_g = u >> 4, ct = u & 15;
        int e = 0; while (e + 1 < NE && ctl[64 + e + 1] <= rt_g) ++e;
        const int rt = rt_g - ctl[64 + e], cnt = ctl[e], sbase = ctl[32 + e];
        const bf16_t* A = p.hid + (size_t)(sbase + rt * 128) * FF;
        const bf16_t* B = p.W2 + ((size_t)e * D + ct * 128) * FF;
        f32x4 acc[4][2];
        gemm_tile128(lds, A + (size_t)R0 * FF + C0, A + (size_t)R1 * FF + C1, B + (size_t)R0 * FF + C0, B + (size_t)R1 * FF + C1, FF, acc, wid, wr, wc, fr, fq);
#pragma unroll
        for (int m = 0; m < 4; ++m) {
            const int r = rt * 128 + wr * 64 + m * 16 + fr;
            if (r < cnt) {
                const unsigned ent = p.list[(size_t)e * T + r];
                bf16_t* yrow = p.Y + ((size_t)(ent & 1u) * T + (ent >> 1)) * D + ct * 128 + wc * 32 + fq * 4;
#pragma unroll
                for (int n = 0; n < 2; ++n) { const f32x4 a = acc[m][n]; u32x2 o; o.x = pk2(a.x, a.y); o.y = pk2(a.z, a.w); *(u32x2*)(yrow + n * 16) = o; }
            }
        }
    }
}

constexpr int AT_QS = 0, AT_KS = 34816, AT_VT = 52224, AT_SS = 70656, AT_AS = 105472;
DI void attn_phase(const bf16_t* Qb, const bf16_t* Kb, const bf16_t* Vt, bf16_t* O, LAS unsigned char* lds, int tid, int wid, int lane) {
    const int fr = lane & 15, fq = lane >> 4;
    for (int bx = blockIdx.x; bx < 1024; bx += gridDim.x) {
        const int rnd = bx >> 8, pos = bx & 255;
        const int qb = (rnd & 1) ? ((3 - rnd) * 4 + (pos >> 6)) : (15 - rnd * 4 - (pos >> 6));
        const int bh = pos & 63, b = bh >> 4, h = bh & 15;
        const int t0 = qb * 128;
#pragma unroll
        for (int c4 = 0; c4 < 4; ++c4) {
            const int c = tid + 512 * c4, row = c >> 4, c16 = c & 15;
            const u32x4 v = *(const u32x4*)(Qb + (size_t)(b * SEQ + t0 + row) * D + h * 128 + c16 * 8);
            *(LAS u32x4*)(lds + AT_QS + row * 272 + c16 * 16) = v;
        }
        f32x4 oacc[8];
#pragma unroll
        for (int n = 0; n < 8; ++n) oacc[n] = (f32x4){0.f, 0.f, 0.f, 0.f};
        float Rrun = 0.f;
        const int erow = 16 * wid + (lane >> 2), eseg = lane & 3;
        const int tq = t0 + erow;
        for (int s0 = t0 + 64; s0 >= 0; s0 -= 64) {
            __syncthreads();
#pragma unroll
            for (int c2 = 0; c2 < 2; ++c2) {
                const int c = tid + 512 * c2;
                { const int row = c >> 4, c16 = c & 15;
                  const u32x4 v = *(const u32x4*)(Kb + (size_t)(b * SEQ + s0 + row) * D + h * 128 + c16 * 8);
                  *(LAS u32x4*)(lds + AT_KS + row * 272 + c16 * 16) = v; }
                { const int row = c >> 3, c8 = c & 7;
                  const u32x4 v = *(const u32x4*)(Vt + (size_t)(h * 128 + row) * T + b * SEQ + s0 + c8 * 8);
                  *(LAS u32x4*)(lds + AT_VT + row * 144 + c8 * 16) = v; }
            }
            __syncthreads();
            f32x4 sacc[4];
#pragma unroll
            for (int n = 0; n < 4; ++n) sacc[n] = (f32x4){0.f, 0.f, 0.f, 0.f};
#pragma unroll
            for (int ks = 0; ks < 4; ++ks) {
                const bf16x8 qa = *(const LAS bf16x8*)(lds + AT_QS + (16 * wid + fr) * 272 + (ks * 32 + fq * 8) * 2);
#pragma unroll
                for (int n = 0; n < 4; ++n) {
                    const bf16x8 kb = *(const LAS bf16x8*)(lds + AT_KS + (16 * n + fr) * 272 + (ks * 32 + fq * 8) * 2);
                    sacc[n] = MFMA16(kb, qa, sacc[n]);
                }
            }
#pragma unroll
            for (int n = 0; n < 4; ++n) *(LAS f32x4*)(lds + AT_SS + (16 * wid + fr) * 272 + (16 * n + 4 * fq) * 4) = sacc[n];
            __syncthreads();
            {
                float z[16];
#pragma unroll
                for (int q4 = 0; q4 < 4; ++q4) { const f32x4 v = *(const LAS f32x4*)(lds + AT_SS + erow * 272 + (16 * eseg + 4 * q4) * 4); z[4 * q4] = v.x; z[4 * q4 + 1] = v.y; z[4 * q4 + 2] = v.z; z[4 * q4 + 3] = v.w; }
                float c[16]; float run = 0.f;
                const int sbase = s0 + 16 * eseg;
#pragma unroll
                for (int k = 15; k >= 0; --k) {
                    const bool ok = (sbase + k) < tq;
                    const float zz = z[k];
                    const float sp = fmaxf(zz, 0.f) + __logf(1.0f + __expf(-fabsf(zz)));
                    run -= ok ? sp : 0.f;
                    c[k] = run;
                }
                const int qbase = lane & ~3;
                const float t0s = __shfl(run, qbase), t1s = __shfl(run, qbase + 1), t2s = __shfl(run, qbase + 2), t3s = __shfl(run, qbase + 3);
                const float offs = Rrun + ((eseg < 1) ? t1s : 0.f) + ((eseg < 2) ? t2s : 0.f) + ((eseg < 3) ? t3s : 0.f);
                unsigned pk[8];
#pragma unroll
                for (int k = 0; k < 16; k += 2) {
                    const float a0 = ((sbase + k) < tq) ? __expf(z[k] + c[k] + offs) : 0.f;
                    const float a1 = ((sbase + k + 1) < tq) ? __expf(z[k + 1] + c[k + 1] + offs) : 0.f;
                    pk[k >> 1] = pk2(a0, a1);
                }
                Rrun += (t0s + t1s) + (t2s + t3s);
                *(LAS u32x4*)(lds + AT_AS + erow * 144 + eseg * 32) = (u32x4){pk[0], pk[1], pk[2], pk[3]};
                *(LAS u32x4*)(lds + AT_AS + erow * 144 + eseg * 32 + 16) = (u32x4){pk[4], pk[5], pk[6], pk[7]};
            }
            __syncthreads();
#pragma unroll
            for (int ks = 0; ks < 2; ++ks) {
                const bf16x8 aa = *(const LAS bf16x8*)(lds + AT_AS + (16 * wid + fr) * 144 + (ks * 32 + fq * 8) * 2);
#pragma unroll
                for (int n = 0; n < 8; ++n) {
                    const bf16x8 vb = *(const LAS bf16x8*)(lds + AT_VT + (16 * n + fr) * 144 + (ks * 32 + fq * 8) * 2);
                    oacc[n] = MFMA16(vb, aa, oacc[n]);
                }
            }
        }
        bf16_t* orow = O + (size_t)(b * SEQ + t0 + 16 * wid + fr) * D + h * 128 + 4 * fq;
#pragma unroll
        for (int n = 0; n < 8; ++n) { u32x2 o; o.x = pk2(oacc[n].x, oacc[n].y); o.y = pk2(oacc[n].z, oacc[n].w); *(u32x2*)(orow + 16 * n) = o; }
        __syncthreads();
    }
}

constexpr int ML_QS = 0, ML_KS = 17408, ML_KD = 34816, ML_VT = 53248, ML_WS = 90112, ML_HB = 99328, ML_SC = 133120;
DI float ml_tab(LAS float* tab, float gi, float gf, float mprev, int lane) {
    const float flog = fminf(gf, 0.f) - __logf(1.0f + __expf(-fabsf(gf)));
    float bb = flog;
#pragma unroll
    for (int o = 1; o < 64; o <<= 1) { const float v = __shfl_up(bb, o); if (lane >= o) bb += v; }
    const float a = gi - bb;
    float pm = a;
#pragma unroll
    for (int o = 1; o < 64; o <<= 1) { const float v = __shfl_up(pm, o); if (lane >= o) pm = fmaxf(pm, v); }
    const float amax = __shfl(pm, 63), bL = __shfl(bb, 63);
    const float Mx = fmaxf(mprev, amax);
    tab[lane] = a; tab[64 + lane] = bb; tab[128 + lane] = fmaxf(pm, mprev);
    if (lane == 0) { tab[192] = mprev; tab[193] = Mx; }
    return bL + Mx;
}
DI void mlstm_phase(const bf16_t* Q1, const bf16_t* K1, const bf16_t* KT, const bf16_t* VT, const bf16_t* OG, const float* G, const float* b_i, const float* b_f,
                    const float* g_head, bf16_t* HS, LAS unsigned char* lds, int tid, int wid, int lane) {
    const int fr = lane & 15, fq = lane >> 4;
    LAS float* sc = (LAS float*)(lds + ML_SC); LAS float* sssq = sc + 512; LAS float* srs = sc + 1024; LAS float* sden = sc + 1280; LAS float* sn = sc + 1344;
    LAS bf16_t* hb = (LAS bf16_t*)(lds + ML_HB);
    for (int unit = blockIdx.x; unit < 32; unit += gridDim.x) {
        const int b = unit >> 3, h = unit & 7;
        __syncthreads();
        float mcarry = 0.f, gi_n = 0.f, gf_n = 0.f;
        const float bi_h = b_i[h], bf_h = b_f[h];
        if (wid == 0) {
            const size_t g0 = (size_t)(b * SEQ + lane) * 16;
            mcarry = ml_tab(sc, G[g0 + h] + bi_h, G[g0 + 8 + h] + bf_h, 0.f, lane);
            gi_n = G[g0 + 64 * 16 + h] + bi_h; gf_n = G[g0 + 64 * 16 + 8 + h] + bf_h;
        }
        if (tid < 128) sn[tid] = 0.f;
        f32x4 C[8][2];
#pragma unroll
        for (int dt = 0; dt < 8; ++dt)
#pragma unroll
            for (int et = 0; et < 2; ++et) C[dt][et] = (f32x4){0.f, 0.f, 0.f, 0.f};
#pragma unroll 1
        for (int c = 0; c < 32; ++c) {
            const int tok0 = b * SEQ + c * 64;
            LAS float* tab = sc + (c & 1) * 256;
            __syncthreads();
            if (wid == 0 && c + 1 < 32) {
                mcarry = ml_tab(sc + ((c + 1) & 1) * 256, gi_n, gf_n, mcarry, lane);
                if (c + 2 < 32) { const size_t g0 = (size_t)(tok0 + 128 + lane) * 16; gi_n = G[g0 + h] + bi_h; gf_n = G[g0 + 8 + h] + bf_h; }
            }
            const float mprev = tab[192], M63 = tab[193];
#pragma unroll
            for (int c2 = 0; c2 < 2; ++c2) {
                const int ch = tid + 512 * c2;
                { const int row = ch >> 4, c16 = ch & 15;
                  *(LAS u32x4*)(lds + ML_QS + row * 272 + c16 * 16) = *(const u32x4*)(Q1 + (size_t)(tok0 + row) * 1024 + h * 128 + c16 * 8);
                  *(LAS u32x4*)(lds + ML_KS + row * 272 + c16 * 16) = *(const u32x4*)(K1 + (size_t)(tok0 + row) * 1024 + h * 128 + c16 * 8); }
                { const int row = ch >> 3, c8 = ch & 7;
                  const u32x4 v = *(const u32x4*)(KT + (size_t)(h * 128 + row) * T + tok0 + c8 * 8);
                  const unsigned w[4] = {v.x, v.y, v.z, v.w}; unsigned o[4];
#pragma unroll
                  for (int q = 0; q < 4; ++q) {
                      const int s = c8 * 8 + 2 * q;
                      const float d0 = __expf(tab[s] - M63), d1 = __expf(tab[s + 1] - M63);
                      o[q] = pk2(bf2f(w[q] & 0xffff) * d0, bf2f(w[q] >> 16) * d1);
                  }
                  *(LAS u32x4*)(lds + ML_KD + row * 144 + c8 * 16) = (u32x4){o[0], o[1], o[2], o[3]}; }
            }
#pragma unroll
            for (int c4 = 0; c4 < 4; ++c4) {
                const int ch = tid + 512 * c4, row = ch >> 3, c8 = ch & 7;
                *(LAS u32x4*)(lds + ML_VT + row * 144 + c8 * 16) = *(const u32x4*)(VT + (size_t)(h * 256 + row) * T + tok0 + c8 * 8);
            }
            __syncthreads();
            {
                const int tb = wid >> 1;
#pragma unroll
                for (int a2 = 0; a2 < 2; ++a2) {
                    const int sa_t = 2 * (wid & 1) + a2;
                    u32x2 o = (u32x2){0u, 0u}; float rsum = 0.f;
                    if (sa_t <= tb) {
                        f32x4 acc = (f32x4){0.f, 0.f, 0.f, 0.f};
#pragma unroll
                        for (int ks = 0; ks < 4; ++ks) {
                            const bf16x8 kf = *(const LAS bf16x8*)(lds + ML_KS + (16 * sa_t + fr) * 272 + (ks * 32 + fq * 8) * 2);
                            const bf16x8 qf = *(const LAS bf16x8*)(lds + ML_QS + (16 * tb + fr) * 272 + (ks * 32 + fq * 8) * 2);
                            acc = MFMA16(kf, qf, acc);
                        }
                        const int tl = 16 * tb + fr; const float Mt = tab[128 + tl];
                        float wv[4];
#pragma unroll
                        for (int j = 0; j < 4; ++j) { const int sl = 16 * sa_t + 4 * fq + j; wv[j] = (sl <= tl) ? acc[j] * __expf(tab[sl] - Mt) : 0.f; }
                        o.x = pk2(wv[0], wv[1]); o.y = pk2(wv[2], wv[3]);
                        rsum = (wv[0] + wv[1]) + (wv[2] + wv[3]);
                        rsum += __shfl_xor(rsum, 16); rsum += __shfl_xor(rsum, 32);
                    }
                    *(LAS u32x2*)(lds + ML_WS + (16 * tb + fr) * 144 + (16 * sa_t + 4 * fq) * 2) = o;
                    if (fq == 0) srs[sa_t * 64 + 16 * tb + fr] = rsum;
                }
            }
            __syncthreads();
            {
                const int tl = tid >> 3, sl = tid & 7;
                const u32x4 qa = *(const LAS u32x4*)(lds + ML_QS + tl * 272 + sl * 32), qb = *(const LAS u32x4*)(lds + ML_QS + tl * 272 + sl * 32 + 16);
                const unsigned qw[8] = {qa.x, qa.y, qa.z, qa.w, qb.x, qb.y, qb.z, qb.w};
                float p = 0.f;
#pragma unroll
                for (int k = 0; k < 8; ++k) p += bf2f(qw[k] & 0xffff) * sn[sl * 16 + 2 * k] + bf2f(qw[k] >> 16) * sn[sl * 16 + 2 * k + 1];
                p += __shfl_xor(p, 1); p += __shfl_xor(p, 2); p += __shfl_xor(p, 4);
                if (sl == 0) sden[tl] = __expf(mprev - tab[128 + tl]) * p + (srs[tl] + srs[64 + tl]) + (srs[128 + tl] + srs[192 + tl]);
            }
#pragma unroll 1
            for (int tt = 0; tt < 4; ++tt) {
                f32x4 num[2];
#pragma unroll
                for (int et = 0; et < 2; ++et) num[et] = (f32x4){0.f, 0.f, 0.f, 0.f};
#pragma unroll
                for (int u = 0; u < 4; ++u) {
                    const s16x4 qlo = *(const LAS s16x4*)(lds + ML_QS + (16 * tt + fr) * 272 + (32 * u + 4 * fq) * 2);
                    const s16x4 qhi = *(const LAS s16x4*)(lds + ML_QS + (16 * tt + fr) * 272 + (32 * u + 16 + 4 * fq) * 2);
                    const bf16x8 qf = __builtin_shufflevector(qlo, qhi, 0, 1, 2, 3, 4, 5, 6, 7);
#pragma unroll
                    for (int et = 0; et < 2; ++et) {
                        const f32x4 c0 = C[2 * u][et], c1 = C[2 * u + 1][et];
                        u32x4 pb; pb.x = pk2(c0.x, c0.y); pb.y = pk2(c0.z, c0.w); pb.z = pk2(c1.x, c1.y); pb.w = pk2(c1.z, c1.w);
                        num[et] = MFMA16(qf, __builtin_bit_cast(bf16x8, pb), num[et]);
                    }
                }
                float scv[4];
#pragma unroll
                for (int j = 0; j < 4; ++j) scv[j] = __expf(mprev - tab[128 + 16 * tt + 4 * fq + j]);
#pragma unroll
                for (int et = 0; et < 2; ++et) { num[et].x *= scv[0]; num[et].y *= scv[1]; num[et].z *= scv[2]; num[et].w *= scv[3]; }
                const int nks = (tt < 2) ? 1 : 2;
                for (int ks = 0; ks < nks; ++ks) {
                    const bf16x8 wf = *(const LAS bf16x8*)(lds + ML_WS + (16 * tt + fr) * 144 + (ks * 32 + fq * 8) * 2);
#pragma unroll
                    for (int et = 0; et < 2; ++et) {
                        const bf16x8 vf = *(const LAS bf16x8*)(lds + ML_VT + (32 * wid + 16 * et + fr) * 144 + (ks * 32 + fq * 8) * 2);
                        num[et] = MFMA16(wf, vf, num[et]);
                    }
                }
#pragma unroll
                for (int j = 0; j < 4; ++j) {
                    const int tl = 16 * tt + 4 * fq + j;
                    const float h0 = num[0][j], h1 = num[1][j];
                    hb[tl * 264 + 32 * wid + fr] = (bf16_t)f2bf(h0);
                    hb[tl * 264 + 32 * wid + 16 + fr] = (bf16_t)f2bf(h1);
                    float s = h0 * h0 + h1 * h1;
                    s += __shfl_xor(s, 1); s += __shfl_xor(s, 2); s += __shfl_xor(s, 4); s += __shfl_xor(s, 8);
                    if (fr == 0) sssq[wid * 64 + tl] = s;
                }
            }
            const float cs = __expf(mprev - M63);
            {
#pragma unroll
                for (int dt = 0; dt < 8; ++dt)
#pragma unroll
                    for (int et = 0; et < 2; ++et) { C[dt][et].x *= cs; C[dt][et].y *= cs; C[dt][et].z *= cs; C[dt][et].w *= cs; }
#pragma unroll
                for (int ks = 0; ks < 2; ++ks) {
                    bf16x8 vf[2];
#pragma unroll
                    for (int et = 0; et < 2; ++et) vf[et] = *(const LAS bf16x8*)(lds + ML_VT + (32 * wid + 16 * et + fr) * 144 + (ks * 32 + fq * 8) * 2);
#pragma unroll
                    for (int dt = 0; dt < 8; ++dt) {
                        const bf16x8 kf = *(const LAS bf16x8*)(lds + ML_KD + (16 * dt + fr) * 144 + (ks * 32 + fq * 8) * 2);
#pragma unroll
                        for (int et = 0; et < 2; ++et) C[dt][et] = MFMA16(kf, vf[et], C[dt][et]);
                    }
                }
            }
            __syncthreads();
            {
                const int dl = tid >> 2, sl = tid & 3;
                const u32x4 ka = *(const LAS u32x4*)(lds + ML_KD + dl * 144 + sl * 32), kb = *(const LAS u32x4*)(lds + ML_KD + dl * 144 + sl * 32 + 16);
                const unsigned kw[8] = {ka.x, ka.y, ka.z, ka.w, kb.x, kb.y, kb.z, kb.w};
                float p = 0.f;
#pragma unroll
                for (int k = 0; k < 8; ++k) p += bf2f(kw[k] & 0xffff) + bf2f(kw[k] >> 16);
                p += __shfl_xor(p, 1); p += __shfl_xor(p, 2);
                if (sl == 0) sn[dl] = cs * sn[dl] + p;
            }
            {
                const int tl = tid >> 3, part = tid & 7;
                float tot = 0.f;
#pragma unroll
                for (int w = 0; w < 8; ++w) tot += sssq[w * 64 + tl];
                const float dd = 1.0f / fmaxf(fabsf(sden[tl]), __expf(-(tab[64 + tl] + tab[128 + tl])));
                const float rinv = dd / sqrtf(tot * dd * dd * (1.0f / 256.0f) + EPS);
#pragma unroll
                for (int q = 0; q < 4; ++q) {
                    const int e0 = (part + 8 * q) * 8;
                    const u32x4 hv = *(const LAS u32x4*)(lds + ML_HB + tl * 528 + e0 * 2);
                    const size_t idx = (size_t)(tok0 + tl) * D + h * 256 + e0;
                    const u32x4 ov = *(const u32x4*)(OG + idx);
                    const f32x4 g0 = *(const f32x4*)(g_head + h * 256 + e0), g1 = *(const f32x4*)(g_head + h * 256 + e0 + 4);
                    const unsigned hw[4] = {hv.x, hv.y, hv.z, hv.w}, ow[4] = {ov.x, ov.y, ov.z, ov.w};
                    const float gg[8] = {g0.x, g0.y, g0.z, g0.w, g1.x, g1.y, g1.z, g1.w};
                    unsigned r[4];
#pragma unroll
                    for (int k = 0; k < 4; ++k) {
                        const float ha = bf2f(hw[k] & 0xffff), hbv = bf2f(hw[k] >> 16), oa = bf2f(ow[k] & 0xffff), ob = bf2f(ow[k] >> 16);
                        r[k] = pk2(ha * rinv * gg[2 * k] / (1.0f + __expf(-oa)), hbv * rinv * gg[2 * k + 1] / (1.0f + __expf(-ob)));
                    }
                    *(u32x4*)(HS + idx) = (u32x4){r[0], r[1], r[2], r[3]};
                }
            }
        }
    }
}

__global__ void __launch_bounds__(NTHREADS, 2) fwd_kernel(Args args) {
    extern __shared__ __attribute__((aligned(16))) unsigned char lds_raw[];
    LAS unsigned char* lds = (LAS unsigned char*)lds_raw;
    const int tid = threadIdx.x, lane = tid & 63, wid = __builtin_amdgcn_readfirstlane(tid >> 6);
    unsigned char* ws = args.ws;
    unsigned* ctl = (unsigned*)(ws + WS_CTL);
    volatile LAS unsigned* misc = (volatile LAS unsigned*)(lds + LDS_BYTES - 64);
    if (tid < 16) misc[tid] = 0u;
    __syncthreads();
    XcdBarrier bar; bar.bar = ctl + CW_BAR; bar.x = 0; bar.st = misc;
    const int lo = args.ph_lo, hi = args.ph_hi;
    if (hi - lo > 1) bar = xcd_barrier_post(ctl + CW_BAR, misc);
#ifndef PHMASK
#define PHMASK 0x7fff
#endif
#define IN(k) (((PHMASK >> (k)) & 1) && lo <= (k) && (k) < hi)
#define SEAM(k) do { if (IN(k) && IN((k) + 1)) xcd_barrier(bar); } while (0)

#define LZ(z) int z = 0; asm volatile("" : "+s"(z))
#define INP(k) (args.in[k] + z)
#define WSP(type, off) ((type*)(ws + (off) + z))
#define ACT(type, off) ((type*)(ws + WS_ACT + (off) + z))

    if (IN(0)) {
        LZ(z);
        const float* sb_w_in = INP(4); const float* sb_w_out = INP(5); const float* ml_w_in = INP(6); const float* ml_w_out = INP(10);
        const float* moe_w1 = INP(15); const float* moe_w3 = INP(16); const float* moe_w2 = INP(17);
        bf16_t* Wsbin = WSP(bf16_t, WS_WSBIN); bf16_t* Wsbout = WSP(bf16_t, WS_WSBOUT); bf16_t* Wmlin = WSP(bf16_t, WS_WMLIN); bf16_t* Wmlout = WSP(bf16_t, WS_WMLOUT);
        bf16_t* W13 = WSP(bf16_t, WS_W13); bf16_t* W2 = WSP(bf16_t, WS_W2);
        LAS float* scr = (LAS float*)(lds + wid * 16384);
        const int gw = blockIdx.x * 8 + wid, NGW = gridDim.x * 8;
        constexpr int I_SBIN = 32 * 192, I_SBOUT = 32 * 64, I_MLIN = 32 * 192, I_MLOUT = 32 * 64, I_W1 = 64 * 32 * 8, I_W2 = 64 * 4 * 64;
        constexpr int NITEMS = I_SBIN + I_SBOUT + I_MLIN + I_MLOUT + 2 * I_W1 + I_W2;
        for (int it = gw; it < NITEMS; it += NGW) {
            int r = it;
            if (r < I_SBIN) { transpose_item(sb_w_in, 6144, Wsbin, D, 64 * (r / 192), 32 * (r % 192), 0, scr, lane); continue; } r -= I_SBIN;
            if (r < I_SBOUT) { transpose_item(sb_w_out, D, Wsbout, D, 64 * (r / 64), 32 * (r % 64), 0, scr, lane); continue; } r -= I_SBOUT;
            if (r < I_MLIN) { transpose_item(ml_w_in, ML_IN, Wmlin, D, 64 * (r / 192), 32 * (r % 192), 0, scr, lane); continue; } r -= I_MLIN;
            if (r < I_MLOUT) { transpose_item(ml_w_out, D, Wmlout, D, 64 * (r / 64), 32 * (r % 64), 0, scr, lane); continue; } r -= I_MLOUT;
            if (r < 2 * I_W1) {
                const int which = r / I_W1; r %= I_W1;
                const int le = r / 256, q = r % 256;
                transpose_item((which ? moe_w3 : moe_w1) + (size_t)le * D * FF, FF, W13 + (size_t)le * 512 * D, D, 64 * (q / 8), 32 * (q % 8), 1 + which, scr, lane); continue; }
            r -= 2 * I_W1;
            { const int le = r / 256, q = r % 256;
              transpose_item(moe_w2 + (size_t)le * FF * D, D, W2 + (size_t)le * D * FF, FF, 64 * (q / 64), 32 * (q % 64), 0, scr, lane); }
        }
        __syncthreads();
        NormP p{}; p.src = INP(0); p.H = WSP(bf16_t, WS_H); p.g = INP(1);
        norm_phase<0>(p, lds, tid, wid, lane);
    }
    SEAM(0);
    if (IN(1)) {
        LZ(z);
        bf16_t* H = WSP(bf16_t, WS_H); bf16_t* Wsbin = WSP(bf16_t, WS_WSBIN);
        Job* jobs = (Job*)((unsigned char*)lds + JOBS_LDS);
        if (tid == 0) {
            jobs[0] = Job{H, Wsbin, ACT(bf16_t, A_Q), nullptr, T, D, D, D, D, D, 0, 0.08838834764831845f};
            jobs[1] = Job{H, Wsbin + (size_t)2048 * D, ACT(bf16_t, A_K), nullptr, T, D, D, D, D, D, 0, 1.0f};
            jobs[2] = Job{Wsbin + (size_t)4096 * D, H, ACT(bf16_t, A_VT), nullptr, D, T, D, D, D, T, 0, 1.0f};
        }
        run_jobs(3, lds, tid, wid, lane);
    }
    SEAM(1);
    if (IN(2)) { LZ(z); attn_phase(ACT(bf16_t, A_Q), ACT(bf16_t, A_K), ACT(bf16_t, A_VT), ACT(bf16_t, A_O), lds, tid, wid, lane); }
    SEAM(2);
    if (IN(3)) { LZ(z); Job* jobs = (Job*)((unsigned char*)lds + JOBS_LDS); if (tid == 0) jobs[0] = Job{ACT(bf16_t, A_O), WSP(bf16_t, WS_WSBOUT), WSP(float, WS_X), INP(0), T, D, D, D, D, D, 1, 1.0f}; run_jobs(1, lds, tid, wid, lane); }
    SEAM(3);
#define MOE_PHASES(l, pb) \
    if (IN(pb)) { LZ(z); NormP p{}; p.X = WSP(float, WS_X); p.H = WSP(bf16_t, WS_H); p.g = INP(2) + (l) * D; p.wg = INP(11) + (size_t)(l) * D * 4; p.bg = INP(12) + (l) * 4; \
        p.we = INP(13) + (size_t)(l) * D * 32; p.be = INP(14) + (l) * 32; p.cnt = ctl + CW_CNT + 64 * (l) + z; p.list = ACT(unsigned, A_LIST); p.listw = ACT(float, A_LISTW); \
        norm_phase<1>(p, lds, tid, wid, lane); } \
    SEAM(pb); \
    if (IN((pb) + 1)) { LZ(z); MoeP mp{WSP(bf16_t, WS_H), WSP(bf16_t, WS_W13) + (size_t)(l) * NE * 512 * D, WSP(bf16_t, WS_W2) + (size_t)(l) * NE * D * FF, ACT(bf16_t, A_HID), ACT(bf16_t, A_Y), \
        ctl + CW_CNT + 64 * (l) + z, ACT(unsigned, A_LIST), ACT(float, A_LISTW)}; moe_gemm1(mp, lds, tid, wid, lane); } \
    SEAM((pb) + 1); \
    if (IN((pb) + 2)) { LZ(z); MoeP mp{WSP(bf16_t, WS_H), WSP(bf16_t, WS_W13) + (size_t)(l) * NE * 512 * D, WSP(bf16_t, WS_W2) + (size_t)(l) * NE * D * FF, ACT(bf16_t, A_HID), ACT(bf16_t, A_Y), \
        ctl + CW_CNT + 64 * (l) + z, ACT(unsigned, A_LIST), ACT(float, A_LISTW)}; moe_gemm2(mp, lds, tid, wid, lane); } \
    SEAM((pb) + 2);
    MOE_PHASES(0, 4)
    if (IN(7)) { LZ(z); NormP p{}; p.X = WSP(float, WS_X); p.Y = ACT(bf16_t, A_Y); p.H = WSP(bf16_t, WS_H); p.g = INP(1) + D; p.wml = INP(6) + 6144; p.G = ACT(float, A_G); norm_phase<2>(p, lds, tid, wid, lane); }
    SEAM(7);
    if (IN(8)) {
        LZ(z);
        bf16_t* H = WSP(bf16_t, WS_H); bf16_t* Wmlin = WSP(bf16_t, WS_WMLIN);
        Job* jobs = (Job*)((unsigned char*)lds + JOBS_LDS);
        if (tid == 0) {
            jobs[0] = Job{H, Wmlin, ACT(bf16_t, A_Q1), nullptr, T, 1024, D, D, D, 1024, 0, 0.08838834764831845f};
            jobs[1] = Job{H, Wmlin + (size_t)1024 * D, ACT(bf16_t, A_K1), nullptr, T, 1024, D, D, D, 1024, 0, 1.0f};
            jobs[2] = Job{H, Wmlin + (size_t)4096 * D, ACT(bf16_t, A_OG), nullptr, T, D, D, D, D, D, 0, 1.0f};
            jobs[3] = Job{Wmlin + (size_t)1024 * D, H, ACT(bf16_t, A_KT), nullptr, 1024, T, D, D, D, T, 0, 1.0f};
            jobs[4] = Job{Wmlin + (size_t)2048 * D, H, ACT(bf16_t, A_VT1), nullptr, D, T, D, D, D, T, 0, 1.0f};
        }
        run_jobs(5, lds, tid, wid, lane);
    }
    SEAM(8);
    if (IN(9)) { LZ(z); mlstm_phase(ACT(bf16_t, A_Q1), ACT(bf16_t, A_K1), ACT(bf16_t, A_KT), ACT(bf16_t, A_VT1), ACT(bf16_t, A_OG), ACT(float, A_G), INP(7), INP(8), INP(9), ACT(bf16_t, A_HS), lds, tid, wid, lane); }
    SEAM(9);
    if (IN(10)) { LZ(z); Job* jobs = (Job*)((unsigned char*)lds + JOBS_LDS); if (tid == 0) jobs[0] = Job{ACT(bf16_t, A_HS), WSP(bf16_t, WS_WMLOUT), WSP(float, WS_X), WSP(float, WS_X), T, D, D, D, D, D, 1, 1.0f}; run_jobs(1, lds, tid, wid, lane); }
    SEAM(10);
    MOE_PHASES(1, 11)
    if (IN(14)) { LZ(z); NormP p{}; p.X = WSP(float, WS_X); p.Y = ACT(bf16_t, A_Y); p.outf = args.out + z; p.g = INP(3); norm_phase<3>(p, lds, tid, wid, lane); }
#undef IN
#undef SEAM
}

extern "C" void kernel_launch(void* const* d_in, const int* in_sizes, int n_in, void* d_out, int out_size, void* d_ws, size_t ws_size, hipStream_t stream) {
    static int grid = 0;
    if (grid == 0) {
        if (n_in != 18 || out_size != T * D || ws_size < WS_END) { fprintf(stderr, "kernel_launch: unexpected shapes (n_in %d out %d ws %zu need %zu)\n", n_in, out_size, ws_size, (size_t)WS_END); grid = -1; return; }
        int dev = 0, cus = 0, per_cu = 0;
        if (hipGetDevice(&dev) != hipSuccess || hipDeviceGetAttribute(&cus, hipDeviceAttributeMultiprocessorCount, dev) != hipSuccess) { grid = -1; return; }
        if (hipFuncSetAttribute((const void*)fwd_kernel, hipFuncAttributeMaxDynamicSharedMemorySize, LDS_BYTES) != hipSuccess) { fprintf(stderr, "kernel_launch: hipFuncSetAttribute failed\n"); grid = -1; return; }
        if (hipOccupancyMaxActiveBlocksPerMultiprocessor(&per_cu, (const void*)fwd_kernel, NTHREADS, LDS_BYTES) != hipSuccess || per_cu < 1) { fprintf(stderr, "kernel_launch: occupancy query says %d\n", per_cu); per_cu = 1; }
        (void)hipGetLastError();
        grid = cus;
    }
    if (grid < 0) return;
    (void)hipMemsetAsync((char*)d_ws + WS_CTL, 0, CTL_BYTES, stream);
    Args a{};
    for (int i = 0; i < 18; ++i) a.in[i] = (const float*)d_in[i];
    a.out = (float*)d_out; a.ws = (unsigned char*)d_ws;
#if MK_MULTI
    for (int ph = 0; ph < NPHASE; ++ph) { a.ph_lo = ph; a.ph_hi = ph + 1; hipLaunchKernelGGL(fwd_kernel, dim3(grid), dim3(NTHREADS), LDS_BYTES, stream, a); }
#else
    a.ph_lo = 0; a.ph_hi = NPHASE;
    void* kargs[] = {&a};
    hipError_t e = hipLaunchCooperativeKernel((const void*)fwd_kernel, dim3(grid), dim3(NTHREADS), kargs, LDS_BYTES, stream);
    if (e != hipSuccess) fprintf(stderr, "kernel_launch: cooperative launch failed: %s\n", hipGetErrorString(e));
#endif
}
```

```cpp
#include <hip/hip_runtime.h>
#include <cstdio>
#include <cstdint>

#define GAS __attribute__((address_space(1)))
#define LAS __attribute__((address_space(3)))
#define DI __device__ __forceinline__
typedef unsigned short bf16_t;
typedef short bf16x8 __attribute__((ext_vector_type(8)));
typedef short s16x4 __attribute__((ext_vector_type(4)));
typedef float f32x4 __attribute__((ext_vector_type(4)));
typedef unsigned u32x4 __attribute__((ext_vector_type(4)));
typedef unsigned u32x2 __attribute__((ext_vector_type(2)));

#ifndef MK_MULTI
#define MK_MULTI 0
#endif

constexpr int T = 8192, D = 2048, SEQ = 2048;
constexpr int SBH = 16;
constexpr int MLH = 8, ML_IN = 6160;
constexpr int NE = 32, FF = 256;
constexpr float EPS = 1e-6f;
constexpr int NPHASE = 15;
constexpr int NTHREADS = 512;
constexpr int LDS_BYTES = 147456;

constexpr size_t MiB = 1u << 20;
constexpr size_t WS_CTL = 0, CTL_BYTES = 1 * MiB;
constexpr size_t WS_WSBIN = 1 * MiB, WS_WSBOUT = 25 * MiB, WS_WMLIN = 33 * MiB, WS_WMLOUT = 57 * MiB;
constexpr size_t WS_W13 = 65 * MiB, WS_W2 = 193 * MiB;
constexpr size_t WS_X = 257 * MiB, WS_H = 321 * MiB, WS_ACT = 353 * MiB;
constexpr size_t A_Q = 0, A_K = 32 * MiB, A_VT = 64 * MiB, A_O = 96 * MiB;
constexpr size_t A_Q1 = 0, A_K1 = 16 * MiB, A_KT = 32 * MiB, A_VT1 = 48 * MiB, A_OG = 80 * MiB, A_HS = 112 * MiB, A_G = 144 * MiB;
constexpr size_t A_HID = 0, A_LIST = 9 * MiB, A_LISTW = 10 * MiB, A_Y = 16 * MiB;
constexpr size_t WS_END = WS_ACT + 145 * MiB;
constexpr int CW_BAR = 4096;
constexpr int CW_CNT = 16384;

typedef __bf16 bf16x2_t __attribute__((ext_vector_type(2)));
typedef float f32x2 __attribute__((ext_vector_type(2)));
DI unsigned pk2(float lo, float hi) { const f32x2 v = {lo, hi}; return __builtin_bit_cast(unsigned, __builtin_convertvector(v, bf16x2_t)); }
DI unsigned f2bf(float f) { return pk2(f, 0.f) & 0xffffu; }
DI float bf2f(unsigned short b) { return __builtin_bit_cast(float, ((unsigned)b) << 16); }
DI float wave_sum(float v) {
#pragma unroll
    for (int o = 1; o < 64; o <<= 1) v += __shfl_xor(v, o);
    return v;
}
#define LDS_WAIT() asm volatile("s_waitcnt lgkmcnt(0)" ::: "memory")
#define VM_WAIT() asm volatile("s_waitcnt vmcnt(0)" ::: "memory")
#define MFMA16(a, b, c) __builtin_amdgcn_mfma_f32_16x16x32_bf16((a), (b), (c), 0, 0, 0)

#define XB_TMO      128
#define XB_XCNT(j)  (256  + 64 * (j))
#define XB_XSUB(j)  (1280 + 64 * (j))
#define XB_XGEN(j)  (2304 + 64 * (j))
#define XB_TOP      3328
#define XB_TOPGEN   3392
#define XCD_BAR_WORDS 3456
#define XB_SPIN_CAP (1u << 18)
DI unsigned xb_ld(unsigned* p)              { return __hip_atomic_load(p, __ATOMIC_RELAXED, __HIP_MEMORY_SCOPE_AGENT); }
DI unsigned xb_add(unsigned* p, unsigned v) { return __hip_atomic_fetch_add(p, v, __ATOMIC_RELAXED, __HIP_MEMORY_SCOPE_AGENT); }
DI unsigned xb_xcc_id() { return (unsigned)__builtin_amdgcn_s_getreg((3 << 11) | 20) & 0xFu; }
#define XB_SPIN(cond, bar) do { unsigned _sp = 0; while (cond) { __builtin_amdgcn_s_sleep(1); \
    if ((++_sp & 255u) == 0u) { if (xb_ld(&(bar)[XB_TMO])) break; if (_sp > XB_SPIN_CAP) { atomicAdd(&(bar)[XB_TMO], 1u); break; } } } } while (0)
struct XcdBarrier { unsigned* bar; unsigned x; volatile LAS unsigned* st; };
DI XcdBarrier xcd_barrier_post(unsigned* bar, volatile LAS unsigned* st) {
    XcdBarrier b; b.bar = bar; b.x = xb_xcc_id(); b.st = st;
    if (threadIdx.x == 0) (void)xb_add(&bar[XB_XCNT(b.x)], 1u);
    return b;
}
DI void xcd_barrier_complete(unsigned* bar, unsigned x, unsigned& nloc, unsigned& nx) {
    const unsigned G = gridDim.x * gridDim.y * gridDim.z;
    unsigned sum, cnt, mine, sp = 0u;
    for (;;) {
        sum = 0u; cnt = 0u; mine = 0u;
#pragma unroll
        for (unsigned j = 0; j < 16; ++j) { const unsigned c = xb_ld(&bar[XB_XCNT(j)]); sum += c; cnt += (c > 0u) ? 1u : 0u; mine = (j == x) ? c : mine; }
        if (sum == G) break;
        __builtin_amdgcn_s_sleep(1);
        if ((++sp & 255u) == 0u) { if (xb_ld(&bar[XB_TMO])) break; if (sp > XB_SPIN_CAP) { atomicAdd(&bar[XB_TMO], 1u); break; } }
    }
    nloc = mine > 0u ? mine : 1u; nx = cnt > 0u ? cnt : 1u;
}
DI void xcd_barrier(const XcdBarrier& b) {
    asm volatile("s_waitcnt vmcnt(0)" ::: "memory");
    __syncthreads();
    if (threadIdx.x == 0) {
        unsigned* bar = b.bar;
        __builtin_amdgcn_s_waitcnt(0);
        unsigned nloc = b.st[0], nx = b.st[1];
        if (nloc == 0u) { xcd_barrier_complete(bar, b.x, nloc, nx); b.st[0] = nloc; b.st[1] = nx; }
        const unsigned old = xb_add(&bar[XB_XSUB(b.x)], 1u);
        const unsigned gen = old / nloc;
        if (old + 1u == (gen + 1u) * nloc) {
            __builtin_amdgcn_fence(__ATOMIC_RELEASE, "agent");
            asm volatile("s_waitcnt vmcnt(0)" ::: "memory");
            const unsigned og = xb_add(&bar[XB_TOP], 1u);
            const unsigned tg = og / nx;
            if (og + 1u == (tg + 1u) * nx) xb_add(&bar[XB_TOPGEN], 1u);
            else XB_SPIN(xb_ld(&bar[XB_TOPGEN]) == tg, bar);
            __builtin_amdgcn_fence(__ATOMIC_ACQUIRE, "agent");
            xb_add(&bar[XB_XGEN(b.x)], 1u);
            asm volatile("s_waitcnt vmcnt(0)" ::: "memory");
        } else {
            XB_SPIN(xb_ld(&bar[XB_XGEN(b.x)]) == gen, bar);
            __builtin_amdgcn_fence(__ATOMIC_ACQUIRE, "agent");
            asm volatile("s_waitcnt vmcnt(0)" ::: "memory");
        }
    }
    __syncthreads();
}

struct Args {
    const float* in[18];
    float* out;
    unsigned char* ws;
    int ph_lo, ph_hi;
};

DI int perm13(int f, int which) { return (f >> 6) * 128 + ((f >> 4) & 3) * 32 + which * 16 + (f & 15); }
DI void transpose_item(const float* W, int ldw, bf16_t* WT, int ldt, int k0, int n0, int mode, LAS float* scr, int lane) {
#pragma unroll 8
    for (int i = 0; i < 32; ++i) { const int kk = 2 * i + (lane >> 5); scr[kk * 33 + (lane & 31)] = W[(size_t)(k0 + kk) * ldw + n0 + (lane & 31)]; }
    LDS_WAIT(); asm volatile("" ::: "memory");
    const int c = lane & 7;
#pragma unroll
    for (int j = 0; j < 4; ++j) {
        const int n = (lane >> 3) + 8 * j; const LAS float* s = scr + (8 * c) * 33 + n;
        u32x4 o; o.x = pk2(s[0 * 33], s[1 * 33]); o.y = pk2(s[2 * 33], s[3 * 33]); o.z = pk2(s[4 * 33], s[5 * 33]); o.w = pk2(s[6 * 33], s[7 * 33]);
        const int nn = n0 + n; const int row = (mode == 0) ? nn : perm13(nn, mode - 1);
        *(u32x4*)(WT + (size_t)row * ldt + k0 + 8 * c) = o;
    }
    LDS_WAIT(); asm volatile("" ::: "memory");
}

struct NormP {
    const float* src; float* X; const bf16_t* Y; bf16_t* H; float* outf; const float* g;
    const float* wg; const float* bg; const float* we; const float* be;
    unsigned* cnt; unsigned* list; float* listw;
    const float* wml; float* G;
};
template <int MODE>
DI void norm_phase(const NormP& p, LAS unsigned char* lds, int tid, int wid, int lane) {
    LAS float* rowbuf = (LAS float*)lds;
    LAS float* part = (LAS float*)(lds + 65536);
    LAS float* logit = (LAS float*)(lds + 65536 + 8 * 8 * 36 * 4);
    constexpr int NOUT = (MODE == 1) ? 36 : 16;
    for (int it = blockIdx.x; it < T / 8; it += gridDim.x) {
        const int row = it * 8 + wid;
        f32x4 v[8]; float ss = 0.f;
        const size_t ro = (size_t)row * D;
#pragma unroll
        for (int j = 0; j < 8; ++j) {
            const int c = 4 * lane + 256 * j;
            f32x4 x = *(const f32x4*)((MODE == 0 ? p.src : (const float*)p.X) + ro + c);
            if (MODE >= 2) {
                const u32x2 a = *(const u32x2*)(p.Y + ro + c), b = *(const u32x2*)(p.Y + (size_t)T * D + ro + c);
                x.x += bf2f(a.x & 0xffff) + bf2f(b.x & 0xffff); x.y += bf2f(a.x >> 16) + bf2f(b.x >> 16);
                x.z += bf2f(a.y & 0xffff) + bf2f(b.y & 0xffff); x.w += bf2f(a.y >> 16) + bf2f(b.y >> 16);
                if (MODE == 2) *(f32x4*)(p.X + ro + c) = x;
            }
            v[j] = x; ss += (x.x * x.x + x.y * x.y) + (x.z * x.z + x.w * x.w);
        }
        const float rstd = 1.0f / sqrtf(wave_sum(ss) * (1.0f / D) + EPS);
#pragma unroll
        for (int j = 0; j < 8; ++j) {
            const int c = 4 * lane + 256 * j;
            const f32x4 gg = *(const f32x4*)(p.g + c);
            f32x4 y; y.x = v[j].x * rstd * gg.x; y.y = v[j].y * rstd * gg.y; y.z = v[j].z * rstd * gg.z; y.w = v[j].w * rstd * gg.w;
            if (MODE == 3) *(f32x4*)(p.outf + ro + c) = y;
            else { u32x2 o; o.x = pk2(y.x, y.y); o.y = pk2(y.z, y.w); *(u32x2*)(p.H + ro + c) = o; }
            if (MODE == 1 || MODE == 2) *(LAS f32x4*)(rowbuf + wid * D + c) = y;
        }
        if (MODE == 1 || MODE == 2) {
            __syncthreads();
            const float* wp; int stride;
            if (MODE == 1) { if (lane < 4) { wp = p.wg + lane; stride = 4; } else { wp = p.we + ((lane - 4) & 31); stride = 32; } }
            else { wp = p.wml + (lane & 15); stride = ML_IN; }
            float acc[8];
#pragma unroll
            for (int r = 0; r < 8; ++r) acc[r] = 0.f;
            if (lane < NOUT) {
                for (int k4 = 0; k4 < 64; ++k4) {
                    const int k = 256 * wid + 4 * k4;
                    const float w0 = wp[(size_t)k * stride], w1 = wp[(size_t)(k + 1) * stride], w2 = wp[(size_t)(k + 2) * stride], w3 = wp[(size_t)(k + 3) * stride];
#pragma unroll
                    for (int r = 0; r < 8; ++r) {
                        const f32x4 h = *(LAS f32x4*)(rowbuf + r * D + k);
                        acc[r] += (h.x * w0 + h.y * w1) + (h.z * w2 + h.w * w3);
                    }
                }
#pragma unroll
                for (int r = 0; r < 8; ++r) part[(wid * 8 + r) * 36 + lane] = acc[r];
            }
            __syncthreads();
            if (tid < 8 * NOUT) {
                const int r = tid / NOUT, j = tid % NOUT;
                float s = 0.f;
#pragma unroll
                for (int w = 0; w < 8; ++w) s += part[(w * 8 + r) * 36 + j];
                if (MODE == 1) { s += (j < 4) ? p.bg[j] : p.be[j - 4]; logit[r * 36 + j] = s; }
                else p.G[(size_t)(it * 8 + r) * 16 + j] = s;
            }
            if (MODE == 1) {
                __syncthreads();
                if (tid < 8) {
                    const int tok = it * 8 + tid; const LAS float* lg = logit + tid * 36;
                    int gs = 0; float gm = lg[0];
#pragma unroll
                    for (int j = 1; j < 4; ++j) if (lg[j] > gm) { gm = lg[j]; gs = j; }
                    float den = 0.f;
#pragma unroll
                    for (int j = 0; j < 4; ++j) den += __expf(lg[j] - gm);
                    const float psel = 1.0f / den;
                    const LAS float* el = lg + 4 + gs * 8;
                    int i0 = 0; float v0 = el[0];
#pragma unroll
                    for (int j = 1; j < 8; ++j) if (el[j] > v0) { v0 = el[j]; i0 = j; }
                    int i1 = -1; float v1 = -3.0e38f;
#pragma unroll
                    for (int j = 0; j < 8; ++j) if (j != i0 && el[j] > v1) { v1 = el[j]; i1 = j; }
                    const float e10 = __expf(v1 - v0); const float w0 = psel / (1.0f + e10), w1 = psel * e10 / (1.0f + e10);
                    const int e0 = gs * 8 + i0, e1 = gs * 8 + i1;
                    const unsigned p0 = atomicAdd(p.cnt + e0, 1u); p.list[(size_t)e0 * T + p0] = (unsigned)tok * 2u; p.listw[(size_t)e0 * T + p0] = w0;
                    const unsigned p1 = atomicAdd(p.cnt + e1, 1u); p.list[(size_t)e1 * T + p1] = (unsigned)tok * 2u + 1u; p.listw[(size_t)e1 * T + p1] = w1;
                }
            }
            __syncthreads();
        }
    }
}

DI int lds_byte(int r, int c) { const int st = (r >> 4) * 2 + (c >> 5), rr = r & 15, cc = c & 31, ob = rr * 64 + cc * 2; return st * 1024 + (ob ^ (((ob >> 9) & 1) << 5)); }
DI void stage_rc(int b, int& R, int& C) { const int st = b / 1024, sb = b % 1024, swz = sb ^ (((sb >> 9) & 1) << 5); R = (st >> 1) * 16 + swz / 64; C = (st & 1) * 32 + (swz % 64) / 2; }

DI void gemm_tile128(LAS unsigned char* lds, const bf16_t* pa0, const bf16_t* pa1, const bf16_t* pb0, const bf16_t* pb1, int K, f32x4 (&acc)[4][2],
                     int wid, int wr, int wc, int fr, int fq) {
    const int nt = K / 64;
    const unsigned ldsw = (unsigned)wid * 1024u;
#define GT_STAGE(buf, t) do { \
        __builtin_amdgcn_global_load_lds((const GAS unsigned*)(pa0 + (t) * 64), (LAS unsigned*)(lds + (buf) * 32768 + ldsw), 16, 0, 0); \
        __builtin_amdgcn_global_load_lds((const GAS unsigned*)(pa1 + (t) * 64), (LAS unsigned*)(lds + (buf) * 32768 + 8192 + ldsw), 16, 0, 0); \
        __builtin_amdgcn_global_load_lds((const GAS unsigned*)(pb0 + (t) * 64), (LAS unsigned*)(lds + (buf) * 32768 + 16384 + ldsw), 16, 0, 0); \
        __builtin_amdgcn_global_load_lds((const GAS unsigned*)(pb1 + (t) * 64), (LAS unsigned*)(lds + (buf) * 32768 + 16384 + 8192 + ldsw), 16, 0, 0); } while (0)
#pragma unroll
    for (int m = 0; m < 4; ++m)
#pragma unroll
        for (int n = 0; n < 2; ++n) acc[m][n] = (f32x4){0.f, 0.f, 0.f, 0.f};
    const int aoff = lds_byte(wr * 64 + fr, fq * 8), boff = lds_byte(wc * 32 + fr, fq * 8);
    GT_STAGE(0, 0);
    for (int t = 0; t < nt; ++t) {
        asm volatile("s_waitcnt vmcnt(0) lgkmcnt(0)" ::: "memory");
        __builtin_amdgcn_s_barrier();
        asm volatile("" ::: "memory");
        if (t + 1 < nt) GT_STAGE((t + 1) & 1, t + 1);
        const LAS unsigned char* sa = lds + (t & 1) * 32768, * sb = sa + 16384;
        bf16x8 Af[4][2], Bf[2][2];
#pragma unroll
        for (int m = 0; m < 4; ++m)
#pragma unroll
            for (int k = 0; k < 2; ++k) Af[m][k] = *(const LAS bf16x8*)(sa + aoff + m * 2048 + k * 1024);
#pragma unroll
        for (int n = 0; n < 2; ++n)
#pragma unroll
            for (int k = 0; k < 2; ++k) Bf[n][k] = *(const LAS bf16x8*)(sb + boff + n * 2048 + k * 1024);
#pragma unroll
        for (int m = 0; m < 4; ++m)
#pragma unroll
            for (int n = 0; n < 2; ++n)
#pragma unroll
                for (int k = 0; k < 2; ++k) acc[m][n] = MFMA16(Bf[n][k], Af[m][k], acc[m][n]);
    }
    asm volatile("s_waitcnt vmcnt(0) lgkmcnt(0)" ::: "memory");
    __builtin_amdgcn_s_barrier();
    asm volatile("" ::: "memory");
#undef GT_STAGE
}

struct Job { const bf16_t* A; const bf16_t* Bt; void* out; const float* base; int M, N, K, lda, ldb, ldo, kind; float scale; };
constexpr int JOBS_LDS = 139264;
DI void run_jobs(int njobs, LAS unsigned char* lds, int tid, int wid, int lane) {
    const Job* jobs = (const Job*)((unsigned char*)lds + JOBS_LDS);
    __syncthreads();
    const int wr = wid >> 2, wc = wid & 3, fr = lane & 15, fq = lane >> 4;
    int R0, C0, R1, C1; stage_rc(tid * 16, R0, C0); stage_rc(tid * 16 + 8192, R1, C1);
    int total = 0;
    for (int j = 0; j < njobs; ++j) total += (jobs[j].M / 128) * (jobs[j].N / 128);
    for (int u = blockIdx.x; u < total; u += gridDim.x) {
        int j = 0, r = u;
        while (r >= (jobs[j].M / 128) * (jobs[j].N / 128)) { r -= (jobs[j].M / 128) * (jobs[j].N / 128); ++j; }
        const Job J = jobs[j];
        const int nN = J.N / 128, pm = r / nN, pn = r % nN;
        const bf16_t* A = J.A + (size_t)(pm * 128) * J.lda; const bf16_t* B = J.Bt + (size_t)(pn * 128) * J.ldb;
        f32x4 acc[4][2];
        gemm_tile128(lds, A + (size_t)R0 * J.lda + C0, A + (size_t)R1 * J.lda + C1, B + (size_t)R0 * J.ldb + C0, B + (size_t)R1 * J.ldb + C1, J.K, acc, wid, wr, wc, fr, fq);
#pragma unroll
        for (int m = 0; m < 4; ++m) {
            const int row = pm * 128 + wr * 64 + m * 16 + fr;
#pragma unroll
            for (int n = 0; n < 2; ++n) {
                const int col = pn * 128 + wc * 32 + n * 16 + fq * 4;
                const f32x4 a = acc[m][n];
                if (J.kind == 0) { u32x2 o; o.x = pk2(a.x * J.scale, a.y * J.scale); o.y = pk2(a.z * J.scale, a.w * J.scale); *(u32x2*)((bf16_t*)J.out + (size_t)row * J.ldo + col) = o; }
                else { const f32x4 b = *(const f32x4*)(J.base + (size_t)row * J.ldo + col); f32x4 o; o.x = a.x + b.x; o.y = a.y + b.y; o.z = a.z + b.z; o.w = a.w + b.w; *(f32x4*)((float*)J.out + (size_t)row * J.ldo + col) = o; }
            }
        }
    }
}

namespace pg8 {
constexpr int BM = 256, BK = 64, HALF = 128, HTB = HALF * BK * 2, NXCD = 8, WGM = 8, KD = 2048;
DI int perm32(int rho) { const int n = rho >> 4, i = rho & 15; return 8 * (i >> 2) + 4 * n + (i & 3); }
struct Unit { int pm, pn, job; };
struct JobRec { const bf16_t* A; const bf16_t* Bt; bf16_t* o0; bf16_t* o1; int M, N, ld, split; float scale0; int pad[5]; };
constexpr int JOBS_OFF = 139264;
DI void put_job(LAS unsigned char* lds, int j, const bf16_t* A, const bf16_t* Bt, int M, int N, bf16_t* o0, bf16_t* o1, int ld, int split, float scale0) {
    LAS JobRec* r = (LAS JobRec*)(lds + JOBS_OFF) + j;
    r->A = A; r->Bt = Bt; r->o0 = o0; r->o1 = o1; r->M = M; r->N = N; r->ld = ld; r->split = split; r->scale0 = scale0;
}
struct Sched {
    const LAS JobRec* tab; int n0, n1, n2, G, c;
    DI void init(LAS unsigned char* lds, int njobs, int G_, int c_) {
        tab = (const LAS JobRec*)(lds + JOBS_OFF);
        n0 = (tab[0].M / BM) * (tab[0].N / BM); n1 = njobs > 1 ? (tab[1].M / BM) * (tab[1].N / BM) : 0; n2 = njobs > 2 ? (tab[2].M / BM) * (tab[2].N / BM) : 0; G = G_; c = c_; }
    DI bool next(int i, Unit& u) const {
        int L = i * G + c, nwg;
        if (L < n0) { u.job = 0; nwg = n0; }
        else if (L < n0 + n1) { L -= n0; u.job = 1; nwg = n1; }
        else if (L < n0 + n1 + n2) { L -= n0 + n1; u.job = 2; nwg = n2; }
        else return false;
        const int nM = tab[u.job].M / BM, nN = tab[u.job].N / BM;
        int wgid = L; { const int q = nwg / NXCD, r = nwg % NXCD, xcd = wgid % NXCD, off = wgid / NXCD; wgid = (xcd < r ? xcd * (q + 1) : r * (q + 1) + (xcd - r) * q) + off; }
        const int nig = WGM * nN, gid = wgid / nig, fm = gid * WGM, gsz = (nM - fm) < WGM ? (nM - fm) : WGM;
        u.pm = fm + ((wgid % nig) % gsz); u.pn = (wgid % nig) / gsz; return true;
    }
    DI const char* aptr(const Unit& u) const { return (const char*)tab[u.job].A + (size_t)u.pm * (2 * HALF * KD * 2); }
    DI const char* bptr(const Unit& u) const { return (const char*)tab[u.job].Bt + (size_t)u.pn * (2 * HALF * KD * 2); }
};
struct EpiBf16 {
    static constexpr bool PERM = true;
    const LAS JobRec* tab;
    DI void operator()(const f32x4 (&acc)[2][2][4][2], const Unit& u, int wr, int wc, int fr, int fq) const {
        const LAS JobRec* jr = tab + u.job;
        const int ldo = jr->ld, split = jr->split;
        float sc = jr->scale0;
        int colt = u.pn * BM; bf16_t* base = jr->o0;
        if (colt >= split) { colt -= split; base = jr->o1; sc = 1.0f; }
        const int row0 = u.pm * BM + wr * 64 + fr, col0 = colt + wc * 32 + 8 * fq;
#pragma unroll
        for (int ai = 0; ai < 2; ++ai)
#pragma unroll
            for (int m = 0; m < 4; ++m) { bf16_t* rowp = base + (size_t)(row0 + ai * HALF + m * 16) * ldo + col0;
#pragma unroll
                for (int bj = 0; bj < 2; ++bj) { const f32x4 v0 = acc[ai][bj][m][0], v1 = acc[ai][bj][m][1];
                    u32x4 w; w.x = pk2(v0.x * sc, v0.y * sc); w.y = pk2(v0.z * sc, v0.w * sc); w.z = pk2(v1.x * sc, v1.y * sc); w.w = pk2(v1.z * sc, v1.w * sc);
                    *(u32x4*)(rowp + bj * HALF) = w; } }
    }
};
struct EpiResF32 {
    static constexpr bool PERM = false;
    const float* base; float* out; int ld;
    DI void operator()(const f32x4 (&acc)[2][2][4][2], const Unit& u, int wr, int wc, int fr, int fq) const {
        const int row0 = u.pm * BM + wr * 64 + fr, col0 = u.pn * BM + wc * 32 + 4 * fq;
#pragma unroll
        for (int ai = 0; ai < 2; ++ai)
#pragma unroll
            for (int m = 0; m < 4; ++m) { const size_t ro = (size_t)(row0 + ai * HALF + m * 16) * ld + col0;
#pragma unroll
                for (int bj = 0; bj < 2; ++bj)
#pragma unroll
                    for (int n = 0; n < 2; ++n) { const f32x4 b = *(const f32x4*)(base + ro + bj * HALF + n * 16); const f32x4 a = acc[ai][bj][m][n];
                        f32x4 o; o.x = a.x + b.x; o.y = a.y + b.y; o.z = a.z + b.z; o.w = a.w + b.w; *(f32x4*)(out + ro + bj * HALF + n * 16) = o; } }
    }
};
template <class Epi>
DI void gemm_phase(LAS unsigned char* lds, const Sched& S, const Epi& E) {
    const int tid = threadIdx.x, wid = __builtin_amdgcn_readfirstlane(tid >> 6), lane = tid & 63, wr = wid >> 2, wc = wid & 3, fr = lane & 15, fq = lane >> 4;
    constexpr int K = KD, nt = K / BK;
    unsigned voffA[2], voffB[2];
#pragma unroll
    for (int i = 0; i < 2; ++i) { int R, C; stage_rc(tid * 16 + i * 8192, R, C); const int Rb = Epi::PERM ? ((R & ~31) + perm32(R & 31)) : R;
        voffA[i] = (unsigned)(R * K + C) * 2u; voffB[i] = (unsigned)(Rb * K + C) * 2u; }
    constexpr size_t kstep = (size_t)(BK * 2);
    constexpr size_t hstep = (size_t)HALF * K * 2;
    const unsigned ldsw = (unsigned)wid * 1024u;
    const int aoff = lds_byte(wr * 64 + fr, fq * 8), boff = lds_byte(wc * 32 + fr, fq * 8);
#define PG8_SA(b, h) (((b) * 2 + (h)) * HTB)
#define PG8_SB(b, h) ((4 + (b) * 2 + (h)) * HTB)
#define PG8_STAGE(bufoff, gbase, voff) do { _Pragma("unroll") for (int _i = 0; _i < 2; ++_i) \
        __builtin_amdgcn_global_load_lds((const GAS unsigned*)((const char*)(gbase) + (voff)[_i]), (LAS unsigned*)(lds + (bufoff) + ldsw + _i * 8192), 16, 0, 0); } while (0)
#define PG8_LDA(dst, b, h) do { _Pragma("unroll") for (int m = 0; m < 4; ++m) _Pragma("unroll") for (int k = 0; k < 2; ++k) dst[m][k] = *(const LAS bf16x8*)(lds + PG8_SA(b, h) + aoff + m * 2048 + k * 1024); } while (0)
#define PG8_LDB(dst, b, h) do { _Pragma("unroll") for (int n = 0; n < 2; ++n) _Pragma("unroll") for (int k = 0; k < 2; ++k) dst[n][k] = *(const LAS bf16x8*)(lds + PG8_SB(b, h) + boff + n * 2048 + k * 1024); } while (0)
#define PG8_MMA(ai, bj, At, Bt) do { __builtin_amdgcn_s_setprio(1); _Pragma("unroll") for (int m = 0; m < 4; ++m) _Pragma("unroll") for (int n = 0; n < 2; ++n) _Pragma("unroll") for (int k = 0; k < 2; ++k) \
        acc[ai][bj][m][n] = __builtin_amdgcn_mfma_f32_16x16x32_bf16(Bt[n][k], At[m][k], acc[ai][bj][m][n], 0, 0, 0); __builtin_amdgcn_s_setprio(0); } while (0)
#define PG8_WAIT_V(n) asm volatile("s_waitcnt vmcnt(" #n ")" ::: "memory")
#define PG8_WAIT_L(n) asm volatile("s_waitcnt lgkmcnt(" #n ")" ::: "memory")
#define PG8_BAR __builtin_amdgcn_s_barrier()
#define PG8_SCHED __builtin_amdgcn_sched_barrier(0)
    Unit cur, nxt; int ui = 0;
    if (!S.next(0, cur)) return;
    f32x4 acc[2][2][4][2];
#pragma unroll
    for (int a = 0; a < 2; ++a)
#pragma unroll
        for (int b = 0; b < 2; ++b)
#pragma unroll
            for (int m = 0; m < 4; ++m)
#pragma unroll
                for (int n = 0; n < 2; ++n) acc[a][b][m][n] = (f32x4){0.f, 0.f, 0.f, 0.f};
    bf16x8 At[4][2], B0[2][2], B1[2][2];
    const char* cA = S.aptr(cur); const char* cB = S.bptr(cur);
    PG8_STAGE(PG8_SB(0, 0), cB, voffB); PG8_STAGE(PG8_SA(0, 0), cA, voffA); PG8_STAGE(PG8_SB(0, 1), cB + hstep, voffB); PG8_STAGE(PG8_SA(0, 1), cA + hstep, voffA);
    if (wr == 1) PG8_BAR;
    PG8_WAIT_V(4); PG8_BAR;
    PG8_STAGE(PG8_SB(1, 0), cB + kstep, voffB); PG8_STAGE(PG8_SA(1, 0), cA + kstep, voffA); PG8_STAGE(PG8_SB(1, 1), cB + hstep + kstep, voffB);
    PG8_WAIT_V(6); PG8_BAR;
    for (;;) {
        const bool has_next = S.next(ui + 1, nxt);
        const char* nA = has_next ? S.aptr(nxt) : cA; const char* nB = has_next ? S.bptr(nxt) : cB;
        for (int t = 0; t < nt; t += 2) {
            const bool last = (t == nt - 2);
            const char* a1 = cA + (size_t)(t + 1) * kstep;
            const char* a2 = last ? nA : cA + (size_t)(t + 2) * kstep; const char* b2 = last ? nB : cB + (size_t)(t + 2) * kstep;
            const char* a3 = a2 + kstep; const char* b3 = b2 + kstep;
            PG8_LDB(B0, 0, 0); PG8_SCHED; PG8_LDA(At, 0, 0); PG8_STAGE(PG8_SA(1, 1), a1 + hstep, voffA);
            PG8_WAIT_L(8); PG8_BAR; PG8_WAIT_L(0); PG8_MMA(0, 0, At, B0); PG8_BAR; PG8_SCHED;
            PG8_LDB(B1, 0, 1); PG8_STAGE(PG8_SB(0, 0), b2, voffB);
            PG8_BAR; PG8_WAIT_L(0); PG8_MMA(0, 1, At, B1); PG8_BAR;
            PG8_LDA(At, 0, 1); PG8_STAGE(PG8_SA(0, 0), a2, voffA);
            PG8_BAR; PG8_WAIT_L(0); PG8_MMA(1, 0, At, B0); PG8_BAR; PG8_SCHED;
            PG8_STAGE(PG8_SB(0, 1), b2 + hstep, voffB);
            PG8_WAIT_V(6); PG8_BAR; PG8_MMA(1, 1, At, B1); PG8_BAR;
            PG8_LDB(B0, 1, 0); PG8_SCHED; PG8_LDA(At, 1, 0); PG8_STAGE(PG8_SA(0, 1), a2 + hstep, voffA);
            PG8_WAIT_L(8); PG8_BAR; PG8_WAIT_L(0); PG8_MMA(0, 0, At, B0); PG8_BAR; PG8_SCHED;
            PG8_LDB(B1, 1, 1); PG8_STAGE(PG8_SB(1, 0), b3, voffB);
            PG8_BAR; PG8_WAIT_L(0); PG8_MMA(0, 1, At, B1); PG8_BAR;
            PG8_LDA(At, 1, 1); PG8_STAGE(PG8_SA(1, 0), a3, voffA);
            PG8_BAR; PG8_WAIT_L(0); PG8_MMA(1, 0, At, B0); PG8_BAR; PG8_SCHED;
            PG8_STAGE(PG8_SB(1, 1), b3 + hstep, voffB);
            PG8_WAIT_V(6); PG8_BAR; PG8_MMA(1, 1, At, B1); PG8_BAR;
        }
        E(acc, cur, wr, wc, fr, fq);
        if (!has_next) break;
#pragma unroll
        for (int a = 0; a < 2; ++a)
#pragma unroll
            for (int b = 0; b < 2; ++b)
#pragma unroll
                for (int m = 0; m < 4; ++m)
#pragma unroll
                    for (int n = 0; n < 2; ++n) acc[a][b][m][n] = (f32x4){0.f, 0.f, 0.f, 0.f};
        cur = nxt; cA = nA; cB = nB; ++ui;
    }
    PG8_WAIT_V(0);
    if (wr == 0) PG8_BAR;
    PG8_BAR;
#undef PG8_SA
#undef PG8_SB
#undef PG8_STAGE
#undef PG8_LDA
#undef PG8_LDB
#undef PG8_MMA
#undef PG8_WAIT_V
#undef PG8_WAIT_L
#undef PG8_BAR
#undef PG8_SCHED
}
}

struct MoeP { const bf16_t* H; const bf16_t* W13; const bf16_t* W2; bf16_t* hid; bf16_t* Y; const unsigned* cnt; const unsigned* list; const float* listw; };
constexpr int MOE_LDS_CTL = 65536;
DI void moe_table(const MoeP& p, LAS unsigned char* lds, int tid) {
    LAS int* ctl = (LAS int*)(lds + MOE_LDS_CTL);
    if (tid == 0) {
        int b = 0, ts = 0;
        for (int e = 0; e < NE; ++e) { const int c = (int)__hip_atomic_load(p.cnt + e, __ATOMIC_RELAXED, __HIP_MEMORY_SCOPE_AGENT); ctl[e] = c; ctl[32 + e] = b; ctl[64 + e] = ts; b += c; ts += (c + 127) / 128; }
        ctl[64 + NE] = ts;
    }
    __syncthreads();
}
DI void moe_gemm1(const MoeP& p, LAS unsigned char* lds, int tid, int wid, int lane) {
    const int wr = wid >> 2, wc = wid & 3, fr = lane & 15, fq = lane >> 4;
    int R0, C0, R1, C1; stage_rc(tid * 16, R0, C0); stage_rc(tid * 16 + 8192, R1, C1);
    moe_table(p, lds, tid);
    const LAS int* ctl = (const LAS int*)(lds + MOE_LDS_CTL);
    const int total = ctl[64 + NE] * 4;
    for (int u = blockIdx.x; u < total; u += gridDim.x) {
        const int rt_g = u >> 2, ct = u & 3;
        int e = 0; while (e + 1 < NE && ctl[64 + e + 1] <= rt_g) ++e;
        const int rt = rt_g - ctl[64 + e], cnt = ctl[e], sbase = ctl[32 + e];
        const int ra = rt * 128 + R0, rb = rt * 128 + R1;
        const unsigned ta = p.list[(size_t)e * T + (ra < cnt ? ra : cnt - 1)] >> 1, tb = p.list[(size_t)e * T + (rb < cnt ? rb : cnt - 1)] >> 1;
        const bf16_t* B = p.W13 + ((size_t)e * 512 + ct * 128) * D;
        f32x4 acc[4][2];
        gemm_tile128(lds, p.H + (size_t)ta * D + C0, p.H + (size_t)tb * D + C1, B + (size_t)R0 * D + C0, B + (size_t)R1 * D + C1, D, acc, wid, wr, wc, fr, fq);
#pragma unroll
        for (int m = 0; m < 4; ++m) {
            const int r = rt * 128 + wr * 64 + m * 16 + fr;
            if (r < cnt) {
                const float gw = p.listw[(size_t)e * T + r];
                const f32x4 g = acc[m][0], uu = acc[m][1];
                float hv[4];
#pragma unroll
                for (int j = 0; j < 4; ++j) { const float gj = g[j]; hv[j] = gj / (1.0f + __expf(-gj)) * uu[j] * gw; }
                u32x2 o; o.x = pk2(hv[0], hv[1]); o.y = pk2(hv[2], hv[3]);
                *(u32x2*)(p.hid + (size_t)(sbase + r) * FF + ct * 64 + wc * 16 + fq * 4) = o;
            }
        }
    }
}
DI void moe_gemm2(const MoeP& p, LAS unsigned char* lds, int tid, int wid, int lane) {
    const int wr = wid >> 2, wc = wid & 3, fr = lane & 15, fq = lane >> 4;
    int R0, C0, R1, C1; stage_rc(tid * 16, R0, C0); stage_rc(tid * 16 + 8192, R1, C1);
    moe_table(p, lds, tid);
    const LAS int* ctl = (const LAS int*)(lds + MOE_LDS_CTL);
    const int total = ctl[64 + NE] * 16;
    for (int u = blockIdx.x; u < total; u += gridDim.x) {
        const int rt_g = u >> 4, ct = u & 15;
        int e = 0; while (e + 1 < NE && ctl[64 + e + 1] <= rt_g) ++e;
        const int rt = rt_g - ctl[64 + e], cnt = ctl[e], sbase = ctl[32 + e];
        const bf16_t* A = p.hid + (size_t)(sbase + rt * 128) * FF;
        const bf16_t* B = p.W2 + ((size_t)e * D + ct * 128) * FF;
        f32x4 acc[4][2];
        gemm_tile128(lds, A + (size_t)R0 * FF + C0, A + (size_t)R1 * FF + C1, B + (size_t)R0 * FF + C0, B + (size_t)R1 * FF + C1, FF, acc, wid, wr, wc, fr, fq);
#pragma unroll
        for (int m = 0; m < 4; ++m) {
            const int r = rt * 128 + wr * 64 + m * 16 + fr;
            if (r < cnt) {
                const unsigned ent = p.list[(size_t)e * T + r];
                bf16_t* yrow = p.Y + ((size_t)(ent & 1u) * T + (ent >> 1)) * D + ct * 128 + wc * 32 + fq * 4;
#pragma unroll
                for (int n = 0; n < 2; ++n) { const f32x4 a = acc[m][n]; u32x2 o; o.x = pk2(a.x, a.y); o.y = pk2(a.z, a.w); *(u32x2*)(yrow + n * 16) = o; }
            }
        }
    }
}

constexpr int AT_QS = 0, AT_KS = 34816, AT_VT = 52224, AT_SS = 70656, AT_AS = 105472;
DI void attn_phase(const bf16_t* Qb, const bf16_t* Kb, const bf16_t* Vt, bf16_t* O, LAS unsigned char* lds, int tid, int wid, int lane) {
    const int fr = lane & 15, fq = lane >> 4;
    for (int bx = blockIdx.x; bx < 1024; bx += gridDim.x) {
        const int rnd = bx >> 8, pos = bx & 255;
        const int qb = (rnd & 1) ? ((3 - rnd) * 4 + (pos >> 6)) : (15 - rnd * 4 - (pos >> 6));
        const int bh = pos & 63, b = bh >> 4, h = bh & 15;
        const int t0 = qb * 128;
#pragma unroll
        for (int c4 = 0; c4 < 4; ++c4) {
            const int c = tid + 512 * c4, row = c >> 4, c16 = c & 15;
            const u32x4 v = *(const u32x4*)(Qb + (size_t)(b * SEQ + t0 + row) * D + h * 128 + c16 * 8);
            *(LAS u32x4*)(lds + AT_QS + row * 272 + c16 * 16) = v;
        }
        f32x4 oacc[8];
#pragma unroll
        for (int n = 0; n < 8; ++n) oacc[n] = (f32x4){0.f, 0.f, 0.f, 0.f};
        float Rrun = 0.f;
        const int erow = 16 * wid + (lane >> 2), eseg = lane & 3;
        const int tq = t0 + erow;
        for (int s0 = t0 + 64; s0 >= 0; s0 -= 64) {
            __syncthreads();
#pragma unroll
            for (int c2 = 0; c2 < 2; ++c2) {
                const int c = tid + 512 * c2;
                { const int row = c >> 4, c16 = c & 15;
                  const u32x4 v = *(const u32x4*)(Kb + (size_t)(b * SEQ + s0 + row) * D + h * 128 + c16 * 8);
                  *(LAS u32x4*)(lds + AT_KS + row * 272 + c16 * 16) = v; }
                { const int row = c >> 3, c8 = c & 7;
                  const u32x4 v = *(const u32x4*)(Vt + (size_t)(h * 128 + row) * T + b * SEQ + s0 + c8 * 8);
                  *(LAS u32x4*)(lds + AT_VT + row * 144 + c8 * 16) = v; }
            }
            __syncthreads();
            f32x4 sacc[4];
#pragma unroll
            for (int n = 0; n < 4; ++n) sacc[n] = (f32x4){0.f, 0.f, 0.f, 0.f};
#pragma unroll
            for (int ks = 0; ks < 4; ++ks) {
                const bf16x8 qa = *(const LAS bf16x8*)(lds + AT_QS + (16 * wid + fr) * 272 + (ks * 32 + fq * 8) * 2);
#pragma unroll
                for (int n = 0; n < 4; ++n) {
                    const bf16x8 kb = *(const LAS bf16x8*)(lds + AT_KS + (16 * n + fr) * 272 + (ks * 32 + fq * 8) * 2);
                    sacc[n] = MFMA16(kb, qa, sacc[n]);
                }
            }
#pragma unroll
            for (int n = 0; n < 4; ++n) *(LAS f32x4*)(lds + AT_SS + (16 * wid + fr) * 272 + (16 * n + 4 * fq) * 4) = sacc[n];
            __syncthreads();
            {
                float z[16];
#pragma unroll
                for (int q4 = 0; q4 < 4; ++q4) { const f32x4 v = *(const LAS f32x4*)(lds + AT_SS + erow * 272 + (16 * eseg + 4 * q4) * 4); z[4 * q4] = v.x; z[4 * q4 + 1] = v.y; z[4 * q4 + 2] = v.z; z[4 * q4 + 3] = v.w; }
                float c[16]; float run = 0.f;
                const int sbase = s0 + 16 * eseg;
#pragma unroll
                for (int k = 15; k >= 0; --k) {
                    const bool ok = (sbase + k) < tq;
                    const float zz = z[k];
                    const float sp = fmaxf(zz, 0.f) + __logf(1.0f + __expf(-fabsf(zz)));
                    run -= ok ? sp : 0.f;
                    c[k] = run;
                }
                const int qbase = lane & ~3;
                const float t0s = __shfl(run, qbase), t1s = __shfl(run, qbase + 1), t2s = __shfl(run, qbase + 2), t3s = __shfl(run, qbase + 3);
                const float offs = Rrun + ((eseg < 1) ? t1s : 0.f) + ((eseg < 2) ? t2s : 0.f) + ((eseg < 3) ? t3s : 0.f);
                unsigned pk[8];
#pragma unroll
                for (int k = 0; k < 16; k += 2) {
                    const float a0 = ((sbase + k) < tq) ? __expf(z[k] + c[k] + offs) : 0.f;
                    const float a1 = ((sbase + k + 1) < tq) ? __expf(z[k + 1] + c[k + 1] + offs) : 0.f;
                    pk[k >> 1] = pk2(a0, a1);
                }
                Rrun += (t0s + t1s) + (t2s + t3s);
                *(LAS u32x4*)(lds + AT_AS + erow * 144 + eseg * 32) = (u32x4){pk[0], pk[1], pk[2], pk[3]};
                *(LAS u32x4*)(lds + AT_AS + erow * 144 + eseg * 32 + 16) = (u32x4){pk[4], pk[5], pk[6], pk[7]};
            }
            __syncthreads();
#pragma unroll
            for (int ks = 0; ks < 2; ++ks) {
                const bf16x8 aa = *(const LAS bf16x8*)(lds + AT_AS + (16 * wid + fr) * 144 + (ks * 32 + fq * 8) * 2);
#pragma unroll
                for (int n = 0; n < 8; ++n) {
                    const bf16x8 vb = *(const LAS bf16x8*)(lds + AT_VT + (16 * n + fr) * 144 + (ks * 32 + fq * 8) * 2);
                    oacc[n] = MFMA16(vb, aa, oacc[n]);
                }
            }
        }
        bf16_t* orow = O + (size_t)(b * SEQ + t0 + 16 * wid + fr) * D + h * 128 + 4 * fq;
#pragma unroll
        for (int n = 0; n < 8; ++n) { u32x2 o; o.x = pk2(oacc[n].x, oacc[n].y); o.y = pk2(oacc[n].z, oacc[n].w); *(u32x2*)(orow + 16 * n) = o; }
        __syncthreads();
    }
}

constexpr int ML_QS = 0, ML_KS = 17408, ML_KD = 34816, ML_VT = 53248, ML_WS = 90112, ML_HB = 99328, ML_SC = 133120;
DI float ml_tab(LAS float* tab, float gi, float gf, float mprev, int lane) {
    const float flog = fminf(gf, 0.f) - __logf(1.0f + __expf(-fabsf(gf)));
    float bb = flog;
#pragma unroll
    for (int o = 1; o < 64; o <<= 1) { const float v = __shfl_up(bb, o); if (lane >= o) bb += v; }
    const float a = gi - bb;
    float pm = a;
#pragma unroll
    for (int o = 1; o < 64; o <<= 1) { const float v = __shfl_up(pm, o); if (lane >= o) pm = fmaxf(pm, v); }
    const float amax = __shfl(pm, 63), bL = __shfl(bb, 63);
    const float Mx = fmaxf(mprev, amax);
    tab[lane] = a; tab[64 + lane] = bb; tab[128 + lane] = fmaxf(pm, mprev);
    if (lane == 0) { tab[192] = mprev; tab[193] = Mx; }
    return bL + Mx;
}
DI void mlstm_phase(const bf16_t* Q1, const bf16_t* K1, const bf16_t* KT, const bf16_t* VT, const bf16_t* OG, const float* G, const float* b_i, const float* b_f,
                    const float* g_head, bf16_t* HS, LAS unsigned char* lds, int tid, int wid, int lane) {
    const int fr = lane & 15, fq = lane >> 4;
    LAS float* sc = (LAS float*)(lds + ML_SC); LAS float* sssq = sc + 512; LAS float* srs = sc + 1024; LAS float* sden = sc + 1280; LAS float* sn = sc + 1344;
    LAS bf16_t* hb = (LAS bf16_t*)(lds + ML_HB);
    for (int unit = blockIdx.x; unit < 32; unit += gridDim.x) {
        const int b = unit >> 3, h = unit & 7;
        __syncthreads();
        float mcarry = 0.f, gi_n = 0.f, gf_n = 0.f;
        const float bi_h = b_i[h], bf_h = b_f[h];
        if (wid == 0) {
            const size_t g0 = (size_t)(b * SEQ + lane) * 16;
            mcarry = ml_tab(sc, G[g0 + h] + bi_h, G[g0 + 8 + h] + bf_h, 0.f, lane);
            gi_n = G[g0 + 64 * 16 + h] + bi_h; gf_n = G[g0 + 64 * 16 + 8 + h] + bf_h;
        }
        if (tid < 128) sn[tid] = 0.f;
        f32x4 C[8][2];
#pragma unroll
        for (int dt = 0; dt < 8; ++dt)
#pragma unroll
            for (int et = 0; et < 2; ++et) C[dt][et] = (f32x4){0.f, 0.f, 0.f, 0.f};
#pragma unroll 1
        for (int c = 0; c < 32; ++c) {
            const int tok0 = b * SEQ + c * 64;
            LAS float* tab = sc + (c & 1) * 256;
            __syncthreads();
            if (wid == 0 && c + 1 < 32) {
                mcarry = ml_tab(sc + ((c + 1) & 1) * 256, gi_n, gf_n, mcarry, lane);
                if (c + 2 < 32) { const size_t g0 = (size_t)(tok0 + 128 + lane) * 16; gi_n = G[g0 + h] + bi_h; gf_n = G[g0 + 8 + h] + bf_h; }
            }
            const float mprev = tab[192], M63 = tab[193];
#pragma unroll
            for (int c2 = 0; c2 < 2; ++c2) {
                const int ch = tid + 512 * c2;
                { const int row = ch >> 4, c16 = ch & 15;
                  *(LAS u32x4*)(lds + ML_QS + row * 272 + c16 * 16) = *(const u32x4*)(Q1 + (size_t)(tok0 + row) * 1024 + h * 128 + c16 * 8);
                  *(LAS u32x4*)(lds + ML_KS + row * 272 + c16 * 16) = *(const u32x4*)(K1 + (size_t)(tok0 + row) * 1024 + h * 128 + c16 * 8); }
                { const int row = ch >> 3, c8 = ch & 7;
                  const u32x4 v = *(const u32x4*)(KT + (size_t)(h * 128 + row) * T + tok0 + c8 * 8);
                  const unsigned w[4] = {v.x, v.y, v.z, v.w}; unsigned o[4];
#pragma unroll
                  for (int q = 0; q < 4; ++q) {
                      const int s = c8 * 8 + 2 * q;
                      const float d0 = __expf(tab[s] - M63), d1 = __expf(tab[s + 1] - M63);
                      o[q] = pk2(bf2f(w[q] & 0xffff) * d0, bf2f(w[q] >> 16) * d1);
                  }
                  *(LAS u32x4*)(lds + ML_KD + row * 144 + c8 * 16) = (u32x4){o[0], o[1], o[2], o[3]}; }
            }
#pragma unroll
            for (int c4 = 0; c4 < 4; ++c4) {
                const int ch = tid + 512 * c4, row = ch >> 3, c8 = ch & 7;
                *(LAS u32x4*)(lds + ML_VT + row * 144 + c8 * 16) = *(const u32x4*)(VT + (size_t)(h * 256 + row) * T + tok0 + c8 * 8);
            }
            __syncthreads();
            {
                const int tb = wid >> 1;
#pragma unroll
                for (int a2 = 0; a2 < 2; ++a2) {
                    const int sa_t = 2 * (wid & 1) + a2;
                    u32x2 o = (u32x2){0u, 0u}; float rsum = 0.f;
                    if (sa_t <= tb) {
                        f32x4 acc = (f32x4){0.f, 0.f, 0.f, 0.f};
#pragma unroll
                        for (int ks = 0; ks < 4; ++ks) {
                            const bf16x8 kf = *(const LAS bf16x8*)(lds + ML_KS + (16 * sa_t + fr) * 272 + (ks * 32 + fq * 8) * 2);
                            const bf16x8 qf = *(const LAS bf16x8*)(lds + ML_QS + (16 * tb + fr) * 272 + (ks * 32 + fq * 8) * 2);
                            acc = MFMA16(kf, qf, acc);
                        }
                        const int tl = 16 * tb + fr; const float Mt = tab[128 + tl];
                        float wv[4];
#pragma unroll
                        for (int j = 0; j < 4; ++j) { const int sl = 16 * sa_t + 4 * fq + j; wv[j] = (sl <= tl) ? acc[j] * __expf(tab[sl] - Mt) : 0.f; }
                        o.x = pk2(wv[0], wv[1]); o.y = pk2(wv[2], wv[3]);
                        rsum = (wv[0] + wv[1]) + (wv[2] + wv[3]);
                        rsum += __shfl_xor(rsum, 16); rsum += __shfl_xor(rsum, 32);
                    }
                    *(LAS u32x2*)(lds + ML_WS + (16 * tb + fr) * 144 + (16 * sa_t + 4 * fq) * 2) = o;
                    if (fq == 0) srs[sa_t * 64 + 16 * tb + fr] = rsum;
                }
            }
            __syncthreads();
            {
                const int tl = tid >> 3, sl = tid & 7;
                const u32x4 qa = *(const LAS u32x4*)(lds + ML_QS + tl * 272 + sl * 32), qb = *(const LAS u32x4*)(lds + ML_QS + tl * 272 + sl * 32 + 16);
                const unsigned qw[8] = {qa.x, qa.y, qa.z, qa.w, qb.x, qb.y, qb.z, qb.w};
                float p = 0.f;
#pragma unroll
                for (int k = 0; k < 8; ++k) p += bf2f(qw[k] & 0xffff) * sn[sl * 16 + 2 * k] + bf2f(qw[k] >> 16) * sn[sl * 16 + 2 * k + 1];
                p += __shfl_xor(p, 1); p += __shfl_xor(p, 2); p += __shfl_xor(p, 4);
                if (sl == 0) sden[tl] = __expf(mprev - tab[128 + tl]) * p + (srs[tl] + srs[64 + tl]) + (srs[128 + tl] + srs[192 + tl]);
            }
#pragma unroll 1
            for (int tt = 0; tt < 4; ++tt) {
                f32x4 num[2];
#pragma unroll
                for (int et = 0; et < 2; ++et) num[et] = (f32x4){0.f, 0.f, 0.f, 0.f};
#pragma unroll
                for (int u = 0; u < 4; ++u) {
                    const s16x4 qlo = *(const LAS s16x4*)(lds + ML_QS + (16 * tt + fr) * 272 + (32 * u + 4 * fq) * 2);
                    const s16x4 qhi = *(const LAS s16x4*)(lds + ML_QS + (16 * tt + fr) * 272 + (32 * u + 16 + 4 * fq) * 2);
                    const bf16x8 qf = __builtin_shufflevector(qlo, qhi, 0, 1, 2, 3, 4, 5, 6, 7);
#pragma unroll
                    for (int et = 0; et < 2; ++et) {
                        const f32x4 c0 = C[2 * u][et], c1 = C[2 * u + 1][et];
                        u32x4 pb; pb.x = pk2(c0.x, c0.y); pb.y = pk2(c0.z, c0.w); pb.z = pk2(c1.x, c1.y); pb.w = pk2(c1.z, c1.w);
                        num[et] = MFMA16(qf, __builtin_bit_cast(bf16x8, pb), num[et]);
                    }
                }
                float scv[4];
#pragma unroll
                for (int j = 0; j < 4; ++j) scv[j] = __expf(mprev - tab[128 + 16 * tt + 4 * fq + j]);
#pragma unroll
                for (int et = 0; et < 2; ++et) { num[et].x *= scv[0]; num[et].y *= scv[1]; num[et].z *= scv[2]; num[et].w *= scv[3]; }
                const int nks = (tt < 2) ? 1 : 2;
                for (int ks = 0; ks < nks; ++ks) {
                    const bf16x8 wf = *(const LAS bf16x8*)(lds + ML_WS + (16 * tt + fr) * 144 + (ks * 32 + fq * 8) * 2);
#pragma unroll
                    for (int et = 0; et < 2; ++et) {
                        const bf16x8 vf = *(const LAS bf16x8*)(lds + ML_VT + (32 * wid + 16 * et + fr) * 144 + (ks * 32 + fq * 8) * 2);
                        num[et] = MFMA16(wf, vf, num[et]);
                    }
                }
#pragma unroll
                for (int j = 0; j < 4; ++j) {
                    const int tl = 16 * tt + 4 * fq + j;
                    const float h0 = num[0][j], h1 = num[1][j];
                    hb[tl * 264 + 32 * wid + fr] = (bf16_t)f2bf(h0);
                    hb[tl * 264 + 32 * wid + 16 + fr] = (bf16_t)f2bf(h1);
                    float s = h0 * h0 + h1 * h1;
                    s += __shfl_xor(s, 1); s += __shfl_xor(s, 2); s += __shfl_xor(s, 4); s += __shfl_xor(s, 8);
                    if (fr == 0) sssq[wid * 64 + tl] = s;
                }
            }
            const float cs = __expf(mprev - M63);
            {
#pragma unroll
                for (int dt = 0; dt < 8; ++dt)
#pragma unroll
                    for (int et = 0; et < 2; ++et) { C[dt][et].x *= cs; C[dt][et].y *= cs; C[dt][et].z *= cs; C[dt][et].w *= cs; }
#pragma unroll
                for (int ks = 0; ks < 2; ++ks) {
                    bf16x8 vf[2];
#pragma unroll
                    for (int et = 0; et < 2; ++et) vf[et] = *(const LAS bf16x8*)(lds + ML_VT + (32 * wid + 16 * et + fr) * 144 + (ks * 32 + fq * 8) * 2);
#pragma unroll
                    for (int dt = 0; dt < 8; ++dt) {
                        const bf16x8 kf = *(const LAS bf16x8*)(lds + ML_KD + (16 * dt + fr) * 144 + (ks * 32 + fq * 8) * 2);
#pragma unroll
                        for (int et = 0; et < 2; ++et) C[dt][et] = MFMA16(kf, vf[et], C[dt][et]);
                    }
                }
            }
            __syncthreads();
            {
                const int dl = tid >> 2, sl = tid & 3;
                const u32x4 ka = *(const LAS u32x4*)(lds + ML_KD + dl * 144 + sl * 32), kb = *(const LAS u32x4*)(lds + ML_KD + dl * 144 + sl * 32 + 16);
                const unsigned kw[8] = {ka.x, ka.y, ka.z, ka.w, kb.x, kb.y, kb.z, kb.w};
                float p = 0.f;
#pragma unroll
                for (int k = 0; k < 8; ++k) p += bf2f(kw[k] & 0xffff) + bf2f(kw[k] >> 16);
                p += __shfl_xor(p, 1); p += __shfl_xor(p, 2);
                if (sl == 0) sn[dl] = cs * sn[dl] + p;
            }
            {
                const int tl = tid >> 3, part = tid & 7;
                float tot = 0.f;
#pragma unroll
                for (int w = 0; w < 8; ++w) tot += sssq[w * 64 + tl];
                const float dd = 1.0f / fmaxf(fabsf(sden[tl]), __expf(-(tab[64 + tl] + tab[128 + tl])));
                const float rinv = dd / sqrtf(tot * dd * dd * (1.0f / 256.0f) + EPS);
#pragma unroll
                for (int q = 0; q < 4; ++q) {
                    const int e0 = (part + 8 * q) * 8;
                    const u32x4 hv = *(const LAS u32x4*)(lds + ML_HB + tl * 528 + e0 * 2);
                    const size_t idx = (size_t)(tok0 + tl) * D + h * 256 + e0;
                    const u32x4 ov = *(const u32x4*)(OG + idx);
                    const f32x4 g0 = *(const f32x4*)(g_head + h * 256 + e0), g1 = *(const f32x4*)(g_head + h * 256 + e0 + 4);
                    const unsigned hw[4] = {hv.x, hv.y, hv.z, hv.w}, ow[4] = {ov.x, ov.y, ov.z, ov.w};
                    const float gg[8] = {g0.x, g0.y, g0.z, g0.w, g1.x, g1.y, g1.z, g1.w};
                    unsigned r[4];
#pragma unroll
                    for (int k = 0; k < 4; ++k) {
                        const float ha = bf2f(hw[k] & 0xffff), hbv = bf2f(hw[k] >> 16), oa = bf2f(ow[k] & 0xffff), ob = bf2f(ow[k] >> 16);
                        r[k] = pk2(ha * rinv * gg[2 * k] / (1.0f + __expf(-oa)), hbv * rinv * gg[2 * k + 1] / (1.0f + __expf(-ob)));
                    }
                    *(u32x4*)(HS + idx) = (u32x4){r[0], r[1], r[2], r[3]};
                }
            }
        }
    }
}

__global__ void __launch_bounds__(NTHREADS, 2) fwd_kernel(Args args) {
    extern __shared__ __attribute__((aligned(16))) unsigned char lds_raw[];
    LAS unsigned char* lds = (LAS unsigned char*)lds_raw;
    const int tid = threadIdx.x, lane = tid & 63, wid = __builtin_amdgcn_readfirstlane(tid >> 6);
    unsigned char* ws = args.ws;
    unsigned* ctl = (unsigned*)(ws + WS_CTL);
    volatile LAS unsigned* misc = (volatile LAS unsigned*)(lds + LDS_BYTES - 64);
    if (tid < 16) misc[tid] = 0u;
    __syncthreads();
    XcdBarrier bar; bar.bar = ctl + CW_BAR; bar.x = 0; bar.st = misc;
    const int lo = args.ph_lo, hi = args.ph_hi;
    if (hi - lo > 1) bar = xcd_barrier_post(ctl + CW_BAR, misc);
#ifndef PHMASK
#define PHMASK 0x7fff
#endif
#define IN(k) (((PHMASK >> (k)) & 1) && lo <= (k) && (k) < hi)
#define SEAM(k) do { if (IN(k) && IN((k) + 1)) xcd_barrier(bar); } while (0)

#define LZ(z) int z = 0; asm volatile("" : "+s"(z))
#define INP(k) (args.in[k] + z)
#define WSP(type, off) ((type*)(ws + (off) + z))
#define ACT(type, off) ((type*)(ws + WS_ACT + (off) + z))

    if (IN(0)) {
        LZ(z);
        const float* sb_w_in = INP(4); const float* sb_w_out = INP(5); const float* ml_w_in = INP(6); const float* ml_w_out = INP(10);
        const float* moe_w1 = INP(15); const float* moe_w3 = INP(16); const float* moe_w2 = INP(17);
        bf16_t* Wsbin = WSP(bf16_t, WS_WSBIN); bf16_t* Wsbout = WSP(bf16_t, WS_WSBOUT); bf16_t* Wmlin = WSP(bf16_t, WS_WMLIN); bf16_t* Wmlout = WSP(bf16_t, WS_WMLOUT);
        bf16_t* W13 = WSP(bf16_t, WS_W13); bf16_t* W2 = WSP(bf16_t, WS_W2);
        LAS float* scr = (LAS float*)(lds + wid * 16384);
        const int gw = blockIdx.x * 8 + wid, NGW = gridDim.x * 8;
        constexpr int I_SBIN = 32 * 192, I_SBOUT = 32 * 64, I_MLIN = 32 * 192, I_MLOUT = 32 * 64, I_W1 = 64 * 32 * 8, I_W2 = 64 * 4 * 64;
        constexpr int NITEMS = I_SBIN + I_SBOUT + I_MLIN + I_MLOUT + 2 * I_W1 + I_W2;
        for (int it = gw; it < NITEMS; it += NGW) {
            int r = it;
            if (r < I_SBIN) { transpose_item(sb_w_in, 6144, Wsbin, D, 64 * (r / 192), 32 * (r % 192), 0, scr, lane); continue; } r -= I_SBIN;
            if (r < I_SBOUT) { transpose_item(sb_w_out, D, Wsbout, D, 64 * (r / 64), 32 * (r % 64), 0, scr, lane); continue; } r -= I_SBOUT;
            if (r < I_MLIN) { transpose_item(ml_w_in, ML_IN, Wmlin, D, 64 * (r / 192), 32 * (r % 192), 0, scr, lane); continue; } r -= I_MLIN;
            if (r < I_MLOUT) { transpose_item(ml_w_out, D, Wmlout, D, 64 * (r / 64), 32 * (r % 64), 0, scr, lane); continue; } r -= I_MLOUT;
            if (r < 2 * I_W1) {
                const int which = r / I_W1; r %= I_W1;
                const int le = r / 256, q = r % 256;
                transpose_item((which ? moe_w3 : moe_w1) + (size_t)le * D * FF, FF, W13 + (size_t)le * 512 * D, D, 64 * (q / 8), 32 * (q % 8), 1 + which, scr, lane); continue; }
            r -= 2 * I_W1;
            { const int le = r / 256, q = r % 256;
              transpose_item(moe_w2 + (size_t)le * FF * D, D, W2 + (size_t)le * D * FF, FF, 64 * (q / 64), 32 * (q % 64), 0, scr, lane); }
        }
        __syncthreads();
        NormP p{}; p.src = INP(0); p.H = WSP(bf16_t, WS_H); p.g = INP(1);
        norm_phase<0>(p, lds, tid, wid, lane);
    }
    SEAM(0);
    if (IN(1)) {
        LZ(z);
        bf16_t* H = WSP(bf16_t, WS_H); bf16_t* Wsbin = WSP(bf16_t, WS_WSBIN);
        if (tid == 0) {
            pg8::put_job(lds, 0, H, Wsbin, T, 4096, ACT(bf16_t, A_Q), ACT(bf16_t, A_K), D, 2048, 0.08838834764831845f);
            pg8::put_job(lds, 1, Wsbin + (size_t)4096 * D, H, D, T, ACT(bf16_t, A_VT), ACT(bf16_t, A_VT), T, 1 << 30, 1.0f);
        }
        __syncthreads();
        pg8::Sched S; S.init(lds, 2, gridDim.x, blockIdx.x);
        pg8::EpiBf16 E{S.tab};
        pg8::gemm_phase(lds, S, E);
    }
    SEAM(1);
    if (IN(2)) { LZ(z); attn_phase(ACT(bf16_t, A_Q), ACT(bf16_t, A_K), ACT(bf16_t, A_VT), ACT(bf16_t, A_O), lds, tid, wid, lane); }
    SEAM(2);
    if (IN(3)) { LZ(z);
        if (tid == 0) pg8::put_job(lds, 0, ACT(bf16_t, A_O), WSP(bf16_t, WS_WSBOUT), T, D, nullptr, nullptr, D, 0, 1.0f);
        __syncthreads();
        pg8::Sched S; S.init(lds, 1, gridDim.x, blockIdx.x);
        pg8::EpiResF32 E{INP(0), WSP(float, WS_X), D}; pg8::gemm_phase(lds, S, E); }
    SEAM(3);
#define MOE_PHASES(l, pb) \
    if (IN(pb)) { LZ(z); NormP p{}; p.X = WSP(float, WS_X); p.H = WSP(bf16_t, WS_H); p.g = INP(2) + (l) * D; p.wg = INP(11) + (size_t)(l) * D * 4; p.bg = INP(12) + (l) * 4; \
        p.we = INP(13) + (size_t)(l) * D * 32; p.be = INP(14) + (l) * 32; p.cnt = ctl + CW_CNT + 64 * (l) + z; p.list = ACT(unsigned, A_LIST); p.listw = ACT(float, A_LISTW); \
        norm_phase<1>(p, lds, tid, wid, lane); } \
    SEAM(pb); \
    if (IN((pb) + 1)) { LZ(z); MoeP mp{WSP(bf16_t, WS_H), WSP(bf16_t, WS_W13) + (size_t)(l) * NE * 512 * D, WSP(bf16_t, WS_W2) + (size_t)(l) * NE * D * FF, ACT(bf16_t, A_HID), ACT(bf16_t, A_Y), \
        ctl + CW_CNT + 64 * (l) + z, ACT(unsigned, A_LIST), ACT(float, A_LISTW)}; moe_gemm1(mp, lds, tid, wid, lane); } \
    SEAM((pb) + 1); \
    if (IN((pb) + 2)) { LZ(z); MoeP mp{WSP(bf16_t, WS_H), WSP(bf16_t, WS_W13) + (size_t)(l) * NE * 512 * D, WSP(bf16_t, WS_W2) + (size_t)(l) * NE * D * FF, ACT(bf16_t, A_HID), ACT(bf16_t, A_Y), \
        ctl + CW_CNT + 64 * (l) + z, ACT(unsigned, A_LIST), ACT(float, A_LISTW)}; moe_gemm2(mp, lds, tid, wid, lane); } \
    SEAM((pb) + 2);
    MOE_PHASES(0, 4)
    if (IN(7)) { LZ(z); NormP p{}; p.X = WSP(float, WS_X); p.Y = ACT(bf16_t, A_Y); p.H = WSP(bf16_t, WS_H); p.g = INP(1) + D; p.wml = INP(6) + 6144; p.G = ACT(float, A_G); norm_phase<2>(p, lds, tid, wid, lane); }
    SEAM(7);
    if (IN(8)) {
        LZ(z);
        bf16_t* H = WSP(bf16_t, WS_H); bf16_t* Wmlin = WSP(bf16_t, WS_WMLIN);
        if (tid == 0) {
            pg8::put_job(lds, 0, H, Wmlin, T, 2048, ACT(bf16_t, A_Q1), ACT(bf16_t, A_K1), 1024, 1024, 0.08838834764831845f);
            pg8::put_job(lds, 1, H, Wmlin + (size_t)4096 * D, T, 2048, ACT(bf16_t, A_OG), ACT(bf16_t, A_OG), D, 1 << 30, 1.0f);
            pg8::put_job(lds, 2, Wmlin + (size_t)1024 * D, H, 3072, T, ACT(bf16_t, A_KT), ACT(bf16_t, A_KT), T, 1 << 30, 1.0f);
        }
        __syncthreads();
        pg8::Sched S; S.init(lds, 3, gridDim.x, blockIdx.x);
        pg8::EpiBf16 E{S.tab};
        pg8::gemm_phase(lds, S, E);
    }
    SEAM(8);
    if (IN(9)) { LZ(z); mlstm_phase(ACT(bf16_t, A_Q1), ACT(bf16_t, A_K1), ACT(bf16_t, A_KT), ACT(bf16_t, A_VT1), ACT(bf16_t, A_OG), ACT(float, A_G), INP(7), INP(8), INP(9), ACT(bf16_t, A_HS), lds, tid, wid, lane); }
    SEAM(9);
    if (IN(10)) { LZ(z);
        if (tid == 0) pg8::put_job(lds, 0, ACT(bf16_t, A_HS), WSP(bf16_t, WS_WMLOUT), T, D, nullptr, nullptr, D, 0, 1.0f);
        __syncthreads();
        pg8::Sched S; S.init(lds, 1, gridDim.x, blockIdx.x);
        pg8::EpiResF32 E{WSP(float, WS_X), WSP(float, WS_X), D}; pg8::gemm_phase(lds, S, E); }
    SEAM(10);
    MOE_PHASES(1, 11)
    if (IN(14)) { LZ(z); NormP p{}; p.X = WSP(float, WS_X); p.Y = ACT(bf16_t, A_Y); p.outf = args.out + z; p.g = INP(3); norm_phase<3>(p, lds, tid, wid, lane); }
#undef IN
#undef SEAM
}

extern "C" void kernel_launch(void* const* d_in, const int* in_sizes, int n_in, void* d_out, int out_size, void* d_ws, size_t ws_size, hipStream_t stream) {
    static int grid = 0;
    if (grid == 0) {
        if (n_in != 18 || out_size != T * D || ws_size < WS_END) { fprintf(stderr, "kernel_launch: unexpected shapes (n_in %d out %d ws %zu need %zu)\n", n_in, out_size, ws_size, (size_t)WS_END); grid = -1; return; }
        int dev = 0, cus = 0, per_cu = 0;
        if (hipGetDevice(&dev) != hipSuccess || hipDeviceGetAttribute(&cus, hipDeviceAttributeMultiprocessorCount, dev) != hipSuccess) { grid = -1; return; }
        if (hipFuncSetAttribute((const void*)fwd_kernel, hipFuncAttributeMaxDynamicSharedMemorySize, LDS_BYTES) != hipSuccess) { fprintf(stderr, "kernel_launch: hipFuncSetAttribute failed\n"); grid = -1; return; }
        if (hipOccupancyMaxActiveBlocksPerMultiprocessor(&per_cu, (const void*)fwd_kernel, NTHREADS, LDS_BYTES) != hipSuccess || per_cu < 1) { fprintf(stderr, "kernel_launch: occupancy query says %d\n", per_cu); per_cu = 1; }
        (void)hipGetLastError();
        grid = cus;
    }
    if (grid < 0) return;
    (void)hipMemsetAsync((char*)d_ws + WS_CTL, 0, CTL_BYTES, stream);
    Args a{};
    for (int i = 0; i < 18; ++i) a.in[i] = (const float*)d_in[i];
    a.out = (float*)d_out; a.ws = (unsigned char*)d_ws;
#if MK_MULTI
    for (int ph = 0; ph < NPHASE; ++ph) { a.ph_lo = ph; a.ph_hi = ph + 1; hipLaunchKernelGGL(fwd_kernel, dim3(grid), dim3(NTHREADS), LDS_BYTES, stream, a); }
#else
    a.ph_lo = 0; a.ph_hi = NPHASE;
    void* kargs[] = {&a};
    hipError_t e = hipLaunchCooperativeKernel((const void*)fwd_kernel, dim3(grid), dim3(NTHREADS), kargs, LDS_BYTES, stream);
    if (e != hipSuccess) fprintf(stderr, "kernel_launch: cooperative launch failed: %s\n", hipGetErrorString(e));
#endif
}
```

```cpp
#include <hip/hip_runtime.h>
#include <cstdio>
#include <cstdint>

#define GAS __attribute__((address_space(1)))
#define LAS __attribute__((address_space(3)))
#define DI __device__ __forceinline__
typedef unsigned short bf16_t;
typedef short bf16x8 __attribute__((ext_vector_type(8)));
typedef short s16x4 __attribute__((ext_vector_type(4)));
typedef float f32x4 __attribute__((ext_vector_type(4)));
typedef unsigned u32x4 __attribute__((ext_vector_type(4)));
typedef unsigned u32x2 __attribute__((ext_vector_type(2)));

#ifndef PROBE_A
#define PROBE_A -1
#define PROBE_B -1
#endif
#ifndef REPEAT_MASK
#define REPEAT_MASK 0
#endif
#ifndef MK_MULTI
#define MK_MULTI 0
#endif

constexpr int T = 8192, D = 2048, SEQ = 2048;
constexpr int SBH = 16;
constexpr int MLH = 8, ML_IN = 6160;
constexpr int NE = 32, FF = 256;
constexpr float EPS = 1e-6f;
constexpr int NPHASE = 16;
constexpr int NTHREADS = 512;
constexpr int LDS_BYTES = 147456;

constexpr size_t MiB = 1u << 20;
constexpr size_t WS_CTL = 0, CTL_BYTES = 128 * 1024;
constexpr size_t WS_WR = 128 * 1024, WR_BYTES = 384 * 1024, WS_WG = 896 * 1024;
constexpr size_t WS_WSBIN = 1 * MiB, WS_WSBOUT = 25 * MiB, WS_WMLIN = 33 * MiB, WS_WMLOUT = 57 * MiB;
constexpr size_t WS_W13 = 65 * MiB, WS_W2 = 193 * MiB;
constexpr size_t WS_X = 257 * MiB, WS_H = 321 * MiB, WS_ACT = 353 * MiB;
constexpr size_t A_Q = 0, A_K = 32 * MiB, A_VT = 64 * MiB, A_O = 96 * MiB;
constexpr size_t A_Q1 = 0, A_K1 = 16 * MiB, A_KT = 32 * MiB, A_VT1 = 48 * MiB, A_OG = 80 * MiB, A_HS = 112 * MiB, A_G = 144 * MiB, A_NJ = 144 * MiB + 524288, A_SUM = 144 * MiB + 524288 + 131072;
constexpr size_t A_HID = 0, A_LIST = 9 * MiB, A_LISTW = 10 * MiB, A_Y = 16 * MiB;
constexpr size_t A_Z0 = 64 * MiB, A_Z1 = 80 * MiB;
constexpr size_t WS_END = WS_ACT + 145 * MiB;
constexpr int CW_BAR = 4096;
constexpr int CW_CNT = 16384;

typedef __bf16 bf16x2_t __attribute__((ext_vector_type(2)));
typedef float f32x2 __attribute__((ext_vector_type(2)));
DI unsigned pk2(float lo, float hi) { const f32x2 v = {lo, hi}; return __builtin_bit_cast(unsigned, __builtin_convertvector(v, bf16x2_t)); }
DI unsigned f2bf(float f) { return pk2(f, 0.f) & 0xffffu; }
DI float bf2f(unsigned short b) { return __builtin_bit_cast(float, ((unsigned)b) << 16); }
template <int CTRL> DI float dpp_t(float v) { return __builtin_bit_cast(float, __builtin_amdgcn_update_dpp(0, __builtin_bit_cast(int, v), CTRL, 0xF, 0xF, false)); }
#define dpp_f(v, ctrl) dpp_t<ctrl>(v)
DI float wave_max(float v) {
    v = fmaxf(v, dpp_f(v, 0xB1)); v = fmaxf(v, dpp_f(v, 0x4E)); v = fmaxf(v, dpp_f(v, 0x141)); v = fmaxf(v, dpp_f(v, 0x140));
    v = fmaxf(v, __shfl_xor(v, 16)); v = fmaxf(v, __shfl_xor(v, 32)); return v;
}
DI float wave_sum(float v) {
#pragma unroll
    for (int o = 1; o < 64; o <<= 1) v += __shfl_xor(v, o);
    return v;
}
#define LDS_WAIT() asm volatile("s_waitcnt lgkmcnt(0)" ::: "memory")
#define VM_WAIT() asm volatile("s_waitcnt vmcnt(0)" ::: "memory")
#define MFMA16(a, b, c) __builtin_amdgcn_mfma_f32_16x16x32_bf16((a), (b), (c), 0, 0, 0)

#define XB_TMO      128
#define XB_XCNT(j)  (256  + 64 * (j))
#define XB_XSUB(j)  (1280 + 64 * (j))
#define XB_XGEN(j)  (2304 + 64 * (j))
#define XB_TOP      3328
#define XB_TOPGEN   3392
#define XCD_BAR_WORDS 3456
#define XB_SPIN_CAP (1u << 18)
DI unsigned xb_ld(unsigned* p)              { return __hip_atomic_load(p, __ATOMIC_RELAXED, __HIP_MEMORY_SCOPE_AGENT); }
DI unsigned xb_add(unsigned* p, unsigned v) { return __hip_atomic_fetch_add(p, v, __ATOMIC_RELAXED, __HIP_MEMORY_SCOPE_AGENT); }
DI unsigned xb_xcc_id() { return (unsigned)__builtin_amdgcn_s_getreg((3 << 11) | 20) & 0xFu; }
#define XB_SPIN(cond, bar) do { unsigned _sp = 0; while (cond) { __builtin_amdgcn_s_sleep(1); \
    if ((++_sp & 255u) == 0u) { if (xb_ld(&(bar)[XB_TMO])) break; if (_sp > XB_SPIN_CAP) { atomicAdd(&(bar)[XB_TMO], 1u); break; } } } } while (0)
struct XcdBarrier { unsigned* bar; unsigned x; volatile LAS unsigned* st; };
DI XcdBarrier xcd_barrier_post(unsigned* bar, volatile LAS unsigned* st) {
    XcdBarrier b; b.bar = bar; b.x = xb_xcc_id(); b.st = st;
    if (threadIdx.x == 0) (void)xb_add(&bar[XB_XCNT(b.x)], 1u);
    return b;
}
DI void xcd_barrier_complete(unsigned* bar, unsigned x, unsigned& nloc, unsigned& nx) {
    const unsigned G = gridDim.x * gridDim.y * gridDim.z;
    unsigned sum, cnt, mine, sp = 0u;
    for (;;) {
        sum = 0u; cnt = 0u; mine = 0u;
#pragma unroll
        for (unsigned j = 0; j < 16; ++j) { const unsigned c = xb_ld(&bar[XB_XCNT(j)]); sum += c; cnt += (c > 0u) ? 1u : 0u; mine = (j == x) ? c : mine; }
        if (sum == G) break;
        __builtin_amdgcn_s_sleep(1);
        if ((++sp & 255u) == 0u) { if (xb_ld(&bar[XB_TMO])) break; if (sp > XB_SPIN_CAP) { atomicAdd(&bar[XB_TMO], 1u); break; } }
    }
    nloc = mine > 0u ? mine : 1u; nx = cnt > 0u ? cnt : 1u;
}
DI void xcd_barrier(const XcdBarrier& b) {
    asm volatile("s_waitcnt vmcnt(0)" ::: "memory");
    __syncthreads();
    if (threadIdx.x == 0) {
        unsigned* bar = b.bar;
        __builtin_amdgcn_s_waitcnt(0);
        unsigned nloc = b.st[0], nx = b.st[1];
        if (nloc == 0u) { xcd_barrier_complete(bar, b.x, nloc, nx); b.st[0] = nloc; b.st[1] = nx; }
        const unsigned old = xb_add(&bar[XB_XSUB(b.x)], 1u);
        const unsigned gen = old / nloc;
        if (old + 1u == (gen + 1u) * nloc) {
            __builtin_amdgcn_fence(__ATOMIC_RELEASE, "agent");
            asm volatile("s_waitcnt vmcnt(0)" ::: "memory");
            const unsigned og = xb_add(&bar[XB_TOP], 1u);
            const unsigned tg = og / nx;
            if (og + 1u == (tg + 1u) * nx) xb_add(&bar[XB_TOPGEN], 1u);
            else XB_SPIN(xb_ld(&bar[XB_TOPGEN]) == tg, bar);
            __builtin_amdgcn_fence(__ATOMIC_ACQUIRE, "agent");
            xb_add(&bar[XB_XGEN(b.x)], 1u);
            asm volatile("s_waitcnt vmcnt(0)" ::: "memory");
        } else {
            XB_SPIN(xb_ld(&bar[XB_XGEN(b.x)]) == gen, bar);
            __builtin_amdgcn_fence(__ATOMIC_ACQUIRE, "agent");
            asm volatile("s_waitcnt vmcnt(0)" ::: "memory");
        }
    }
    __syncthreads();
}

struct Args {
    const float* in[18];
    float* out;
    unsigned char* ws;
    int ph_lo, ph_hi;
};

DI int perm13(int f, int which) { return (f >> 7) * 256 + ((f >> 5) & 3) * 64 + which * 32 + (f & 31); }
DI void transpose_item(const float* W, int ldw, bf16_t* WT, int ldt, int k0, int n0, int mode, LAS float* scr, int lane) {
#pragma unroll 16
    for (int i = 0; i < 64; ++i) scr[i * 65 + lane] = __builtin_nontemporal_load(W + (size_t)(k0 + i) * ldw + n0 + lane);
    LDS_WAIT(); asm volatile("" ::: "memory");
    const int c = lane & 7;
#pragma unroll
    for (int j = 0; j < 8; ++j) {
        const int n = (lane >> 3) + 8 * j; const LAS float* s = scr + (8 * c) * 65 + n;
        u32x4 o; o.x = pk2(s[0 * 65], s[1 * 65]); o.y = pk2(s[2 * 65], s[3 * 65]); o.z = pk2(s[4 * 65], s[5 * 65]); o.w = pk2(s[6 * 65], s[7 * 65]);
        const int nn = n0 + n; const int row = (mode == 0) ? nn : perm13(nn, mode - 1);
        *(u32x4*)(WT + (size_t)row * ldt + k0 + 8 * c) = o;
    }
    LDS_WAIT(); asm volatile("" ::: "memory");
}

struct NormP {
    const float* src; bf16_t* X; const bf16_t* Y; bf16_t* H; float* outf; const float* g;
    const bf16_t* wimg; const float* bg; const float* be;
    unsigned* cnt; unsigned* list; float* listw;
    float* G;
};
template <int MODE, bool XB>
DI void norm_phase(const NormP& p, LAS unsigned char* lds, int tid, int wid, int lane) {
    constexpr int RB_LDB = 4112;
    LAS unsigned char* rb_hi = lds;
    LAS float* part = (LAS float*)(lds + 8 * RB_LDB);
    LAS float* logit = part + 8 * 8 * 48;
    LAS int* pex = (LAS int*)(logit + 512); LAS unsigned* pen = (LAS unsigned*)(pex + 512); LAS float* pwt = (LAS float*)(pen + 512);
    int itn = 0;
    constexpr bool PROJ = (MODE == 1 || MODE == 2);
    const float* xin = p.src;
    const bf16_t* xbn = (MODE <= 1) ? (const bf16_t*)p.src : (const bf16_t*)p.X;
    f32x4 v[8]; u32x2 xb[8], ya[8], yb[8];
    int it = blockIdx.x;
#define NP_LOADV(itx) do { const size_t ro_ = (size_t)((itx) * 8 + wid) * D; _Pragma("unroll") for (int j = 0; j < 8; ++j) { if (XB) xb[j] = *(const u32x2*)(xbn + ro_ + 4 * lane + 256 * j); else v[j] = __builtin_nontemporal_load((const f32x4*)(xin + ro_ + 4 * lane + 256 * j)); } } while (0)
#define NP_LOADY(itx) do { const size_t ro_ = (size_t)((itx) * 8 + wid) * D; _Pragma("unroll") for (int j = 0; j < 8; ++j) { const int c = 4 * lane + 256 * j; \
        if (MODE >= 1) ya[j] = *(const u32x2*)(p.Y + ro_ + c); if (MODE >= 2) yb[j] = *(const u32x2*)(p.Y + (size_t)T * D + ro_ + c); } } while (0)
#define NP_LOAD(itx) do { NP_LOADV(itx); NP_LOADY(itx); } while (0)
    if (it < T / 8) NP_LOAD(it);
    for (; it < T / 8; it += gridDim.x, ++itn) {
        const int row = it * 8 + wid;
        const size_t ro = (size_t)row * D;
        f32x4 gv[8];
#pragma unroll
        for (int j = 0; j < 8; ++j) gv[j] = *(const f32x4*)(p.g + 4 * lane + 256 * j);
        float ss = 0.f;
#pragma unroll
        for (int j = 0; j < 8; ++j) {
            f32x4 x;
            if (XB) { const u32x2 q = xb[j]; x.x = bf2f(q.x & 0xffff); x.y = bf2f(q.x >> 16); x.z = bf2f(q.y & 0xffff); x.w = bf2f(q.y >> 16); } else x = v[j];
            if (MODE >= 1) {
                const u32x2 a = ya[j];
                x.x += bf2f(a.x & 0xffff); x.y += bf2f(a.x >> 16); x.z += bf2f(a.y & 0xffff); x.w += bf2f(a.y >> 16);
                if (MODE >= 2) { const u32x2 b = yb[j]; x.x += bf2f(b.x & 0xffff); x.y += bf2f(b.x >> 16); x.z += bf2f(b.y & 0xffff); x.w += bf2f(b.y >> 16); }
                if (MODE <= 2) { u32x2 o; o.x = pk2(x.x, x.y); o.y = pk2(x.z, x.w); *(u32x2*)(p.X + ro + 4 * lane + 256 * j) = o; }
            }
            v[j] = x;
            ss += (x.x * x.x + x.y * x.y) + (x.z * x.z + x.w * x.w);
        }
        const float rstd = 1.0f / sqrtf(wave_sum(ss) * (1.0f / D) + EPS);
#pragma unroll
        for (int j = 0; j < 8; ++j) {
            const int c = 4 * lane + 256 * j;
            const f32x4 gg = gv[j];
            f32x4 y; y.x = v[j].x * rstd * gg.x; y.y = v[j].y * rstd * gg.y; y.z = v[j].z * rstd * gg.z; y.w = v[j].w * rstd * gg.w;
            if (MODE == 3) *(f32x4*)(p.outf + ro + c) = y;
            else { u32x2 o; o.x = pk2(y.x, y.y); o.y = pk2(y.z, y.w); *(u32x2*)(p.H + ro + c) = o; }
            if (PROJ) *(LAS u32x2*)(rb_hi + wid * RB_LDB + c * 2) = (u32x2){pk2(y.x, y.y), pk2(y.z, y.w)};
        }
        const bool more = it + (int)gridDim.x < T / 8;
        if (!PROJ && more) NP_LOAD(it + gridDim.x);
        if (PROJ) {
            __syncthreads();
            {
                constexpr int NT = (MODE == 1) ? 3 : 1;
                f32x4 pacc[NT];
#pragma unroll
                for (int nt = 0; nt < NT; ++nt) pacc[nt] = (f32x4){0.f, 0.f, 0.f, 0.f};
                const LAS unsigned char* ahi = rb_hi + (lane & 7) * RB_LDB + (lane >> 4) * 16 + wid * 512;
                const bf16_t* wim = p.wimg + (size_t)lane * 8 + (size_t)(8 * wid) * NT * 512;
                bf16x8 w0[4][NT], w1[4][NT];
#define NP_LDW(dst, g) do { _Pragma("unroll") for (int kk = 0; kk < 4; ++kk) _Pragma("unroll") for (int nt = 0; nt < NT; ++nt) dst[kk][nt] = *(const bf16x8*)(wim + (size_t)((4 * (g) + kk) * NT + nt) * 512); } while (0)
#define NP_MM(src, g) do { _Pragma("unroll") for (int kk = 0; kk < 4; ++kk) { const bf16x8 xh = *(const LAS bf16x8*)(ahi + (4 * (g) + kk) * 64); \
        _Pragma("unroll") for (int nt = 0; nt < NT; ++nt) pacc[nt] = MFMA16(xh, src[kk][nt], pacc[nt]); } } while (0)
#define NP_PIN __builtin_amdgcn_sched_barrier(0)
                NP_LDW(w0, 0); NP_LDW(w1, 1); NP_PIN;
                if (more) NP_LOADV(it + gridDim.x);
                NP_PIN; NP_MM(w0, 0); NP_MM(w1, 1); NP_PIN;
#undef NP_PIN
#undef NP_LDW
#undef NP_MM
                if (more) NP_LOADY(it + gridDim.x);
                if (lane < 32) {
#pragma unroll
                    for (int nt = 0; nt < NT; ++nt)
#pragma unroll
                        for (int r = 0; r < 4; ++r) part[(wid * 8 + 4 * (lane >> 4) + r) * 48 + 16 * nt + (lane & 15)] = pacc[nt][r];
                }
            }
            __syncthreads();
            {
                float sl = 0.f;
                if (lane < 48) {
#pragma unroll
                    for (int w = 0; w < 8; ++w) sl += part[(w * 8 + wid) * 48 + lane];
                }
                if (MODE == 2) { if (lane < 16) p.G[(size_t)row * 16 + lane] = sl; }
                else {
                    if (lane < 36) sl += (lane < 4) ? p.bg[lane] : p.be[lane - 4];
                    const float NEG = -3.0e38f;
                    const float gl = (lane < 4) ? sl : NEG;
                    float gm = fmaxf(gl, dpp_f(gl, 0xB1)); gm = fmaxf(gm, dpp_f(gm, 0x4E));
                    gm = __shfl(gm, 0);
                    const int gs = __ffsll((long long)__ballot(lane < 4 && sl == gm)) - 1;
                    float ge = (lane < 4) ? __expf(sl - gm) : 0.f;
                    ge += dpp_f(ge, 0xB1); ge += dpp_f(ge, 0x4E);
                    const float psel = 1.0f / __shfl(ge, 0);
                    const int eb = 4 + 8 * gs;
                    const bool inr = lane >= eb && lane < eb + 8;
                    const float v0 = wave_max(inr ? sl : NEG);
                    const int l0 = __ffsll((long long)__ballot(inr && sl == v0)) - 1;
                    const float v1 = wave_max((inr && lane != l0) ? sl : NEG);
                    const int l1 = __ffsll((long long)__ballot(inr && lane != l0 && sl == v1)) - 1;
                    if (lane == 0) {
                        const float e10 = __expf(v1 - v0); const float w0 = psel / (1.0f + e10), w1 = psel * e10 / (1.0f + e10);
                        const int e0 = gs * 8 + (l0 - eb), e1 = gs * 8 + (l1 - eb);
                        const int sl0 = itn * 16 + wid * 2;
                        pex[sl0] = e0; pen[sl0] = (unsigned)row * 2u; pwt[sl0] = w0;
                        pex[sl0 + 1] = e1; pen[sl0 + 1] = (unsigned)row * 2u + 1u; pwt[sl0 + 1] = w1;
                    }
                }
            }
        }
    }
#undef NP_LOAD
#undef NP_LOADV
#undef NP_LOADY
    if (MODE == 1) {
        __syncthreads();
        if (wid == 0) {
            const int np = itn * 16;
            for (int c0 = 0; c0 < np; c0 += 64) {
                const bool have = c0 + lane < np;
                const int ei = have ? pex[c0 + lane] : -1;
                int cnt_e = 0, rank = 0;
#pragma unroll 4
                for (int e = 0; e < NE; ++e) {
                    const unsigned long long m = __ballot(ei == e);
                    if (lane == e) cnt_e = __popcll(m);
                    if (ei == e) rank = __popcll(m & ((1ull << lane) - 1ull));
                }
                unsigned base = 0u;
                if (lane < NE && cnt_e > 0) base = atomicAdd(p.cnt + lane, (unsigned)cnt_e);
                const unsigned mybase = (unsigned)__shfl((int)base, ei < 0 ? 0 : ei);
                if (have) { const size_t pos = (size_t)ei * T + mybase + rank; p.list[pos] = pen[c0 + lane]; p.listw[pos] = pwt[c0 + lane]; }
            }
        }
        __syncthreads();
    }
}

DI int lds_byte(int r, int c) { const int st = (r >> 4) * 2 + (c >> 5), rr = r & 15, cc = c & 31, ob = rr * 64 + cc * 2; return st * 1024 + (ob ^ (((ob >> 9) & 1) << 5)); }
DI void stage_rc(int b, int& R, int& C) { const int st = b / 1024, sb = b % 1024, swz = sb ^ (((sb >> 9) & 1) << 5); R = (st >> 1) * 16 + swz / 64; C = (st & 1) * 32 + (swz % 64) / 2; }

namespace pg8 {
constexpr int BM = 256, BK = 64, HALF = 128, HTB = HALF * BK * 2, NXCD = 8, WGM = 8, KD = 2048;
DI int perm32(int rho) { const int n = rho >> 4, i = rho & 15; return 8 * (i >> 2) + 4 * n + (i & 3); }
struct Unit { int pm, pn, job; };
struct JobRec { const bf16_t* A; const bf16_t* Bt; bf16_t* o0; bf16_t* o1; int M, N, ld, split; float scale0; int pad[5]; };
constexpr int JOBS_OFF = 139264;
DI void put_job(LAS unsigned char* lds, int j, const bf16_t* A, const bf16_t* Bt, int M, int N, bf16_t* o0, bf16_t* o1, int ld, int split, float scale0) {
    LAS JobRec* r = (LAS JobRec*)(lds + JOBS_OFF) + j;
    r->A = A; r->Bt = Bt; r->o0 = o0; r->o1 = o1; r->M = M; r->N = N; r->ld = ld; r->split = split; r->scale0 = scale0;
}
struct Sched {
    const LAS JobRec* tab; int n0, n1, n2, G, c;
    DI void init(LAS unsigned char* lds, int njobs, int G_, int c_) {
        tab = (const LAS JobRec*)(lds + JOBS_OFF);
        n0 = (tab[0].M / BM) * (tab[0].N / BM); n1 = njobs > 1 ? (tab[1].M / BM) * (tab[1].N / BM) : 0; n2 = njobs > 2 ? (tab[2].M / BM) * (tab[2].N / BM) : 0; G = G_; c = c_; }
    DI bool next(int i, Unit& u) const {
        int L = i * G + c, nwg;
        if (L < n0) { u.job = 0; nwg = n0; }
        else if (L < n0 + n1) { L -= n0; u.job = 1; nwg = n1; }
        else if (L < n0 + n1 + n2) { L -= n0 + n1; u.job = 2; nwg = n2; }
        else return false;
        const int nM = tab[u.job].M / BM, nN = tab[u.job].N / BM;
        int wgid = L; { const int q = nwg / NXCD, r = nwg % NXCD, xcd = wgid % NXCD, off = wgid / NXCD; wgid = (xcd < r ? xcd * (q + 1) : r * (q + 1) + (xcd - r) * q) + off; }
        const int nig = WGM * nN, gid = wgid / nig, fm = gid * WGM, gsz = (nM - fm) < WGM ? (nM - fm) : WGM;
        u.pm = fm + ((wgid % nig) % gsz); u.pn = (wgid % nig) / gsz; return true;
    }
    DI const char* aptr(const Unit& u) const { return (const char*)tab[u.job].A + (size_t)u.pm * (2 * HALF * KD * 2); }
    DI const char* bptr(const Unit& u) const { return (const char*)tab[u.job].Bt + (size_t)u.pn * (2 * HALF * KD * 2); }
};
struct EpiBf16 {
    static constexpr bool PERM = true;
    const LAS JobRec* tab;
    DI void operator()(const f32x4 (&acc)[2][2][4][2], const Unit& u, int wr, int wc, int fr, int fq) const {
        const LAS JobRec* jr = tab + u.job;
        const int ldo = jr->ld, split = jr->split;
        float sc = jr->scale0;
        int colt = u.pn * BM; bf16_t* base = jr->o0;
        if (colt >= split) { colt -= split; base = jr->o1; sc = 1.0f; }
        const int row0 = u.pm * BM + wr * 64 + fr, col0 = colt + wc * 64 + 8 * fq;
#pragma unroll
        for (int ai = 0; ai < 2; ++ai)
#pragma unroll
            for (int m = 0; m < 4; ++m) { bf16_t* rowp = base + (size_t)(row0 + ai * HALF + m * 16) * ldo + col0;
#pragma unroll
                for (int bj = 0; bj < 2; ++bj) { const f32x4 v0 = acc[ai][bj][m][0], v1 = acc[ai][bj][m][1];
                    u32x4 w; w.x = pk2(v0.x * sc, v0.y * sc); w.y = pk2(v0.z * sc, v0.w * sc); w.z = pk2(v1.x * sc, v1.y * sc); w.w = pk2(v1.z * sc, v1.w * sc);
                    *(u32x4*)(rowp + bj * 32) = w; } }
    }
};
struct EpiResF32 {
    static constexpr bool PERM = false;
    const float* base; float* out; int ld;
    DI void operator()(const f32x4 (&acc)[2][2][4][2], const Unit& u, int wr, int wc, int fr, int fq) const {
        const int row0 = u.pm * BM + wr * 64 + fr, col0 = u.pn * BM + wc * 32 + 4 * fq;
#pragma unroll
        for (int ai = 0; ai < 2; ++ai)
#pragma unroll
            for (int m = 0; m < 4; ++m) { const size_t ro = (size_t)(row0 + ai * HALF + m * 16) * ld + col0;
#pragma unroll
                for (int bj = 0; bj < 2; ++bj)
#pragma unroll
                    for (int n = 0; n < 2; ++n) { const f32x4 b = *(const f32x4*)(base + ro + bj * HALF + n * 16); const f32x4 a = acc[ai][bj][m][n];
                        f32x4 o; o.x = a.x + b.x; o.y = a.y + b.y; o.z = a.z + b.z; o.w = a.w + b.w; *(f32x4*)(out + ro + bj * HALF + n * 16) = o; } }
    }
};
struct EpiNull {
    static constexpr bool PERM = false;
    DI void operator()(const f32x4 (&acc)[2][2][4][2], const Unit&, int, int, int, int) const {
#pragma unroll
        for (int ai = 0; ai < 2; ++ai)
#pragma unroll
            for (int bj = 0; bj < 2; ++bj)
#pragma unroll
                for (int m = 0; m < 4; ++m)
#pragma unroll
                    for (int n = 0; n < 2; ++n) asm volatile("" :: "v"(acc[ai][bj][m][n]));
    }
};
template <class Epi>
DI void gemm_phase(LAS unsigned char* lds, const Sched& S, const Epi& E) {
    const int tid = threadIdx.x, wid = __builtin_amdgcn_readfirstlane(tid >> 6), lane = tid & 63, wr = wid >> 2, wc = wid & 3, fr = lane & 15, fq = lane >> 4;
    constexpr int K = KD, nt = K / BK;
    unsigned voffA[2], voffB[2][2];
#pragma unroll
    for (int i = 0; i < 2; ++i) { int R, C; stage_rc(tid * 16 + i * 8192, R, C);
        voffA[i] = (unsigned)(R * K + C) * 2u;
#pragma unroll
        for (int h = 0; h < 2; ++h) { const int Rb = Epi::PERM ? (64 * (R >> 5) + 32 * h + perm32(R & 31)) : (128 * h + R); voffB[h][i] = (unsigned)(Rb * K + C) * 2u; } }
    constexpr size_t kstep = (size_t)(BK * 2);
    constexpr size_t hstep = (size_t)HALF * K * 2;
    const unsigned ldsw = (unsigned)wid * 1024u;
    const int aoff = lds_byte(wr * 64 + fr, fq * 8), boff = lds_byte(wc * 32 + fr, fq * 8);
#define PG8_SA(b, h) (((b) * 2 + (h)) * HTB)
#define PG8_SB(b, h) ((4 + (b) * 2 + (h)) * HTB)
#define PG8_STAGE(bufoff, gbase, voff) do { _Pragma("unroll") for (int _i = 0; _i < 2; ++_i) \
        __builtin_amdgcn_global_load_lds((const GAS unsigned*)((const char*)(gbase) + (voff)[_i]), (LAS unsigned*)(lds + (bufoff) + ldsw + _i * 8192), 16, 0, 0); } while (0)
#define PG8_LDA(dst, b, h) do { _Pragma("unroll") for (int m = 0; m < 4; ++m) _Pragma("unroll") for (int k = 0; k < 2; ++k) dst[m][k] = *(const LAS bf16x8*)(lds + PG8_SA(b, h) + aoff + m * 2048 + k * 1024); } while (0)
#define PG8_LDB(dst, b, h) do { _Pragma("unroll") for (int n = 0; n < 2; ++n) _Pragma("unroll") for (int k = 0; k < 2; ++k) dst[n][k] = *(const LAS bf16x8*)(lds + PG8_SB(b, h) + boff + n * 2048 + k * 1024); } while (0)
#define PG8_MMA(ai, bj, At, Bt) do { __builtin_amdgcn_s_setprio(1); _Pragma("unroll") for (int m = 0; m < 4; ++m) _Pragma("unroll") for (int n = 0; n < 2; ++n) _Pragma("unroll") for (int k = 0; k < 2; ++k) \
        acc[ai][bj][m][n] = __builtin_amdgcn_mfma_f32_16x16x32_bf16(Bt[n][k], At[m][k], acc[ai][bj][m][n], 0, 0, 0); __builtin_amdgcn_s_setprio(0); } while (0)
#define PG8_WAIT_V(n) asm volatile("s_waitcnt vmcnt(" #n ")" ::: "memory")
#define PG8_WAIT_L(n) asm volatile("s_waitcnt lgkmcnt(" #n ")" ::: "memory")
#define PG8_BAR __builtin_amdgcn_s_barrier()
#define PG8_SCHED __builtin_amdgcn_sched_barrier(0)
    Unit cur, nxt; int ui = 0;
    if (!S.next(0, cur)) return;
    f32x4 acc[2][2][4][2];
#pragma unroll
    for (int a = 0; a < 2; ++a)
#pragma unroll
        for (int b = 0; b < 2; ++b)
#pragma unroll
            for (int m = 0; m < 4; ++m)
#pragma unroll
                for (int n = 0; n < 2; ++n) acc[a][b][m][n] = (f32x4){0.f, 0.f, 0.f, 0.f};
    bf16x8 At[4][2], B0[2][2], B1[2][2];
    const char* cA = S.aptr(cur); const char* cB = S.bptr(cur);
    PG8_STAGE(PG8_SB(0, 0), cB, voffB[0]); PG8_STAGE(PG8_SA(0, 0), cA, voffA); PG8_STAGE(PG8_SB(0, 1), cB, voffB[1]); PG8_STAGE(PG8_SA(0, 1), cA + hstep, voffA);
    if (wr == 1) PG8_BAR;
    PG8_WAIT_V(4); PG8_BAR;
    PG8_STAGE(PG8_SB(1, 0), cB + kstep, voffB[0]); PG8_STAGE(PG8_SA(1, 0), cA + kstep, voffA); PG8_STAGE(PG8_SB(1, 1), cB + kstep, voffB[1]);
    PG8_WAIT_V(6); PG8_BAR;
    for (;;) {
        const bool has_next = S.next(ui + 1, nxt);
        const char* nA = has_next ? S.aptr(nxt) : cA; const char* nB = has_next ? S.bptr(nxt) : cB;
        for (int t = 0; t < nt; t += 2) {
            const bool last = (t == nt - 2);
            const char* a1 = cA + (size_t)(t + 1) * kstep;
            const char* a2 = last ? nA : cA + (size_t)(t + 2) * kstep; const char* b2 = last ? nB : cB + (size_t)(t + 2) * kstep;
            const char* a3 = a2 + kstep; const char* b3 = b2 + kstep;
            PG8_LDB(B0, 0, 0); PG8_SCHED; PG8_LDA(At, 0, 0); PG8_STAGE(PG8_SA(1, 1), a1 + hstep, voffA);
            PG8_WAIT_L(8); PG8_BAR; PG8_WAIT_L(0); PG8_MMA(0, 0, At, B0); PG8_BAR; PG8_SCHED;
            PG8_LDB(B1, 0, 1); PG8_STAGE(PG8_SB(0, 0), b2, voffB[0]);
            PG8_BAR; PG8_WAIT_L(0); PG8_MMA(0, 1, At, B1); PG8_BAR;
            PG8_LDA(At, 0, 1); PG8_STAGE(PG8_SA(0, 0), a2, voffA);
            PG8_BAR; PG8_WAIT_L(0); PG8_MMA(1, 0, At, B0); PG8_BAR; PG8_SCHED;
            PG8_STAGE(PG8_SB(0, 1), b2, voffB[1]);
            PG8_WAIT_V(6); PG8_BAR; PG8_MMA(1, 1, At, B1); PG8_BAR;
            PG8_LDB(B0, 1, 0); PG8_SCHED; PG8_LDA(At, 1, 0); PG8_STAGE(PG8_SA(0, 1), a2 + hstep, voffA);
            PG8_WAIT_L(8); PG8_BAR; PG8_WAIT_L(0); PG8_MMA(0, 0, At, B0); PG8_BAR; PG8_SCHED;
            PG8_LDB(B1, 1, 1); PG8_STAGE(PG8_SB(1, 0), b3, voffB[0]);
            PG8_BAR; PG8_WAIT_L(0); PG8_MMA(0, 1, At, B1); PG8_BAR;
            PG8_LDA(At, 1, 1); PG8_STAGE(PG8_SA(1, 0), a3, voffA);
            PG8_BAR; PG8_WAIT_L(0); PG8_MMA(1, 0, At, B0); PG8_BAR; PG8_SCHED;
            PG8_STAGE(PG8_SB(1, 1), b3, voffB[1]);
            PG8_WAIT_V(6); PG8_BAR; PG8_MMA(1, 1, At, B1); PG8_BAR;
        }
        E(acc, cur, wr, wc, fr, fq);
        if (!has_next) break;
#pragma unroll
        for (int a = 0; a < 2; ++a)
#pragma unroll
            for (int b = 0; b < 2; ++b)
#pragma unroll
                for (int m = 0; m < 4; ++m)
#pragma unroll
                    for (int n = 0; n < 2; ++n) acc[a][b][m][n] = (f32x4){0.f, 0.f, 0.f, 0.f};
        cur = nxt; cA = nA; cB = nB; ++ui;
    }
    PG8_WAIT_V(0);
    if (wr == 0) PG8_BAR;
    PG8_BAR;
#undef PG8_SA
#undef PG8_SB
#undef PG8_STAGE
#undef PG8_LDA
#undef PG8_LDB
#undef PG8_MMA
#undef PG8_WAIT_V
#undef PG8_WAIT_L
#undef PG8_BAR
#undef PG8_SCHED
}

struct MUnit { int e, rt, pn, cnt, sbase; };
constexpr int MTAB_OFF = JOBS_OFF + 256;
DI void moe_table256(const unsigned* cntg, LAS unsigned char* lds, int tid) {
    LAS int* ctl = (LAS int*)(lds + MTAB_OFF);
    if (tid < 64) {
        const int c = (tid < NE) ? (int)__hip_atomic_load(cntg + tid, __ATOMIC_RELAXED, __HIP_MEMORY_SCOPE_AGENT) : 0;
        const int n = (c + 255) / 256;
        int pb = c, pt = n;
#pragma unroll
        for (int o = 1; o < 32; o <<= 1) { const int vb = __shfl_up(pb, o), vt = __shfl_up(pt, o); if (tid >= o) { pb += vb; pt += vt; } }
        if (tid < NE) { ctl[tid] = c; ctl[32 + tid] = pb - c; ctl[64 + tid] = pt - n; for (int i = 0; i < n && pt - n + i < 128; ++i) ctl[128 + pt - n + i] = tid; }
        if (tid == NE - 1) ctl[64 + NE] = pt;
    }
    __syncthreads();
}
template <int NPN>
struct MSched {
    const LAS int* ctl; int G, c, total;
    DI void init(LAS unsigned char* lds, int G_, int c_) { ctl = (const LAS int*)(lds + MTAB_OFF); G = G_; c = c_; total = ctl[64 + NE] * NPN; }
    DI bool next(int i, MUnit& u) const {
        const int L = i * G + c; if (L >= total) return false;
        const int rtg = L / NPN; u.pn = L % NPN;
        const int e = ctl[128 + rtg];
        u.e = e; u.rt = rtg - ctl[64 + e]; u.cnt = ctl[e]; u.sbase = ctl[32 + e]; return true;
    }
};
struct MOps1 {
    const bf16_t* H; const bf16_t* W; const unsigned* list;
    DI const char* abase(const MUnit&) const { return (const char*)H; }
    DI void aoffs(const MUnit& u, int R0, int C0, int R1, int C1, unsigned (&o)[2][2]) const {
#pragma unroll
        for (int h = 0; h < 2; ++h) {
            const int ra = u.rt * 256 + h * 128 + R0, rb = u.rt * 256 + h * 128 + R1;
            const unsigned ta = list[(size_t)u.e * T + (ra < u.cnt ? ra : u.cnt - 1)] >> 1, tb = list[(size_t)u.e * T + (rb < u.cnt ? rb : u.cnt - 1)] >> 1;
            o[h][0] = (ta * (unsigned)D + (unsigned)C0) * 2u; o[h][1] = (tb * (unsigned)D + (unsigned)C1) * 2u;
        }
    }
    DI const char* bptr(const MUnit& u) const { return (const char*)(W + ((size_t)u.e * 512 + u.pn * 256) * D); }
};
struct MOps2 {
    const bf16_t* hid; const bf16_t* W;
    DI const char* abase(const MUnit& u) const { return (const char*)(hid + (size_t)(u.sbase + u.rt * 256) * FF); }
    DI void aoffs(const MUnit&, int R0, int C0, int R1, int C1, unsigned (&o)[2][2]) const {
#pragma unroll
        for (int h = 0; h < 2; ++h) { o[h][0] = (unsigned)((h * 128 + R0) * FF + C0) * 2u; o[h][1] = (unsigned)((h * 128 + R1) * FF + C1) * 2u; }
    }
    DI const char* bptr(const MUnit& u) const { return (const char*)(W + ((size_t)u.e * D + u.pn * 256) * FF); }
};
constexpr int MROW_OFF = 131072;
struct EpiSwiglu {
    bf16_t* hid; const float* listw;
    DI void prep(const MUnit& u, LAS unsigned char* lds, int par, int tid) const {
        if (tid < 256) { const int r = u.rt * 256 + tid;
            __builtin_amdgcn_global_load_lds((const GAS unsigned*)(listw + (size_t)u.e * T + (r < u.cnt ? r : u.cnt - 1)), (LAS unsigned*)(lds + MROW_OFF + par * 1024 + (tid >> 6) * 256), 4, 0, 0); }
    }
    DI void operator()(const f32x4 (&acc)[2][2][4][2], const MUnit& u, int wr, int wc, int fr, int fq, const LAS unsigned char* lds, int par) const {
#pragma unroll
        for (int ai = 0; ai < 2; ++ai)
#pragma unroll
            for (int m = 0; m < 4; ++m) {
                const int r = u.rt * 256 + ai * HALF + wr * 64 + m * 16 + fr;
                if (r < u.cnt) {
                    const float gw = ((const LAS float*)(lds + MROW_OFF))[par * 256 + ai * HALF + wr * 64 + m * 16 + fr];
                    unsigned o[4];
#pragma unroll
                    for (int n = 0; n < 2; ++n) { const f32x4 g = acc[ai][0][m][n], uu = acc[ai][1][m][n]; float hv[4];
#pragma unroll
                        for (int j = 0; j < 4; ++j) hv[j] = g[j] / (1.0f + __expf(-g[j])) * uu[j] * gw;
                        o[2 * n] = pk2(hv[0], hv[1]); o[2 * n + 1] = pk2(hv[2], hv[3]); }
                    *(u32x4*)(hid + (size_t)(u.sbase + r) * FF + u.pn * 128 + wc * 32 + 8 * fq) = (u32x4){o[0], o[1], o[2], o[3]};
                }
            }
    }
};
struct EpiScatter {
    bf16_t* Y; const unsigned* list;
    DI void prep(const MUnit& u, LAS unsigned char* lds, int par, int tid) const {
        if (tid < 256) { const int r = u.rt * 256 + tid;
            __builtin_amdgcn_global_load_lds((const GAS unsigned*)(list + (size_t)u.e * T + (r < u.cnt ? r : u.cnt - 1)), (LAS unsigned*)(lds + MROW_OFF + par * 1024 + (tid >> 6) * 256), 4, 0, 0); }
    }
    DI void operator()(const f32x4 (&acc)[2][2][4][2], const MUnit& u, int wr, int wc, int fr, int fq, const LAS unsigned char* lds, int par) const {
#pragma unroll
        for (int ai = 0; ai < 2; ++ai)
#pragma unroll
            for (int m = 0; m < 4; ++m) {
                const int r = u.rt * 256 + ai * HALF + wr * 64 + m * 16 + fr;
                if (r < u.cnt) {
                    const unsigned ent = ((const LAS unsigned*)(lds + MROW_OFF))[par * 256 + ai * HALF + wr * 64 + m * 16 + fr];
                    bf16_t* yrow = Y + ((size_t)(ent & 1u) * T + (ent >> 1)) * D + u.pn * 256 + wc * 64 + 8 * fq;
#pragma unroll
                    for (int bj = 0; bj < 2; ++bj) { const f32x4 v0 = acc[ai][bj][m][0], v1 = acc[ai][bj][m][1];
                        *(u32x4*)(yrow + bj * 32) = (u32x4){pk2(v0.x, v0.y), pk2(v0.z, v0.w), pk2(v1.x, v1.y), pk2(v1.z, v1.w)}; }
                }
            }
    }
};
struct EpiMNull {
    DI void prep(const MUnit&, LAS unsigned char*, int, int) const {}
    DI void operator()(const f32x4 (&acc)[2][2][4][2], const MUnit&, int, int, int, int, const LAS unsigned char*, int) const {
#pragma unroll
        for (int ai = 0; ai < 2; ++ai)
#pragma unroll
            for (int bj = 0; bj < 2; ++bj)
#pragma unroll
                for (int m = 0; m < 4; ++m)
#pragma unroll
                    for (int n = 0; n < 2; ++n) asm volatile("" :: "v"(acc[ai][bj][m][n]));
    }
};
template <int K, class Sched, class Ops, class Epi>
DI void gemm_phase_m(LAS unsigned char* lds, const Sched& S, const Ops& P, const Epi& E) {
    const int tid = threadIdx.x, wid = __builtin_amdgcn_readfirstlane(tid >> 6), lane = tid & 63, wr = wid >> 2, wc = wid & 3, fr = lane & 15, fq = lane >> 4;
    constexpr int nt = K / BK;
    int R0, C0, R1, C1; stage_rc(tid * 16, R0, C0); stage_rc(tid * 16 + 8192, R1, C1);
    unsigned voffB[2][2];
#pragma unroll
    for (int h = 0; h < 2; ++h) { voffB[h][0] = (unsigned)((64 * (R0 >> 5) + 32 * h + perm32(R0 & 31)) * K + C0) * 2u; voffB[h][1] = (unsigned)((64 * (R1 >> 5) + 32 * h + perm32(R1 & 31)) * K + C1) * 2u; }
    constexpr size_t kstep = (size_t)(BK * 2);
    constexpr size_t hstep = (size_t)HALF * K * 2;
    const unsigned ldsw = (unsigned)wid * 1024u;
    const int aoff = lds_byte(wr * 64 + fr, fq * 8), boff = lds_byte(wc * 32 + fr, fq * 8);
#define PG8_SA(b, h) (((b) * 2 + (h)) * HTB)
#define PG8_SB(b, h) ((4 + (b) * 2 + (h)) * HTB)
#define PG8_STAGEB(bufoff, gbase, h) do { _Pragma("unroll") for (int _i = 0; _i < 2; ++_i) \
        __builtin_amdgcn_global_load_lds((const GAS unsigned*)((const char*)(gbase) + voffB[h][_i]), (LAS unsigned*)(lds + (bufoff) + ldsw + _i * 8192), 16, 0, 0); } while (0)
#define PG8_STAGEA(bufoff, bb, pp, h, koff) do { _Pragma("unroll") for (int _i = 0; _i < 2; ++_i) \
        __builtin_amdgcn_global_load_lds((const GAS unsigned*)((bb) + (koff) + (pp)[h][_i]), (LAS unsigned*)(lds + (bufoff) + ldsw + _i * 8192), 16, 0, 0); } while (0)
#define PG8_LDA(dst, b, h) do { _Pragma("unroll") for (int m = 0; m < 4; ++m) _Pragma("unroll") for (int k = 0; k < 2; ++k) dst[m][k] = *(const LAS bf16x8*)(lds + PG8_SA(b, h) + aoff + m * 2048 + k * 1024); } while (0)
#define PG8_LDB(dst, b, h) do { _Pragma("unroll") for (int n = 0; n < 2; ++n) _Pragma("unroll") for (int k = 0; k < 2; ++k) dst[n][k] = *(const LAS bf16x8*)(lds + PG8_SB(b, h) + boff + n * 2048 + k * 1024); } while (0)
#define PG8_MMA(ai, bj, At, Bt) do { __builtin_amdgcn_s_setprio(1); _Pragma("unroll") for (int m = 0; m < 4; ++m) _Pragma("unroll") for (int n = 0; n < 2; ++n) _Pragma("unroll") for (int k = 0; k < 2; ++k) \
        acc[ai][bj][m][n] = __builtin_amdgcn_mfma_f32_16x16x32_bf16(Bt[n][k], At[m][k], acc[ai][bj][m][n], 0, 0, 0); __builtin_amdgcn_s_setprio(0); } while (0)
#define PG8_WAIT_V(n) asm volatile("s_waitcnt vmcnt(" #n ")" ::: "memory")
#define PG8_WAIT_L(n) asm volatile("s_waitcnt lgkmcnt(" #n ")" ::: "memory")
#define PG8_BAR __builtin_amdgcn_s_barrier()
#define PG8_SCHED __builtin_amdgcn_sched_barrier(0)
    MUnit cur, nxt; int ui = 0;
    if (!S.next(0, cur)) return;
    f32x4 acc[2][2][4][2];
#pragma unroll
    for (int a = 0; a < 2; ++a)
#pragma unroll
        for (int b = 0; b < 2; ++b)
#pragma unroll
            for (int m = 0; m < 4; ++m)
#pragma unroll
                for (int n = 0; n < 2; ++n) acc[a][b][m][n] = (f32x4){0.f, 0.f, 0.f, 0.f};
    bf16x8 At[4][2], B0[2][2], B1[2][2];
    unsigned pA[2][2], qA[2][2];
    P.aoffs(cur, R0, C0, R1, C1, pA);
    const char* cAb = P.abase(cur);
    E.prep(cur, lds, 0, tid);
    const char* cB = P.bptr(cur);
    PG8_STAGEB(PG8_SB(0, 0), cB, 0); PG8_STAGEA(PG8_SA(0, 0), cAb, pA, 0, 0); PG8_STAGEB(PG8_SB(0, 1), cB, 1); PG8_STAGEA(PG8_SA(0, 1), cAb, pA, 1, 0);
    if (wr == 1) PG8_BAR;
    PG8_WAIT_V(4); PG8_BAR;
    PG8_STAGEB(PG8_SB(1, 0), cB + kstep, 0); PG8_STAGEA(PG8_SA(1, 0), cAb, pA, 0, kstep); PG8_STAGEB(PG8_SB(1, 1), cB + kstep, 1);
    PG8_WAIT_V(6); PG8_BAR;
    for (;;) {
        const bool has_next = S.next(ui + 1, nxt);
        const char* nB = cB; const char* nAb = cAb;
#pragma unroll
        for (int h = 0; h < 2; ++h) { qA[h][0] = pA[h][0]; qA[h][1] = pA[h][1]; }
        if (has_next) { P.aoffs(nxt, R0, C0, R1, C1, qA); nAb = P.abase(nxt); nB = P.bptr(nxt); E.prep(nxt, lds, (ui + 1) % 3, tid); }
#pragma unroll 1
        for (int t = 0; t < nt; t += 2) {
            const bool last = (t == nt - 2);
            const size_t k1 = (size_t)(t + 1) * kstep;
            const size_t k2 = last ? 0 : (size_t)(t + 2) * kstep, k3 = k2 + kstep;
            const char* b2 = last ? nB : cB + k2; const char* b3 = b2 + kstep;
            const char* a2 = last ? nAb : cAb;
            unsigned o2[2][2];
#pragma unroll
            for (int h = 0; h < 2; ++h) { o2[h][0] = last ? qA[h][0] : pA[h][0]; o2[h][1] = last ? qA[h][1] : pA[h][1]; }
            PG8_LDB(B0, 0, 0); PG8_SCHED; PG8_LDA(At, 0, 0); PG8_STAGEA(PG8_SA(1, 1), cAb, pA, 1, k1);
            PG8_WAIT_L(8); PG8_BAR; PG8_WAIT_L(0); PG8_MMA(0, 0, At, B0); PG8_BAR; PG8_SCHED;
            PG8_LDB(B1, 0, 1); PG8_STAGEB(PG8_SB(0, 0), b2, 0);
            PG8_BAR; PG8_WAIT_L(0); PG8_MMA(0, 1, At, B1); PG8_BAR;
            PG8_LDA(At, 0, 1); PG8_STAGEA(PG8_SA(0, 0), a2, o2, 0, k2);
            PG8_BAR; PG8_WAIT_L(0); PG8_MMA(1, 0, At, B0); PG8_BAR; PG8_SCHED;
            PG8_STAGEB(PG8_SB(0, 1), b2, 1);
            PG8_WAIT_V(6); PG8_BAR; PG8_MMA(1, 1, At, B1); PG8_BAR;
            PG8_LDB(B0, 1, 0); PG8_SCHED; PG8_LDA(At, 1, 0); PG8_STAGEA(PG8_SA(0, 1), a2, o2, 1, k2);
            PG8_WAIT_L(8); PG8_BAR; PG8_WAIT_L(0); PG8_MMA(0, 0, At, B0); PG8_BAR; PG8_SCHED;
            PG8_LDB(B1, 1, 1); PG8_STAGEB(PG8_SB(1, 0), b3, 0);
            PG8_BAR; PG8_WAIT_L(0); PG8_MMA(0, 1, At, B1); PG8_BAR;
            PG8_LDA(At, 1, 1); PG8_STAGEA(PG8_SA(1, 0), a2, o2, 0, k3);
            PG8_BAR; PG8_WAIT_L(0); PG8_MMA(1, 0, At, B0); PG8_BAR; PG8_SCHED;
            PG8_STAGEB(PG8_SB(1, 1), b3, 1);
            PG8_WAIT_V(6); PG8_BAR; PG8_MMA(1, 1, At, B1); PG8_BAR;
        }
        E(acc, cur, wr, wc, fr, fq, lds, ui % 3);
        if (!has_next) break;
#pragma unroll
        for (int a = 0; a < 2; ++a)
#pragma unroll
            for (int b = 0; b < 2; ++b)
#pragma unroll
                for (int m = 0; m < 4; ++m)
#pragma unroll
                    for (int n = 0; n < 2; ++n) acc[a][b][m][n] = (f32x4){0.f, 0.f, 0.f, 0.f};
        cur = nxt; cB = nB; cAb = nAb; ++ui;
#pragma unroll
        for (int h = 0; h < 2; ++h) { pA[h][0] = qA[h][0]; pA[h][1] = qA[h][1]; }
    }
    PG8_WAIT_V(0);
    if (wr == 0) PG8_BAR;
    PG8_BAR;
#undef PG8_SA
#undef PG8_SB
#undef PG8_STAGEA
#undef PG8_STAGEB
#undef PG8_LDA
#undef PG8_LDB
#undef PG8_MMA
#undef PG8_WAIT_V
#undef PG8_WAIT_L
#undef PG8_BAR
#undef PG8_SCHED
}
}

constexpr int AT_K0 = 0, AT_V0 = 17408, AT_KVB = 35840, AT_FL = 71680, AT_QS = 71936;
DI void attn_phase(const bf16_t* Qb, const bf16_t* Kb, const bf16_t* Vt, bf16_t* O, LAS unsigned char* lds, int tid, int wid, int lane) {
    const int fr = lane & 15, fq = lane >> 4;
    LAS int* flags = (LAS int*)(lds + AT_FL);
    for (int bx = blockIdx.x; bx < 512; bx += gridDim.x) {
        const int rnd = bx >> 8, pos = bx & 255;
        const int qb = (rnd & 1) ? (pos >> 6) : (7 - (pos >> 6));
        const int bh = pos & 63, b = bh >> 4, h = bh & 15;
        const int t0 = qb * 256;
        __syncthreads();
        const int kr0 = tid >> 4, kc = tid & 15, vr0 = tid >> 3, vc = tid & 7;
        const bf16_t* kg = Kb + (size_t)(b * SEQ + kr0) * D + h * 128 + kc * 8;
        const bf16_t* vg = Vt + (size_t)(h * 128 + vr0) * T + b * SEQ + vc * 8;
        u32x4 pk0, pk1, pv0, pv1;
        int s0 = t0 + 192;
        pk0 = *(const u32x4*)(kg + (size_t)s0 * D); pk1 = *(const u32x4*)(kg + (size_t)(s0 + 32) * D);
        pv0 = *(const u32x4*)(vg + s0); pv1 = *(const u32x4*)(vg + (size_t)64 * T + s0);
#pragma unroll
        for (int c8 = 0; c8 < 8; ++c8) {
            const int c = tid + 512 * c8, row = c >> 4, c16 = c & 15;
            *(LAS u32x4*)(lds + AT_QS + row * 272 + c16 * 16) = *(const u32x4*)(Qb + (size_t)(b * SEQ + t0 + row) * D + h * 128 + c16 * 8);
        }
        {
            LAS unsigned char* kb_ = lds + AT_K0; LAS unsigned char* vb_ = lds + AT_V0;
            *(LAS u32x4*)(kb_ + kr0 * 272 + kc * 16) = pk0; *(LAS u32x4*)(kb_ + (kr0 + 32) * 272 + kc * 16) = pk1;
            *(LAS u32x4*)(vb_ + vr0 * 144 + vc * 16) = pv0; *(LAS u32x4*)(vb_ + (vr0 + 64) * 144 + vc * 16) = pv1;
            const int s1 = s0 - 64;
            pk0 = *(const u32x4*)(kg + (size_t)s1 * D); pk1 = *(const u32x4*)(kg + (size_t)(s1 + 32) * D); pv0 = *(const u32x4*)(vg + s1); pv1 = *(const u32x4*)(vg + (size_t)64 * T + s1);
        }
        __syncthreads();
        f32x4 oacc[2][8];
#pragma unroll
        for (int r = 0; r < 2; ++r)
#pragma unroll
            for (int n = 0; n < 8; ++n) oacc[r][n] = (f32x4){0.f, 0.f, 0.f, 0.f};
        float Rrun[2] = {0.f, 0.f};
        bool wave_alive = true;
        int it = 0;
        for (;; ++it, s0 -= 64) {
            int zz = 0; asm volatile("" : "+v"(zz));
            const LAS unsigned char* kb_ = lds + zz + AT_K0 + (it & 1) * AT_KVB; const LAS unsigned char* vb_ = lds + zz + AT_V0 + (it & 1) * AT_KVB;
            const bool wave_on = (s0 < t0 + 32 * wid + 31) && wave_alive;
            if (wave_on) {
            f32x4 sacc[2][4];
#pragma unroll
            for (int r = 0; r < 2; ++r)
#pragma unroll
                for (int n = 0; n < 4; ++n) sacc[r][n] = (f32x4){0.f, 0.f, 0.f, 0.f};
#pragma unroll
            for (int ks = 0; ks < 4; ++ks) {
                const bf16x8 qa0 = *(const LAS bf16x8*)(lds + zz + AT_QS + (32 * wid + fr) * 272 + (ks * 32 + fq * 8) * 2);
                const bf16x8 qa1 = *(const LAS bf16x8*)(lds + zz + AT_QS + (32 * wid + 16 + fr) * 272 + (ks * 32 + fq * 8) * 2);
#pragma unroll
                for (int n = 0; n < 4; ++n) {
                    const bf16x8 kf = *(const LAS bf16x8*)(kb_ + (16 * n + fr) * 272 + (ks * 32 + fq * 8) * 2);
                    sacc[0][n] = MFMA16(kf, qa0, sacc[0][n]);
                    sacc[1][n] = MFMA16(kf, qa1, sacc[1][n]);
                }
            }
            unsigned ap[2][4][2];
            const int sb = s0 + 4 * fq;
#pragma unroll
            for (int r = 0; r < 2; ++r) {
                const int tq = t0 + 32 * wid + 16 * r + fr;
                float cs_[4][4], gsum[4];
#pragma unroll
                for (int n = 0; n < 4; ++n) {
                    float run = 0.f;
#pragma unroll
                    for (int j = 3; j >= 0; --j) {
                        const float zz = sacc[r][n][j];
                        const float sp = fmaxf(zz, 0.f) + __builtin_amdgcn_logf(1.0f + __builtin_amdgcn_exp2f(-fabsf(zz)));
                        run -= ((sb + 16 * n + j) < tq) ? sp : 0.f;
                        cs_[n][j] = run;
                    }
                    gsum[n] = run;
                }
                float offs[4]; float acc_after = 0.f;
#pragma unroll
                for (int n = 3; n >= 0; --n) {
                    const float bq = __shfl_xor(gsum[n], 16); const float s01 = gsum[n] + bq; const float oth = __shfl_xor(s01, 32);
                    offs[n] = Rrun[r] + acc_after + (((fq & 1) == 0) ? bq : 0.f) + ((fq < 2) ? oth : 0.f);
                    acc_after += s01 + oth;
                }
                Rrun[r] += acc_after;
#pragma unroll
                for (int n = 0; n < 4; ++n) {
                    float av[4];
#pragma unroll
                    for (int j = 0; j < 4; ++j) av[j] = ((sb + 16 * n + j) < tq) ? __builtin_amdgcn_exp2f(sacc[r][n][j] + cs_[n][j] + offs[n]) : 0.f;
                    ap[r][n][0] = pk2(av[0], av[1]); ap[r][n][1] = pk2(av[2], av[3]);
                }
            }
#pragma unroll
            for (int u = 0; u < 2; ++u) {
                const bf16x8 aa0 = __builtin_bit_cast(bf16x8, ((u32x4){ap[0][2 * u][0], ap[0][2 * u][1], ap[0][2 * u + 1][0], ap[0][2 * u + 1][1]}));
                const bf16x8 aa1 = __builtin_bit_cast(bf16x8, ((u32x4){ap[1][2 * u][0], ap[1][2 * u][1], ap[1][2 * u + 1][0], ap[1][2 * u + 1][1]}));
#pragma unroll
                for (int n = 0; n < 8; ++n) {
                    const s16x4 vlo = *(const LAS s16x4*)(vb_ + (16 * n + fr) * 144 + (32 * u + 4 * fq) * 2);
                    const s16x4 vhi = *(const LAS s16x4*)(vb_ + (16 * n + fr) * 144 + (32 * u + 16 + 4 * fq) * 2);
                    const bf16x8 vf = __builtin_shufflevector(vlo, vhi, 0, 1, 2, 3, 4, 5, 6, 7);
                    oacc[0][n] = MFMA16(vf, aa0, oacc[0][n]);
                    oacc[1][n] = MFMA16(vf, aa1, oacc[1][n]);
                }
            }
            }
            const int sn1 = s0 - 64, sn2 = s0 - 128;
            wave_alive = __any(fmaxf(Rrun[0], Rrun[1]) > -160.0f);
            if (lane == 0) flags[(it & 1) * 8 + wid] = wave_alive ? 1 : 0;
            if (sn1 >= 0) {
                LAS unsigned char* kn = lds + AT_K0 + ((it + 1) & 1) * AT_KVB; LAS unsigned char* vn = lds + AT_V0 + ((it + 1) & 1) * AT_KVB;
                *(LAS u32x4*)(kn + kr0 * 272 + kc * 16) = pk0; *(LAS u32x4*)(kn + (kr0 + 32) * 272 + kc * 16) = pk1;
                *(LAS u32x4*)(vn + vr0 * 144 + vc * 16) = pv0; *(LAS u32x4*)(vn + (vr0 + 64) * 144 + vc * 16) = pv1;
                if (sn2 >= 0) { pk0 = *(const u32x4*)(kg + (size_t)sn2 * D); pk1 = *(const u32x4*)(kg + (size_t)(sn2 + 32) * D); pv0 = *(const u32x4*)(vg + sn2); pv1 = *(const u32x4*)(vg + (size_t)64 * T + sn2); }
            }
            __syncthreads();
            if (sn1 < 0) break;
            int any_alive = 0;
#pragma unroll
            for (int w = 0; w < 8; ++w) any_alive |= flags[(it & 1) * 8 + w];
            if (!any_alive) break;
        }
#pragma unroll
        for (int r = 0; r < 2; ++r) {
            bf16_t* orow = O + (size_t)(b * SEQ + t0 + 32 * wid + 16 * r + fr) * D + h * 128 + 4 * fq;
#pragma unroll
            for (int n = 0; n < 8; ++n) { u32x2 o; o.x = pk2(oacc[r][n].x, oacc[r][n].y); o.y = pk2(oacc[r][n].z, oacc[r][n].w); *(u32x2*)(orow + 16 * n) = o; }
        }
    }
}

constexpr int ML_QS = 0, ML_KS = 17408, ML_KD = 34816, ML_VT = 53248, ML_WS = 90112, ML_HB = 99328, ML_SC = 133120;
DI float ml_tab(LAS float* tab, float gi, float gf, float mprev, int lane) {
    const float flog = fminf(gf, 0.f) - __logf(1.0f + __expf(-fabsf(gf)));
    float bb = flog;
#pragma unroll
    for (int o = 1; o < 64; o <<= 1) { const float v = __shfl_up(bb, o); if (lane >= o) bb += v; }
    const float a = gi - bb;
    float pm = a;
#pragma unroll
    for (int o = 1; o < 64; o <<= 1) { const float v = __shfl_up(pm, o); if (lane >= o) pm = fmaxf(pm, v); }
    const float amax = __shfl(pm, 63), bL = __shfl(bb, 63);
    const float Mx = fmaxf(mprev, amax);
    tab[lane] = a; tab[64 + lane] = bb; tab[128 + lane] = fmaxf(pm, mprev);
    if (lane == 0) { tab[192] = mprev; tab[193] = Mx; }
    return bL + Mx;
}
constexpr int MLA_KD = 0, MLA_SC = 69632;
DI void mlstm_local(const bf16_t* K1, const bf16_t* VT, const float* G, const float* b_i, const float* b_f, bf16_t* KV, float* NJ, float* SUM,
                    LAS unsigned char* lds, int tid, int wid, int lane) {
    const int fr = lane & 15, fq = lane >> 4;
    LAS float* sa = (LAS float*)(lds + MLA_SC); LAS float* swsum = sa + 256; LAS float* swmax = sa + 264;
    for (int unit = blockIdx.x; unit < 256; unit += gridDim.x) {
        const int J = unit & 7, bh = unit >> 3, b = bh >> 3, h = bh & 7;
        if (J == 7) continue;
        const int tok0 = b * SEQ + J * 256;
        __syncthreads();
        float a = 0.f, bb = 0.f;
        if (tid < 256) {
            const size_t g0 = (size_t)(tok0 + tid) * 16;
            const float gi = G[g0 + h] + b_i[h], gf = G[g0 + 8 + h] + b_f[h];
            const float flog = fminf(gf, 0.f) - __logf(1.0f + __expf(-fabsf(gf)));
            bb = flog;
#pragma unroll
            for (int o = 1; o < 64; o <<= 1) { const float v = __shfl_up(bb, o); if (lane >= o) bb += v; }
            if (lane == 63) swsum[wid] = bb;
        }
        __syncthreads();
        if (tid < 256) {
            float off = 0.f;
            for (int w = 0; w < 4; ++w) off += (w < wid) ? swsum[w] : 0.f;
            bb += off;
            const size_t g0 = (size_t)(tok0 + tid) * 16;
            a = (G[g0 + h] + b_i[h]) - bb;
            float mx = a;
#pragma unroll
            for (int o = 1; o < 64; o <<= 1) mx = fmaxf(mx, __shfl_xor(mx, o));
            if (lane == 0) swmax[wid] = mx;
            sa[tid] = a;
        }
        __syncthreads();
        const float amax = fmaxf(fmaxf(swmax[0], swmax[1]), fmaxf(swmax[2], swmax[3]));
        if (tid == 255) { SUM[unit * 2] = amax; SUM[unit * 2 + 1] = bb; }
        bf16x8 vfa[8][2];
#pragma unroll
        for (int ks = 0; ks < 8; ++ks)
#pragma unroll
            for (int et = 0; et < 2; ++et) vfa[ks][et] = *(const bf16x8*)(VT + (size_t)(h * 256 + 32 * wid + 16 * et + fr) * T + tok0 + ks * 32 + fq * 8);
#pragma unroll 2
        for (int c8i = 0; c8i < 8; ++c8i) {
            const int ch = tid + 512 * c8i, sp = ch & 255, c16 = ch >> 8;
            const u32x4 v = *(const u32x4*)(K1 + (size_t)(tok0 + sp) * 1024 + h * 128 + c16 * 8);
            const float dsc = __expf(sa[sp] - amax);
            const unsigned w[4] = {v.x, v.y, v.z, v.w};
            LAS bf16_t* dst = (LAS bf16_t*)(lds + MLA_KD + (c16 * 8) * 528 + sp * 2);
#pragma unroll
            for (int q = 0; q < 4; ++q) { dst[(2 * q) * 264] = (bf16_t)f2bf(bf2f(w[q] & 0xffff) * dsc); dst[(2 * q + 1) * 264] = (bf16_t)f2bf(bf2f(w[q] >> 16) * dsc); }
        }
        __syncthreads();
        f32x4 C[8][2];
#pragma unroll
        for (int dt = 0; dt < 8; ++dt)
#pragma unroll
            for (int et = 0; et < 2; ++et) C[dt][et] = (f32x4){0.f, 0.f, 0.f, 0.f};
#pragma unroll
        for (int ks = 0; ks < 8; ++ks) {
#pragma unroll
            for (int dt = 0; dt < 8; ++dt) {
                const bf16x8 kf = *(const LAS bf16x8*)(lds + MLA_KD + (16 * dt + fr) * 528 + (ks * 32 + fq * 8) * 2);
#pragma unroll
                for (int et = 0; et < 2; ++et) C[dt][et] = MFMA16(kf, vfa[ks][et], C[dt][et]);
            }
        }
        bf16_t* kv = KV + (size_t)unit * 32768;
#pragma unroll
        for (int dt = 0; dt < 8; ++dt)
#pragma unroll
            for (int et = 0; et < 2; ++et) { u32x2 o; o.x = pk2(C[dt][et].x, C[dt][et].y); o.y = pk2(C[dt][et].z, C[dt][et].w); *(u32x2*)(kv + (size_t)(32 * wid + 16 * et + fr) * 128 + 16 * dt + 4 * fq) = o; }
        {
            const int dl = tid >> 2, sl = tid & 3;
            float p = 0.f;
#pragma unroll
            for (int i = 0; i < 8; ++i) {
                const u32x4 kq = *(const LAS u32x4*)(lds + MLA_KD + dl * 528 + sl * 128 + i * 16);
                p += (bf2f(kq.x & 0xffff) + bf2f(kq.x >> 16)) + (bf2f(kq.y & 0xffff) + bf2f(kq.y >> 16)) + (bf2f(kq.z & 0xffff) + bf2f(kq.z >> 16)) + (bf2f(kq.w & 0xffff) + bf2f(kq.w >> 16));
            }
            p += __shfl_xor(p, 1); p += __shfl_xor(p, 2);
            if (sl == 0) NJ[unit * 128 + dl] = p;
        }
    }
}
template <int skip>
DI void mlstm_phase(const bf16_t* Q1, const bf16_t* K1, const bf16_t* VT, const bf16_t* OG, const float* G, const float* b_i, const float* b_f,
                    const float* g_head, bf16_t* HS, const bf16_t* KV, const float* NJ, const float* SUM, LAS unsigned char* lds, int tid, int wid, int lane, int nsteps = 4) {
    const int fr = lane & 15, fq = lane >> 4;
    LAS float* sc = (LAS float*)(lds + ML_SC); LAS float* sssq = sc + 1024; LAS float* srs = sc + 1536; LAS float* sden = sc + 1792; LAS float* sn = sc + 1856; LAS float* sgh = sc + 2112; LAS float* scf = sc + 2368;
    LAS bf16_t* hb = (LAS bf16_t*)(lds + ML_HB);
    for (int unit = blockIdx.x; unit < 256; unit += gridDim.x) {
        const int J = unit & 7, bh = unit >> 3, b = bh >> 3, h = bh & 7;
        const int c0 = 4 * J, c1 = c0 + nsteps;
        __syncthreads();
        if (wid < 4) {
            LAS float* tab = sc + wid * 256;
            const size_t g0 = (size_t)(b * SEQ + (c0 + wid) * 64 + lane) * 16;
            const float gi = G[g0 + h] + b_i[h], gf = G[g0 + 8 + h] + b_f[h];
            const float flog = fminf(gf, 0.f) - __logf(1.0f + __expf(-fabsf(gf)));
            float bb = flog;
#pragma unroll
            for (int o = 1; o < 64; o <<= 1) { const float v = __shfl_up(bb, o); if (lane >= o) bb += v; }
            const float a = gi - bb;
            float pm = a;
#pragma unroll
            for (int o = 1; o < 64; o <<= 1) { const float v = __shfl_up(pm, o); if (lane >= o) pm = fmaxf(pm, v); }
            tab[lane] = a; tab[64 + lane] = bb; tab[128 + lane] = pm;
            if (lane == 63) { tab[192] = pm; tab[193] = bb; }
        }
        if (tid >= 448 && tid < 462) scf[8 + tid - 448] = SUM[bh * 16 + tid - 448];
        __syncthreads();
        if (tid == 0) {
            float cf[7]; float m0 = 0.f;
#pragma unroll
            for (int jp = 0; jp < 7; ++jp) {
                cf[jp] = 0.f;
                if (jp < J) {
                    const float am = scf[8 + 2 * jp], bl = scf[9 + 2 * jp];
                    const float M63 = fmaxf(m0, am), csj = __expf(m0 - M63);
#pragma unroll
                    for (int i = 0; i < 7; ++i) if (i < jp) cf[i] *= csj;
                    cf[jp] = __expf(am - M63);
                    m0 = bl + M63;
                }
            }
#pragma unroll
            for (int jp = 0; jp < 7; ++jp) scf[jp] = cf[jp];
            scf[7] = m0;
        }
        __syncthreads();
        const float m0 = scf[7];
        f32x4 C[8][2];
#pragma unroll
        for (int dt = 0; dt < 8; ++dt)
#pragma unroll
            for (int et = 0; et < 2; ++et) C[dt][et] = (f32x4){0.f, 0.f, 0.f, 0.f};
        float n0 = 0.f;
#pragma unroll 1
        for (int jp = 0; jp < J; ++jp) {
            const bf16_t* kv = KV + (size_t)(bh * 8 + jp) * 32768; const float cf = scf[jp];
#pragma unroll
            for (int dt = 0; dt < 8; ++dt)
#pragma unroll
                for (int et = 0; et < 2; ++et) { const u32x2 v = *(const u32x2*)(kv + (size_t)(32 * wid + 16 * et + fr) * 128 + 16 * dt + 4 * fq);
                    C[dt][et].x += cf * bf2f(v.x & 0xffff); C[dt][et].y += cf * bf2f(v.x >> 16); C[dt][et].z += cf * bf2f(v.y & 0xffff); C[dt][et].w += cf * bf2f(v.y >> 16); }
            if (tid < 128) n0 += cf * NJ[(bh * 8 + jp) * 128 + tid];
        }
        if (tid < 128) sn[tid] = n0;
        if (tid >= 256) sgh[tid - 256] = g_head[h * 256 + tid - 256];
        __syncthreads();
        if (tid == 0) { float m = m0; for (int cc = 0; cc < 4; ++cc) { LAS float* tab = sc + cc * 256; const float M63 = fmaxf(m, tab[192]); tab[194] = m; tab[195] = M63; m = tab[193] + M63; } }
        __syncthreads();
        u32x4 rq[2], rk[2], rt[2], rv[4];
#define ML_LOAD(cc) do { const int tk_ = b * SEQ + (cc) * 64; _Pragma("unroll") for (int c2 = 0; c2 < 2; ++c2) { const int ch = tid + 512 * c2; \
            rq[c2] = *(const u32x4*)(Q1 + (size_t)(tk_ + (ch >> 4)) * 1024 + h * 128 + (ch & 15) * 8); rk[c2] = *(const u32x4*)(K1 + (size_t)(tk_ + (ch >> 4)) * 1024 + h * 128 + (ch & 15) * 8); \
            rt[c2] = *(const u32x4*)(K1 + (size_t)(tk_ + (ch & 63)) * 1024 + h * 128 + (ch >> 6) * 8); } \
        _Pragma("unroll") for (int c4 = 0; c4 < 4; ++c4) { const int ch = tid + 512 * c4; rv[c4] = *(const u32x4*)(VT + (size_t)(h * 256 + (ch >> 3)) * T + tk_ + (ch & 7) * 8); } } while (0)
#define ML_STORE(cc) do { const LAS float* tb_ = sc + ((cc) - c0) * 256; const float M63_ = tb_[195]; _Pragma("unroll") for (int c2 = 0; c2 < 2; ++c2) { const int ch = tid + 512 * c2; \
            *(LAS u32x4*)(lds + ML_QS + (ch >> 4) * 272 + (ch & 15) * 16) = rq[c2]; *(LAS u32x4*)(lds + ML_KS + (ch >> 4) * 272 + (ch & 15) * 16) = rk[c2]; \
            const int sp = ch & 63, c16 = ch >> 6; const float dsc = __expf(tb_[sp] - M63_); const unsigned w_[4] = {rt[c2].x, rt[c2].y, rt[c2].z, rt[c2].w}; \
            LAS bf16_t* dst = (LAS bf16_t*)(lds + ML_KD + (c16 * 8) * 144 + sp * 2); \
            _Pragma("unroll") for (int q = 0; q < 4; ++q) { dst[(2 * q) * 72] = (bf16_t)f2bf(bf2f(w_[q] & 0xffff) * dsc); dst[(2 * q + 1) * 72] = (bf16_t)f2bf(bf2f(w_[q] >> 16) * dsc); } } \
        _Pragma("unroll") for (int c4 = 0; c4 < 4; ++c4) { const int ch = tid + 512 * c4; *(LAS u32x4*)(lds + ML_VT + (ch >> 3) * 144 + (ch & 7) * 16) = rv[c4]; } } while (0)
        if (c0 < c1) { ML_LOAD(c0); ML_STORE(c0); }
#pragma unroll 1
        for (int c = c0; c < c1; ++c) {
            int zz = 0; asm volatile("" : "+v"(zz));
            LAS unsigned char* const L = lds + zz; LAS float* const scz = (LAS float*)(L + ML_SC);
            LAS float* const sssq = scz + 1024; LAS float* const srs = scz + 1536; LAS float* const sden = scz + 1792; LAS float* const sn = scz + 1856; LAS float* const sgh = scz + 2112; LAS bf16_t* const hb = (LAS bf16_t*)(L + ML_HB);
            const int tok0 = b * SEQ + c * 64;
            const LAS float* tab = scz + (c - c0) * 256;
            LAS float* sncur = sn + ((c - c0) & 1) * 128; LAS float* snnxt = sn + (((c - c0) & 1) ^ 1) * 128;
            __syncthreads();
            const float mprev = tab[194], M63 = tab[195];
            if (!(skip & 1)) {
                const int tb = wid >> 1;
#pragma unroll
                for (int a2 = 0; a2 < 2; ++a2) {
                    const int sa_t = 2 * (wid & 1) + a2;
                    u32x2 o = (u32x2){0u, 0u}; float rsum = 0.f;
                    if (sa_t <= tb) {
                        f32x4 acc = (f32x4){0.f, 0.f, 0.f, 0.f};
#pragma unroll
                        for (int ks = 0; ks < 4; ++ks) {
                            const bf16x8 kf = *(const LAS bf16x8*)(L + ML_KS + (16 * sa_t + fr) * 272 + (ks * 32 + fq * 8) * 2);
                            const bf16x8 qf = *(const LAS bf16x8*)(L + ML_QS + (16 * tb + fr) * 272 + (ks * 32 + fq * 8) * 2);
                            acc = MFMA16(kf, qf, acc);
                        }
                        const int tl = 16 * tb + fr; const float Mt = fmaxf(tab[128 + tl], mprev);
                        float wv[4];
#pragma unroll
                        for (int j = 0; j < 4; ++j) { const int sl = 16 * sa_t + 4 * fq + j; wv[j] = (sl <= tl) ? acc[j] * __expf(tab[sl] - Mt) : 0.f; }
                        o.x = pk2(wv[0], wv[1]); o.y = pk2(wv[2], wv[3]);
                        rsum = (wv[0] + wv[1]) + (wv[2] + wv[3]);
                        rsum += __shfl_xor(rsum, 16); rsum += __shfl_xor(rsum, 32);
                    }
                    *(LAS u32x2*)(L + ML_WS + (16 * tb + fr) * 144 + (16 * sa_t + 4 * fq) * 2) = o;
                    if (fq == 0) srs[sa_t * 64 + 16 * tb + fr] = rsum;
                }
            }
            __syncthreads();
            if (!(skip & 2)) {
                const int tl = tid >> 3, sl = tid & 7;
                const u32x4 qa = *(const LAS u32x4*)(L + ML_QS + tl * 272 + sl * 32), qb = *(const LAS u32x4*)(L + ML_QS + tl * 272 + sl * 32 + 16);
                const unsigned qw[8] = {qa.x, qa.y, qa.z, qa.w, qb.x, qb.y, qb.z, qb.w};
                float p = 0.f;
#pragma unroll
                for (int k = 0; k < 8; ++k) p += bf2f(qw[k] & 0xffff) * sncur[sl * 16 + 2 * k] + bf2f(qw[k] >> 16) * sncur[sl * 16 + 2 * k + 1];
                p += __shfl_xor(p, 1); p += __shfl_xor(p, 2); p += __shfl_xor(p, 4);
                if (sl == 0) sden[tl] = __expf(mprev - fmaxf(tab[128 + tl], mprev)) * p + (srs[tl] + srs[64 + tl]) + (srs[128 + tl] + srs[192 + tl]);
            }
#pragma unroll 1
            for (int tt = 0; tt < ((skip & 4) ? 0 : 4); ++tt) {
                f32x4 num[2];
#pragma unroll
                for (int et = 0; et < 2; ++et) num[et] = (f32x4){0.f, 0.f, 0.f, 0.f};
#pragma unroll
                for (int u = 0; u < 4; ++u) {
                    const s16x4 qlo = *(const LAS s16x4*)(L + ML_QS + (16 * tt + fr) * 272 + (32 * u + 4 * fq) * 2);
                    const s16x4 qhi = *(const LAS s16x4*)(L + ML_QS + (16 * tt + fr) * 272 + (32 * u + 16 + 4 * fq) * 2);
                    const bf16x8 qf = __builtin_shufflevector(qlo, qhi, 0, 1, 2, 3, 4, 5, 6, 7);
#pragma unroll
                    for (int et = 0; et < 2; ++et) {
                        const f32x4 c0v = C[2 * u][et], c1v = C[2 * u + 1][et];
                        u32x4 pb; pb.x = pk2(c0v.x, c0v.y); pb.y = pk2(c0v.z, c0v.w); pb.z = pk2(c1v.x, c1v.y); pb.w = pk2(c1v.z, c1v.w);
                        num[et] = MFMA16(qf, __builtin_bit_cast(bf16x8, pb), num[et]);
                    }
                }
                float scv[4];
#pragma unroll
                for (int j = 0; j < 4; ++j) scv[j] = __expf(mprev - fmaxf(tab[128 + 16 * tt + 4 * fq + j], mprev));
#pragma unroll
                for (int et = 0; et < 2; ++et) { num[et].x *= scv[0]; num[et].y *= scv[1]; num[et].z *= scv[2]; num[et].w *= scv[3]; }
                const int nks = (tt < 2) ? 1 : 2;
                for (int ks = 0; ks < nks; ++ks) {
                    const bf16x8 wf = *(const LAS bf16x8*)(L + ML_WS + (16 * tt + fr) * 144 + (ks * 32 + fq * 8) * 2);
#pragma unroll
                    for (int et = 0; et < 2; ++et) {
                        const bf16x8 vf = *(const LAS bf16x8*)(L + ML_VT + (32 * wid + 16 * et + fr) * 144 + (ks * 32 + fq * 8) * 2);
                        num[et] = MFMA16(wf, vf, num[et]);
                    }
                }
#pragma unroll
                for (int j = 0; j < 4; ++j) {
                    const int tl = 16 * tt + 4 * fq + j;
                    const float h0 = num[0][j], h1 = num[1][j];
                    hb[tl * 264 + 32 * wid + fr] = (bf16_t)f2bf(h0);
                    hb[tl * 264 + 32 * wid + 16 + fr] = (bf16_t)f2bf(h1);
                    float s = h0 * h0 + h1 * h1;
                    s += dpp_f(s, 0xB1); s += dpp_f(s, 0x4E); s += dpp_f(s, 0x141); s += dpp_f(s, 0x140);
                    if (fr == 0) sssq[wid * 64 + tl] = s;
                }
            }
            const float cs = __expf(mprev - M63);
            if (!(skip & 8)) {
#pragma unroll
                for (int dt = 0; dt < 8; ++dt)
#pragma unroll
                    for (int et = 0; et < 2; ++et) { C[dt][et].x *= cs; C[dt][et].y *= cs; C[dt][et].z *= cs; C[dt][et].w *= cs; }
#pragma unroll
                for (int ks = 0; ks < 2; ++ks) {
                    bf16x8 vf[2];
#pragma unroll
                    for (int et = 0; et < 2; ++et) vf[et] = *(const LAS bf16x8*)(L + ML_VT + (32 * wid + 16 * et + fr) * 144 + (ks * 32 + fq * 8) * 2);
#pragma unroll
                    for (int dt = 0; dt < 8; ++dt) {
                        const bf16x8 kf = *(const LAS bf16x8*)(L + ML_KD + (16 * dt + fr) * 144 + (ks * 32 + fq * 8) * 2);
#pragma unroll
                        for (int et = 0; et < 2; ++et) C[dt][et] = MFMA16(kf, vf[et], C[dt][et]);
                    }
                }
            }
            {
                const int dl = tid >> 2, sl = tid & 3;
                const u32x4 ka = *(const LAS u32x4*)(L + ML_KD + dl * 144 + sl * 32), kb = *(const LAS u32x4*)(L + ML_KD + dl * 144 + sl * 32 + 16);
                const unsigned kw[8] = {ka.x, ka.y, ka.z, ka.w, kb.x, kb.y, kb.z, kb.w};
                float p = 0.f;
#pragma unroll
                for (int k = 0; k < 8; ++k) p += bf2f(kw[k] & 0xffff) + bf2f(kw[k] >> 16);
                p += __shfl_xor(p, 1); p += __shfl_xor(p, 2);
                if (sl == 0) snnxt[dl] = cs * sncur[dl] + p;
            }
            __syncthreads();
            if (skip & 16) { if (c + 1 < c1) ML_LOAD(c + 1); } else {
                const int tl = tid >> 3, part = tid & 7;
                u32x4 ovq[4];
#pragma unroll
                for (int q = 0; q < 4; ++q) ovq[q] = *(const u32x4*)(OG + (size_t)(tok0 + tl) * D + h * 256 + (part + 8 * q) * 8);
                if (c + 1 < c1) ML_LOAD(c + 1);
                float tot = 0.f;
#pragma unroll
                for (int w = 0; w < 8; ++w) tot += sssq[w * 64 + tl];
                const float dd = 1.0f / fmaxf(fabsf(sden[tl]), __expf(-(tab[64 + tl] + fmaxf(tab[128 + tl], mprev))));
                const float rinv = dd / sqrtf(tot * dd * dd * (1.0f / 256.0f) + EPS);
#pragma unroll
                for (int q = 0; q < 4; ++q) {
                    const int e0 = (part + 8 * q) * 8;
                    const u32x4 hv = *(const LAS u32x4*)(L + ML_HB + tl * 528 + e0 * 2);
                    const size_t idx = (size_t)(tok0 + tl) * D + h * 256 + e0;
                    const u32x4 ov = ovq[q];
                    const f32x4 g0 = *(const LAS f32x4*)(sgh + e0), g1 = *(const LAS f32x4*)(sgh + e0 + 4);
                    const unsigned hw[4] = {hv.x, hv.y, hv.z, hv.w}, ow[4] = {ov.x, ov.y, ov.z, ov.w};
                    const float gg[8] = {g0.x, g0.y, g0.z, g0.w, g1.x, g1.y, g1.z, g1.w};
                    unsigned r[4];
#pragma unroll
                    for (int k = 0; k < 4; ++k) {
                        const float ha = bf2f(hw[k] & 0xffff), hbv = bf2f(hw[k] >> 16), oa = bf2f(ow[k] & 0xffff), ob = bf2f(ow[k] >> 16);
                        r[k] = pk2(ha * rinv * gg[2 * k] / (1.0f + __expf(-oa)), hbv * rinv * gg[2 * k + 1] / (1.0f + __expf(-ob)));
                    }
                    *(u32x4*)(HS + idx) = (u32x4){r[0], r[1], r[2], r[3]};
                }
            }
            if (c + 1 < c1) ML_STORE(c + 1);
        }
#undef ML_LOAD
#undef ML_STORE
    }
}

DI void convert_moe_layer(int l, bool do13, bool do2, int gw, int NGW, const float* w1, const float* w3, const float* w2, bf16_t* W13, bf16_t* W2, LAS unsigned char* lds, int wid, int lane) {
    LAS float* scr = (LAS float*)(lds + wid * 16640);
    constexpr int I_W1 = 32 * 32 * 4, I_W2 = 32 * 4 * 32;
    if (do13) for (int it = gw; it < 2 * I_W1; it += NGW) {
        const int which = it / I_W1, r = it % I_W1, le = l * NE + r / 128, q = r % 128;
        transpose_item((which ? w3 : w1) + (size_t)le * D * FF, FF, W13 + (size_t)le * 512 * D, D, 64 * (q / 4), 64 * (q % 4), 1 + which, scr, lane); }
    if (do2) for (int it = gw; it < I_W2; it += NGW) {
        const int le = l * NE + it / 128, q = it % 128;
        transpose_item(w2 + (size_t)le * FF * D, D, W2 + (size_t)le * D * FF, FF, 64 * (q / 32), 64 * (q % 32), 0, scr, lane); }
}

__global__ void __launch_bounds__(NTHREADS, 2) fwd_kernel(Args args) {
    extern __shared__ __attribute__((aligned(16))) unsigned char lds_raw[];
    LAS unsigned char* lds = (LAS unsigned char*)lds_raw;
    const int tid = threadIdx.x, lane = tid & 63, wid = __builtin_amdgcn_readfirstlane(tid >> 6);
    unsigned char* ws = args.ws;
    unsigned* ctl = (unsigned*)(ws + WS_CTL);
    volatile LAS unsigned* misc = (volatile LAS unsigned*)(lds + LDS_BYTES - 256);
    if (tid < 16) misc[tid] = 0u;
    __syncthreads();
    XcdBarrier bar; bar.bar = ctl + CW_BAR; bar.x = 0; bar.st = misc;
    const int lo = args.ph_lo, hi = args.ph_hi;
    if (PROBE_A >= 0 && blockIdx.x == 0 && tid == 0) misc[16] = (unsigned)__builtin_amdgcn_s_memrealtime();
    if (hi - lo > 1) bar = xcd_barrier_post(ctl + CW_BAR, misc);
#ifndef PHMASK
#define PHMASK 0xffff
#endif
#define IN(k) (((PHMASK >> (k)) & 1) && lo <= (k) && (k) < hi)
#ifndef XBAR
#define XBAR 0
#endif
#define SEAM(k) do { if (IN(k) && IN((k) + 1)) { xcd_barrier(bar); if ((k) == 5) for (int xb_ = 0; xb_ < XBAR; ++xb_) xcd_barrier(bar); } if (PROBE_A >= 0 && blockIdx.x == 0 && tid == 0) misc[16 + (k) + 1] = (unsigned)__builtin_amdgcn_s_memrealtime(); } while (0)

#define PH(k, ...) { __VA_ARGS__ } if ((REPEAT_MASK >> (k)) & 1) { xcd_barrier(bar); { __VA_ARGS__ } }
#define LZ(z) int z = 0; asm volatile("" : "+s"(z))
#define INP(k) (args.in[k] + z)
#define WSP(type, off) ((type*)(ws + (off) + z))
#define ACT(type, off) ((type*)(ws + WS_ACT + (off) + z))

    PH(0, if (IN(0)) {
        LZ(z);
        const float* sb_w_in = INP(4); const float* sb_w_out = INP(5); const float* ml_w_in = INP(6); const float* ml_w_out = INP(10);
        const float* moe_w1 = INP(15); const float* moe_w3 = INP(16); const float* moe_w2 = INP(17);
        bf16_t* Wsbin = WSP(bf16_t, WS_WSBIN); bf16_t* Wsbout = WSP(bf16_t, WS_WSBOUT); bf16_t* Wmlin = WSP(bf16_t, WS_WMLIN); bf16_t* Wmlout = WSP(bf16_t, WS_WMLOUT);
        bf16_t* W13 = WSP(bf16_t, WS_W13); bf16_t* W2 = WSP(bf16_t, WS_W2);
        LAS float* scr = (LAS float*)(lds + wid * 16640);
        const int gw = blockIdx.x * 8 + wid, NGW = gridDim.x * 8;
        constexpr int I_SBIN = 32 * 96, I_SBOUT = 32 * 32, I_MLIN = 32 * 96, I_MLOUT = 32 * 32;
        constexpr int NITEMS = I_SBIN + I_SBOUT + I_MLIN + I_MLOUT;
        for (int it0 = gw; it0 < NITEMS; it0 += NGW) {
            int r = NITEMS - 1 - it0;
            if (r < I_SBIN) { transpose_item(sb_w_in, 6144, Wsbin, D, 64 * (r / 96), 64 * (r % 96), 0, scr, lane); continue; } r -= I_SBIN;
            if (r < I_SBOUT) { transpose_item(sb_w_out, D, Wsbout, D, 64 * (r / 32), 64 * (r % 32), 0, scr, lane); continue; } r -= I_SBOUT;
            if (r < I_MLIN) { transpose_item(ml_w_in, ML_IN, Wmlin, D, 64 * (r / 96), 64 * (r % 96), 0, scr, lane); continue; } r -= I_MLIN;
            transpose_item(ml_w_out, D, Wmlout, D, 64 * (r / 32), 64 * (r % 32), 0, scr, lane);
        }
        {
            const float* wg = INP(11); const float* we = INP(13); const float* wml = INP(6);
            bf16_t* wr = WSP(bf16_t, WS_WR); bf16_t* wgi = WSP(bf16_t, WS_WG);
            const int gt = blockIdx.x * NTHREADS + tid, NGT = gridDim.x * NTHREADS;
            for (int idx = gt; idx < 2 * 98304 + 32768; idx += NGT) {
                if (idx < 2 * 98304) {
                    const int l = idx / 98304, r = idx % 98304, j = r & 7, ln = (r >> 3) & 63, q = r >> 9, nt = q % 3, ks = q / 3;
                    const int k = 32 * ks + 8 * (ln >> 4) + j, n = 16 * nt + (ln & 15);
                    const float w = (n < 4) ? wg[(size_t)l * D * 4 + k * 4 + n] : ((n < 36) ? we[(size_t)l * D * 32 + k * 32 + (n - 4)] : 0.f);
                    wr[(size_t)l * (WR_BYTES / 2) + r] = (bf16_t)f2bf(w);
                } else {
                    const int r = idx - 2 * 98304, j = r & 7, ln = (r >> 3) & 63, ks = r >> 9;
                    const int k = 32 * ks + 8 * (ln >> 4) + j, n = ln & 15;
                    wgi[r] = (bf16_t)f2bf(wml[(size_t)k * ML_IN + 6144 + n]);
                }
            }
        }
        __syncthreads();
        NormP p{}; p.src = INP(0); p.H = WSP(bf16_t, WS_H); p.g = INP(1);
        norm_phase<0, false>(p, lds, tid, wid, lane);
    })
    SEAM(0);
    PH(1, if (IN(1)) {
        LZ(z);
        bf16_t* H = WSP(bf16_t, WS_H); bf16_t* Wsbin = WSP(bf16_t, WS_WSBIN);
        if (tid == 0) {
            pg8::put_job(lds, 0, H, Wsbin, T, 4096, ACT(bf16_t, A_Q), ACT(bf16_t, A_K), D, 2048, 0.12751743074602467f);
            pg8::put_job(lds, 1, Wsbin + (size_t)4096 * D, H, D, T, ACT(bf16_t, A_VT), ACT(bf16_t, A_VT), T, 1 << 30, 1.0f);
        }
        __syncthreads();
        pg8::Sched S; S.init(lds, 2, gridDim.x, blockIdx.x);
        pg8::EpiBf16 E{S.tab};
        pg8::gemm_phase(lds, S, E);
    })
    SEAM(1);
    PH(2, if (IN(2)) { LZ(z); attn_phase(ACT(bf16_t, A_Q), ACT(bf16_t, A_K), ACT(bf16_t, A_VT), ACT(bf16_t, A_O), lds, tid, wid, lane); })
    SEAM(2);
    PH(3, if (IN(3)) { LZ(z);
        if (tid == 0) pg8::put_job(lds, 0, ACT(bf16_t, A_O), WSP(bf16_t, WS_WSBOUT), T, D, ACT(bf16_t, A_Z0), ACT(bf16_t, A_Z0), D, 1 << 30, 1.0f);
        __syncthreads();
        pg8::Sched S; S.init(lds, 1, gridDim.x, blockIdx.x);
        pg8::EpiBf16 E{S.tab}; pg8::gemm_phase(lds, S, E); })
    SEAM(3);
#if defined(OUTPROJ_PROBE)
    {
        LZ(z);
        if (tid == 0) pg8::put_job(lds, 0, ACT(bf16_t, A_O), WSP(bf16_t, WS_WSBOUT), T, D, nullptr, nullptr, D, 0, 1.0f);
        __syncthreads();
        pg8::Sched S; S.init(lds, 1, gridDim.x, blockIdx.x);
#if OUTPROJ_PROBE == 1
        pg8::EpiNull E; pg8::gemm_phase(lds, S, E);
#else
        pg8::EpiResF32 E{INP(0), ACT(float, A_Q), D}; pg8::gemm_phase(lds, S, E);
#endif
        xcd_barrier(bar);
    }
#endif
#define MOE_PHASES(l, pb) \
    PH(pb, if (IN(pb)) { LZ(z); convert_moe_layer(l, true, false, blockIdx.x * 8 + wid, gridDim.x * 8, INP(15), INP(16), INP(17), WSP(bf16_t, WS_W13), WSP(bf16_t, WS_W2), lds, wid, lane); __syncthreads(); NormP p{}; p.src = (l) ? (const float*)WSP(bf16_t, WS_X) : INP(0); p.Y = (l) ? ACT(bf16_t, A_Z1) : ACT(bf16_t, A_Z0); p.X = WSP(bf16_t, WS_X); p.H = WSP(bf16_t, WS_H); p.g = INP(2) + (l) * D; p.wimg = WSP(bf16_t, WS_WR + (l) * WR_BYTES); p.bg = INP(12) + (l) * 4; \
        p.be = INP(14) + (l) * 32; p.cnt = ctl + CW_CNT + 64 * (l) + z; p.list = ACT(unsigned, A_LIST); p.listw = ACT(float, A_LISTW); \
        if (l) norm_phase<1, true>(p, lds, tid, wid, lane); else norm_phase<1, false>(p, lds, tid, wid, lane); }) \
    SEAM(pb); \
    PH((pb) + 1, if (IN((pb) + 1)) { LZ(z); pg8::moe_table256(ctl + CW_CNT + 64 * (l) + z, lds, tid); \
        pg8::MSched<2> S; S.init(lds, gridDim.x, blockIdx.x); \
        { const int nun = S.total; const int idle = (int)gridDim.x - nun;        \
          if (idle > 0) { if ((int)blockIdx.x >= nun) convert_moe_layer(l, false, true, ((int)blockIdx.x - nun) * 8 + wid, idle * 8, INP(15), INP(16), INP(17), WSP(bf16_t, WS_W13), WSP(bf16_t, WS_W2), lds, wid, lane); } \
          else { convert_moe_layer(l, false, true, blockIdx.x * 8 + wid, gridDim.x * 8, INP(15), INP(16), INP(17), WSP(bf16_t, WS_W13), WSP(bf16_t, WS_W2), lds, wid, lane); __syncthreads(); } } \
        pg8::MOps1 P{WSP(bf16_t, WS_H), WSP(bf16_t, WS_W13) + (size_t)(l) * NE * 512 * D, ACT(unsigned, A_LIST)}; \
        pg8::EpiSwiglu E{ACT(bf16_t, A_HID), ACT(float, A_LISTW)}; \
        pg8::gemm_phase_m<2048>(lds, S, P, E); }) \
    SEAM((pb) + 1); \
    PH((pb) + 2, if (IN((pb) + 2)) { LZ(z); pg8::moe_table256(ctl + CW_CNT + 64 * (l) + z, lds, tid); \
        pg8::MSched<8> S; S.init(lds, gridDim.x, blockIdx.x); \
        pg8::MOps2 P{ACT(bf16_t, A_HID), WSP(bf16_t, WS_W2) + (size_t)(l) * NE * D * FF}; \
        pg8::EpiScatter E{ACT(bf16_t, A_Y), ACT(unsigned, A_LIST)}; \
        pg8::gemm_phase_m<256>(lds, S, P, E); }) \
    SEAM((pb) + 2);
    MOE_PHASES(0, 4)
#if defined(MOE2_PROBE)
    {
        xcd_barrier(bar); LZ(z); pg8::moe_table256(ctl + CW_CNT + z, lds, tid);
        pg8::MSched<8> S; S.init(lds, gridDim.x, blockIdx.x);
        pg8::MOps2 P{ACT(bf16_t, A_HID), WSP(bf16_t, WS_W2)};
#if MOE2_PROBE == 1
        pg8::EpiMNull E; pg8::gemm_phase_m<256>(lds, S, P, E);
#else
        pg8::EpiScatter E{ACT(bf16_t, A_Y), ACT(unsigned, A_LIST)}; pg8::gemm_phase_m<256>(lds, S, P, E);
#endif
        xcd_barrier(bar);
    }
#endif
#if defined(ROUTER2X)
    { xcd_barrier(bar); LZ(z); NormP p{}; p.src = INP(0); p.Y = ACT(bf16_t, A_Z0); p.X = ACT(bf16_t, 96 * MiB); p.H = ACT(bf16_t, A_O); p.g = INP(2); p.wimg = WSP(bf16_t, WS_WR); p.bg = INP(12); p.be = INP(14);
      p.cnt = ctl + CW_CNT + 64 * 2 + z; p.list = ACT(unsigned, 128 * MiB); p.listw = ACT(float, 130 * MiB); norm_phase<1, false>(p, lds, tid, wid, lane); xcd_barrier(bar); }
#endif
    PH(7, if (IN(7)) { LZ(z); NormP p{}; p.X = WSP(bf16_t, WS_X); p.Y = ACT(bf16_t, A_Y); p.H = WSP(bf16_t, WS_H); p.g = INP(1) + D; p.wimg = WSP(bf16_t, WS_WG); p.G = ACT(float, A_G); norm_phase<2, true>(p, lds, tid, wid, lane); })
    SEAM(7);
    PH(8, if (IN(8)) {
        LZ(z);
        bf16_t* H = WSP(bf16_t, WS_H); bf16_t* Wmlin = WSP(bf16_t, WS_WMLIN);
        if (tid == 0) {
            pg8::put_job(lds, 0, H, Wmlin, T, 2048, ACT(bf16_t, A_Q1), ACT(bf16_t, A_K1), 1024, 1024, 0.08838834764831845f);
            pg8::put_job(lds, 1, H, Wmlin + (size_t)4096 * D, T, 2048, ACT(bf16_t, A_OG), ACT(bf16_t, A_OG), D, 1 << 30, 1.0f);
            pg8::put_job(lds, 2, Wmlin + (size_t)2048 * D, H, 2048, T, ACT(bf16_t, A_VT1), ACT(bf16_t, A_VT1), T, 1 << 30, 1.0f);
        }
        __syncthreads();
        pg8::Sched S; S.init(lds, 3, gridDim.x, blockIdx.x);
        pg8::EpiBf16 E{S.tab};
        pg8::gemm_phase(lds, S, E);
    })
    SEAM(8);
    PH(9, if (IN(9)) { LZ(z); mlstm_local(ACT(bf16_t, A_K1), ACT(bf16_t, A_VT1), ACT(float, A_G), INP(7), INP(8), WSP(bf16_t, WS_H), ACT(float, A_NJ), ACT(float, A_SUM), lds, tid, wid, lane); })
    SEAM(9);
    PH(10, if (IN(10)) { LZ(z); mlstm_phase<0>(ACT(bf16_t, A_Q1), ACT(bf16_t, A_K1), ACT(bf16_t, A_VT1), ACT(bf16_t, A_OG), ACT(float, A_G), INP(7), INP(8), INP(9), ACT(bf16_t, A_HS),
        WSP(bf16_t, WS_H), ACT(float, A_NJ), ACT(float, A_SUM), lds, tid, wid, lane); })
    SEAM(10);
#if defined(ML_PROBE)
    {
        LZ(z); mlstm_phase<ML_PROBE>(ACT(bf16_t, A_Q1), ACT(bf16_t, A_K1), ACT(bf16_t, A_VT1), ACT(bf16_t, A_OG), ACT(float, A_G), INP(7), INP(8), INP(9), (bf16_t*)(args.out + z),
            WSP(bf16_t, WS_H), ACT(float, A_NJ), ACT(float, A_SUM), lds, tid, wid, lane, 4); xcd_barrier(bar); }
#endif
    PH(11, if (IN(11)) { LZ(z);
        if (tid == 0) pg8::put_job(lds, 0, ACT(bf16_t, A_HS), WSP(bf16_t, WS_WMLOUT), T, D, ACT(bf16_t, A_Z1), ACT(bf16_t, A_Z1), D, 1 << 30, 1.0f);
        __syncthreads();
        pg8::Sched S; S.init(lds, 1, gridDim.x, blockIdx.x);
        pg8::EpiBf16 E{S.tab}; pg8::gemm_phase(lds, S, E); })
    SEAM(11);
    MOE_PHASES(1, 12)
    PH(15, if (IN(15)) { LZ(z); NormP p{}; p.X = WSP(bf16_t, WS_X); p.Y = ACT(bf16_t, A_Y); p.outf = args.out + z; p.g = INP(3); norm_phase<3, true>(p, lds, tid, wid, lane); })
    if (PROBE_A >= 0 && blockIdx.x == 0 && tid == 0) {
        misc[16 + 16] = (unsigned)__builtin_amdgcn_s_memrealtime();
        const float tA = (float)(misc[16 + PROBE_A + 1] - misc[16 + PROBE_A]) * 0.01f, tB = (PROBE_B >= 0) ? (float)(misc[16 + PROBE_B + 1] - misc[16 + PROBE_B]) * 0.01f : 0.f;
        args.out[0] = (1.0f + tA * 0.02f) * __builtin_powf(10.0f, __builtin_rintf(tB * 0.1f));
    }
#undef IN
#undef SEAM
}

extern "C" void kernel_launch(void* const* d_in, const int* in_sizes, int n_in, void* d_out, int out_size, void* d_ws, size_t ws_size, hipStream_t stream) {
    static int grid = 0;
    if (grid == 0) {
        if (n_in != 18 || out_size != T * D || ws_size < WS_END) { fprintf(stderr, "kernel_launch: unexpected shapes (n_in %d out %d ws %zu need %zu)\n", n_in, out_size, ws_size, (size_t)WS_END); grid = -1; return; }
        int dev = 0, cus = 0, per_cu = 0;
        if (hipGetDevice(&dev) != hipSuccess || hipDeviceGetAttribute(&cus, hipDeviceAttributeMultiprocessorCount, dev) != hipSuccess) { grid = -1; return; }
        if (hipFuncSetAttribute((const void*)fwd_kernel, hipFuncAttributeMaxDynamicSharedMemorySize, LDS_BYTES) != hipSuccess) { fprintf(stderr, "kernel_launch: hipFuncSetAttribute failed\n"); grid = -1; return; }
        if (hipOccupancyMaxActiveBlocksPerMultiprocessor(&per_cu, (const void*)fwd_kernel, NTHREADS, LDS_BYTES) != hipSuccess || per_cu < 1) { fprintf(stderr, "kernel_launch: occupancy query says %d\n", per_cu); per_cu = 1; }
        (void)hipGetLastError();
        grid = cus;
    }
    if (grid < 0) return;
    (void)hipMemsetAsync((char*)d_ws + WS_CTL, 0, CTL_BYTES, stream);
    Args a{};
    for (int i = 0; i < 18; ++i) a.in[i] = (const float*)d_in[i];
    a.out = (float*)d_out; a.ws = (unsigned char*)d_ws;
#if MK_MULTI
    for (int ph = 0; ph < NPHASE; ++ph) { a.ph_lo = ph; a.ph_hi = ph + 1; hipLaunchKernelGGL(fwd_kernel, dim3(grid), dim3(NTHREADS), LDS_BYTES, stream, a); }
#else
    a.ph_lo = 0; a.ph_hi = NPHASE;
    void* kargs[] = {&a};
    hipError_t e = hipLaunchCooperativeKernel((const void*)fwd_kernel, dim3(grid), dim3(NTHREADS), kargs, LDS_BYTES, stream);
    if (e != hipSuccess) fprintf(stderr, "kernel_launch: cooperative launch failed: %s\n", hipGetErrorString(e));
#endif
}
```

```cpp
#include <hip/hip_runtime.h>
#include <cstdio>
#include <cstdint>

#define GAS __attribute__((address_space(1)))
#define LAS __attribute__((address_space(3)))
#define DI __device__ __forceinline__
typedef unsigned short bf16_t;
typedef short bf16x8 __attribute__((ext_vector_type(8)));
typedef short s16x4 __attribute__((ext_vector_type(4)));
typedef float f32x4 __attribute__((ext_vector_type(4)));
typedef unsigned u32x4 __attribute__((ext_vector_type(4)));
typedef unsigned u32x2 __attribute__((ext_vector_type(2)));

#ifndef PROBE_A
#define PROBE_A -1
#define PROBE_B -1
#endif
#ifndef REPEAT_MASK
#define REPEAT_MASK 0
#endif
#ifndef MK_MULTI
#define MK_MULTI 0
#endif

constexpr int T = 8192, D = 2048, SEQ = 2048;
constexpr int SBH = 16;
constexpr int MLH = 8, ML_IN = 6160;
constexpr int NE = 32, FF = 256;
constexpr float EPS = 1e-6f;
constexpr int NPHASE = 16;
constexpr int NTHREADS = 512;
constexpr int LDS_BYTES = 147456;

constexpr size_t MiB = 1u << 20;
constexpr size_t WS_CTL = 0, CTL_BYTES = 128 * 1024;
constexpr size_t WS_WR = 128 * 1024, WR_BYTES = 384 * 1024, WS_WG = 896 * 1024;
constexpr size_t WS_WSBIN = 1 * MiB, WS_WSBOUT = 25 * MiB, WS_WMLIN = 33 * MiB, WS_WMLOUT = 57 * MiB;
constexpr size_t WS_W13 = 65 * MiB, WS_W2 = 193 * MiB;
constexpr size_t WS_X = 257 * MiB, WS_H = 321 * MiB, WS_ACT = 353 * MiB;
constexpr size_t A_Q = 0, A_K = 32 * MiB, A_VT = 64 * MiB, A_O = 96 * MiB;
constexpr size_t A_Q1 = 0, A_K1 = 16 * MiB, A_KT = 32 * MiB, A_VT1 = 48 * MiB, A_OG = 80 * MiB, A_HS = 112 * MiB, A_G = 144 * MiB, A_NJ = 144 * MiB + 524288, A_SUM = 144 * MiB + 524288 + 131072;
constexpr size_t A_HID = 0, A_LIST = 9 * MiB, A_LISTW = 10 * MiB, A_Y = 16 * MiB;
constexpr size_t A_Z0 = 64 * MiB, A_Z1 = 80 * MiB;
constexpr size_t WS_END = WS_ACT + 145 * MiB;
constexpr int CW_BAR = 4096;
constexpr int CW_CNT = 16384;

typedef __bf16 bf16x2_t __attribute__((ext_vector_type(2)));
typedef float f32x2 __attribute__((ext_vector_type(2)));
DI unsigned pk2(float lo, float hi) { const f32x2 v = {lo, hi}; return __builtin_bit_cast(unsigned, __builtin_convertvector(v, bf16x2_t)); }
DI unsigned f2bf(float f) { return pk2(f, 0.f) & 0xffffu; }
DI float bf2f(unsigned short b) { return __builtin_bit_cast(float, ((unsigned)b) << 16); }
template <int CTRL> DI float dpp_t(float v) { return __builtin_bit_cast(float, __builtin_amdgcn_update_dpp(0, __builtin_bit_cast(int, v), CTRL, 0xF, 0xF, false)); }
#define dpp_f(v, ctrl) dpp_t<ctrl>(v)
DI float wave_max(float v) {
    v = fmaxf(v, dpp_f(v, 0xB1)); v = fmaxf(v, dpp_f(v, 0x4E)); v = fmaxf(v, dpp_f(v, 0x141)); v = fmaxf(v, dpp_f(v, 0x140));
    v = fmaxf(v, __shfl_xor(v, 16)); v = fmaxf(v, __shfl_xor(v, 32)); return v;
}
DI float wave_sum(float v) {
#pragma unroll
    for (int o = 1; o < 64; o <<= 1) v += __shfl_xor(v, o);
    return v;
}
#define LDS_WAIT() asm volatile("s_waitcnt lgkmcnt(0)" ::: "memory")
#define VM_WAIT() asm volatile("s_waitcnt vmcnt(0)" ::: "memory")
#define MFMA16(a, b, c) __builtin_amdgcn_mfma_f32_16x16x32_bf16((a), (b), (c), 0, 0, 0)

#define XB_TMO      128
#define XB_XCNT(j)  (256  + 64 * (j))
#define XB_XSUB(j)  (1280 + 64 * (j))
#define XB_XGEN(j)  (2304 + 64 * (j))
#define XB_TOP      3328
#define XB_TOPGEN   3392
#define XCD_BAR_WORDS 3456
#define XB_SPIN_CAP (1u << 18)
DI unsigned xb_ld(unsigned* p)              { return __hip_atomic_load(p, __ATOMIC_RELAXED, __HIP_MEMORY_SCOPE_AGENT); }
DI unsigned xb_add(unsigned* p, unsigned v) { return __hip_atomic_fetch_add(p, v, __ATOMIC_RELAXED, __HIP_MEMORY_SCOPE_AGENT); }
DI unsigned xb_xcc_id() { return (unsigned)__builtin_amdgcn_s_getreg((3 << 11) | 20) & 0xFu; }
#define XB_SPIN(cond, bar) do { unsigned _sp = 0; while (cond) { __builtin_amdgcn_s_sleep(1); \
    if ((++_sp & 255u) == 0u) { if (xb_ld(&(bar)[XB_TMO])) break; if (_sp > XB_SPIN_CAP) { atomicAdd(&(bar)[XB_TMO], 1u); break; } } } } while (0)
struct XcdBarrier { unsigned* bar; unsigned x; volatile LAS unsigned* st; };
DI XcdBarrier xcd_barrier_post(unsigned* bar, volatile LAS unsigned* st) {
    XcdBarrier b; b.bar = bar; b.x = xb_xcc_id(); b.st = st;
    if (threadIdx.x == 0) (void)xb_add(&bar[XB_XCNT(b.x)], 1u);
    return b;
}
DI void xcd_barrier_complete(unsigned* bar, unsigned x, unsigned& nloc, unsigned& nx) {
    const unsigned G = gridDim.x * gridDim.y * gridDim.z;
    unsigned sum, cnt, mine, sp = 0u;
    for (;;) {
        sum = 0u; cnt = 0u; mine = 0u;
#pragma unroll
        for (unsigned j = 0; j < 16; ++j) { const unsigned c = xb_ld(&bar[XB_XCNT(j)]); sum += c; cnt += (c > 0u) ? 1u : 0u; mine = (j == x) ? c : mine; }
        if (sum == G) break;
        __builtin_amdgcn_s_sleep(1);
        if ((++sp & 255u) == 0u) { if (xb_ld(&bar[XB_TMO])) break; if (sp > XB_SPIN_CAP) { atomicAdd(&bar[XB_TMO], 1u); break; } }
    }
    nloc = mine > 0u ? mine : 1u; nx = cnt > 0u ? cnt : 1u;
}
DI void xcd_barrier(const XcdBarrier& b) {
    asm volatile("s_waitcnt vmcnt(0)" ::: "memory");
    __syncthreads();
    if (threadIdx.x == 0) {
        unsigned* bar = b.bar;
        __builtin_amdgcn_s_waitcnt(0);
        unsigned nloc = b.st[0], nx = b.st[1];
        if (nloc == 0u) { xcd_barrier_complete(bar, b.x, nloc, nx); b.st[0] = nloc; b.st[1] = nx; }
        const unsigned old = xb_add(&bar[XB_XSUB(b.x)], 1u);
        const unsigned gen = old / nloc;
        if (old + 1u == (gen + 1u) * nloc) {
            __builtin_amdgcn_fence(__ATOMIC_RELEASE, "agent");
            asm volatile("s_waitcnt vmcnt(0)" ::: "memory");
            const unsigned og = xb_add(&bar[XB_TOP], 1u);
            const unsigned tg = og / nx;
            if (og + 1u == (tg + 1u) * nx) xb_add(&bar[XB_TOPGEN], 1u);
            else XB_SPIN(xb_ld(&bar[XB_TOPGEN]) == tg, bar);
            __builtin_amdgcn_fence(__ATOMIC_ACQUIRE, "agent");
            xb_add(&bar[XB_XGEN(b.x)], 1u);
            asm volatile("s_waitcnt vmcnt(0)" ::: "memory");
        } else {
            XB_SPIN(xb_ld(&bar[XB_XGEN(b.x)]) == gen, bar);
            __builtin_amdgcn_fence(__ATOMIC_ACQUIRE, "agent");
            asm volatile("s_waitcnt vmcnt(0)" ::: "memory");
        }
    }
    __syncthreads();
}

struct Args {
    const float* in[18];
    float* out;
    unsigned char* ws;
    int ph_lo, ph_hi;
};

DI int perm13(int f, int which) { return (f >> 7) * 256 + ((f >> 5) & 3) * 64 + which * 32 + (f & 31); }
DI void transpose_item(const float* W, int ldw, bf16_t* WT, int ldt, int k0, int n0, int mode, LAS float* scr, int lane) {
#pragma unroll 16
    for (int i = 0; i < 64; ++i) scr[i * 65 + lane] = __builtin_nontemporal_load(W + (size_t)(k0 + i) * ldw + n0 + lane);
    LDS_WAIT(); asm volatile("" ::: "memory");
    const int c = lane & 7;
#pragma unroll
    for (int j = 0; j < 8; ++j) {
        const int n = (lane >> 3) + 8 * j; const LAS float* s = scr + (8 * c) * 65 + n;
        u32x4 o; o.x = pk2(s[0 * 65], s[1 * 65]); o.y = pk2(s[2 * 65], s[3 * 65]); o.z = pk2(s[4 * 65], s[5 * 65]); o.w = pk2(s[6 * 65], s[7 * 65]);
        const int nn = n0 + n; const int row = (mode == 0) ? nn : perm13(nn, mode - 1);
        *(u32x4*)(WT + (size_t)row * ldt + k0 + 8 * c) = o;
    }
    LDS_WAIT(); asm volatile("" ::: "memory");
}

struct NormP {
    const float* src; bf16_t* X; const bf16_t* Y; bf16_t* H; float* outf; const float* g;
    const bf16_t* wimg; const float* bg; const float* be;
    unsigned* cnt; unsigned* list; float* listw;
    float* G;
};
template <int MODE, bool XB>
DI void norm_phase(const NormP& p, LAS unsigned char* lds, int tid, int wid, int lane) {
    constexpr int RB_LDB = 4112;
    LAS unsigned char* rb_hi = lds;
    LAS float* part = (LAS float*)(lds + 8 * RB_LDB);
    LAS float* logit = part + 8 * 8 * 48;
    LAS int* pex = (LAS int*)(logit + 512); LAS unsigned* pen = (LAS unsigned*)(pex + 512); LAS float* pwt = (LAS float*)(pen + 512);
    int itn = 0;
    constexpr bool PROJ = (MODE == 1 || MODE == 2);
    const float* xin = p.src;
    const bf16_t* xbn = (MODE <= 1) ? (const bf16_t*)p.src : (const bf16_t*)p.X;
    f32x4 v[8]; u32x2 xb[8], ya[8], yb[8];
    int it = blockIdx.x;
#define NP_LOADV(itx) do { const size_t ro_ = (size_t)((itx) * 8 + wid) * D; _Pragma("unroll") for (int j = 0; j < 8; ++j) { if (XB) xb[j] = *(const u32x2*)(xbn + ro_ + 4 * lane + 256 * j); else v[j] = __builtin_nontemporal_load((const f32x4*)(xin + ro_ + 4 * lane + 256 * j)); } } while (0)
#define NP_LOADY(itx) do { const size_t ro_ = (size_t)((itx) * 8 + wid) * D; _Pragma("unroll") for (int j = 0; j < 8; ++j) { const int c = 4 * lane + 256 * j; \
        if (MODE >= 1) ya[j] = *(const u32x2*)(p.Y + ro_ + c); if (MODE >= 2) yb[j] = *(const u32x2*)(p.Y + (size_t)T * D + ro_ + c); } } while (0)
#define NP_LOAD(itx) do { NP_LOADV(itx); NP_LOADY(itx); } while (0)
    if (it < T / 8) NP_LOAD(it);
    for (; it < T / 8; it += gridDim.x, ++itn) {
        const int row = it * 8 + wid;
        const size_t ro = (size_t)row * D;
        f32x4 gv[8];
#pragma unroll
        for (int j = 0; j < 8; ++j) gv[j] = *(const f32x4*)(p.g + 4 * lane + 256 * j);
        float ss = 0.f;
#pragma unroll
        for (int j = 0; j < 8; ++j) {
            f32x4 x;
            if (XB) { const u32x2 q = xb[j]; x.x = bf2f(q.x & 0xffff); x.y = bf2f(q.x >> 16); x.z = bf2f(q.y & 0xffff); x.w = bf2f(q.y >> 16); } else x = v[j];
            if (MODE >= 1) {
                const u32x2 a = ya[j];
                x.x += bf2f(a.x & 0xffff); x.y += bf2f(a.x >> 16); x.z += bf2f(a.y & 0xffff); x.w += bf2f(a.y >> 16);
                if (MODE >= 2) { const u32x2 b = yb[j]; x.x += bf2f(b.x & 0xffff); x.y += bf2f(b.x >> 16); x.z += bf2f(b.y & 0xffff); x.w += bf2f(b.y >> 16); }
                if (MODE <= 2) { u32x2 o; o.x = pk2(x.x, x.y); o.y = pk2(x.z, x.w); *(u32x2*)(p.X + ro + 4 * lane + 256 * j) = o; }
            }
            v[j] = x;
            ss += (x.x * x.x + x.y * x.y) + (x.z * x.z + x.w * x.w);
        }
        const float rstd = 1.0f / sqrtf(wave_sum(ss) * (1.0f / D) + EPS);
#pragma unroll
        for (int j = 0; j < 8; ++j) {
            const int c = 4 * lane + 256 * j;
            const f32x4 gg = gv[j];
            f32x4 y; y.x = v[j].x * rstd * gg.x; y.y = v[j].y * rstd * gg.y; y.z = v[j].z * rstd * gg.z; y.w = v[j].w * rstd * gg.w;
            if (MODE == 3) *(f32x4*)(p.outf + ro + c) = y;
            else { u32x2 o; o.x = pk2(y.x, y.y); o.y = pk2(y.z, y.w); *(u32x2*)(p.H + ro + c) = o; }
            if (PROJ) *(LAS u32x2*)(rb_hi + wid * RB_LDB + c * 2) = (u32x2){pk2(y.x, y.y), pk2(y.z, y.w)};
        }
        const bool more = it + (int)gridDim.x < T / 8;
        if (!PROJ && more) NP_LOAD(it + gridDim.x);
        if (PROJ) {
            __syncthreads();
            {
                constexpr int NT = (MODE == 1) ? 3 : 1;
                f32x4 pacc[NT];
#pragma unroll
                for (int nt = 0; nt < NT; ++nt) pacc[nt] = (f32x4){0.f, 0.f, 0.f, 0.f};
                const LAS unsigned char* ahi = rb_hi + (lane & 7) * RB_LDB + (lane >> 4) * 16 + wid * 512;
                const bf16_t* wim = p.wimg + (size_t)lane * 8 + (size_t)(8 * wid) * NT * 512;
                bf16x8 w0[4][NT], w1[4][NT];
#define NP_LDW(dst, g) do { _Pragma("unroll") for (int kk = 0; kk < 4; ++kk) _Pragma("unroll") for (int nt = 0; nt < NT; ++nt) dst[kk][nt] = *(const bf16x8*)(wim + (size_t)((4 * (g) + kk) * NT + nt) * 512); } while (0)
#define NP_MM(src, g) do { _Pragma("unroll") for (int kk = 0; kk < 4; ++kk) { const bf16x8 xh = *(const LAS bf16x8*)(ahi + (4 * (g) + kk) * 64); \
        _Pragma("unroll") for (int nt = 0; nt < NT; ++nt) pacc[nt] = MFMA16(xh, src[kk][nt], pacc[nt]); } } while (0)
#define NP_PIN __builtin_amdgcn_sched_barrier(0)
                NP_LDW(w0, 0); NP_LDW(w1, 1); NP_PIN;
                if (more) NP_LOADV(it + gridDim.x);
                NP_PIN; NP_MM(w0, 0); NP_MM(w1, 1); NP_PIN;
#undef NP_PIN
#undef NP_LDW
#undef NP_MM
                if (more) NP_LOADY(it + gridDim.x);
                if (lane < 32) {
#pragma unroll
                    for (int nt = 0; nt < NT; ++nt)
#pragma unroll
                        for (int r = 0; r < 4; ++r) part[(wid * 8 + 4 * (lane >> 4) + r) * 48 + 16 * nt + (lane & 15)] = pacc[nt][r];
                }
            }
            __syncthreads();
            {
                float sl = 0.f;
                if (lane < 48) {
#pragma unroll
                    for (int w = 0; w < 8; ++w) sl += part[(w * 8 + wid) * 48 + lane];
                }
                if (MODE == 2) { if (lane < 16) p.G[(size_t)row * 16 + lane] = sl; }
                else {
                    if (lane < 36) sl += (lane < 4) ? p.bg[lane] : p.be[lane - 4];
                    const float NEG = -3.0e38f;
                    const float gl = (lane < 4) ? sl : NEG;
                    float gm = fmaxf(gl, dpp_f(gl, 0xB1)); gm = fmaxf(gm, dpp_f(gm, 0x4E));
                    gm = __shfl(gm, 0);
                    const int gs = __ffsll((long long)__ballot(lane < 4 && sl == gm)) - 1;
                    float ge = (lane < 4) ? __expf(sl - gm) : 0.f;
                    ge += dpp_f(ge, 0xB1); ge += dpp_f(ge, 0x4E);
                    const float psel = 1.0f / __shfl(ge, 0);
                    const int eb = 4 + 8 * gs;
                    const bool inr = lane >= eb && lane < eb + 8;
                    const float v0 = wave_max(inr ? sl : NEG);
                    const int l0 = __ffsll((long long)__ballot(inr && sl == v0)) - 1;
                    const float v1 = wave_max((inr && lane != l0) ? sl : NEG);
                    const int l1 = __ffsll((long long)__ballot(inr && lane != l0 && sl == v1)) - 1;
                    if (lane == 0) {
                        const float e10 = __expf(v1 - v0); const float w0 = psel / (1.0f + e10), w1 = psel * e10 / (1.0f + e10);
                        const int e0 = gs * 8 + (l0 - eb), e1 = gs * 8 + (l1 - eb);
                        const int sl0 = itn * 16 + wid * 2;
                        pex[sl0] = e0; pen[sl0] = (unsigned)row * 2u; pwt[sl0] = w0;
                        pex[sl0 + 1] = e1; pen[sl0 + 1] = (unsigned)row * 2u + 1u; pwt[sl0 + 1] = w1;
                    }
                }
            }
        }
    }
#undef NP_LOAD
#undef NP_LOADV
#undef NP_LOADY
    if (MODE == 1) {
        __syncthreads();
        if (wid == 0) {
            const int np = itn * 16;
            for (int c0 = 0; c0 < np; c0 += 64) {
                const bool have = c0 + lane < np;
                const int ei = have ? pex[c0 + lane] : -1;
                int cnt_e = 0, rank = 0;
#pragma unroll 4
                for (int e = 0; e < NE; ++e) {
                    const unsigned long long m = __ballot(ei == e);
                    if (lane == e) cnt_e = __popcll(m);
                    if (ei == e) rank = __popcll(m & ((1ull << lane) - 1ull));
                }
                unsigned base = 0u;
                if (lane < NE && cnt_e > 0) base = atomicAdd(p.cnt + lane, (unsigned)cnt_e);
                const unsigned mybase = (unsigned)__shfl((int)base, ei < 0 ? 0 : ei);
                if (have) { const size_t pos = (size_t)ei * T + mybase + rank; p.list[pos] = pen[c0 + lane]; p.listw[pos] = pwt[c0 + lane]; }
            }
        }
        __syncthreads();
    }
}

DI int lds_byte(int r, int c) { const int st = (r >> 4) * 2 + (c >> 5), rr = r & 15, cc = c & 31, ob = rr * 64 + cc * 2; return st * 1024 + (ob ^ (((ob >> 9) & 1) << 5)); }
DI void stage_rc(int b, int& R, int& C) { const int st = b / 1024, sb = b % 1024, swz = sb ^ (((sb >> 9) & 1) << 5); R = (st >> 1) * 16 + swz / 64; C = (st & 1) * 32 + (swz % 64) / 2; }

namespace pg8 {
constexpr int BM = 256, BK = 64, HALF = 128, HTB = HALF * BK * 2, NXCD = 8, WGM = 8, KD = 2048;
DI int perm32(int rho) { const int n = rho >> 4, i = rho & 15; return 8 * (i >> 2) + 4 * n + (i & 3); }
struct Unit { int pm, pn, job; };
struct JobRec { const bf16_t* A; const bf16_t* Bt; bf16_t* o0; bf16_t* o1; int M, N, ld, split; float scale0; int pad[5]; };
constexpr int JOBS_OFF = 139264;
DI void put_job(LAS unsigned char* lds, int j, const bf16_t* A, const bf16_t* Bt, int M, int N, bf16_t* o0, bf16_t* o1, int ld, int split, float scale0) {
    LAS JobRec* r = (LAS JobRec*)(lds + JOBS_OFF) + j;
    r->A = A; r->Bt = Bt; r->o0 = o0; r->o1 = o1; r->M = M; r->N = N; r->ld = ld; r->split = split; r->scale0 = scale0;
}
struct Sched {
    const LAS JobRec* tab; int n0, n1, n2, G, c;
    DI void init(LAS unsigned char* lds, int njobs, int G_, int c_) {
        tab = (const LAS JobRec*)(lds + JOBS_OFF);
        n0 = (tab[0].M / BM) * (tab[0].N / BM); n1 = njobs > 1 ? (tab[1].M / BM) * (tab[1].N / BM) : 0; n2 = njobs > 2 ? (tab[2].M / BM) * (tab[2].N / BM) : 0; G = G_; c = c_; }
    DI bool next(int i, Unit& u) const {
        int L = i * G + c, nwg;
        if (L < n0) { u.job = 0; nwg = n0; }
        else if (L < n0 + n1) { L -= n0; u.job = 1; nwg = n1; }
        else if (L < n0 + n1 + n2) { L -= n0 + n1; u.job = 2; nwg = n2; }
        else return false;
        const int nM = tab[u.job].M / BM, nN = tab[u.job].N / BM;
        int wgid = L; { const int q = nwg / NXCD, r = nwg % NXCD, xcd = wgid % NXCD, off = wgid / NXCD; wgid = (xcd < r ? xcd * (q + 1) : r * (q + 1) + (xcd - r) * q) + off; }
        const int nig = WGM * nN, gid = wgid / nig, fm = gid * WGM, gsz = (nM - fm) < WGM ? (nM - fm) : WGM;
        u.pm = fm + ((wgid % nig) % gsz); u.pn = (wgid % nig) / gsz; return true;
    }
    DI const char* aptr(const Unit& u) const { return (const char*)tab[u.job].A + (size_t)u.pm * (2 * HALF * KD * 2); }
    DI const char* bptr(const Unit& u) const { return (const char*)tab[u.job].Bt + (size_t)u.pn * (2 * HALF * KD * 2); }
};
struct EpiBf16 {
    static constexpr bool PERM = true;
    const LAS JobRec* tab;
    DI void operator()(const f32x4 (&acc)[2][2][4][2], const Unit& u, int wr, int wc, int fr, int fq) const {
        const LAS JobRec* jr = tab + u.job;
        const int ldo = jr->ld, split = jr->split;
        float sc = jr->scale0;
        int colt = u.pn * BM; bf16_t* base = jr->o0;
        if (colt >= split) { colt -= split; base = jr->o1; sc = 1.0f; }
        const int row0 = u.pm * BM + wr * 64 + fr, col0 = colt + wc * 64 + 8 * fq;
#pragma unroll
        for (int ai = 0; ai < 2; ++ai)
#pragma unroll
            for (int m = 0; m < 4; ++m) { bf16_t* rowp = base + (size_t)(row0 + ai * HALF + m * 16) * ldo + col0;
#pragma unroll
                for (int bj = 0; bj < 2; ++bj) { const f32x4 v0 = acc[ai][bj][m][0], v1 = acc[ai][bj][m][1];
                    u32x4 w; w.x = pk2(v0.x * sc, v0.y * sc); w.y = pk2(v0.z * sc, v0.w * sc); w.z = pk2(v1.x * sc, v1.y * sc); w.w = pk2(v1.z * sc, v1.w * sc);
                    *(u32x4*)(rowp + bj * 32) = w; } }
    }
};
struct EpiResF32 {
    static constexpr bool PERM = false;
    const float* base; float* out; int ld;
    DI void operator()(const f32x4 (&acc)[2][2][4][2], const Unit& u, int wr, int wc, int fr, int fq) const {
        const int row0 = u.pm * BM + wr * 64 + fr, col0 = u.pn * BM + wc * 32 + 4 * fq;
#pragma unroll
        for (int ai = 0; ai < 2; ++ai)
#pragma unroll
            for (int m = 0; m < 4; ++m) { const size_t ro = (size_t)(row0 + ai * HALF + m * 16) * ld + col0;
#pragma unroll
                for (int bj = 0; bj < 2; ++bj)
#pragma unroll
                    for (int n = 0; n < 2; ++n) { const f32x4 b = *(const f32x4*)(base + ro + bj * HALF + n * 16); const f32x4 a = acc[ai][bj][m][n];
                        f32x4 o; o.x = a.x + b.x; o.y = a.y + b.y; o.z = a.z + b.z; o.w = a.w + b.w; *(f32x4*)(out + ro + bj * HALF + n * 16) = o; } }
    }
};
struct EpiNull {
    static constexpr bool PERM = false;
    DI void operator()(const f32x4 (&acc)[2][2][4][2], const Unit&, int, int, int, int) const {
#pragma unroll
        for (int ai = 0; ai < 2; ++ai)
#pragma unroll
            for (int bj = 0; bj < 2; ++bj)
#pragma unroll
                for (int m = 0; m < 4; ++m)
#pragma unroll
                    for (int n = 0; n < 2; ++n) asm volatile("" :: "v"(acc[ai][bj][m][n]));
    }
};
template <class Epi>
DI void gemm_phase(LAS unsigned char* lds, const Sched& S, const Epi& E) {
    const int tid = threadIdx.x, wid = __builtin_amdgcn_readfirstlane(tid >> 6), lane = tid & 63, wr = wid >> 2, wc = wid & 3, fr = lane & 15, fq = lane >> 4;
    constexpr int K = KD, nt = K / BK;
    unsigned voffA[2], voffB[2][2];
#pragma unroll
    for (int i = 0; i < 2; ++i) { int R, C; stage_rc(tid * 16 + i * 8192, R, C);
        voffA[i] = (unsigned)(R * K + C) * 2u;
#pragma unroll
        for (int h = 0; h < 2; ++h) { const int Rb = Epi::PERM ? (64 * (R >> 5) + 32 * h + perm32(R & 31)) : (128 * h + R); voffB[h][i] = (unsigned)(Rb * K + C) * 2u; } }
    constexpr size_t kstep = (size_t)(BK * 2);
    constexpr size_t hstep = (size_t)HALF * K * 2;
    const unsigned ldsw = (unsigned)wid * 1024u;
    const int aoff = lds_byte(wr * 64 + fr, fq * 8), boff = lds_byte(wc * 32 + fr, fq * 8);
#define PG8_SA(b, h) (((b) * 2 + (h)) * HTB)
#define PG8_SB(b, h) ((4 + (b) * 2 + (h)) * HTB)
#define PG8_STAGE(bufoff, gbase, voff) do { _Pragma("unroll") for (int _i = 0; _i < 2; ++_i) \
        __builtin_amdgcn_global_load_lds((const GAS unsigned*)((const char*)(gbase) + (voff)[_i]), (LAS unsigned*)(lds + (bufoff) + ldsw + _i * 8192), 16, 0, 0); } while (0)
#define PG8_LDA(dst, b, h) do { _Pragma("unroll") for (int m = 0; m < 4; ++m) _Pragma("unroll") for (int k = 0; k < 2; ++k) dst[m][k] = *(const LAS bf16x8*)(lds + PG8_SA(b, h) + aoff + m * 2048 + k * 1024); } while (0)
#define PG8_LDB(dst, b, h) do { _Pragma("unroll") for (int n = 0; n < 2; ++n) _Pragma("unroll") for (int k = 0; k < 2; ++k) dst[n][k] = *(const LAS bf16x8*)(lds + PG8_SB(b, h) + boff + n * 2048 + k * 1024); } while (0)
#define PG8_MMA(ai, bj, At, Bt) do { __builtin_amdgcn_s_setprio(1); _Pragma("unroll") for (int m = 0; m < 4; ++m) _Pragma("unroll") for (int n = 0; n < 2; ++n) _Pragma("unroll") for (int k = 0; k < 2; ++k) \
        acc[ai][bj][m][n] = __builtin_amdgcn_mfma_f32_16x16x32_bf16(Bt[n][k], At[m][k], acc[ai][bj][m][n], 0, 0, 0); __builtin_amdgcn_s_setprio(0); } while (0)
#define PG8_WAIT_V(n) asm volatile("s_waitcnt vmcnt(" #n ")" ::: "memory")
#define PG8_WAIT_L(n) asm volatile("s_waitcnt lgkmcnt(" #n ")" ::: "memory")
#define PG8_BAR __builtin_amdgcn_s_barrier()
#define PG8_SCHED __builtin_amdgcn_sched_barrier(0)
    Unit cur, nxt; int ui = 0;
    if (!S.next(0, cur)) return;
    f32x4 acc[2][2][4][2];
#pragma unroll
    for (int a = 0; a < 2; ++a)
#pragma unroll
        for (int b = 0; b < 2; ++b)
#pragma unroll
            for (int m = 0; m < 4; ++m)
#pragma unroll
                for (int n = 0; n < 2; ++n) acc[a][b][m][n] = (f32x4){0.f, 0.f, 0.f, 0.f};
    bf16x8 At[4][2], B0[2][2], B1[2][2];
    const char* cA = S.aptr(cur); const char* cB = S.bptr(cur);
    PG8_STAGE(PG8_SB(0, 0), cB, voffB[0]); PG8_STAGE(PG8_SA(0, 0), cA, voffA); PG8_STAGE(PG8_SB(0, 1), cB, voffB[1]); PG8_STAGE(PG8_SA(0, 1), cA + hstep, voffA);
    if (wr == 1) PG8_BAR;
    PG8_WAIT_V(4); PG8_BAR;
    PG8_STAGE(PG8_SB(1, 0), cB + kstep, voffB[0]); PG8_STAGE(PG8_SA(1, 0), cA + kstep, voffA); PG8_STAGE(PG8_SB(1, 1), cB + kstep, voffB[1]);
    PG8_WAIT_V(6); PG8_BAR;
    for (;;) {
        const bool has_next = S.next(ui + 1, nxt);
        const char* nA = has_next ? S.aptr(nxt) : cA; const char* nB = has_next ? S.bptr(nxt) : cB;
        for (int t = 0; t < nt; t += 2) {
            const bool last = (t == nt - 2);
            const char* a1 = cA + (size_t)(t + 1) * kstep;
            const char* a2 = last ? nA : cA + (size_t)(t + 2) * kstep; const char* b2 = last ? nB : cB + (size_t)(t + 2) * kstep;
            const char* a3 = a2 + kstep; const char* b3 = b2 + kstep;
            PG8_LDB(B0, 0, 0); PG8_SCHED; PG8_LDA(At, 0, 0); PG8_STAGE(PG8_SA(1, 1), a1 + hstep, voffA);
            PG8_WAIT_L(8); PG8_BAR; PG8_WAIT_L(0); PG8_MMA(0, 0, At, B0); PG8_BAR; PG8_SCHED;
            PG8_LDB(B1, 0, 1); PG8_STAGE(PG8_SB(0, 0), b2, voffB[0]);
            PG8_BAR; PG8_WAIT_L(0); PG8_MMA(0, 1, At, B1); PG8_BAR;
            PG8_LDA(At, 0, 1); PG8_STAGE(PG8_SA(0, 0), a2, voffA);
            PG8_BAR; PG8_WAIT_L(0); PG8_MMA(1, 0, At, B0); PG8_BAR; PG8_SCHED;
            PG8_STAGE(PG8_SB(0, 1), b2, voffB[1]);
            PG8_WAIT_V(6); PG8_BAR; PG8_MMA(1, 1, At, B1); PG8_BAR;
            PG8_LDB(B0, 1, 0); PG8_SCHED; PG8_LDA(At, 1, 0); PG8_STAGE(PG8_SA(0, 1), a2 + hstep, voffA);
            PG8_WAIT_L(8); PG8_BAR; PG8_WAIT_L(0); PG8_MMA(0, 0, At, B0); PG8_BAR; PG8_SCHED;
            PG8_LDB(B1, 1, 1); PG8_STAGE(PG8_SB(1, 0), b3, voffB[0]);
            PG8_BAR; PG8_WAIT_L(0); PG8_MMA(0, 1, At, B1); PG8_BAR;
            PG8_LDA(At, 1, 1); PG8_STAGE(PG8_SA(1, 0), a3, voffA);
            PG8_BAR; PG8_WAIT_L(0); PG8_MMA(1, 0, At, B0); PG8_BAR; PG8_SCHED;
            PG8_STAGE(PG8_SB(1, 1), b3, voffB[1]);
            PG8_WAIT_V(6); PG8_BAR; PG8_MMA(1, 1, At, B1); PG8_BAR;
        }
        E(acc, cur, wr, wc, fr, fq);
        if (!has_next) break;
#pragma unroll
        for (int a = 0; a < 2; ++a)
#pragma unroll
            for (int b = 0; b < 2; ++b)
#pragma unroll
                for (int m = 0; m < 4; ++m)
#pragma unroll
                    for (int n = 0; n < 2; ++n) acc[a][b][m][n] = (f32x4){0.f, 0.f, 0.f, 0.f};
        cur = nxt; cA = nA; cB = nB; ++ui;
    }
    PG8_WAIT_V(0);
    if (wr == 0) PG8_BAR;
    PG8_BAR;
#undef PG8_SA
#undef PG8_SB
#undef PG8_STAGE
#undef PG8_LDA
#undef PG8_LDB
#undef PG8_MMA
#undef PG8_WAIT_V
#undef PG8_WAIT_L
#undef PG8_BAR
#undef PG8_SCHED
}

struct MUnit { int e, rt, pn, cnt, sbase; };
constexpr int MTAB_OFF = JOBS_OFF + 256;
DI void moe_table256(const unsigned* cntg, LAS unsigned char* lds, int tid) {
    LAS int* ctl = (LAS int*)(lds + MTAB_OFF);
    if (tid < 64) {
        const int c = (tid < NE) ? (int)__hip_atomic_load(cntg + tid, __ATOMIC_RELAXED, __HIP_MEMORY_SCOPE_AGENT) : 0;
        const int n = (c + 255) / 256;
        int pb = c, pt = n;
#pragma unroll
        for (int o = 1; o < 32; o <<= 1) { const int vb = __shfl_up(pb, o), vt = __shfl_up(pt, o); if (tid >= o) { pb += vb; pt += vt; } }
        if (tid < NE) { ctl[tid] = c; ctl[32 + tid] = pb - c; ctl[64 + tid] = pt - n; for (int i = 0; i < n && pt - n + i < 128; ++i) ctl[128 + pt - n + i] = tid; }
        if (tid == NE - 1) ctl[64 + NE] = pt;
    }
    __syncthreads();
}
template <int NPN>
struct MSched {
    const LAS int* ctl; int G, c, total;
    DI void init(LAS unsigned char* lds, int G_, int c_) { ctl = (const LAS int*)(lds + MTAB_OFF); G = G_; c = c_; total = ctl[64 + NE] * NPN; }
    DI bool next(int i, MUnit& u) const {
        const int L = i * G + c; if (L >= total) return false;
        const int rtg = L / NPN; u.pn = L % NPN;
        const int e = ctl[128 + rtg];
        u.e = e; u.rt = rtg - ctl[64 + e]; u.cnt = ctl[e]; u.sbase = ctl[32 + e]; return true;
    }
};
struct MOps1 {
    const bf16_t* H; const bf16_t* W; const unsigned* list;
    DI const char* abase(const MUnit&) const { return (const char*)H; }
    DI void aoffs(const MUnit& u, int R0, int C0, int R1, int C1, unsigned (&o)[2][2]) const {
#pragma unroll
        for (int h = 0; h < 2; ++h) {
            const int ra = u.rt * 256 + h * 128 + R0, rb = u.rt * 256 + h * 128 + R1;
            const unsigned ta = list[(size_t)u.e * T + (ra < u.cnt ? ra : u.cnt - 1)] >> 1, tb = list[(size_t)u.e * T + (rb < u.cnt ? rb : u.cnt - 1)] >> 1;
            o[h][0] = (ta * (unsigned)D + (unsigned)C0) * 2u; o[h][1] = (tb * (unsigned)D + (unsigned)C1) * 2u;
        }
    }
    DI const char* bptr(const MUnit& u) const { return (const char*)(W + ((size_t)u.e * 512 + u.pn * 256) * D); }
};
struct MOps2 {
    const bf16_t* hid; const bf16_t* W;
    DI const char* abase(const MUnit& u) const { return (const char*)(hid + (size_t)(u.sbase + u.rt * 256) * FF); }
    DI void aoffs(const MUnit&, int R0, int C0, int R1, int C1, unsigned (&o)[2][2]) const {
#pragma unroll
        for (int h = 0; h < 2; ++h) { o[h][0] = (unsigned)((h * 128 + R0) * FF + C0) * 2u; o[h][1] = (unsigned)((h * 128 + R1) * FF + C1) * 2u; }
    }
    DI const char* bptr(const MUnit& u) const { return (const char*)(W + ((size_t)u.e * D + u.pn * 256) * FF); }
};
constexpr int MROW_OFF = 131072;
struct EpiSwiglu {
    bf16_t* hid; const float* listw;
    DI void prep(const MUnit& u, LAS unsigned char* lds, int par, int tid) const {
        if (tid < 256) { const int r = u.rt * 256 + tid;
            __builtin_amdgcn_global_load_lds((const GAS unsigned*)(listw + (size_t)u.e * T + (r < u.cnt ? r : u.cnt - 1)), (LAS unsigned*)(lds + MROW_OFF + par * 1024 + (tid >> 6) * 256), 4, 0, 0); }
    }
    DI void operator()(const f32x4 (&acc)[2][2][4][2], const MUnit& u, int wr, int wc, int fr, int fq, const LAS unsigned char* lds, int par) const {
#pragma unroll
        for (int ai = 0; ai < 2; ++ai)
#pragma unroll
            for (int m = 0; m < 4; ++m) {
                const int r = u.rt * 256 + ai * HALF + wr * 64 + m * 16 + fr;
                if (r < u.cnt) {
                    const float gw = ((const LAS float*)(lds + MROW_OFF))[par * 256 + ai * HALF + wr * 64 + m * 16 + fr];
                    unsigned o[4];
#pragma unroll
                    for (int n = 0; n < 2; ++n) { const f32x4 g = acc[ai][0][m][n], uu = acc[ai][1][m][n]; float hv[4];
#pragma unroll
                        for (int j = 0; j < 4; ++j) hv[j] = g[j] / (1.0f + __expf(-g[j])) * uu[j] * gw;
                        o[2 * n] = pk2(hv[0], hv[1]); o[2 * n + 1] = pk2(hv[2], hv[3]); }
                    *(u32x4*)(hid + (size_t)(u.sbase + r) * FF + u.pn * 128 + wc * 32 + 8 * fq) = (u32x4){o[0], o[1], o[2], o[3]};
                }
            }
    }
};
struct EpiScatter {
    bf16_t* Y; const unsigned* list;
    DI void prep(const MUnit& u, LAS unsigned char* lds, int par, int tid) const {
        if (tid < 256) { const int r = u.rt * 256 + tid;
            __builtin_amdgcn_global_load_lds((const GAS unsigned*)(list + (size_t)u.e * T + (r < u.cnt ? r : u.cnt - 1)), (LAS unsigned*)(lds + MROW_OFF + par * 1024 + (tid >> 6) * 256), 4, 0, 0); }
    }
    DI void operator()(const f32x4 (&acc)[2][2][4][2], const MUnit& u, int wr, int wc, int fr, int fq, const LAS unsigned char* lds, int par) const {
#pragma unroll
        for (int ai = 0; ai < 2; ++ai)
#pragma unroll
            for (int m = 0; m < 4; ++m) {
                const int r = u.rt * 256 + ai * HALF + wr * 64 + m * 16 + fr;
                if (r < u.cnt) {
                    const unsigned ent = ((const LAS unsigned*)(lds + MROW_OFF))[par * 256 + ai * HALF + wr * 64 + m * 16 + fr];
                    bf16_t* yrow = Y + ((size_t)(ent & 1u) * T + (ent >> 1)) * D + u.pn * 256 + wc * 64 + 8 * fq;
#pragma unroll
                    for (int bj = 0; bj < 2; ++bj) { const f32x4 v0 = acc[ai][bj][m][0], v1 = acc[ai][bj][m][1];
                        __builtin_nontemporal_store(((u32x4){pk2(v0.x, v0.y), pk2(v0.z, v0.w), pk2(v1.x, v1.y), pk2(v1.z, v1.w)}), (u32x4*)(yrow + bj * 32)); }
                }
            }
    }
};
struct EpiMNull {
    DI void prep(const MUnit&, LAS unsigned char*, int, int) const {}
    DI void operator()(const f32x4 (&acc)[2][2][4][2], const MUnit&, int, int, int, int, const LAS unsigned char*, int) const {
#pragma unroll
        for (int ai = 0; ai < 2; ++ai)
#pragma unroll
            for (int bj = 0; bj < 2; ++bj)
#pragma unroll
                for (int m = 0; m < 4; ++m)
#pragma unroll
                    for (int n = 0; n < 2; ++n) asm volatile("" :: "v"(acc[ai][bj][m][n]));
    }
};
template <int K, class Sched, class Ops, class Epi>
DI void gemm_phase_m(LAS unsigned char* lds, const Sched& S, const Ops& P, const Epi& E) {
    const int tid = threadIdx.x, wid = __builtin_amdgcn_readfirstlane(tid >> 6), lane = tid & 63, wr = wid >> 2, wc = wid & 3, fr = lane & 15, fq = lane >> 4;
    constexpr int nt = K / BK;
    int R0, C0, R1, C1; stage_rc(tid * 16, R0, C0); stage_rc(tid * 16 + 8192, R1, C1);
    unsigned voffB[2][2];
#pragma unroll
    for (int h = 0; h < 2; ++h) { voffB[h][0] = (unsigned)((64 * (R0 >> 5) + 32 * h + perm32(R0 & 31)) * K + C0) * 2u; voffB[h][1] = (unsigned)((64 * (R1 >> 5) + 32 * h + perm32(R1 & 31)) * K + C1) * 2u; }
    constexpr size_t kstep = (size_t)(BK * 2);
    constexpr size_t hstep = (size_t)HALF * K * 2;
    const unsigned ldsw = (unsigned)wid * 1024u;
    const int aoff = lds_byte(wr * 64 + fr, fq * 8), boff = lds_byte(wc * 32 + fr, fq * 8);
#define PG8_SA(b, h) (((b) * 2 + (h)) * HTB)
#define PG8_SB(b, h) ((4 + (b) * 2 + (h)) * HTB)
#define PG8_STAGEB(bufoff, gbase, h) do { _Pragma("unroll") for (int _i = 0; _i < 2; ++_i) \
        __builtin_amdgcn_global_load_lds((const GAS unsigned*)((const char*)(gbase) + voffB[h][_i]), (LAS unsigned*)(lds + (bufoff) + ldsw + _i * 8192), 16, 0, 0); } while (0)
#define PG8_STAGEA(bufoff, bb, pp, h, koff) do { _Pragma("unroll") for (int _i = 0; _i < 2; ++_i) \
        __builtin_amdgcn_global_load_lds((const GAS unsigned*)((bb) + (koff) + (pp)[h][_i]), (LAS unsigned*)(lds + (bufoff) + ldsw + _i * 8192), 16, 0, 0); } while (0)
#define PG8_LDA(dst, b, h) do { _Pragma("unroll") for (int m = 0; m < 4; ++m) _Pragma("unroll") for (int k = 0; k < 2; ++k) dst[m][k] = *(const LAS bf16x8*)(lds + PG8_SA(b, h) + aoff + m * 2048 + k * 1024); } while (0)
#define PG8_LDB(dst, b, h) do { _Pragma("unroll") for (int n = 0; n < 2; ++n) _Pragma("unroll") for (int k = 0; k < 2; ++k) dst[n][k] = *(const LAS bf16x8*)(lds + PG8_SB(b, h) + boff + n * 2048 + k * 1024); } while (0)
#define PG8_MMA(ai, bj, At, Bt) do { __builtin_amdgcn_s_setprio(1); _Pragma("unroll") for (int m = 0; m < 4; ++m) _Pragma("unroll") for (int n = 0; n < 2; ++n) _Pragma("unroll") for (int k = 0; k < 2; ++k) \
        acc[ai][bj][m][n] = __builtin_amdgcn_mfma_f32_16x16x32_bf16(Bt[n][k], At[m][k], acc[ai][bj][m][n], 0, 0, 0); __builtin_amdgcn_s_setprio(0); } while (0)
#define PG8_WAIT_V(n) asm volatile("s_waitcnt vmcnt(" #n ")" ::: "memory")
#define PG8_WAIT_L(n) asm volatile("s_waitcnt lgkmcnt(" #n ")" ::: "memory")
#define PG8_BAR __builtin_amdgcn_s_barrier()
#define PG8_SCHED __builtin_amdgcn_sched_barrier(0)
    MUnit cur, nxt; int ui = 0;
    if (!S.next(0, cur)) return;
    f32x4 acc[2][2][4][2];
#pragma unroll
    for (int a = 0; a < 2; ++a)
#pragma unroll
        for (int b = 0; b < 2; ++b)
#pragma unroll
            for (int m = 0; m < 4; ++m)
#pragma unroll
                for (int n = 0; n < 2; ++n) acc[a][b][m][n] = (f32x4){0.f, 0.f, 0.f, 0.f};
    bf16x8 At[4][2], B0[2][2], B1[2][2];
    unsigned pA[2][2], qA[2][2];
    P.aoffs(cur, R0, C0, R1, C1, pA);
    const char* cAb = P.abase(cur);
    E.prep(cur, lds, 0, tid);
    const char* cB = P.bptr(cur);
    PG8_STAGEB(PG8_SB(0, 0), cB, 0); PG8_STAGEA(PG8_SA(0, 0), cAb, pA, 0, 0); PG8_STAGEB(PG8_SB(0, 1), cB, 1); PG8_STAGEA(PG8_SA(0, 1), cAb, pA, 1, 0);
    if (wr == 1) PG8_BAR;
    PG8_WAIT_V(4); PG8_BAR;
    PG8_STAGEB(PG8_SB(1, 0), cB + kstep, 0); PG8_STAGEA(PG8_SA(1, 0), cAb, pA, 0, kstep); PG8_STAGEB(PG8_SB(1, 1), cB + kstep, 1);
    PG8_WAIT_V(6); PG8_BAR;
    for (;;) {
        const bool has_next = S.next(ui + 1, nxt);
        const char* nB = cB; const char* nAb = cAb;
#pragma unroll
        for (int h = 0; h < 2; ++h) { qA[h][0] = pA[h][0]; qA[h][1] = pA[h][1]; }
        if (has_next) { P.aoffs(nxt, R0, C0, R1, C1, qA); nAb = P.abase(nxt); nB = P.bptr(nxt); E.prep(nxt, lds, (ui + 1) % 3, tid); }
#pragma unroll 1
        for (int t = 0; t < nt; t += 2) {
            const bool last = (t == nt - 2);
            const size_t k1 = (size_t)(t + 1) * kstep;
            const size_t k2 = last ? 0 : (size_t)(t + 2) * kstep, k3 = k2 + kstep;
            const char* b2 = last ? nB : cB + k2; const char* b3 = b2 + kstep;
            const char* a2 = last ? nAb : cAb;
            unsigned o2[2][2];
#pragma unroll
            for (int h = 0; h < 2; ++h) { o2[h][0] = last ? qA[h][0] : pA[h][0]; o2[h][1] = last ? qA[h][1] : pA[h][1]; }
            PG8_LDB(B0, 0, 0); PG8_SCHED; PG8_LDA(At, 0, 0); PG8_STAGEA(PG8_SA(1, 1), cAb, pA, 1, k1);
            PG8_WAIT_L(8); PG8_BAR; PG8_WAIT_L(0); PG8_MMA(0, 0, At, B0); PG8_BAR; PG8_SCHED;
            PG8_LDB(B1, 0, 1); PG8_STAGEB(PG8_SB(0, 0), b2, 0);
            PG8_BAR; PG8_WAIT_L(0); PG8_MMA(0, 1, At, B1); PG8_BAR;
            PG8_LDA(At, 0, 1); PG8_STAGEA(PG8_SA(0, 0), a2, o2, 0, k2);
            PG8_BAR; PG8_WAIT_L(0); PG8_MMA(1, 0, At, B0); PG8_BAR; PG8_SCHED;
            PG8_STAGEB(PG8_SB(0, 1), b2, 1);
            PG8_WAIT_V(6); PG8_BAR; PG8_MMA(1, 1, At, B1); PG8_BAR;
            PG8_LDB(B0, 1, 0); PG8_SCHED; PG8_LDA(At, 1, 0); PG8_STAGEA(PG8_SA(0, 1), a2, o2, 1, k2);
            PG8_WAIT_L(8); PG8_BAR; PG8_WAIT_L(0); PG8_MMA(0, 0, At, B0); PG8_BAR; PG8_SCHED;
            PG8_LDB(B1, 1, 1); PG8_STAGEB(PG8_SB(1, 0), b3, 0);
            PG8_BAR; PG8_WAIT_L(0); PG8_MMA(0, 1, At, B1); PG8_BAR;
            PG8_LDA(At, 1, 1); PG8_STAGEA(PG8_SA(1, 0), a2, o2, 0, k3);
            PG8_BAR; PG8_WAIT_L(0); PG8_MMA(1, 0, At, B0); PG8_BAR; PG8_SCHED;
            PG8_STAGEB(PG8_SB(1, 1), b3, 1);
            PG8_WAIT_V(6); PG8_BAR; PG8_MMA(1, 1, At, B1); PG8_BAR;
        }
        E(acc, cur, wr, wc, fr, fq, lds, ui % 3);
        if (!has_next) break;
#pragma unroll
        for (int a = 0; a < 2; ++a)
#pragma unroll
            for (int b = 0; b < 2; ++b)
#pragma unroll
                for (int m = 0; m < 4; ++m)
#pragma unroll
                    for (int n = 0; n < 2; ++n) acc[a][b][m][n] = (f32x4){0.f, 0.f, 0.f, 0.f};
        cur = nxt; cB = nB; cAb = nAb; ++ui;
#pragma unroll
        for (int h = 0; h < 2; ++h) { pA[h][0] = qA[h][0]; pA[h][1] = qA[h][1]; }
    }
    PG8_WAIT_V(0);
    if (wr == 0) PG8_BAR;
    PG8_BAR;
#undef PG8_SA
#undef PG8_SB
#undef PG8_STAGEA
#undef PG8_STAGEB
#undef PG8_LDA
#undef PG8_LDB
#undef PG8_MMA
#undef PG8_WAIT_V
#undef PG8_WAIT_L
#undef PG8_BAR
#undef PG8_SCHED
}
}

constexpr int AT_K0 = 0, AT_V0 = 17408, AT_KVB = 35840, AT_FL = 71680, AT_QS = 71936;
DI void attn_phase(const bf16_t* Qb, const bf16_t* Kb, const bf16_t* Vt, bf16_t* O, LAS unsigned char* lds, int tid, int wid, int lane) {
    const int fr = lane & 15, fq = lane >> 4;
    LAS int* flags = (LAS int*)(lds + AT_FL);
    for (int bx = blockIdx.x; bx < 512; bx += gridDim.x) {
        const int rnd = bx >> 8, pos = bx & 255;
        const int qb = (rnd & 1) ? (pos >> 6) : (7 - (pos >> 6));
        const int bh = pos & 63, b = bh >> 4, h = bh & 15;
        const int t0 = qb * 256;
        __syncthreads();
        const int kr0 = tid >> 4, kc = tid & 15, vr0 = tid >> 3, vc = tid & 7;
        const bf16_t* kg = Kb + (size_t)(b * SEQ + kr0) * D + h * 128 + kc * 8;
        const bf16_t* vg = Vt + (size_t)(h * 128 + vr0) * T + b * SEQ + vc * 8;
        u32x4 pk0, pk1, pv0, pv1;
        int s0 = t0 + 192;
        pk0 = *(const u32x4*)(kg + (size_t)s0 * D); pk1 = *(const u32x4*)(kg + (size_t)(s0 + 32) * D);
        pv0 = *(const u32x4*)(vg + s0); pv1 = *(const u32x4*)(vg + (size_t)64 * T + s0);
#pragma unroll
        for (int c8 = 0; c8 < 8; ++c8) {
            const int c = tid + 512 * c8, row = c >> 4, c16 = c & 15;
            *(LAS u32x4*)(lds + AT_QS + row * 272 + c16 * 16) = *(const u32x4*)(Qb + (size_t)(b * SEQ + t0 + row) * D + h * 128 + c16 * 8);
        }
        {
            LAS unsigned char* kb_ = lds + AT_K0; LAS unsigned char* vb_ = lds + AT_V0;
            *(LAS u32x4*)(kb_ + kr0 * 272 + kc * 16) = pk0; *(LAS u32x4*)(kb_ + (kr0 + 32) * 272 + kc * 16) = pk1;
            *(LAS u32x4*)(vb_ + vr0 * 144 + vc * 16) = pv0; *(LAS u32x4*)(vb_ + (vr0 + 64) * 144 + vc * 16) = pv1;
            const int s1 = s0 - 64;
            pk0 = *(const u32x4*)(kg + (size_t)s1 * D); pk1 = *(const u32x4*)(kg + (size_t)(s1 + 32) * D); pv0 = *(const u32x4*)(vg + s1); pv1 = *(const u32x4*)(vg + (size_t)64 * T + s1);
        }
        __syncthreads();
        f32x4 oacc[2][8];
#pragma unroll
        for (int r = 0; r < 2; ++r)
#pragma unroll
            for (int n = 0; n < 8; ++n) oacc[r][n] = (f32x4){0.f, 0.f, 0.f, 0.f};
        float Rrun[2] = {0.f, 0.f};
        bool wave_alive = true;
        int it = 0;
        for (;; ++it, s0 -= 64) {
            int zz = 0; asm volatile("" : "+v"(zz));
            const LAS unsigned char* kb_ = lds + zz + AT_K0 + (it & 1) * AT_KVB; const LAS unsigned char* vb_ = lds + zz + AT_V0 + (it & 1) * AT_KVB;
            const bool wave_on = (s0 < t0 + 32 * wid + 31) && wave_alive;
            if (wave_on) {
            f32x4 sacc[2][4];
#pragma unroll
            for (int r = 0; r < 2; ++r)
#pragma unroll
                for (int n = 0; n < 4; ++n) sacc[r][n] = (f32x4){0.f, 0.f, 0.f, 0.f};
#pragma unroll
            for (int ks = 0; ks < 4; ++ks) {
                const bf16x8 qa0 = *(const LAS bf16x8*)(lds + zz + AT_QS + (32 * wid + fr) * 272 + (ks * 32 + fq * 8) * 2);
                const bf16x8 qa1 = *(const LAS bf16x8*)(lds + zz + AT_QS + (32 * wid + 16 + fr) * 272 + (ks * 32 + fq * 8) * 2);
#pragma unroll
                for (int n = 0; n < 4; ++n) {
                    const bf16x8 kf = *(const LAS bf16x8*)(kb_ + (16 * n + fr) * 272 + (ks * 32 + fq * 8) * 2);
                    sacc[0][n] = MFMA16(kf, qa0, sacc[0][n]);
                    sacc[1][n] = MFMA16(kf, qa1, sacc[1][n]);
                }
            }
            unsigned ap[2][4][2];
            const int sb = s0 + 4 * fq;
#pragma unroll
            for (int r = 0; r < 2; ++r) {
                const int tq = t0 + 32 * wid + 16 * r + fr;
                float cs_[4][4], gsum[4];
#pragma unroll
                for (int n = 0; n < 4; ++n) {
                    float run = 0.f;
#pragma unroll
                    for (int j = 3; j >= 0; --j) {
                        const float zz = sacc[r][n][j];
                        const float sp = fmaxf(zz, 0.f) + __builtin_amdgcn_logf(1.0f + __builtin_amdgcn_exp2f(-fabsf(zz)));
                        run -= ((sb + 16 * n + j) < tq) ? sp : 0.f;
                        cs_[n][j] = run;
                    }
                    gsum[n] = run;
                }
                float offs[4]; float acc_after = 0.f;
#pragma unroll
                for (int n = 3; n >= 0; --n) {
                    const float bq = __shfl_xor(gsum[n], 16); const float s01 = gsum[n] + bq; const float oth = __shfl_xor(s01, 32);
                    offs[n] = Rrun[r] + acc_after + (((fq & 1) == 0) ? bq : 0.f) + ((fq < 2) ? oth : 0.f);
                    acc_after += s01 + oth;
                }
                Rrun[r] += acc_after;
#pragma unroll
                for (int n = 0; n < 4; ++n) {
                    float av[4];
#pragma unroll
                    for (int j = 0; j < 4; ++j) av[j] = ((sb + 16 * n + j) < tq) ? __builtin_amdgcn_exp2f(sacc[r][n][j] + cs_[n][j] + offs[n]) : 0.f;
                    ap[r][n][0] = pk2(av[0], av[1]); ap[r][n][1] = pk2(av[2], av[3]);
                }
            }
#pragma unroll
            for (int u = 0; u < 2; ++u) {
                const bf16x8 aa0 = __builtin_bit_cast(bf16x8, ((u32x4){ap[0][2 * u][0], ap[0][2 * u][1], ap[0][2 * u + 1][0], ap[0][2 * u + 1][1]}));
                const bf16x8 aa1 = __builtin_bit_cast(bf16x8, ((u32x4){ap[1][2 * u][0], ap[1][2 * u][1], ap[1][2 * u + 1][0], ap[1][2 * u + 1][1]}));
#pragma unroll
                for (int n = 0; n < 8; ++n) {
                    const s16x4 vlo = *(const LAS s16x4*)(vb_ + (16 * n + fr) * 144 + (32 * u + 4 * fq) * 2);
                    const s16x4 vhi = *(const LAS s16x4*)(vb_ + (16 * n + fr) * 144 + (32 * u + 16 + 4 * fq) * 2);
                    const bf16x8 vf = __builtin_shufflevector(vlo, vhi, 0, 1, 2, 3, 4, 5, 6, 7);
                    oacc[0][n] = MFMA16(vf, aa0, oacc[0][n]);
                    oacc[1][n] = MFMA16(vf, aa1, oacc[1][n]);
                }
            }
            }
            const int sn1 = s0 - 64, sn2 = s0 - 128;
            wave_alive = __any(fmaxf(Rrun[0], Rrun[1]) > -160.0f);
            if (lane == 0) flags[(it & 1) * 8 + wid] = wave_alive ? 1 : 0;
            if (sn1 >= 0) {
                LAS unsigned char* kn = lds + AT_K0 + ((it + 1) & 1) * AT_KVB; LAS unsigned char* vn = lds + AT_V0 + ((it + 1) & 1) * AT_KVB;
                *(LAS u32x4*)(kn + kr0 * 272 + kc * 16) = pk0; *(LAS u32x4*)(kn + (kr0 + 32) * 272 + kc * 16) = pk1;
                *(LAS u32x4*)(vn + vr0 * 144 + vc * 16) = pv0; *(LAS u32x4*)(vn + (vr0 + 64) * 144 + vc * 16) = pv1;
                if (sn2 >= 0) { pk0 = *(const u32x4*)(kg + (size_t)sn2 * D); pk1 = *(const u32x4*)(kg + (size_t)(sn2 + 32) * D); pv0 = *(const u32x4*)(vg + sn2); pv1 = *(const u32x4*)(vg + (size_t)64 * T + sn2); }
            }
            __syncthreads();
            if (sn1 < 0) break;
            int any_alive = 0;
#pragma unroll
            for (int w = 0; w < 8; ++w) any_alive |= flags[(it & 1) * 8 + w];
            if (!any_alive) break;
        }
#pragma unroll
        for (int r = 0; r < 2; ++r) {
            bf16_t* orow = O + (size_t)(b * SEQ + t0 + 32 * wid + 16 * r + fr) * D + h * 128 + 4 * fq;
#pragma unroll
            for (int n = 0; n < 8; ++n) { u32x2 o; o.x = pk2(oacc[r][n].x, oacc[r][n].y); o.y = pk2(oacc[r][n].z, oacc[r][n].w); *(u32x2*)(orow + 16 * n) = o; }
        }
    }
}

constexpr int ML_QS = 0, ML_KS = 17408, ML_KD = 34816, ML_VT = 53248, ML_WS = 90112, ML_HB = 99328, ML_SC = 133120;
DI float ml_tab(LAS float* tab, float gi, float gf, float mprev, int lane) {
    const float flog = fminf(gf, 0.f) - __logf(1.0f + __expf(-fabsf(gf)));
    float bb = flog;
#pragma unroll
    for (int o = 1; o < 64; o <<= 1) { const float v = __shfl_up(bb, o); if (lane >= o) bb += v; }
    const float a = gi - bb;
    float pm = a;
#pragma unroll
    for (int o = 1; o < 64; o <<= 1) { const float v = __shfl_up(pm, o); if (lane >= o) pm = fmaxf(pm, v); }
    const float amax = __shfl(pm, 63), bL = __shfl(bb, 63);
    const float Mx = fmaxf(mprev, amax);
    tab[lane] = a; tab[64 + lane] = bb; tab[128 + lane] = fmaxf(pm, mprev);
    if (lane == 0) { tab[192] = mprev; tab[193] = Mx; }
    return bL + Mx;
}
constexpr int MLA_KD = 0, MLA_SC = 69632;
DI void mlstm_local(const bf16_t* K1, const bf16_t* VT, const float* G, const float* b_i, const float* b_f, bf16_t* KV, float* NJ, float* SUM,
                    LAS unsigned char* lds, int tid, int wid, int lane) {
    const int fr = lane & 15, fq = lane >> 4;
    LAS float* sa = (LAS float*)(lds + MLA_SC); LAS float* swsum = sa + 256; LAS float* swmax = sa + 264;
    for (int unit = blockIdx.x; unit < 256; unit += gridDim.x) {
        const int J = unit & 7, bh = unit >> 3, b = bh >> 3, h = bh & 7;
        if (J == 7) continue;
        const int tok0 = b * SEQ + J * 256;
        __syncthreads();
        float a = 0.f, bb = 0.f;
        if (tid < 256) {
            const size_t g0 = (size_t)(tok0 + tid) * 16;
            const float gi = G[g0 + h] + b_i[h], gf = G[g0 + 8 + h] + b_f[h];
            const float flog = fminf(gf, 0.f) - __logf(1.0f + __expf(-fabsf(gf)));
            bb = flog;
#pragma unroll
            for (int o = 1; o < 64; o <<= 1) { const float v = __shfl_up(bb, o); if (lane >= o) bb += v; }
            if (lane == 63) swsum[wid] = bb;
        }
        __syncthreads();
        if (tid < 256) {
            float off = 0.f;
            for (int w = 0; w < 4; ++w) off += (w < wid) ? swsum[w] : 0.f;
            bb += off;
            const size_t g0 = (size_t)(tok0 + tid) * 16;
            a = (G[g0 + h] + b_i[h]) - bb;
            float mx = a;
#pragma unroll
            for (int o = 1; o < 64; o <<= 1) mx = fmaxf(mx, __shfl_xor(mx, o));
            if (lane == 0) swmax[wid] = mx;
            sa[tid] = a;
        }
        __syncthreads();
        const float amax = fmaxf(fmaxf(swmax[0], swmax[1]), fmaxf(swmax[2], swmax[3]));
        if (tid == 255) { SUM[unit * 2] = amax; SUM[unit * 2 + 1] = bb; }
        bf16x8 vfa[8][2];
#pragma unroll
        for (int ks = 0; ks < 8; ++ks)
#pragma unroll
            for (int et = 0; et < 2; ++et) vfa[ks][et] = *(const bf16x8*)(VT + (size_t)(h * 256 + 32 * wid + 16 * et + fr) * T + tok0 + ks * 32 + fq * 8);
#pragma unroll 2
        for (int c8i = 0; c8i < 8; ++c8i) {
            const int ch = tid + 512 * c8i, sp = ch & 255, c16 = ch >> 8;
            const u32x4 v = *(const u32x4*)(K1 + (size_t)(tok0 + sp) * 1024 + h * 128 + c16 * 8);
            const float dsc = __expf(sa[sp] - amax);
            const unsigned w[4] = {v.x, v.y, v.z, v.w};
            LAS bf16_t* dst = (LAS bf16_t*)(lds + MLA_KD + (c16 * 8) * 528 + sp * 2);
#pragma unroll
            for (int q = 0; q < 4; ++q) { dst[(2 * q) * 264] = (bf16_t)f2bf(bf2f(w[q] & 0xffff) * dsc); dst[(2 * q + 1) * 264] = (bf16_t)f2bf(bf2f(w[q] >> 16) * dsc); }
        }
        __syncthreads();
        f32x4 C[8][2];
#pragma unroll
        for (int dt = 0; dt < 8; ++dt)
#pragma unroll
            for (int et = 0; et < 2; ++et) C[dt][et] = (f32x4){0.f, 0.f, 0.f, 0.f};
#pragma unroll
        for (int ks = 0; ks < 8; ++ks) {
#pragma unroll
            for (int dt = 0; dt < 8; ++dt) {
                const bf16x8 kf = *(const LAS bf16x8*)(lds + MLA_KD + (16 * dt + fr) * 528 + (ks * 32 + fq * 8) * 2);
#pragma unroll
                for (int et = 0; et < 2; ++et) C[dt][et] = MFMA16(kf, vfa[ks][et], C[dt][et]);
            }
        }
        bf16_t* kv = KV + (size_t)unit * 32768;
#pragma unroll
        for (int dt = 0; dt < 8; ++dt)
#pragma unroll
            for (int et = 0; et < 2; ++et) { u32x2 o; o.x = pk2(C[dt][et].x, C[dt][et].y); o.y = pk2(C[dt][et].z, C[dt][et].w); *(u32x2*)(kv + (size_t)(32 * wid + 16 * et + fr) * 128 + 16 * dt + 4 * fq) = o; }
        {
            const int dl = tid >> 2, sl = tid & 3;
            float p = 0.f;
#pragma unroll
            for (int i = 0; i < 8; ++i) {
                const u32x4 kq = *(const LAS u32x4*)(lds + MLA_KD + dl * 528 + sl * 128 + i * 16);
                p += (bf2f(kq.x & 0xffff) + bf2f(kq.x >> 16)) + (bf2f(kq.y & 0xffff) + bf2f(kq.y >> 16)) + (bf2f(kq.z & 0xffff) + bf2f(kq.z >> 16)) + (bf2f(kq.w & 0xffff) + bf2f(kq.w >> 16));
            }
            p += __shfl_xor(p, 1); p += __shfl_xor(p, 2);
            if (sl == 0) NJ[unit * 128 + dl] = p;
        }
    }
}
template <int skip>
DI void mlstm_phase(const bf16_t* Q1, const bf16_t* K1, const bf16_t* VT, const bf16_t* OG, const float* G, const float* b_i, const float* b_f,
                    const float* g_head, bf16_t* HS, const bf16_t* KV, const float* NJ, const float* SUM, LAS unsigned char* lds, int tid, int wid, int lane, int nsteps = 4) {
    const int fr = lane & 15, fq = lane >> 4;
    LAS float* sc = (LAS float*)(lds + ML_SC); LAS float* sssq = sc + 1024; LAS float* srs = sc + 1536; LAS float* sden = sc + 1792; LAS float* sn = sc + 1856; LAS float* sgh = sc + 2112; LAS float* scf = sc + 2368;
    LAS bf16_t* hb = (LAS bf16_t*)(lds + ML_HB);
    for (int unit = blockIdx.x; unit < 256; unit += gridDim.x) {
        const int J = unit & 7, bh = unit >> 3, b = bh >> 3, h = bh & 7;
        const int c0 = 4 * J, c1 = c0 + nsteps;
        __syncthreads();
        if (wid < 4) {
            LAS float* tab = sc + wid * 256;
            const size_t g0 = (size_t)(b * SEQ + (c0 + wid) * 64 + lane) * 16;
            const float gi = G[g0 + h] + b_i[h], gf = G[g0 + 8 + h] + b_f[h];
            const float flog = fminf(gf, 0.f) - __logf(1.0f + __expf(-fabsf(gf)));
            float bb = flog;
#pragma unroll
            for (int o = 1; o < 64; o <<= 1) { const float v = __shfl_up(bb, o); if (lane >= o) bb += v; }
            const float a = gi - bb;
            float pm = a;
#pragma unroll
            for (int o = 1; o < 64; o <<= 1) { const float v = __shfl_up(pm, o); if (lane >= o) pm = fmaxf(pm, v); }
            tab[lane] = a; tab[64 + lane] = bb; tab[128 + lane] = pm;
            if (lane == 63) { tab[192] = pm; tab[193] = bb; }
        }
        if (tid >= 448 && tid < 462) scf[8 + tid - 448] = SUM[bh * 16 + tid - 448];
        __syncthreads();
        if (tid == 0) {
            float cf[7]; float m0 = 0.f;
#pragma unroll
            for (int jp = 0; jp < 7; ++jp) {
                cf[jp] = 0.f;
                if (jp < J) {
                    const float am = scf[8 + 2 * jp], bl = scf[9 + 2 * jp];
                    const float M63 = fmaxf(m0, am), csj = __expf(m0 - M63);
#pragma unroll
                    for (int i = 0; i < 7; ++i) if (i < jp) cf[i] *= csj;
                    cf[jp] = __expf(am - M63);
                    m0 = bl + M63;
                }
            }
#pragma unroll
            for (int jp = 0; jp < 7; ++jp) scf[jp] = cf[jp];
            scf[7] = m0;
        }
        __syncthreads();
        const float m0 = scf[7];
        f32x4 C[8][2];
#pragma unroll
        for (int dt = 0; dt < 8; ++dt)
#pragma unroll
            for (int et = 0; et < 2; ++et) C[dt][et] = (f32x4){0.f, 0.f, 0.f, 0.f};
        float n0 = 0.f;
#pragma unroll 1
        for (int jp = 0; jp < J; ++jp) {
            const bf16_t* kv = KV + (size_t)(bh * 8 + jp) * 32768; const float cf = scf[jp];
#pragma unroll
            for (int dt = 0; dt < 8; ++dt)
#pragma unroll
                for (int et = 0; et < 2; ++et) { const u32x2 v = *(const u32x2*)(kv + (size_t)(32 * wid + 16 * et + fr) * 128 + 16 * dt + 4 * fq);
                    C[dt][et].x += cf * bf2f(v.x & 0xffff); C[dt][et].y += cf * bf2f(v.x >> 16); C[dt][et].z += cf * bf2f(v.y & 0xffff); C[dt][et].w += cf * bf2f(v.y >> 16); }
            if (tid < 128) n0 += cf * NJ[(bh * 8 + jp) * 128 + tid];
        }
        if (tid < 128) sn[tid] = n0;
        if (tid >= 256) sgh[tid - 256] = g_head[h * 256 + tid - 256];
        __syncthreads();
        if (tid == 0) { float m = m0; for (int cc = 0; cc < 4; ++cc) { LAS float* tab = sc + cc * 256; const float M63 = fmaxf(m, tab[192]); tab[194] = m; tab[195] = M63; m = tab[193] + M63; } }
        __syncthreads();
        u32x4 rq[2], rk[2], rt[2], rv[4];
#define ML_LOAD(cc) do { const int tk_ = b * SEQ + (cc) * 64; _Pragma("unroll") for (int c2 = 0; c2 < 2; ++c2) { const int ch = tid + 512 * c2; \
            rq[c2] = *(const u32x4*)(Q1 + (size_t)(tk_ + (ch >> 4)) * 1024 + h * 128 + (ch & 15) * 8); rk[c2] = *(const u32x4*)(K1 + (size_t)(tk_ + (ch >> 4)) * 1024 + h * 128 + (ch & 15) * 8); \
            rt[c2] = *(const u32x4*)(K1 + (size_t)(tk_ + (ch & 63)) * 1024 + h * 128 + (ch >> 6) * 8); } \
        _Pragma("unroll") for (int c4 = 0; c4 < 4; ++c4) { const int ch = tid + 512 * c4; rv[c4] = *(const u32x4*)(VT + (size_t)(h * 256 + (ch >> 3)) * T + tk_ + (ch & 7) * 8); } } while (0)
#define ML_STORE(cc) do { const LAS float* tb_ = sc + ((cc) - c0) * 256; const float M63_ = tb_[195]; _Pragma("unroll") for (int c2 = 0; c2 < 2; ++c2) { const int ch = tid + 512 * c2; \
            *(LAS u32x4*)(lds + ML_QS + (ch >> 4) * 272 + (ch & 15) * 16) = rq[c2]; *(LAS u32x4*)(lds + ML_KS + (ch >> 4) * 272 + (ch & 15) * 16) = rk[c2]; \
            const int sp = ch & 63, c16 = ch >> 6; const float dsc = __expf(tb_[sp] - M63_); const unsigned w_[4] = {rt[c2].x, rt[c2].y, rt[c2].z, rt[c2].w}; \
            LAS bf16_t* dst = (LAS bf16_t*)(lds + ML_KD + (c16 * 8) * 144 + sp * 2); \
            _Pragma("unroll") for (int q = 0; q < 4; ++q) { dst[(2 * q) * 72] = (bf16_t)f2bf(bf2f(w_[q] & 0xffff) * dsc); dst[(2 * q + 1) * 72] = (bf16_t)f2bf(bf2f(w_[q] >> 16) * dsc); } } \
        _Pragma("unroll") for (int c4 = 0; c4 < 4; ++c4) { const int ch = tid + 512 * c4; *(LAS u32x4*)(lds + ML_VT + (ch >> 3) * 144 + (ch & 7) * 16) = rv[c4]; } } while (0)
        if (c0 < c1) { ML_LOAD(c0); ML_STORE(c0); }
#pragma unroll 1
        for (int c = c0; c < c1; ++c) {
            int zz = 0; asm volatile("" : "+v"(zz));
            LAS unsigned char* const L = lds + zz; LAS float* const scz = (LAS float*)(L + ML_SC);
            LAS float* const sssq = scz + 1024; LAS float* const srs = scz + 1536; LAS float* const sden = scz + 1792; LAS float* const sn = scz + 1856; LAS float* const sgh = scz + 2112; LAS bf16_t* const hb = (LAS bf16_t*)(L + ML_HB);
            const int tok0 = b * SEQ + c * 64;
            const LAS float* tab = scz + (c - c0) * 256;
            LAS float* sncur = sn + ((c - c0) & 1) * 128; LAS float* snnxt = sn + (((c - c0) & 1) ^ 1) * 128;
            __syncthreads();
            const float mprev = tab[194], M63 = tab[195];
            if (!(skip & 1)) {
                const int tb = wid >> 1;
#pragma unroll
                for (int a2 = 0; a2 < 2; ++a2) {
                    const int sa_t = 2 * (wid & 1) + a2;
                    u32x2 o = (u32x2){0u, 0u}; float rsum = 0.f;
                    if (sa_t <= tb) {
                        f32x4 acc = (f32x4){0.f, 0.f, 0.f, 0.f};
#pragma unroll
                        for (int ks = 0; ks < 4; ++ks) {
                            const bf16x8 kf = *(const LAS bf16x8*)(L + ML_KS + (16 * sa_t + fr) * 272 + (ks * 32 + fq * 8) * 2);
                            const bf16x8 qf = *(const LAS bf16x8*)(L + ML_QS + (16 * tb + fr) * 272 + (ks * 32 + fq * 8) * 2);
                            acc = MFMA16(kf, qf, acc);
                        }
                        const int tl = 16 * tb + fr; const float Mt = fmaxf(tab[128 + tl], mprev);
                        float wv[4];
#pragma unroll
                        for (int j = 0; j < 4; ++j) { const int sl = 16 * sa_t + 4 * fq + j; wv[j] = (sl <= tl) ? acc[j] * __expf(tab[sl] - Mt) : 0.f; }
                        o.x = pk2(wv[0], wv[1]); o.y = pk2(wv[2], wv[3]);
                        rsum = (wv[0] + wv[1]) + (wv[2] + wv[3]);
                        rsum += __shfl_xor(rsum, 16); rsum += __shfl_xor(rsum, 32);
                    }
                    *(LAS u32x2*)(L + ML_WS + (16 * tb + fr) * 144 + (16 * sa_t + 4 * fq) * 2) = o;
                    if (fq == 0) srs[sa_t * 64 + 16 * tb + fr] = rsum;
                }
            }
            __syncthreads();
            if (!(skip & 2)) {
                const int tl = tid >> 3, sl = tid & 7;
                const u32x4 qa = *(const LAS u32x4*)(L + ML_QS + tl * 272 + sl * 32), qb = *(const LAS u32x4*)(L + ML_QS + tl * 272 + sl * 32 + 16);
                const unsigned qw[8] = {qa.x, qa.y, qa.z, qa.w, qb.x, qb.y, qb.z, qb.w};
                float p = 0.f;
#pragma unroll
                for (int k = 0; k < 8; ++k) p += bf2f(qw[k] & 0xffff) * sncur[sl * 16 + 2 * k] + bf2f(qw[k] >> 16) * sncur[sl * 16 + 2 * k + 1];
                p += __shfl_xor(p, 1); p += __shfl_xor(p, 2); p += __shfl_xor(p, 4);
                if (sl == 0) sden[tl] = __expf(mprev - fmaxf(tab[128 + tl], mprev)) * p + (srs[tl] + srs[64 + tl]) + (srs[128 + tl] + srs[192 + tl]);
            }
#pragma unroll 1
            for (int tt = 0; tt < ((skip & 4) ? 0 : 4); ++tt) {
                f32x4 num[2];
#pragma unroll
                for (int et = 0; et < 2; ++et) num[et] = (f32x4){0.f, 0.f, 0.f, 0.f};
#pragma unroll
                for (int u = 0; u < 4; ++u) {
                    const s16x4 qlo = *(const LAS s16x4*)(L + ML_QS + (16 * tt + fr) * 272 + (32 * u + 4 * fq) * 2);
                    const s16x4 qhi = *(const LAS s16x4*)(L + ML_QS + (16 * tt + fr) * 272 + (32 * u + 16 + 4 * fq) * 2);
                    const bf16x8 qf = __builtin_shufflevector(qlo, qhi, 0, 1, 2, 3, 4, 5, 6, 7);
#pragma unroll
                    for (int et = 0; et < 2; ++et) {
                        const f32x4 c0v = C[2 * u][et], c1v = C[2 * u + 1][et];
                        u32x4 pb; pb.x = pk2(c0v.x, c0v.y); pb.y = pk2(c0v.z, c0v.w); pb.z = pk2(c1v.x, c1v.y); pb.w = pk2(c1v.z, c1v.w);
                        num[et] = MFMA16(qf, __builtin_bit_cast(bf16x8, pb), num[et]);
                    }
                }
                float scv[4];
#pragma unroll
                for (int j = 0; j < 4; ++j) scv[j] = __expf(mprev - fmaxf(tab[128 + 16 * tt + 4 * fq + j], mprev));
#pragma unroll
                for (int et = 0; et < 2; ++et) { num[et].x *= scv[0]; num[et].y *= scv[1]; num[et].z *= scv[2]; num[et].w *= scv[3]; }
                const int nks = (tt < 2) ? 1 : 2;
                for (int ks = 0; ks < nks; ++ks) {
                    const bf16x8 wf = *(const LAS bf16x8*)(L + ML_WS + (16 * tt + fr) * 144 + (ks * 32 + fq * 8) * 2);
#pragma unroll
                    for (int et = 0; et < 2; ++et) {
                        const bf16x8 vf = *(const LAS bf16x8*)(L + ML_VT + (32 * wid + 16 * et + fr) * 144 + (ks * 32 + fq * 8) * 2);
                        num[et] = MFMA16(wf, vf, num[et]);
                    }
                }
#pragma unroll
                for (int j = 0; j < 4; ++j) {
                    const int tl = 16 * tt + 4 * fq + j;
                    const float h0 = num[0][j], h1 = num[1][j];
                    hb[tl * 264 + 32 * wid + fr] = (bf16_t)f2bf(h0);
                    hb[tl * 264 + 32 * wid + 16 + fr] = (bf16_t)f2bf(h1);
                    float s = h0 * h0 + h1 * h1;
                    s += dpp_f(s, 0xB1); s += dpp_f(s, 0x4E); s += dpp_f(s, 0x141); s += dpp_f(s, 0x140);
                    if (fr == 0) sssq[wid * 64 + tl] = s;
                }
            }
            const float cs = __expf(mprev - M63);
            if (!(skip & 8)) {
#pragma unroll
                for (int dt = 0; dt < 8; ++dt)
#pragma unroll
                    for (int et = 0; et < 2; ++et) { C[dt][et].x *= cs; C[dt][et].y *= cs; C[dt][et].z *= cs; C[dt][et].w *= cs; }
#pragma unroll
                for (int ks = 0; ks < 2; ++ks) {
                    bf16x8 vf[2];
#pragma unroll
                    for (int et = 0; et < 2; ++et) vf[et] = *(const LAS bf16x8*)(L + ML_VT + (32 * wid + 16 * et + fr) * 144 + (ks * 32 + fq * 8) * 2);
#pragma unroll
                    for (int dt = 0; dt < 8; ++dt) {
                        const bf16x8 kf = *(const LAS bf16x8*)(L + ML_KD + (16 * dt + fr) * 144 + (ks * 32 + fq * 8) * 2);
#pragma unroll
                        for (int et = 0; et < 2; ++et) C[dt][et] = MFMA16(kf, vf[et], C[dt][et]);
                    }
                }
            }
            {
                const int dl = tid >> 2, sl = tid & 3;
                const u32x4 ka = *(const LAS u32x4*)(L + ML_KD + dl * 144 + sl * 32), kb = *(const LAS u32x4*)(L + ML_KD + dl * 144 + sl * 32 + 16);
                const unsigned kw[8] = {ka.x, ka.y, ka.z, ka.w, kb.x, kb.y, kb.z, kb.w};
                float p = 0.f;
#pragma unroll
                for (int k = 0; k < 8; ++k) p += bf2f(kw[k] & 0xffff) + bf2f(kw[k] >> 16);
                p += __shfl_xor(p, 1); p += __shfl_xor(p, 2);
                if (sl == 0) snnxt[dl] = cs * sncur[dl] + p;
            }
            __syncthreads();
            if (skip & 16) { if (c + 1 < c1) ML_LOAD(c + 1); } else {
                const int tl = tid >> 3, part = tid & 7;
                u32x4 ovq[4];
#pragma unroll
                for (int q = 0; q < 4; ++q) ovq[q] = *(const u32x4*)(OG + (size_t)(tok0 + tl) * D + h * 256 + (part + 8 * q) * 8);
                if (c + 1 < c1) ML_LOAD(c + 1);
                float tot = 0.f;
#pragma unroll
                for (int w = 0; w < 8; ++w) tot += sssq[w * 64 + tl];
                const float dd = 1.0f / fmaxf(fabsf(sden[tl]), __expf(-(tab[64 + tl] + fmaxf(tab[128 + tl], mprev))));
                const float rinv = dd / sqrtf(tot * dd * dd * (1.0f / 256.0f) + EPS);
#pragma unroll
                for (int q = 0; q < 4; ++q) {
                    const int e0 = (part + 8 * q) * 8;
                    const u32x4 hv = *(const LAS u32x4*)(L + ML_HB + tl * 528 + e0 * 2);
                    const size_t idx = (size_t)(tok0 + tl) * D + h * 256 + e0;
                    const u32x4 ov = ovq[q];
                    const f32x4 g0 = *(const LAS f32x4*)(sgh + e0), g1 = *(const LAS f32x4*)(sgh + e0 + 4);
                    const unsigned hw[4] = {hv.x, hv.y, hv.z, hv.w}, ow[4] = {ov.x, ov.y, ov.z, ov.w};
                    const float gg[8] = {g0.x, g0.y, g0.z, g0.w, g1.x, g1.y, g1.z, g1.w};
                    unsigned r[4];
#pragma unroll
                    for (int k = 0; k < 4; ++k) {
                        const float ha = bf2f(hw[k] & 0xffff), hbv = bf2f(hw[k] >> 16), oa = bf2f(ow[k] & 0xffff), ob = bf2f(ow[k] >> 16);
                        r[k] = pk2(ha * rinv * gg[2 * k] / (1.0f + __expf(-oa)), hbv * rinv * gg[2 * k + 1] / (1.0f + __expf(-ob)));
                    }
                    *(u32x4*)(HS + idx) = (u32x4){r[0], r[1], r[2], r[3]};
                }
            }
            if (c + 1 < c1) ML_STORE(c + 1);
        }
#undef ML_LOAD
#undef ML_STORE
    }
}

DI void convert_moe_layer(int l, bool do13, bool do2, int gw, int NGW, const float* w1, const float* w3, const float* w2, bf16_t* W13, bf16_t* W2, LAS unsigned char* lds, int wid, int lane) {
    LAS float* scr = (LAS float*)(lds + wid * 16640);
    constexpr int I_W1 = 32 * 32 * 4, I_W2 = 32 * 4 * 32;
    if (do13) for (int it = gw; it < 2 * I_W1; it += NGW) {
        const int which = it / I_W1, r = it % I_W1, le = l * NE + r / 128, q = r % 128;
        transpose_item((which ? w3 : w1) + (size_t)le * D * FF, FF, W13 + (size_t)le * 512 * D, D, 64 * (q / 4), 64 * (q % 4), 1 + which, scr, lane); }
    if (do2) for (int it = gw; it < I_W2; it += NGW) {
        const int le = l * NE + it / 128, q = it % 128;
        transpose_item(w2 + (size_t)le * FF * D, D, W2 + (size_t)le * D * FF, FF, 64 * (q / 32), 64 * (q % 32), 0, scr, lane); }
}

__global__ void __launch_bounds__(NTHREADS, 2) fwd_kernel(Args args) {
    extern __shared__ __attribute__((aligned(16))) unsigned char lds_raw[];
    LAS unsigned char* lds = (LAS unsigned char*)lds_raw;
    const int tid = threadIdx.x, lane = tid & 63, wid = __builtin_amdgcn_readfirstlane(tid >> 6);
    unsigned char* ws = args.ws;
    unsigned* ctl = (unsigned*)(ws + WS_CTL);
    volatile LAS unsigned* misc = (volatile LAS unsigned*)(lds + LDS_BYTES - 256);
    if (tid < 16) misc[tid] = 0u;
    __syncthreads();
    XcdBarrier bar; bar.bar = ctl + CW_BAR; bar.x = 0; bar.st = misc;
    const int lo = args.ph_lo, hi = args.ph_hi;
    if (PROBE_A >= 0 && blockIdx.x == 0 && tid == 0) misc[16] = (unsigned)__builtin_amdgcn_s_memrealtime();
    if (hi - lo > 1) bar = xcd_barrier_post(ctl + CW_BAR, misc);
#ifndef PHMASK
#define PHMASK 0xffff
#endif
#define IN(k) (((PHMASK >> (k)) & 1) && lo <= (k) && (k) < hi)
#ifndef XBAR
#define XBAR 0
#endif
#define SEAM(k) do { if (IN(k) && IN((k) + 1)) { xcd_barrier(bar); if ((k) == 5) for (int xb_ = 0; xb_ < XBAR; ++xb_) xcd_barrier(bar); } if (PROBE_A >= 0 && blockIdx.x == 0 && tid == 0) misc[16 + (k) + 1] = (unsigned)__builtin_amdgcn_s_memrealtime(); } while (0)

#define PH(k, ...) { __VA_ARGS__ } if ((REPEAT_MASK >> (k)) & 1) { xcd_barrier(bar); { __VA_ARGS__ } }
#define LZ(z) int z = 0; asm volatile("" : "+s"(z))
#define INP(k) (args.in[k] + z)
#define WSP(type, off) ((type*)(ws + (off) + z))
#define ACT(type, off) ((type*)(ws + WS_ACT + (off) + z))

    PH(0, if (IN(0)) {
        LZ(z);
        const float* sb_w_in = INP(4); const float* sb_w_out = INP(5); const float* ml_w_in = INP(6); const float* ml_w_out = INP(10);
        const float* moe_w1 = INP(15); const float* moe_w3 = INP(16); const float* moe_w2 = INP(17);
        bf16_t* Wsbin = WSP(bf16_t, WS_WSBIN); bf16_t* Wsbout = WSP(bf16_t, WS_WSBOUT); bf16_t* Wmlin = WSP(bf16_t, WS_WMLIN); bf16_t* Wmlout = WSP(bf16_t, WS_WMLOUT);
        bf16_t* W13 = WSP(bf16_t, WS_W13); bf16_t* W2 = WSP(bf16_t, WS_W2);
        LAS float* scr = (LAS float*)(lds + wid * 16640);
        const int gw = blockIdx.x * 8 + wid, NGW = gridDim.x * 8;
        constexpr int I_SBIN = 32 * 96, I_SBOUT = 32 * 32, I_MLIN = 32 * 96, I_MLOUT = 32 * 32;
        constexpr int NITEMS = I_SBIN + I_SBOUT + I_MLIN + I_MLOUT;
        for (int it0 = gw; it0 < NITEMS; it0 += NGW) {
            int r = NITEMS - 1 - it0;
            if (r < I_SBIN) { transpose_item(sb_w_in, 6144, Wsbin, D, 64 * (r / 96), 64 * (r % 96), 0, scr, lane); continue; } r -= I_SBIN;
            if (r < I_SBOUT) { transpose_item(sb_w_out, D, Wsbout, D, 64 * (r / 32), 64 * (r % 32), 0, scr, lane); continue; } r -= I_SBOUT;
            if (r < I_MLIN) { transpose_item(ml_w_in, ML_IN, Wmlin, D, 64 * (r / 96), 64 * (r % 96), 0, scr, lane); continue; } r -= I_MLIN;
            transpose_item(ml_w_out, D, Wmlout, D, 64 * (r / 32), 64 * (r % 32), 0, scr, lane);
        }
        {
            const float* wg = INP(11); const float* we = INP(13); const float* wml = INP(6);
            bf16_t* wr = WSP(bf16_t, WS_WR); bf16_t* wgi = WSP(bf16_t, WS_WG);
            const int gt = blockIdx.x * NTHREADS + tid, NGT = gridDim.x * NTHREADS;
            for (int idx = gt; idx < 2 * 98304 + 32768; idx += NGT) {
                if (idx < 2 * 98304) {
                    const int l = idx / 98304, r = idx % 98304, j = r & 7, ln = (r >> 3) & 63, q = r >> 9, nt = q % 3, ks = q / 3;
                    const int k = 32 * ks + 8 * (ln >> 4) + j, n = 16 * nt + (ln & 15);
                    const float w = (n < 4) ? wg[(size_t)l * D * 4 + k * 4 + n] : ((n < 36) ? we[(size_t)l * D * 32 + k * 32 + (n - 4)] : 0.f);
                    wr[(size_t)l * (WR_BYTES / 2) + r] = (bf16_t)f2bf(w);
                } else {
                    const int r = idx - 2 * 98304, j = r & 7, ln = (r >> 3) & 63, ks = r >> 9;
                    const int k = 32 * ks + 8 * (ln >> 4) + j, n = ln & 15;
                    wgi[r] = (bf16_t)f2bf(wml[(size_t)k * ML_IN + 6144 + n]);
                }
            }
        }
        __syncthreads();
        NormP p{}; p.src = INP(0); p.H = WSP(bf16_t, WS_H); p.g = INP(1);
        norm_phase<0, false>(p, lds, tid, wid, lane);
    })
    SEAM(0);
    PH(1, if (IN(1)) {
        LZ(z);
        bf16_t* H = WSP(bf16_t, WS_H); bf16_t* Wsbin = WSP(bf16_t, WS_WSBIN);
        if (tid == 0) {
            pg8::put_job(lds, 0, H, Wsbin, T, 4096, ACT(bf16_t, A_Q), ACT(bf16_t, A_K), D, 2048, 0.12751743074602467f);
            pg8::put_job(lds, 1, Wsbin + (size_t)4096 * D, H, D, T, ACT(bf16_t, A_VT), ACT(bf16_t, A_VT), T, 1 << 30, 1.0f);
        }
        __syncthreads();
        pg8::Sched S; S.init(lds, 2, gridDim.x, blockIdx.x);
        pg8::EpiBf16 E{S.tab};
        pg8::gemm_phase(lds, S, E);
    })
    SEAM(1);
    PH(2, if (IN(2)) { LZ(z); attn_phase(ACT(bf16_t, A_Q), ACT(bf16_t, A_K), ACT(bf16_t, A_VT), ACT(bf16_t, A_O), lds, tid, wid, lane); })
    SEAM(2);
    PH(3, if (IN(3)) { LZ(z);
        if (tid == 0) pg8::put_job(lds, 0, ACT(bf16_t, A_O), WSP(bf16_t, WS_WSBOUT), T, D, ACT(bf16_t, A_Z0), ACT(bf16_t, A_Z0), D, 1 << 30, 1.0f);
        __syncthreads();
        pg8::Sched S; S.init(lds, 1, gridDim.x, blockIdx.x);
        pg8::EpiBf16 E{S.tab}; pg8::gemm_phase(lds, S, E); })
    SEAM(3);
#if defined(OUTPROJ_PROBE)
    {
        LZ(z);
        if (tid == 0) pg8::put_job(lds, 0, ACT(bf16_t, A_O), WSP(bf16_t, WS_WSBOUT), T, D, nullptr, nullptr, D, 0, 1.0f);
        __syncthreads();
        pg8::Sched S; S.init(lds, 1, gridDim.x, blockIdx.x);
#if OUTPROJ_PROBE == 1
        pg8::EpiNull E; pg8::gemm_phase(lds, S, E);
#else
        pg8::EpiResF32 E{INP(0), ACT(float, A_Q), D}; pg8::gemm_phase(lds, S, E);
#endif
        xcd_barrier(bar);
    }
#endif
#define MOE_PHASES(l, pb) \
    PH(pb, if (IN(pb)) { LZ(z); convert_moe_layer(l, true, false, blockIdx.x * 8 + wid, gridDim.x * 8, INP(15), INP(16), INP(17), WSP(bf16_t, WS_W13), WSP(bf16_t, WS_W2), lds, wid, lane); __syncthreads(); NormP p{}; p.src = (l) ? (const float*)WSP(bf16_t, WS_X) : INP(0); p.Y = (l) ? ACT(bf16_t, A_Z1) : ACT(bf16_t, A_Z0); p.X = WSP(bf16_t, WS_X); p.H = WSP(bf16_t, WS_H); p.g = INP(2) + (l) * D; p.wimg = WSP(bf16_t, WS_WR + (l) * WR_BYTES); p.bg = INP(12) + (l) * 4; \
        p.be = INP(14) + (l) * 32; p.cnt = ctl + CW_CNT + 64 * (l) + z; p.list = ACT(unsigned, A_LIST); p.listw = ACT(float, A_LISTW); \
        if (l) norm_phase<1, true>(p, lds, tid, wid, lane); else norm_phase<1, false>(p, lds, tid, wid, lane); }) \
    SEAM(pb); \
    PH((pb) + 1, if (IN((pb) + 1)) { LZ(z); pg8::moe_table256(ctl + CW_CNT + 64 * (l) + z, lds, tid); \
        pg8::MSched<2> S; S.init(lds, gridDim.x, blockIdx.x); \
        { const int nun = S.total; const int idle = (int)gridDim.x - nun;        \
          if (idle > 0) { if ((int)blockIdx.x >= nun) convert_moe_layer(l, false, true, ((int)blockIdx.x - nun) * 8 + wid, idle * 8, INP(15), INP(16), INP(17), WSP(bf16_t, WS_W13), WSP(bf16_t, WS_W2), lds, wid, lane); } \
          else { convert_moe_layer(l, false, true, blockIdx.x * 8 + wid, gridDim.x * 8, INP(15), INP(16), INP(17), WSP(bf16_t, WS_W13), WSP(bf16_t, WS_W2), lds, wid, lane); __syncthreads(); } } \
        pg8::MOps1 P{WSP(bf16_t, WS_H), WSP(bf16_t, WS_W13) + (size_t)(l) * NE * 512 * D, ACT(unsigned, A_LIST)}; \
        pg8::EpiSwiglu E{ACT(bf16_t, A_HID), ACT(float, A_LISTW)}; \
        pg8::gemm_phase_m<2048>(lds, S, P, E); }) \
    SEAM((pb) + 1); \
    PH((pb) + 2, if (IN((pb) + 2)) { LZ(z); pg8::moe_table256(ctl + CW_CNT + 64 * (l) + z, lds, tid); \
        pg8::MSched<8> S; S.init(lds, gridDim.x, blockIdx.x); \
        pg8::MOps2 P{ACT(bf16_t, A_HID), WSP(bf16_t, WS_W2) + (size_t)(l) * NE * D * FF}; \
        pg8::EpiScatter E{ACT(bf16_t, A_Y), ACT(unsigned, A_LIST)}; \
        pg8::gemm_phase_m<256>(lds, S, P, E); }) \
    SEAM((pb) + 2);
    MOE_PHASES(0, 4)
#if defined(MOE2_PROBE)
    {
        xcd_barrier(bar); LZ(z); pg8::moe_table256(ctl + CW_CNT + z, lds, tid);
        pg8::MSched<8> S; S.init(lds, gridDim.x, blockIdx.x);
        pg8::MOps2 P{ACT(bf16_t, A_HID), WSP(bf16_t, WS_W2)};
#if MOE2_PROBE == 1
        pg8::EpiMNull E; pg8::gemm_phase_m<256>(lds, S, P, E);
#else
        pg8::EpiScatter E{ACT(bf16_t, A_Y), ACT(unsigned, A_LIST)}; pg8::gemm_phase_m<256>(lds, S, P, E);
#endif
        xcd_barrier(bar);
    }
#endif
#if defined(ROUTER2X)
    { xcd_barrier(bar); LZ(z); NormP p{}; p.src = INP(0); p.Y = ACT(bf16_t, A_Z0); p.X = ACT(bf16_t, 96 * MiB); p.H = ACT(bf16_t, A_O); p.g = INP(2); p.wimg = WSP(bf16_t, WS_WR); p.bg = INP(12); p.be = INP(14);
      p.cnt = ctl + CW_CNT + 64 * 2 + z; p.list = ACT(unsigned, 128 * MiB); p.listw = ACT(float, 130 * MiB); norm_phase<1, false>(p, lds, tid, wid, lane); xcd_barrier(bar); }
#endif
    PH(7, if (IN(7)) { LZ(z); NormP p{}; p.X = WSP(bf16_t, WS_X); p.Y = ACT(bf16_t, A_Y); p.H = WSP(bf16_t, WS_H); p.g = INP(1) + D; p.wimg = WSP(bf16_t, WS_WG); p.G = ACT(float, A_G); norm_phase<2, true>(p, lds, tid, wid, lane); })
    SEAM(7);
    PH(8, if (IN(8)) {
        LZ(z);
        bf16_t* H = WSP(bf16_t, WS_H); bf16_t* Wmlin = WSP(bf16_t, WS_WMLIN);
        if (tid == 0) {
            pg8::put_job(lds, 0, H, Wmlin, T, 2048, ACT(bf16_t, A_Q1), ACT(bf16_t, A_K1), 1024, 1024, 0.08838834764831845f);
            pg8::put_job(lds, 1, H, Wmlin + (size_t)4096 * D, T, 2048, ACT(bf16_t, A_OG), ACT(bf16_t, A_OG), D, 1 << 30, 1.0f);
            pg8::put_job(lds, 2, Wmlin + (size_t)2048 * D, H, 2048, T, ACT(bf16_t, A_VT1), ACT(bf16_t, A_VT1), T, 1 << 30, 1.0f);
        }
        __syncthreads();
        pg8::Sched S; S.init(lds, 3, gridDim.x, blockIdx.x);
        pg8::EpiBf16 E{S.tab};
        pg8::gemm_phase(lds, S, E);
    })
    SEAM(8);
    PH(9, if (IN(9)) { LZ(z); mlstm_local(ACT(bf16_t, A_K1), ACT(bf16_t, A_VT1), ACT(float, A_G), INP(7), INP(8), WSP(bf16_t, WS_H), ACT(float, A_NJ), ACT(float, A_SUM), lds, tid, wid, lane); })
    SEAM(9);
    PH(10, if (IN(10)) { LZ(z); mlstm_phase<0>(ACT(bf16_t, A_Q1), ACT(bf16_t, A_K1), ACT(bf16_t, A_VT1), ACT(bf16_t, A_OG), ACT(float, A_G), INP(7), INP(8), INP(9), ACT(bf16_t, A_HS),
        WSP(bf16_t, WS_H), ACT(float, A_NJ), ACT(float, A_SUM), lds, tid, wid, lane); })
    SEAM(10);
#if defined(ML_PROBE)
    {
        LZ(z); mlstm_phase<ML_PROBE>(ACT(bf16_t, A_Q1), ACT(bf16_t, A_K1), ACT(bf16_t, A_VT1), ACT(bf16_t, A_OG), ACT(float, A_G), INP(7), INP(8), INP(9), (bf16_t*)(args.out + z),
            WSP(bf16_t, WS_H), ACT(float, A_NJ), ACT(float, A_SUM), lds, tid, wid, lane, 4); xcd_barrier(bar); }
#endif
    PH(11, if (IN(11)) { LZ(z);
        if (tid == 0) pg8::put_job(lds, 0, ACT(bf16_t, A_HS), WSP(bf16_t, WS_WMLOUT), T, D, ACT(bf16_t, A_Z1), ACT(bf16_t, A_Z1), D, 1 << 30, 1.0f);
        __syncthreads();
        pg8::Sched S; S.init(lds, 1, gridDim.x, blockIdx.x);
        pg8::EpiBf16 E{S.tab}; pg8::gemm_phase(lds, S, E); })
    SEAM(11);
    MOE_PHASES(1, 12)
    PH(15, if (IN(15)) { LZ(z); NormP p{}; p.X = WSP(bf16_t, WS_X); p.Y = ACT(bf16_t, A_Y); p.outf = args.out + z; p.g = INP(3); norm_phase<3, true>(p, lds, tid, wid, lane); })
    if (PROBE_A >= 0 && blockIdx.x == 0 && tid == 0) {
        misc[16 + 16] = (unsigned)__builtin_amdgcn_s_memrealtime();
        const float tA = (float)(misc[16 + PROBE_A + 1] - misc[16 + PROBE_A]) * 0.01f, tB = (PROBE_B >= 0) ? (float)(misc[16 + PROBE_B + 1] - misc[16 + PROBE_B]) * 0.01f : 0.f;
        args.out[0] = (1.0f + tA * 0.02f) * __builtin_powf(10.0f, __builtin_rintf(tB * 0.1f));
    }
#undef IN
#undef SEAM
}

extern "C" void kernel_launch(void* const* d_in, const int* in_sizes, int n_in, void* d_out, int out_size, void* d_ws, size_t ws_size, hipStream_t stream) {
    static int grid = 0;
    if (grid == 0) {
        if (n_in != 18 || out_size != T * D || ws_size < WS_END) { fprintf(stderr, "kernel_launch: unexpected shapes (n_in %d out %d ws %zu need %zu)\n", n_in, out_size, ws_size, (size_t)WS_END); grid = -1; return; }
        int dev = 0, cus = 0, per_cu = 0;
        if (hipGetDevice(&dev) != hipSuccess || hipDeviceGetAttribute(&cus, hipDeviceAttributeMultiprocessorCount, dev) != hipSuccess) { grid = -1; return; }
        if (hipFuncSetAttribute((const void*)fwd_kernel, hipFuncAttributeMaxDynamicSharedMemorySize, LDS_BYTES) != hipSuccess) { fprintf(stderr, "kernel_launch: hipFuncSetAttribute failed\n"); grid = -1; return; }
        if (hipOccupancyMaxActiveBlocksPerMultiprocessor(&per_cu, (const void*)fwd_kernel, NTHREADS, LDS_BYTES) != hipSuccess || per_cu < 1) { fprintf(stderr, "kernel_launch: occupancy query says %d\n", per_cu); per_cu = 1; }
        (void)hipGetLastError();
        grid = cus;
    }
    if (grid < 0) return;
    (void)hipMemsetAsync((char*)d_ws + WS_CTL, 0, CTL_BYTES, stream);
    Args a{};
    for (int i = 0; i < 18; ++i) a.in[i] = (const float*)d_in[i];
    a.out = (float*)d_out; a.ws = (unsigned char*)d_ws;
#if MK_MULTI
    for (int ph = 0; ph < NPHASE; ++ph) { a.ph_lo = ph; a.ph_hi = ph + 1; hipLaunchKernelGGL(fwd_kernel, dim3(grid), dim3(NTHREADS), LDS_BYTES, stream, a); }
#else
    a.ph_lo = 0; a.ph_hi = NPHASE;
    void* kargs[] = {&a};
    hipError_t e = hipLaunchCooperativeKernel((const void*)fwd_kernel, dim3(grid), dim3(NTHREADS), kargs, LDS_BYTES, stream);
    if (e != hipSuccess) fprintf(stderr, "kernel_launch: cooperative launch failed: %s\n", hipGetErrorString(e));
#endif
}
```

```cpp
#include <hip/hip_runtime.h>
#include <cstdio>
#include <cstdint>

#define GAS __attribute__((address_space(1)))
#define LAS __attribute__((address_space(3)))
#define DI __device__ __forceinline__
typedef unsigned short bf16_t;
typedef short bf16x8 __attribute__((ext_vector_type(8)));
typedef short s16x4 __attribute__((ext_vector_type(4)));
typedef float f32x4 __attribute__((ext_vector_type(4)));
typedef unsigned u32x4 __attribute__((ext_vector_type(4)));
typedef unsigned u32x2 __attribute__((ext_vector_type(2)));

#ifndef PROBE_A
#define PROBE_A -1
#define PROBE_B -1
#endif
#ifndef REPEAT_MASK
#define REPEAT_MASK 0
#endif
#ifndef MK_MULTI
#define MK_MULTI 0
#endif

constexpr int T = 8192, D = 2048, SEQ = 2048;
constexpr int SBH = 16;
constexpr int MLH = 8, ML_IN = 6160;
constexpr int NE = 32, FF = 256;
constexpr float EPS = 1e-6f;
constexpr int NPHASE = 16;
constexpr int NTHREADS = 512;
constexpr int LDS_BYTES = 147456;

constexpr size_t MiB = 1u << 20;
constexpr size_t WS_CTL = 0, CTL_BYTES = 128 * 1024;
constexpr size_t WS_WR = 128 * 1024, WR_BYTES = 384 * 1024, WS_WG = 896 * 1024;
constexpr size_t WS_WSBIN = 1 * MiB, WS_WSBOUT = 25 * MiB, WS_WMLIN = 33 * MiB, WS_WMLOUT = 57 * MiB;
constexpr size_t WS_W13 = 65 * MiB, WS_W2 = 193 * MiB;
constexpr size_t WS_X = 257 * MiB, WS_H = 321 * MiB, WS_ACT = 353 * MiB;
constexpr size_t A_Q = 0, A_K = 32 * MiB, A_VT = 64 * MiB, A_O = 96 * MiB;
constexpr size_t A_Q1 = 0, A_K1 = 16 * MiB, A_KT = 32 * MiB, A_VT1 = 48 * MiB, A_OG = 80 * MiB, A_HS = 112 * MiB, A_G = 144 * MiB, A_NJ = 144 * MiB + 524288, A_SUM = 144 * MiB + 524288 + 131072;
constexpr size_t A_HID = 0, A_LIST = 9 * MiB, A_LISTW = 10 * MiB, A_Y = 16 * MiB;
constexpr size_t A_Z0 = 64 * MiB, A_Z1 = 80 * MiB;
constexpr size_t WS_END = WS_ACT + 145 * MiB;
constexpr int CW_BAR = 4096;
constexpr int CW_CNT = 16384;

typedef __bf16 bf16x2_t __attribute__((ext_vector_type(2)));
typedef float f32x2 __attribute__((ext_vector_type(2)));
DI unsigned pk2(float lo, float hi) { const f32x2 v = {lo, hi}; return __builtin_bit_cast(unsigned, __builtin_convertvector(v, bf16x2_t)); }
DI unsigned f2bf(float f) { return pk2(f, 0.f) & 0xffffu; }
DI float bf2f(unsigned short b) { return __builtin_bit_cast(float, ((unsigned)b) << 16); }
template <int CTRL> DI float dpp_t(float v) { return __builtin_bit_cast(float, __builtin_amdgcn_update_dpp(0, __builtin_bit_cast(int, v), CTRL, 0xF, 0xF, false)); }
#define dpp_f(v, ctrl) dpp_t<ctrl>(v)
DI float wave_max(float v) {
    v = fmaxf(v, dpp_f(v, 0xB1)); v = fmaxf(v, dpp_f(v, 0x4E)); v = fmaxf(v, dpp_f(v, 0x141)); v = fmaxf(v, dpp_f(v, 0x140));
    v = fmaxf(v, __shfl_xor(v, 16)); v = fmaxf(v, __shfl_xor(v, 32)); return v;
}
DI float wave_sum(float v) {
#pragma unroll
    for (int o = 1; o < 64; o <<= 1) v += __shfl_xor(v, o);
    return v;
}
#define LDS_WAIT() asm volatile("s_waitcnt lgkmcnt(0)" ::: "memory")
#define VM_WAIT() asm volatile("s_waitcnt vmcnt(0)" ::: "memory")
#define MFMA16(a, b, c) __builtin_amdgcn_mfma_f32_16x16x32_bf16((a), (b), (c), 0, 0, 0)

#define XB_TMO      128
#define XB_XCNT(j)  (256  + 64 * (j))
#define XB_XSUB(j)  (1280 + 64 * (j))
#define XB_XGEN(j)  (2304 + 64 * (j))
#define XB_TOP      3328
#define XB_TOPGEN   3392
#define XCD_BAR_WORDS 3456
#define XB_SPIN_CAP (1u << 18)
DI unsigned xb_ld(unsigned* p)              { return __hip_atomic_load(p, __ATOMIC_RELAXED, __HIP_MEMORY_SCOPE_AGENT); }
DI unsigned xb_add(unsigned* p, unsigned v) { return __hip_atomic_fetch_add(p, v, __ATOMIC_RELAXED, __HIP_MEMORY_SCOPE_AGENT); }
DI unsigned xb_xcc_id() { return (unsigned)__builtin_amdgcn_s_getreg((3 << 11) | 20) & 0xFu; }
#define XB_SPIN(cond, bar) do { unsigned _sp = 0; while (cond) { __builtin_amdgcn_s_sleep(1); \
    if ((++_sp & 255u) == 0u) { if (xb_ld(&(bar)[XB_TMO])) break; if (_sp > XB_SPIN_CAP) { atomicAdd(&(bar)[XB_TMO], 1u); break; } } } } while (0)
struct XcdBarrier { unsigned* bar; unsigned x; volatile LAS unsigned* st; };
DI XcdBarrier xcd_barrier_post(unsigned* bar, volatile LAS unsigned* st) {
    XcdBarrier b; b.bar = bar; b.x = xb_xcc_id(); b.st = st;
    if (threadIdx.x == 0) (void)xb_add(&bar[XB_XCNT(b.x)], 1u);
    return b;
}
DI void xcd_barrier_complete(unsigned* bar, unsigned x, unsigned& nloc, unsigned& nx) {
    const unsigned G = gridDim.x * gridDim.y * gridDim.z;
    unsigned sum, cnt, mine, sp = 0u;
    for (;;) {
        sum = 0u; cnt = 0u; mine = 0u;
#pragma unroll
        for (unsigned j = 0; j < 16; ++j) { const unsigned c = xb_ld(&bar[XB_XCNT(j)]); sum += c; cnt += (c > 0u) ? 1u : 0u; mine = (j == x) ? c : mine; }
        if (sum == G) break;
        __builtin_amdgcn_s_sleep(1);
        if ((++sp & 255u) == 0u) { if (xb_ld(&bar[XB_TMO])) break; if (sp > XB_SPIN_CAP) { atomicAdd(&bar[XB_TMO], 1u); break; } }
    }
    nloc = mine > 0u ? mine : 1u; nx = cnt > 0u ? cnt : 1u;
}
DI void xcd_barrier(const XcdBarrier& b) {
    asm volatile("s_waitcnt vmcnt(0)" ::: "memory");
    __syncthreads();
    if (threadIdx.x == 0) {
        unsigned* bar = b.bar;
        __builtin_amdgcn_s_waitcnt(0);
        unsigned nloc = b.st[0], nx = b.st[1];
        if (nloc == 0u) { xcd_barrier_complete(bar, b.x, nloc, nx); b.st[0] = nloc; b.st[1] = nx; }
        const unsigned old = xb_add(&bar[XB_XSUB(b.x)], 1u);
        const unsigned gen = old / nloc;
        if (old + 1u == (gen + 1u) * nloc) {
            __builtin_amdgcn_fence(__ATOMIC_RELEASE, "agent");
            asm volatile("s_waitcnt vmcnt(0)" ::: "memory");
            const unsigned og = xb_add(&bar[XB_TOP], 1u);
            const unsigned tg = og / nx;
            if (og + 1u == (tg + 1u) * nx) xb_add(&bar[XB_TOPGEN], 1u);
            else XB_SPIN(xb_ld(&bar[XB_TOPGEN]) == tg, bar);
            __builtin_amdgcn_fence(__ATOMIC_ACQUIRE, "agent");
            xb_add(&bar[XB_XGEN(b.x)], 1u);
            asm volatile("s_waitcnt vmcnt(0)" ::: "memory");
        } else {
            XB_SPIN(xb_ld(&bar[XB_XGEN(b.x)]) == gen, bar);
            __builtin_amdgcn_fence(__ATOMIC_ACQUIRE, "agent");
            asm volatile("s_waitcnt vmcnt(0)" ::: "memory");
        }
    }
    __syncthreads();
}

struct Args {
    const float* in[18];
    float* out;
    unsigned char* ws;
    int ph_lo, ph_hi;
};

DI int perm13(int f, int which) { return (f >> 7) * 256 + ((f >> 5) & 3) * 64 + which * 32 + (f & 31); }
DI void transpose_item(const float* W, int ldw, bf16_t* WT, int ldt, int k0, int n0, int mode, LAS float* scr, int lane) {
#pragma unroll 16
    for (int i = 0; i < 64; ++i) scr[i * 65 + lane] = __builtin_nontemporal_load(W + (size_t)(k0 + i) * ldw + n0 + lane);
    LDS_WAIT(); asm volatile("" ::: "memory");
    const int c = lane & 7;
#pragma unroll
    for (int j = 0; j < 8; ++j) {
        const int n = (lane >> 3) + 8 * j; const LAS float* s = scr + (8 * c) * 65 + n;
        u32x4 o; o.x = pk2(s[0 * 65], s[1 * 65]); o.y = pk2(s[2 * 65], s[3 * 65]); o.z = pk2(s[4 * 65], s[5 * 65]); o.w = pk2(s[6 * 65], s[7 * 65]);
        const int nn = n0 + n; const int row = (mode == 0) ? nn : perm13(nn, mode - 1);
        *(u32x4*)(WT + (size_t)row * ldt + k0 + 8 * c) = o;
    }
    LDS_WAIT(); asm volatile("" ::: "memory");
}

struct NormP {
    const float* src; bf16_t* X; const bf16_t* Y; bf16_t* H; float* outf; const float* g;
    const bf16_t* wimg; const float* bg; const float* be;
    unsigned* cnt; unsigned* list; float* listw;
    float* G;
};
template <int MODE, bool XB>
DI void norm_phase(const NormP& p, LAS unsigned char* lds, int tid, int wid, int lane) {
    constexpr int RB_LDB = 4112;
    LAS unsigned char* rb_hi = lds;
    LAS float* part = (LAS float*)(lds + 8 * RB_LDB);
    LAS float* logit = part + 8 * 8 * 48;
    LAS int* pex = (LAS int*)(logit + 512); LAS unsigned* pen = (LAS unsigned*)(pex + 512); LAS float* pwt = (LAS float*)(pen + 512);
    int itn = 0;
    constexpr bool PROJ = (MODE == 1 || MODE == 2);
    const float* xin = p.src;
    const bf16_t* xbn = (MODE <= 1) ? (const bf16_t*)p.src : (const bf16_t*)p.X;
    f32x4 v[8]; u32x2 xb[8], ya[8], yb[8];
    int it = blockIdx.x;
#define NP_LOADV(itx) do { const size_t ro_ = (size_t)((itx) * 8 + wid) * D; _Pragma("unroll") for (int j = 0; j < 8; ++j) { if (XB) xb[j] = *(const u32x2*)(xbn + ro_ + 4 * lane + 256 * j); else v[j] = __builtin_nontemporal_load((const f32x4*)(xin + ro_ + 4 * lane + 256 * j)); } } while (0)
#define NP_LOADY(itx) do { const size_t ro_ = (size_t)((itx) * 8 + wid) * D; _Pragma("unroll") for (int j = 0; j < 8; ++j) { const int c = 4 * lane + 256 * j; \
        if (MODE >= 1) ya[j] = *(const u32x2*)(p.Y + ro_ + c); if (MODE >= 2) yb[j] = *(const u32x2*)(p.Y + (size_t)T * D + ro_ + c); } } while (0)
#define NP_LOAD(itx) do { NP_LOADV(itx); NP_LOADY(itx); } while (0)
    if (it < T / 8) NP_LOAD(it);
    for (; it < T / 8; it += gridDim.x, ++itn) {
        const int row = it * 8 + wid;
        const size_t ro = (size_t)row * D;
        f32x4 gv[8];
#pragma unroll
        for (int j = 0; j < 8; ++j) gv[j] = *(const f32x4*)(p.g + 4 * lane + 256 * j);
        float ss = 0.f;
#pragma unroll
        for (int j = 0; j < 8; ++j) {
            f32x4 x;
            if (XB) { const u32x2 q = xb[j]; x.x = bf2f(q.x & 0xffff); x.y = bf2f(q.x >> 16); x.z = bf2f(q.y & 0xffff); x.w = bf2f(q.y >> 16); } else x = v[j];
            if (MODE >= 1) {
                const u32x2 a = ya[j];
                x.x += bf2f(a.x & 0xffff); x.y += bf2f(a.x >> 16); x.z += bf2f(a.y & 0xffff); x.w += bf2f(a.y >> 16);
                if (MODE >= 2) { const u32x2 b = yb[j]; x.x += bf2f(b.x & 0xffff); x.y += bf2f(b.x >> 16); x.z += bf2f(b.y & 0xffff); x.w += bf2f(b.y >> 16); }
                if (MODE <= 2) { u32x2 o; o.x = pk2(x.x, x.y); o.y = pk2(x.z, x.w); *(u32x2*)(p.X + ro + 4 * lane + 256 * j) = o; }
            }
            v[j] = x;
            ss += (x.x * x.x + x.y * x.y) + (x.z * x.z + x.w * x.w);
        }
        const float rstd = 1.0f / sqrtf(wave_sum(ss) * (1.0f / D) + EPS);
#pragma unroll
        for (int j = 0; j < 8; ++j) {
            const int c = 4 * lane + 256 * j;
            const f32x4 gg = gv[j];
            f32x4 y; y.x = v[j].x * rstd * gg.x; y.y = v[j].y * rstd * gg.y; y.z = v[j].z * rstd * gg.z; y.w = v[j].w * rstd * gg.w;
            if (MODE == 3) *(f32x4*)(p.outf + ro + c) = y;
            else { u32x2 o; o.x = pk2(y.x, y.y); o.y = pk2(y.z, y.w); *(u32x2*)(p.H + ro + c) = o; }
            if (PROJ) *(LAS u32x2*)(rb_hi + wid * RB_LDB + c * 2) = (u32x2){pk2(y.x, y.y), pk2(y.z, y.w)};
        }
        const bool more = it + (int)gridDim.x < T / 8;
        if (!PROJ && more) NP_LOAD(it + gridDim.x);
        if (PROJ) {
            __syncthreads();
            {
                constexpr int NT = (MODE == 1) ? 3 : 1;
                f32x4 pacc[NT];
#pragma unroll
                for (int nt = 0; nt < NT; ++nt) pacc[nt] = (f32x4){0.f, 0.f, 0.f, 0.f};
                const LAS unsigned char* ahi = rb_hi + (lane & 7) * RB_LDB + (lane >> 4) * 16 + wid * 512;
                const bf16_t* wim = p.wimg + (size_t)lane * 8 + (size_t)(8 * wid) * NT * 512;
                bf16x8 w0[4][NT], w1[4][NT];
#define NP_LDW(dst, g) do { _Pragma("unroll") for (int kk = 0; kk < 4; ++kk) _Pragma("unroll") for (int nt = 0; nt < NT; ++nt) dst[kk][nt] = *(const bf16x8*)(wim + (size_t)((4 * (g) + kk) * NT + nt) * 512); } while (0)
#define NP_MM(src, g) do { _Pragma("unroll") for (int kk = 0; kk < 4; ++kk) { const bf16x8 xh = *(const LAS bf16x8*)(ahi + (4 * (g) + kk) * 64); \
        _Pragma("unroll") for (int nt = 0; nt < NT; ++nt) pacc[nt] = MFMA16(xh, src[kk][nt], pacc[nt]); } } while (0)
#define NP_PIN __builtin_amdgcn_sched_barrier(0)
                NP_LDW(w0, 0); NP_LDW(w1, 1); NP_PIN;
                if (more) NP_LOADV(it + gridDim.x);
                NP_PIN; NP_MM(w0, 0); NP_MM(w1, 1); NP_PIN;
#undef NP_PIN
#undef NP_LDW
#undef NP_MM
                if (more) NP_LOADY(it + gridDim.x);
                if (lane < 32) {
#pragma unroll
                    for (int nt = 0; nt < NT; ++nt)
#pragma unroll
                        for (int r = 0; r < 4; ++r) part[(wid * 8 + 4 * (lane >> 4) + r) * 48 + 16 * nt + (lane & 15)] = pacc[nt][r];
                }
            }
            __syncthreads();
            {
                float sl = 0.f;
                if (lane < 48) {
#pragma unroll
                    for (int w = 0; w < 8; ++w) sl += part[(w * 8 + wid) * 48 + lane];
                }
                if (MODE == 2) { if (lane < 16) p.G[(size_t)row * 16 + lane] = sl; }
                else {
                    if (lane < 36) sl += (lane < 4) ? p.bg[lane] : p.be[lane - 4];
                    const float NEG = -3.0e38f;
                    const float gl = (lane < 4) ? sl : NEG;
                    float gm = fmaxf(gl, dpp_f(gl, 0xB1)); gm = fmaxf(gm, dpp_f(gm, 0x4E));
                    gm = __shfl(gm, 0);
                    const int gs = __ffsll((long long)__ballot(lane < 4 && sl == gm)) - 1;
                    float ge = (lane < 4) ? __expf(sl - gm) : 0.f;
                    ge += dpp_f(ge, 0xB1); ge += dpp_f(ge, 0x4E);
                    const float psel = 1.0f / __shfl(ge, 0);
                    const int eb = 4 + 8 * gs;
                    const bool inr = lane >= eb && lane < eb + 8;
                    const float v0 = wave_max(inr ? sl : NEG);
                    const int l0 = __ffsll((long long)__ballot(inr && sl == v0)) - 1;
                    const float v1 = wave_max((inr && lane != l0) ? sl : NEG);
                    const int l1 = __ffsll((long long)__ballot(inr && lane != l0 && sl == v1)) - 1;
                    if (lane == 0) {
                        const float e10 = __expf(v1 - v0); const float w0 = psel / (1.0f + e10), w1 = psel * e10 / (1.0f + e10);
                        const int e0 = gs * 8 + (l0 - eb), e1 = gs * 8 + (l1 - eb);
                        const int sl0 = itn * 16 + wid * 2;
                        pex[sl0] = e0; pen[sl0] = (unsigned)row * 2u; pwt[sl0] = w0;
                        pex[sl0 + 1] = e1; pen[sl0 + 1] = (unsigned)row * 2u + 1u; pwt[sl0 + 1] = w1;
                    }
                }
            }
        }
    }
#undef NP_LOAD
#undef NP_LOADV
#undef NP_LOADY
    if (MODE == 1) {
        __syncthreads();
        if (wid == 0) {
            const int np = itn * 16;
            for (int c0 = 0; c0 < np; c0 += 64) {
                const bool have = c0 + lane < np;
                const int ei = have ? pex[c0 + lane] : -1;
                int cnt_e = 0, rank = 0;
#pragma unroll 4
                for (int e = 0; e < NE; ++e) {
                    const unsigned long long m = __ballot(ei == e);
                    if (lane == e) cnt_e = __popcll(m);
                    if (ei == e) rank = __popcll(m & ((1ull << lane) - 1ull));
                }
                unsigned base = 0u;
                if (lane < NE && cnt_e > 0) base = atomicAdd(p.cnt + lane, (unsigned)cnt_e);
                const unsigned mybase = (unsigned)__shfl((int)base, ei < 0 ? 0 : ei);
                if (have) { const size_t pos = (size_t)ei * T + mybase + rank; p.list[pos] = pen[c0 + lane]; p.listw[pos] = pwt[c0 + lane]; }
            }
        }
        __syncthreads();
    }
}

DI int lds_byte(int r, int c) { const int st = (r >> 4) * 2 + (c >> 5), rr = r & 15, cc = c & 31, ob = rr * 64 + cc * 2; return st * 1024 + (ob ^ (((ob >> 9) & 1) << 5)); }
DI void stage_rc(int b, int& R, int& C) { const int st = b / 1024, sb = b % 1024, swz = sb ^ (((sb >> 9) & 1) << 5); R = (st >> 1) * 16 + swz / 64; C = (st & 1) * 32 + (swz % 64) / 2; }

namespace pg8 {
constexpr int BM = 256, BK = 64, HALF = 128, HTB = HALF * BK * 2, NXCD = 8, WGM = 8, KD = 2048;
DI int perm32(int rho) { const int n = rho >> 4, i = rho & 15; return 8 * (i >> 2) + 4 * n + (i & 3); }
struct Unit { int pm, pn, job; };
struct JobRec { const bf16_t* A; const bf16_t* Bt; bf16_t* o0; bf16_t* o1; int M, N, ld, split; float scale0; int pad[5]; };
constexpr int JOBS_OFF = 139264;
DI void put_job(LAS unsigned char* lds, int j, const bf16_t* A, const bf16_t* Bt, int M, int N, bf16_t* o0, bf16_t* o1, int ld, int split, float scale0) {
    LAS JobRec* r = (LAS JobRec*)(lds + JOBS_OFF) + j;
    r->A = A; r->Bt = Bt; r->o0 = o0; r->o1 = o1; r->M = M; r->N = N; r->ld = ld; r->split = split; r->scale0 = scale0;
}
struct Sched {
    const LAS JobRec* tab; int n0, n1, n2, G, c;
    DI void init(LAS unsigned char* lds, int njobs, int G_, int c_) {
        tab = (const LAS JobRec*)(lds + JOBS_OFF);
        n0 = (tab[0].M / BM) * (tab[0].N / BM); n1 = njobs > 1 ? (tab[1].M / BM) * (tab[1].N / BM) : 0; n2 = njobs > 2 ? (tab[2].M / BM) * (tab[2].N / BM) : 0; G = G_; c = c_; }
    DI bool next(int i, Unit& u) const {
        int L = i * G + c, nwg;
        if (L < n0) { u.job = 0; nwg = n0; }
        else if (L < n0 + n1) { L -= n0; u.job = 1; nwg = n1; }
        else if (L < n0 + n1 + n2) { L -= n0 + n1; u.job = 2; nwg = n2; }
        else return false;
        const int nM = tab[u.job].M / BM, nN = tab[u.job].N / BM;
        int wgid = L; { const int q = nwg / NXCD, r = nwg % NXCD, xcd = wgid % NXCD, off = wgid / NXCD; wgid = (xcd < r ? xcd * (q + 1) : r * (q + 1) + (xcd - r) * q) + off; }
        const int nig = WGM * nN, gid = wgid / nig, fm = gid * WGM, gsz = (nM - fm) < WGM ? (nM - fm) : WGM;
        u.pm = fm + ((wgid % nig) % gsz); u.pn = (wgid % nig) / gsz; return true;
    }
    DI const char* aptr(const Unit& u) const { return (const char*)tab[u.job].A + (size_t)u.pm * (2 * HALF * KD * 2); }
    DI const char* bptr(const Unit& u) const { return (const char*)tab[u.job].Bt + (size_t)u.pn * (2 * HALF * KD * 2); }
};
struct EpiBf16 {
    static constexpr bool PERM = true;
    const LAS JobRec* tab;
    DI void operator()(const f32x4 (&acc)[2][2][4][2], const Unit& u, int wr, int wc, int fr, int fq) const {
        const LAS JobRec* jr = tab + u.job;
        const int ldo = jr->ld, split = jr->split;
        float sc = jr->scale0;
        int colt = u.pn * BM; bf16_t* base = jr->o0;
        if (colt >= split) { colt -= split; base = jr->o1; sc = 1.0f; }
        const int row0 = u.pm * BM + wr * 64 + fr, col0 = colt + wc * 64 + 8 * fq;
#pragma unroll
        for (int ai = 0; ai < 2; ++ai)
#pragma unroll
            for (int m = 0; m < 4; ++m) { bf16_t* rowp = base + (size_t)(row0 + ai * HALF + m * 16) * ldo + col0;
#pragma unroll
                for (int bj = 0; bj < 2; ++bj) { const f32x4 v0 = acc[ai][bj][m][0], v1 = acc[ai][bj][m][1];
                    u32x4 w; w.x = pk2(v0.x * sc, v0.y * sc); w.y = pk2(v0.z * sc, v0.w * sc); w.z = pk2(v1.x * sc, v1.y * sc); w.w = pk2(v1.z * sc, v1.w * sc);
                    *(u32x4*)(rowp + bj * 32) = w; } }
    }
};
struct EpiResF32 {
    static constexpr bool PERM = false;
    const float* base; float* out; int ld;
    DI void operator()(const f32x4 (&acc)[2][2][4][2], const Unit& u, int wr, int wc, int fr, int fq) const {
        const int row0 = u.pm * BM + wr * 64 + fr, col0 = u.pn * BM + wc * 32 + 4 * fq;
#pragma unroll
        for (int ai = 0; ai < 2; ++ai)
#pragma unroll
            for (int m = 0; m < 4; ++m) { const size_t ro = (size_t)(row0 + ai * HALF + m * 16) * ld + col0;
#pragma unroll
                for (int bj = 0; bj < 2; ++bj)
#pragma unroll
                    for (int n = 0; n < 2; ++n) { const f32x4 b = *(const f32x4*)(base + ro + bj * HALF + n * 16); const f32x4 a = acc[ai][bj][m][n];
                        f32x4 o; o.x = a.x + b.x; o.y = a.y + b.y; o.z = a.z + b.z; o.w = a.w + b.w; *(f32x4*)(out + ro + bj * HALF + n * 16) = o; } }
    }
};
struct EpiNull {
    static constexpr bool PERM = false;
    DI void operator()(const f32x4 (&acc)[2][2][4][2], const Unit&, int, int, int, int) const {
#pragma unroll
        for (int ai = 0; ai < 2; ++ai)
#pragma unroll
            for (int bj = 0; bj < 2; ++bj)
#pragma unroll
                for (int m = 0; m < 4; ++m)
#pragma unroll
                    for (int n = 0; n < 2; ++n) asm volatile("" :: "v"(acc[ai][bj][m][n]));
    }
};
template <class Epi>
DI void gemm_phase(LAS unsigned char* lds, const Sched& S, const Epi& E) {
    const int tid = threadIdx.x, wid = __builtin_amdgcn_readfirstlane(tid >> 6), lane = tid & 63, wr = wid >> 2, wc = wid & 3, fr = lane & 15, fq = lane >> 4;
    constexpr int K = KD, nt = K / BK;
    unsigned voffA[2], voffB[2][2];
#pragma unroll
    for (int i = 0; i < 2; ++i) { int R, C; stage_rc(tid * 16 + i * 8192, R, C);
        voffA[i] = (unsigned)(R * K + C) * 2u;
#pragma unroll
        for (int h = 0; h < 2; ++h) { const int Rb = Epi::PERM ? (64 * (R >> 5) + 32 * h + perm32(R & 31)) : (128 * h + R); voffB[h][i] = (unsigned)(Rb * K + C) * 2u; } }
    constexpr size_t kstep = (size_t)(BK * 2);
    constexpr size_t hstep = (size_t)HALF * K * 2;
    const unsigned ldsw = (unsigned)wid * 1024u;
    const int aoff = lds_byte(wr * 64 + fr, fq * 8), boff = lds_byte(wc * 32 + fr, fq * 8);
#define PG8_SA(b, h) (((b) * 2 + (h)) * HTB)
#define PG8_SB(b, h) ((4 + (b) * 2 + (h)) * HTB)
#define PG8_STAGE(bufoff, gbase, voff) do { _Pragma("unroll") for (int _i = 0; _i < 2; ++_i) \
        __builtin_amdgcn_global_load_lds((const GAS unsigned*)((const char*)(gbase) + (voff)[_i]), (LAS unsigned*)(lds + (bufoff) + ldsw + _i * 8192), 16, 0, 0); } while (0)
#define PG8_LDA(dst, b, h) do { _Pragma("unroll") for (int m = 0; m < 4; ++m) _Pragma("unroll") for (int k = 0; k < 2; ++k) dst[m][k] = *(const LAS bf16x8*)(lds + PG8_SA(b, h) + aoff + m * 2048 + k * 1024); } while (0)
#define PG8_LDB(dst, b, h) do { _Pragma("unroll") for (int n = 0; n < 2; ++n) _Pragma("unroll") for (int k = 0; k < 2; ++k) dst[n][k] = *(const LAS bf16x8*)(lds + PG8_SB(b, h) + boff + n * 2048 + k * 1024); } while (0)
#define PG8_MMA(ai, bj, At, Bt) do { __builtin_amdgcn_s_setprio(1); _Pragma("unroll") for (int m = 0; m < 4; ++m) _Pragma("unroll") for (int n = 0; n < 2; ++n) _Pragma("unroll") for (int k = 0; k < 2; ++k) \
        acc[ai][bj][m][n] = __builtin_amdgcn_mfma_f32_16x16x32_bf16(Bt[n][k], At[m][k], acc[ai][bj][m][n], 0, 0, 0); __builtin_amdgcn_s_setprio(0); } while (0)
#define PG8_WAIT_V(n) asm volatile("s_waitcnt vmcnt(" #n ")" ::: "memory")
#define PG8_WAIT_L(n) asm volatile("s_waitcnt lgkmcnt(" #n ")" ::: "memory")
#define PG8_BAR __builtin_amdgcn_s_barrier()
#define PG8_SCHED __builtin_amdgcn_sched_barrier(0)
    Unit cur, nxt; int ui = 0;
    if (!S.next(0, cur)) return;
    f32x4 acc[2][2][4][2];
#pragma unroll
    for (int a = 0; a < 2; ++a)
#pragma unroll
        for (int b = 0; b < 2; ++b)
#pragma unroll
            for (int m = 0; m < 4; ++m)
#pragma unroll
                for (int n = 0; n < 2; ++n) acc[a][b][m][n] = (f32x4){0.f, 0.f, 0.f, 0.f};
    bf16x8 At[4][2], B0[2][2], B1[2][2];
    const char* cA = S.aptr(cur); const char* cB = S.bptr(cur);
    PG8_STAGE(PG8_SB(0, 0), cB, voffB[0]); PG8_STAGE(PG8_SA(0, 0), cA, voffA); PG8_STAGE(PG8_SB(0, 1), cB, voffB[1]); PG8_STAGE(PG8_SA(0, 1), cA + hstep, voffA);
    if (wr == 1) PG8_BAR;
    PG8_WAIT_V(4); PG8_BAR;
    PG8_STAGE(PG8_SB(1, 0), cB + kstep, voffB[0]); PG8_STAGE(PG8_SA(1, 0), cA + kstep, voffA); PG8_STAGE(PG8_SB(1, 1), cB + kstep, voffB[1]);
    PG8_WAIT_V(6); PG8_BAR;
    for (;;) {
        const bool has_next = S.next(ui + 1, nxt);
        const char* nA = has_next ? S.aptr(nxt) : cA; const char* nB = has_next ? S.bptr(nxt) : cB;
        for (int t = 0; t < nt; t += 2) {
            const bool last = (t == nt - 2);
            const char* a1 = cA + (size_t)(t + 1) * kstep;
            const char* a2 = last ? nA : cA + (size_t)(t + 2) * kstep; const char* b2 = last ? nB : cB + (size_t)(t + 2) * kstep;
            const char* a3 = a2 + kstep; const char* b3 = b2 + kstep;
            PG8_LDB(B0, 0, 0); PG8_SCHED; PG8_LDA(At, 0, 0); PG8_STAGE(PG8_SA(1, 1), a1 + hstep, voffA);
            PG8_WAIT_L(8); PG8_BAR; PG8_WAIT_L(0); PG8_MMA(0, 0, At, B0); PG8_BAR; PG8_SCHED;
            PG8_LDB(B1, 0, 1); PG8_STAGE(PG8_SB(0, 0), b2, voffB[0]);
            PG8_BAR; PG8_WAIT_L(0); PG8_MMA(0, 1, At, B1); PG8_BAR;
            PG8_LDA(At, 0, 1); PG8_STAGE(PG8_SA(0, 0), a2, voffA);
            PG8_BAR; PG8_WAIT_L(0); PG8_MMA(1, 0, At, B0); PG8_BAR; PG8_SCHED;
            PG8_STAGE(PG8_SB(0, 1), b2, voffB[1]);
            PG8_WAIT_V(6); PG8_BAR; PG8_MMA(1, 1, At, B1); PG8_BAR;
            PG8_LDB(B0, 1, 0); PG8_SCHED; PG8_LDA(At, 1, 0); PG8_STAGE(PG8_SA(0, 1), a2 + hstep, voffA);
            PG8_WAIT_L(8); PG8_BAR; PG8_WAIT_L(0); PG8_MMA(0, 0, At, B0); PG8_BAR; PG8_SCHED;
            PG8_LDB(B1, 1, 1); PG8_STAGE(PG8_SB(1, 0), b3, voffB[0]);
            PG8_BAR; PG8_WAIT_L(0); PG8_MMA(0, 1, At, B1); PG8_BAR;
            PG8_LDA(At, 1, 1); PG8_STAGE(PG8_SA(1, 0), a3, voffA);
            PG8_BAR; PG8_WAIT_L(0); PG8_MMA(1, 0, At, B0); PG8_BAR; PG8_SCHED;
            PG8_STAGE(PG8_SB(1, 1), b3, voffB[1]);
            PG8_WAIT_V(6); PG8_BAR; PG8_MMA(1, 1, At, B1); PG8_BAR;
        }
        E(acc, cur, wr, wc, fr, fq);
        if (!has_next) break;
#pragma unroll
        for (int a = 0; a < 2; ++a)
#pragma unroll
            for (int b = 0; b < 2; ++b)
#pragma unroll
                for (int m = 0; m < 4; ++m)
#pragma unroll
                    for (int n = 0; n < 2; ++n) acc[a][b][m][n] = (f32x4){0.f, 0.f, 0.f, 0.f};
        cur = nxt; cA = nA; cB = nB; ++ui;
    }
    PG8_WAIT_V(0);
    if (wr == 0) PG8_BAR;
    PG8_BAR;
#undef PG8_SA
#undef PG8_SB
#undef PG8_STAGE
#undef PG8_LDA
#undef PG8_LDB
#undef PG8_MMA
#undef PG8_WAIT_V
#undef PG8_WAIT_L
#undef PG8_BAR
#undef PG8_SCHED
}

struct MUnit { int e, rt, pn, cnt, sbase; };
constexpr int MTAB_OFF = JOBS_OFF + 256;
DI void moe_table256(const unsigned* cntg, LAS unsigned char* lds, int tid) {
    LAS int* ctl = (LAS int*)(lds + MTAB_OFF);
    if (tid < 64) {
        const int c = (tid < NE) ? (int)__hip_atomic_load(cntg + tid, __ATOMIC_RELAXED, __HIP_MEMORY_SCOPE_AGENT) : 0;
        const int n = (c + 255) / 256;
        int pb = c, pt = n;
#pragma unroll
        for (int o = 1; o < 32; o <<= 1) { const int vb = __shfl_up(pb, o), vt = __shfl_up(pt, o); if (tid >= o) { pb += vb; pt += vt; } }
        if (tid < NE) { ctl[tid] = c; ctl[32 + tid] = pb - c; ctl[64 + tid] = pt - n; for (int i = 0; i < n && pt - n + i < 128; ++i) ctl[128 + pt - n + i] = tid; }
        if (tid == NE - 1) ctl[64 + NE] = pt;
    }
    __syncthreads();
}
template <int NPN>
struct MSched {
    const LAS int* ctl; int G, c, total;
    DI void init(LAS unsigned char* lds, int G_, int c_) { ctl = (const LAS int*)(lds + MTAB_OFF); G = G_; c = c_; total = ctl[64 + NE] * NPN; }
    DI bool next(int i, MUnit& u) const {
        const int L = i * G + c; if (L >= total) return false;
        const int rtg = L / NPN; u.pn = L % NPN;
        const int e = ctl[128 + rtg];
        u.e = e; u.rt = rtg - ctl[64 + e]; u.cnt = ctl[e]; u.sbase = ctl[32 + e]; return true;
    }
};
struct MOps1 {
    const bf16_t* H; const bf16_t* W; const unsigned* list;
    DI const char* abase(const MUnit&) const { return (const char*)H; }
    DI void aoffs(const MUnit& u, int R0, int C0, int R1, int C1, unsigned (&o)[2][2]) const {
#pragma unroll
        for (int h = 0; h < 2; ++h) {
            const int ra = u.rt * 256 + h * 128 + R0, rb = u.rt * 256 + h * 128 + R1;
            const unsigned ta = list[(size_t)u.e * T + (ra < u.cnt ? ra : u.cnt - 1)] >> 1, tb = list[(size_t)u.e * T + (rb < u.cnt ? rb : u.cnt - 1)] >> 1;
            o[h][0] = (ta * (unsigned)D + (unsigned)C0) * 2u; o[h][1] = (tb * (unsigned)D + (unsigned)C1) * 2u;
        }
    }
    DI const char* bptr(const MUnit& u) const { return (const char*)(W + ((size_t)u.e * 512 + u.pn * 256) * D); }
};
struct MOps2 {
    const bf16_t* hid; const bf16_t* W;
    DI const char* abase(const MUnit& u) const { return (const char*)(hid + (size_t)(u.sbase + u.rt * 256) * FF); }
    DI void aoffs(const MUnit&, int R0, int C0, int R1, int C1, unsigned (&o)[2][2]) const {
#pragma unroll
        for (int h = 0; h < 2; ++h) { o[h][0] = (unsigned)((h * 128 + R0) * FF + C0) * 2u; o[h][1] = (unsigned)((h * 128 + R1) * FF + C1) * 2u; }
    }
    DI const char* bptr(const MUnit& u) const { return (const char*)(W + ((size_t)u.e * D + u.pn * 256) * FF); }
};
constexpr int MROW_OFF = 131072;
struct EpiSwiglu {
    bf16_t* hid; const float* listw;
    DI void prep(const MUnit& u, LAS unsigned char* lds, int par, int tid) const {
        if (tid < 256) { const int r = u.rt * 256 + tid;
            __builtin_amdgcn_global_load_lds((const GAS unsigned*)(listw + (size_t)u.e * T + (r < u.cnt ? r : u.cnt - 1)), (LAS unsigned*)(lds + MROW_OFF + par * 1024 + (tid >> 6) * 256), 4, 0, 0); }
    }
    DI void operator()(const f32x4 (&acc)[2][2][4][2], const MUnit& u, int wr, int wc, int fr, int fq, const LAS unsigned char* lds, int par) const {
#pragma unroll
        for (int ai = 0; ai < 2; ++ai)
#pragma unroll
            for (int m = 0; m < 4; ++m) {
                const int r = u.rt * 256 + ai * HALF + wr * 64 + m * 16 + fr;
                if (r < u.cnt) {
                    const float gw = ((const LAS float*)(lds + MROW_OFF))[par * 256 + ai * HALF + wr * 64 + m * 16 + fr];
                    unsigned o[4];
#pragma unroll
                    for (int n = 0; n < 2; ++n) { const f32x4 g = acc[ai][0][m][n], uu = acc[ai][1][m][n]; float hv[4];
#pragma unroll
                        for (int j = 0; j < 4; ++j) hv[j] = g[j] / (1.0f + __expf(-g[j])) * uu[j] * gw;
                        o[2 * n] = pk2(hv[0], hv[1]); o[2 * n + 1] = pk2(hv[2], hv[3]); }
                    *(u32x4*)(hid + (size_t)(u.sbase + r) * FF + u.pn * 128 + wc * 32 + 8 * fq) = (u32x4){o[0], o[1], o[2], o[3]};
                }
            }
    }
};
struct EpiScatter {
    bf16_t* Y; const unsigned* list;
    DI void prep(const MUnit& u, LAS unsigned char* lds, int par, int tid) const {
        if (tid < 256) { const int r = u.rt * 256 + tid;
            __builtin_amdgcn_global_load_lds((const GAS unsigned*)(list + (size_t)u.e * T + (r < u.cnt ? r : u.cnt - 1)), (LAS unsigned*)(lds + MROW_OFF + par * 1024 + (tid >> 6) * 256), 4, 0, 0); }
    }
    DI void operator()(const f32x4 (&acc)[2][2][4][2], const MUnit& u, int wr, int wc, int fr, int fq, const LAS unsigned char* lds, int par) const {
#pragma unroll
        for (int ai = 0; ai < 2; ++ai)
#pragma unroll
            for (int m = 0; m < 4; ++m) {
                const int r = u.rt * 256 + ai * HALF + wr * 64 + m * 16 + fr;
                if (r < u.cnt) {
                    const unsigned ent = ((const LAS unsigned*)(lds + MROW_OFF))[par * 256 + ai * HALF + wr * 64 + m * 16 + fr];
                    bf16_t* yrow = Y + ((size_t)(ent & 1u) * T + (ent >> 1)) * D + u.pn * 256 + wc * 64 + 8 * fq;
#pragma unroll
                    for (int bj = 0; bj < 2; ++bj) { const f32x4 v0 = acc[ai][bj][m][0], v1 = acc[ai][bj][m][1];
                        __builtin_nontemporal_store(((u32x4){pk2(v0.x, v0.y), pk2(v0.z, v0.w), pk2(v1.x, v1.y), pk2(v1.z, v1.w)}), (u32x4*)(yrow + bj * 32)); }
                }
            }
    }
};
struct EpiMNull {
    DI void prep(const MUnit&, LAS unsigned char*, int, int) const {}
    DI void operator()(const f32x4 (&acc)[2][2][4][2], const MUnit&, int, int, int, int, const LAS unsigned char*, int) const {
#pragma unroll
        for (int ai = 0; ai < 2; ++ai)
#pragma unroll
            for (int bj = 0; bj < 2; ++bj)
#pragma unroll
                for (int m = 0; m < 4; ++m)
#pragma unroll
                    for (int n = 0; n < 2; ++n) asm volatile("" :: "v"(acc[ai][bj][m][n]));
    }
};
template <int K, class Sched, class Ops, class Epi>
DI void gemm_phase_m(LAS unsigned char* lds, const Sched& S, const Ops& P, const Epi& E) {
    const int tid = threadIdx.x, wid = __builtin_amdgcn_readfirstlane(tid >> 6), lane = tid & 63, wr = wid >> 2, wc = wid & 3, fr = lane & 15, fq = lane >> 4;
    constexpr int nt = K / BK;
    int R0, C0, R1, C1; stage_rc(tid * 16, R0, C0); stage_rc(tid * 16 + 8192, R1, C1);
    unsigned voffB[2][2];
#pragma unroll
    for (int h = 0; h < 2; ++h) { voffB[h][0] = (unsigned)((64 * (R0 >> 5) + 32 * h + perm32(R0 & 31)) * K + C0) * 2u; voffB[h][1] = (unsigned)((64 * (R1 >> 5) + 32 * h + perm32(R1 & 31)) * K + C1) * 2u; }
    constexpr size_t kstep = (size_t)(BK * 2);
    constexpr size_t hstep = (size_t)HALF * K * 2;
    const unsigned ldsw = (unsigned)wid * 1024u;
    const int aoff = lds_byte(wr * 64 + fr, fq * 8), boff = lds_byte(wc * 32 + fr, fq * 8);
#define PG8_SA(b, h) (((b) * 2 + (h)) * HTB)
#define PG8_SB(b, h) ((4 + (b) * 2 + (h)) * HTB)
#define PG8_STAGEB(bufoff, gbase, h) do { _Pragma("unroll") for (int _i = 0; _i < 2; ++_i) \
        __builtin_amdgcn_global_load_lds((const GAS unsigned*)((const char*)(gbase) + voffB[h][_i]), (LAS unsigned*)(lds + (bufoff) + ldsw + _i * 8192), 16, 0, 0); } while (0)
#define PG8_STAGEA(bufoff, bb, pp, h, koff) do { _Pragma("unroll") for (int _i = 0; _i < 2; ++_i) \
        __builtin_amdgcn_global_load_lds((const GAS unsigned*)((bb) + (koff) + (pp)[h][_i]), (LAS unsigned*)(lds + (bufoff) + ldsw + _i * 8192), 16, 0, 0); } while (0)
#define PG8_LDA(dst, b, h) do { _Pragma("unroll") for (int m = 0; m < 4; ++m) _Pragma("unroll") for (int k = 0; k < 2; ++k) dst[m][k] = *(const LAS bf16x8*)(lds + PG8_SA(b, h) + aoff + m * 2048 + k * 1024); } while (0)
#define PG8_LDB(dst, b, h) do { _Pragma("unroll") for (int n = 0; n < 2; ++n) _Pragma("unroll") for (int k = 0; k < 2; ++k) dst[n][k] = *(const LAS bf16x8*)(lds + PG8_SB(b, h) + boff + n * 2048 + k * 1024); } while (0)
#define PG8_MMA(ai, bj, At, Bt) do { __builtin_amdgcn_s_setprio(1); _Pragma("unroll") for (int m = 0; m < 4; ++m) _Pragma("unroll") for (int n = 0; n < 2; ++n) _Pragma("unroll") for (int k = 0; k < 2; ++k) \
        acc[ai][bj][m][n] = __builtin_amdgcn_mfma_f32_16x16x32_bf16(Bt[n][k], At[m][k], acc[ai][bj][m][n], 0, 0, 0); __builtin_amdgcn_s_setprio(0); } while (0)
#define PG8_WAIT_V(n) asm volatile("s_waitcnt vmcnt(" #n ")" ::: "memory")
#define PG8_WAIT_L(n) asm volatile("s_waitcnt lgkmcnt(" #n ")" ::: "memory")
#define PG8_BAR __builtin_amdgcn_s_barrier()
#define PG8_SCHED __builtin_amdgcn_sched_barrier(0)
    MUnit cur, nxt; int ui = 0;
    if (!S.next(0, cur)) return;
    f32x4 acc[2][2][4][2];
#pragma unroll
    for (int a = 0; a < 2; ++a)
#pragma unroll
        for (int b = 0; b < 2; ++b)
#pragma unroll
            for (int m = 0; m < 4; ++m)
#pragma unroll
                for (int n = 0; n < 2; ++n) acc[a][b][m][n] = (f32x4){0.f, 0.f, 0.f, 0.f};
    bf16x8 At[4][2], B0[2][2], B1[2][2];
    unsigned pA[2][2], qA[2][2];
    P.aoffs(cur, R0, C0, R1, C1, pA);
    const char* cAb = P.abase(cur);
    E.prep(cur, lds, 0, tid);
    const char* cB = P.bptr(cur);
    PG8_STAGEB(PG8_SB(0, 0), cB, 0); PG8_STAGEA(PG8_SA(0, 0), cAb, pA, 0, 0); PG8_STAGEB(PG8_SB(0, 1), cB, 1); PG8_STAGEA(PG8_SA(0, 1), cAb, pA, 1, 0);
    if (wr == 1) PG8_BAR;
    PG8_WAIT_V(4); PG8_BAR;
    PG8_STAGEB(PG8_SB(1, 0), cB + kstep, 0); PG8_STAGEA(PG8_SA(1, 0), cAb, pA, 0, kstep); PG8_STAGEB(PG8_SB(1, 1), cB + kstep, 1);
    PG8_WAIT_V(6); PG8_BAR;
    for (;;) {
        const bool has_next = S.next(ui + 1, nxt);
        const char* nB = cB; const char* nAb = cAb;
#pragma unroll
        for (int h = 0; h < 2; ++h) { qA[h][0] = pA[h][0]; qA[h][1] = pA[h][1]; }
        if (has_next) { P.aoffs(nxt, R0, C0, R1, C1, qA); nAb = P.abase(nxt); nB = P.bptr(nxt); E.prep(nxt, lds, (ui + 1) % 3, tid); }
#pragma unroll 1
        for (int t = 0; t < nt; t += 2) {
            const bool last = (t == nt - 2);
            const size_t k1 = (size_t)(t + 1) * kstep;
            const size_t k2 = last ? 0 : (size_t)(t + 2) * kstep, k3 = k2 + kstep;
            const char* b2 = last ? nB : cB + k2; const char* b3 = b2 + kstep;
            const char* a2 = last ? nAb : cAb;
            unsigned o2[2][2];
#pragma unroll
            for (int h = 0; h < 2; ++h) { o2[h][0] = last ? qA[h][0] : pA[h][0]; o2[h][1] = last ? qA[h][1] : pA[h][1]; }
            PG8_LDB(B0, 0, 0); PG8_SCHED; PG8_LDA(At, 0, 0); PG8_STAGEA(PG8_SA(1, 1), cAb, pA, 1, k1);
            PG8_WAIT_L(8); PG8_BAR; PG8_WAIT_L(0); PG8_MMA(0, 0, At, B0); PG8_BAR; PG8_SCHED;
            PG8_LDB(B1, 0, 1); PG8_STAGEB(PG8_SB(0, 0), b2, 0);
            PG8_BAR; PG8_WAIT_L(0); PG8_MMA(0, 1, At, B1); PG8_BAR;
            PG8_LDA(At, 0, 1); PG8_STAGEA(PG8_SA(0, 0), a2, o2, 0, k2);
            PG8_BAR; PG8_WAIT_L(0); PG8_MMA(1, 0, At, B0); PG8_BAR; PG8_SCHED;
            PG8_STAGEB(PG8_SB(0, 1), b2, 1);
            PG8_WAIT_V(6); PG8_BAR; PG8_MMA(1, 1, At, B1); PG8_BAR;
            PG8_LDB(B0, 1, 0); PG8_SCHED; PG8_LDA(At, 1, 0); PG8_STAGEA(PG8_SA(0, 1), a2, o2, 1, k2);
            PG8_WAIT_L(8); PG8_BAR; PG8_WAIT_L(0); PG8_MMA(0, 0, At, B0); PG8_BAR; PG8_SCHED;
            PG8_LDB(B1, 1, 1); PG8_STAGEB(PG8_SB(1, 0), b3, 0);
            PG8_BAR; PG8_WAIT_L(0); PG8_MMA(0, 1, At, B1); PG8_BAR;
            PG8_LDA(At, 1, 1); PG8_STAGEA(PG8_SA(1, 0), a2, o2, 0, k3);
            PG8_BAR; PG8_WAIT_L(0); PG8_MMA(1, 0, At, B0); PG8_BAR; PG8_SCHED;
            PG8_STAGEB(PG8_SB(1, 1), b3, 1);
            PG8_WAIT_V(6); PG8_BAR; PG8_MMA(1, 1, At, B1); PG8_BAR;
        }
        E(acc, cur, wr, wc, fr, fq, lds, ui % 3);
        if (!has_next) break;
#pragma unroll
        for (int a = 0; a < 2; ++a)
#pragma unroll
            for (int b = 0; b < 2; ++b)
#pragma unroll
                for (int m = 0; m < 4; ++m)
#pragma unroll
                    for (int n = 0; n < 2; ++n) acc[a][b][m][n] = (f32x4){0.f, 0.f, 0.f, 0.f};
        cur = nxt; cB = nB; cAb = nAb; ++ui;
#pragma unroll
        for (int h = 0; h < 2; ++h) { pA[h][0] = qA[h][0]; pA[h][1] = qA[h][1]; }
    }
    PG8_WAIT_V(0);
    if (wr == 0) PG8_BAR;
    PG8_BAR;
#undef PG8_SA
#undef PG8_SB
#undef PG8_STAGEA
#undef PG8_STAGEB
#undef PG8_LDA
#undef PG8_LDB
#undef PG8_MMA
#undef PG8_WAIT_V
#undef PG8_WAIT_L
#undef PG8_BAR
#undef PG8_SCHED
}
}

constexpr int AT_K0 = 0, AT_V0 = 17408, AT_KVB = 35840, AT_FL = 71680, AT_QS = 71936;
DI void attn_phase(const bf16_t* Qb, const bf16_t* Kb, const bf16_t* Vt, bf16_t* O, LAS unsigned char* lds, int tid, int wid, int lane) {
    const int fr = lane & 15, fq = lane >> 4;
    LAS int* flags = (LAS int*)(lds + AT_FL);
    for (int bx = blockIdx.x; bx < 512; bx += gridDim.x) {
        const int rnd = bx >> 8, pos = bx & 255;
        const int qb = (rnd & 1) ? (pos >> 6) : (7 - (pos >> 6));
        const int bh = pos & 63, b = bh >> 4, h = bh & 15;
        const int t0 = qb * 256;
        __syncthreads();
        const int kr0 = tid >> 4, kc = tid & 15, vr0 = tid >> 3, vc = tid & 7;
        const bf16_t* kg = Kb + (size_t)(b * SEQ + kr0) * D + h * 128 + kc * 8;
        const bf16_t* vg = Vt + (size_t)(h * 128 + vr0) * T + b * SEQ + vc * 8;
        u32x4 pk0, pk1, pv0, pv1;
        int s0 = t0 + 192;
        pk0 = *(const u32x4*)(kg + (size_t)s0 * D); pk1 = *(const u32x4*)(kg + (size_t)(s0 + 32) * D);
        pv0 = *(const u32x4*)(vg + s0); pv1 = *(const u32x4*)(vg + (size_t)64 * T + s0);
#pragma unroll
        for (int c8 = 0; c8 < 8; ++c8) {
            const int c = tid + 512 * c8, row = c >> 4, c16 = c & 15;
            *(LAS u32x4*)(lds + AT_QS + row * 272 + c16 * 16) = *(const u32x4*)(Qb + (size_t)(b * SEQ + t0 + row) * D + h * 128 + c16 * 8);
        }
        {
            LAS unsigned char* kb_ = lds + AT_K0; LAS unsigned char* vb_ = lds + AT_V0;
            *(LAS u32x4*)(kb_ + kr0 * 272 + kc * 16) = pk0; *(LAS u32x4*)(kb_ + (kr0 + 32) * 272 + kc * 16) = pk1;
            *(LAS u32x4*)(vb_ + vr0 * 144 + vc * 16) = pv0; *(LAS u32x4*)(vb_ + (vr0 + 64) * 144 + vc * 16) = pv1;
            const int s1 = s0 - 64;
            pk0 = *(const u32x4*)(kg + (size_t)s1 * D); pk1 = *(const u32x4*)(kg + (size_t)(s1 + 32) * D); pv0 = *(const u32x4*)(vg + s1); pv1 = *(const u32x4*)(vg + (size_t)64 * T + s1);
        }
        __syncthreads();
        f32x4 oacc[2][8];
#pragma unroll
        for (int r = 0; r < 2; ++r)
#pragma unroll
            for (int n = 0; n < 8; ++n) oacc[r][n] = (f32x4){0.f, 0.f, 0.f, 0.f};
        float Rrun[2] = {1.f, 1.f};
        bool wave_alive = true;
        int it = 0;
        for (;; ++it, s0 -= 64) {
            int zz = 0; asm volatile("" : "+v"(zz));
            const LAS unsigned char* kb_ = lds + zz + AT_K0 + (it & 1) * AT_KVB; const LAS unsigned char* vb_ = lds + zz + AT_V0 + (it & 1) * AT_KVB;
            const bool wave_on = (s0 < t0 + 32 * wid + 31) && wave_alive;
            if (wave_on) {
            f32x4 sacc[2][4];
#pragma unroll
            for (int r = 0; r < 2; ++r)
#pragma unroll
                for (int n = 0; n < 4; ++n) sacc[r][n] = (f32x4){0.f, 0.f, 0.f, 0.f};
#pragma unroll
            for (int ks = 0; ks < 4; ++ks) {
                const bf16x8 qa0 = *(const LAS bf16x8*)(lds + zz + AT_QS + (32 * wid + fr) * 272 + (ks * 32 + fq * 8) * 2);
                const bf16x8 qa1 = *(const LAS bf16x8*)(lds + zz + AT_QS + (32 * wid + 16 + fr) * 272 + (ks * 32 + fq * 8) * 2);
#pragma unroll
                for (int n = 0; n < 4; ++n) {
                    const bf16x8 kf = *(const LAS bf16x8*)(kb_ + (16 * n + fr) * 272 + (ks * 32 + fq * 8) * 2);
                    sacc[0][n] = MFMA16(kf, qa0, sacc[0][n]);
                    sacc[1][n] = MFMA16(kf, qa1, sacc[1][n]);
                }
            }
            unsigned ap[2][4][2];
            const int sb = s0 + 4 * fq;
#pragma unroll
            for (int r = 0; r < 2; ++r) {
                const int tq = t0 + 32 * wid + 16 * r + fr;
                float apart[4][4], gprod[4];
#pragma unroll
                for (int n = 0; n < 4; ++n) {
                    float run = 1.f;
#pragma unroll
                    for (int j = 3; j >= 0; --j) {
                        const float zz = ((sb + 16 * n + j) < tq) ? fminf(sacc[r][n][j], 80.f) : -200.f;
                        const float p2 = __builtin_amdgcn_exp2f(zz);
                        const float om = __builtin_amdgcn_rcpf(1.0f + p2);
                        apart[n][j] = p2 * om * run;
                        run *= om;
                    }
                    gprod[n] = run;
                }
                float offs[4]; float acc_after = 1.f;
#pragma unroll
                for (int n = 3; n >= 0; --n) {
                    const float bq = __shfl_xor(gprod[n], 16); const float s01 = gprod[n] * bq; const float oth = __shfl_xor(s01, 32);
                    offs[n] = Rrun[r] * acc_after * (((fq & 1) == 0) ? bq : 1.f) * ((fq < 2) ? oth : 1.f);
                    acc_after *= s01 * oth;
                }
                Rrun[r] *= acc_after;
#pragma unroll
                for (int n = 0; n < 4; ++n) { ap[r][n][0] = pk2(apart[n][0] * offs[n], apart[n][1] * offs[n]); ap[r][n][1] = pk2(apart[n][2] * offs[n], apart[n][3] * offs[n]); }
            }
#pragma unroll
            for (int u = 0; u < 2; ++u) {
                const bf16x8 aa0 = __builtin_bit_cast(bf16x8, ((u32x4){ap[0][2 * u][0], ap[0][2 * u][1], ap[0][2 * u + 1][0], ap[0][2 * u + 1][1]}));
                const bf16x8 aa1 = __builtin_bit_cast(bf16x8, ((u32x4){ap[1][2 * u][0], ap[1][2 * u][1], ap[1][2 * u + 1][0], ap[1][2 * u + 1][1]}));
#pragma unroll
                for (int n = 0; n < 8; ++n) {
                    const s16x4 vlo = *(const LAS s16x4*)(vb_ + (16 * n + fr) * 144 + (32 * u + 4 * fq) * 2);
                    const s16x4 vhi = *(const LAS s16x4*)(vb_ + (16 * n + fr) * 144 + (32 * u + 16 + 4 * fq) * 2);
                    const bf16x8 vf = __builtin_shufflevector(vlo, vhi, 0, 1, 2, 3, 4, 5, 6, 7);
                    oacc[0][n] = MFMA16(vf, aa0, oacc[0][n]);
                    oacc[1][n] = MFMA16(vf, aa1, oacc[1][n]);
                }
            }
            }
            const int sn1 = s0 - 64, sn2 = s0 - 128;
            wave_alive = __any(fmaxf(Rrun[0], Rrun[1]) > 0.f);
            if (lane == 0) flags[(it & 1) * 8 + wid] = wave_alive ? 1 : 0;
            if (sn1 >= 0) {
                LAS unsigned char* kn = lds + AT_K0 + ((it + 1) & 1) * AT_KVB; LAS unsigned char* vn = lds + AT_V0 + ((it + 1) & 1) * AT_KVB;
                *(LAS u32x4*)(kn + kr0 * 272 + kc * 16) = pk0; *(LAS u32x4*)(kn + (kr0 + 32) * 272 + kc * 16) = pk1;
                *(LAS u32x4*)(vn + vr0 * 144 + vc * 16) = pv0; *(LAS u32x4*)(vn + (vr0 + 64) * 144 + vc * 16) = pv1;
                if (sn2 >= 0) { pk0 = *(const u32x4*)(kg + (size_t)sn2 * D); pk1 = *(const u32x4*)(kg + (size_t)(sn2 + 32) * D); pv0 = *(const u32x4*)(vg + sn2); pv1 = *(const u32x4*)(vg + (size_t)64 * T + sn2); }
            }
            __syncthreads();
            if (sn1 < 0) break;
            int any_alive = 0;
#pragma unroll
            for (int w = 0; w < 8; ++w) any_alive |= flags[(it & 1) * 8 + w];
            if (!any_alive) break;
        }
#pragma unroll
        for (int r = 0; r < 2; ++r) {
            bf16_t* orow = O + (size_t)(b * SEQ + t0 + 32 * wid + 16 * r + fr) * D + h * 128 + 4 * fq;
#pragma unroll
            for (int n = 0; n < 8; ++n) { u32x2 o; o.x = pk2(oacc[r][n].x, oacc[r][n].y); o.y = pk2(oacc[r][n].z, oacc[r][n].w); *(u32x2*)(orow + 16 * n) = o; }
        }
    }
}

constexpr int ML_QS = 0, ML_KS = 17408, ML_KD = 34816, ML_VT = 53248, ML_WS = 90112, ML_HB = 99328, ML_SC = 133120;
DI float ml_tab(LAS float* tab, float gi, float gf, float mprev, int lane) {
    const float flog = fminf(gf, 0.f) - __logf(1.0f + __expf(-fabsf(gf)));
    float bb = flog;
#pragma unroll
    for (int o = 1; o < 64; o <<= 1) { const float v = __shfl_up(bb, o); if (lane >= o) bb += v; }
    const float a = gi - bb;
    float pm = a;
#pragma unroll
    for (int o = 1; o < 64; o <<= 1) { const float v = __shfl_up(pm, o); if (lane >= o) pm = fmaxf(pm, v); }
    const float amax = __shfl(pm, 63), bL = __shfl(bb, 63);
    const float Mx = fmaxf(mprev, amax);
    tab[lane] = a; tab[64 + lane] = bb; tab[128 + lane] = fmaxf(pm, mprev);
    if (lane == 0) { tab[192] = mprev; tab[193] = Mx; }
    return bL + Mx;
}
constexpr int MLA_KD = 0, MLA_SC = 69632;
DI void mlstm_local(const bf16_t* K1, const bf16_t* VT, const float* G, const float* b_i, const float* b_f, bf16_t* KV, float* NJ, float* SUM,
                    LAS unsigned char* lds, int tid, int wid, int lane) {
    const int fr = lane & 15, fq = lane >> 4;
    LAS float* sa = (LAS float*)(lds + MLA_SC); LAS float* swsum = sa + 256; LAS float* swmax = sa + 264;
    for (int unit = blockIdx.x; unit < 256; unit += gridDim.x) {
        const int J = unit & 7, bh = unit >> 3, b = bh >> 3, h = bh & 7;
        if (J == 7) continue;
        const int tok0 = b * SEQ + J * 256;
        __syncthreads();
        float a = 0.f, bb = 0.f;
        if (tid < 256) {
            const size_t g0 = (size_t)(tok0 + tid) * 16;
            const float gi = G[g0 + h] + b_i[h], gf = G[g0 + 8 + h] + b_f[h];
            const float flog = fminf(gf, 0.f) - __logf(1.0f + __expf(-fabsf(gf)));
            bb = flog;
#pragma unroll
            for (int o = 1; o < 64; o <<= 1) { const float v = __shfl_up(bb, o); if (lane >= o) bb += v; }
            if (lane == 63) swsum[wid] = bb;
        }
        __syncthreads();
        if (tid < 256) {
            float off = 0.f;
            for (int w = 0; w < 4; ++w) off += (w < wid) ? swsum[w] : 0.f;
            bb += off;
            const size_t g0 = (size_t)(tok0 + tid) * 16;
            a = (G[g0 + h] + b_i[h]) - bb;
            float mx = a;
#pragma unroll
            for (int o = 1; o < 64; o <<= 1) mx = fmaxf(mx, __shfl_xor(mx, o));
            if (lane == 0) swmax[wid] = mx;
            sa[tid] = a;
        }
        __syncthreads();
        const float amax = fmaxf(fmaxf(swmax[0], swmax[1]), fmaxf(swmax[2], swmax[3]));
        if (tid == 255) { SUM[unit * 2] = amax; SUM[unit * 2 + 1] = bb; }
        bf16x8 vfa[8][2];
#pragma unroll
        for (int ks = 0; ks < 8; ++ks)
#pragma unroll
            for (int et = 0; et < 2; ++et) vfa[ks][et] = *(const bf16x8*)(VT + (size_t)(h * 256 + 32 * wid + 16 * et + fr) * T + tok0 + ks * 32 + fq * 8);
#pragma unroll 2
        for (int c8i = 0; c8i < 8; ++c8i) {
            const int ch = tid + 512 * c8i, sp = ch & 255, c16 = ch >> 8;
            const u32x4 v = *(const u32x4*)(K1 + (size_t)(tok0 + sp) * 1024 + h * 128 + c16 * 8);
            const float dsc = __expf(sa[sp] - amax);
            const unsigned w[4] = {v.x, v.y, v.z, v.w};
            LAS bf16_t* dst = (LAS bf16_t*)(lds + MLA_KD + (c16 * 8) * 528 + sp * 2);
#pragma unroll
            for (int q = 0; q < 4; ++q) { dst[(2 * q) * 264] = (bf16_t)f2bf(bf2f(w[q] & 0xffff) * dsc); dst[(2 * q + 1) * 264] = (bf16_t)f2bf(bf2f(w[q] >> 16) * dsc); }
        }
        __syncthreads();
        f32x4 C[8][2];
#pragma unroll
        for (int dt = 0; dt < 8; ++dt)
#pragma unroll
            for (int et = 0; et < 2; ++et) C[dt][et] = (f32x4){0.f, 0.f, 0.f, 0.f};
#pragma unroll
        for (int ks = 0; ks < 8; ++ks) {
#pragma unroll
            for (int dt = 0; dt < 8; ++dt) {
                const bf16x8 kf = *(const LAS bf16x8*)(lds + MLA_KD + (16 * dt + fr) * 528 + (ks * 32 + fq * 8) * 2);
#pragma unroll
                for (int et = 0; et < 2; ++et) C[dt][et] = MFMA16(kf, vfa[ks][et], C[dt][et]);
            }
        }
        bf16_t* kv = KV + (size_t)unit * 32768;
#pragma unroll
        for (int dt = 0; dt < 8; ++dt)
#pragma unroll
            for (int et = 0; et < 2; ++et) { u32x2 o; o.x = pk2(C[dt][et].x, C[dt][et].y); o.y = pk2(C[dt][et].z, C[dt][et].w); *(u32x2*)(kv + (size_t)(32 * wid + 16 * et + fr) * 128 + 16 * dt + 4 * fq) = o; }
        {
            const int dl = tid >> 2, sl = tid & 3;
            float p = 0.f;
#pragma unroll
            for (int i = 0; i < 8; ++i) {
                const u32x4 kq = *(const LAS u32x4*)(lds + MLA_KD + dl * 528 + sl * 128 + i * 16);
                p += (bf2f(kq.x & 0xffff) + bf2f(kq.x >> 16)) + (bf2f(kq.y & 0xffff) + bf2f(kq.y >> 16)) + (bf2f(kq.z & 0xffff) + bf2f(kq.z >> 16)) + (bf2f(kq.w & 0xffff) + bf2f(kq.w >> 16));
            }
            p += __shfl_xor(p, 1); p += __shfl_xor(p, 2);
            if (sl == 0) NJ[unit * 128 + dl] = p;
        }
    }
}
template <int skip>
DI void mlstm_phase(const bf16_t* Q1, const bf16_t* K1, const bf16_t* VT, const bf16_t* OG, const float* G, const float* b_i, const float* b_f,
                    const float* g_head, bf16_t* HS, const bf16_t* KV, const float* NJ, const float* SUM, LAS unsigned char* lds, int tid, int wid, int lane, int nsteps = 4) {
    const int fr = lane & 15, fq = lane >> 4;
    LAS float* sc = (LAS float*)(lds + ML_SC); LAS float* sssq = sc + 1024; LAS float* srs = sc + 1536; LAS float* sden = sc + 1792; LAS float* sn = sc + 1856; LAS float* sgh = sc + 2112; LAS float* scf = sc + 2368;
    LAS bf16_t* hb = (LAS bf16_t*)(lds + ML_HB);
    for (int unit = blockIdx.x; unit < 256; unit += gridDim.x) {
        const int J = unit & 7, bh = unit >> 3, b = bh >> 3, h = bh & 7;
        const int c0 = 4 * J, c1 = c0 + nsteps;
        __syncthreads();
        if (wid < 4) {
            LAS float* tab = sc + wid * 256;
            const size_t g0 = (size_t)(b * SEQ + (c0 + wid) * 64 + lane) * 16;
            const float gi = G[g0 + h] + b_i[h], gf = G[g0 + 8 + h] + b_f[h];
            const float flog = fminf(gf, 0.f) - __logf(1.0f + __expf(-fabsf(gf)));
            float bb = flog;
#pragma unroll
            for (int o = 1; o < 64; o <<= 1) { const float v = __shfl_up(bb, o); if (lane >= o) bb += v; }
            const float a = gi - bb;
            float pm = a;
#pragma unroll
            for (int o = 1; o < 64; o <<= 1) { const float v = __shfl_up(pm, o); if (lane >= o) pm = fmaxf(pm, v); }
            tab[lane] = a; tab[64 + lane] = bb; tab[128 + lane] = pm;
            if (lane == 63) { tab[192] = pm; tab[193] = bb; }
        }
        if (tid >= 448 && tid < 462) scf[8 + tid - 448] = SUM[bh * 16 + tid - 448];
        __syncthreads();
        if (tid == 0) {
            float cf[7]; float m0 = 0.f;
#pragma unroll
            for (int jp = 0; jp < 7; ++jp) {
                cf[jp] = 0.f;
                if (jp < J) {
                    const float am = scf[8 + 2 * jp], bl = scf[9 + 2 * jp];
                    const float M63 = fmaxf(m0, am), csj = __expf(m0 - M63);
#pragma unroll
                    for (int i = 0; i < 7; ++i) if (i < jp) cf[i] *= csj;
                    cf[jp] = __expf(am - M63);
                    m0 = bl + M63;
                }
            }
#pragma unroll
            for (int jp = 0; jp < 7; ++jp) scf[jp] = cf[jp];
            scf[7] = m0;
        }
        __syncthreads();
        const float m0 = scf[7];
        f32x4 C[8][2];
#pragma unroll
        for (int dt = 0; dt < 8; ++dt)
#pragma unroll
            for (int et = 0; et < 2; ++et) C[dt][et] = (f32x4){0.f, 0.f, 0.f, 0.f};
        float n0 = 0.f;
#pragma unroll 1
        for (int jp = 0; jp < J; ++jp) {
            const bf16_t* kv = KV + (size_t)(bh * 8 + jp) * 32768; const float cf = scf[jp];
#pragma unroll
            for (int dt = 0; dt < 8; ++dt)
#pragma unroll
                for (int et = 0; et < 2; ++et) { const u32x2 v = *(const u32x2*)(kv + (size_t)(32 * wid + 16 * et + fr) * 128 + 16 * dt + 4 * fq);
                    C[dt][et].x += cf * bf2f(v.x & 0xffff); C[dt][et].y += cf * bf2f(v.x >> 16); C[dt][et].z += cf * bf2f(v.y & 0xffff); C[dt][et].w += cf * bf2f(v.y >> 16); }
            if (tid < 128) n0 += cf * NJ[(bh * 8 + jp) * 128 + tid];
        }
        if (tid < 128) sn[tid] = n0;
        if (tid >= 256) sgh[tid - 256] = g_head[h * 256 + tid - 256];
        __syncthreads();
        if (tid == 0) { float m = m0; for (int cc = 0; cc < 4; ++cc) { LAS float* tab = sc + cc * 256; const float M63 = fmaxf(m, tab[192]); tab[194] = m; tab[195] = M63; m = tab[193] + M63; } }
        __syncthreads();
        u32x4 rq[2], rk[2], rt[2], rv[4];
#define ML_LOAD(cc) do { const int tk_ = b * SEQ + (cc) * 64; _Pragma("unroll") for (int c2 = 0; c2 < 2; ++c2) { const int ch = tid + 512 * c2; \
            rq[c2] = *(const u32x4*)(Q1 + (size_t)(tk_ + (ch >> 4)) * 1024 + h * 128 + (ch & 15) * 8); rk[c2] = *(const u32x4*)(K1 + (size_t)(tk_ + (ch >> 4)) * 1024 + h * 128 + (ch & 15) * 8); \
            rt[c2] = *(const u32x4*)(K1 + (size_t)(tk_ + (ch & 63)) * 1024 + h * 128 + (ch >> 6) * 8); } \
        _Pragma("unroll") for (int c4 = 0; c4 < 4; ++c4) { const int ch = tid + 512 * c4; rv[c4] = *(const u32x4*)(VT + (size_t)(h * 256 + (ch >> 3)) * T + tk_ + (ch & 7) * 8); } } while (0)
#define ML_STORE(cc) do { const LAS float* tb_ = sc + ((cc) - c0) * 256; const float M63_ = tb_[195]; _Pragma("unroll") for (int c2 = 0; c2 < 2; ++c2) { const int ch = tid + 512 * c2; \
            *(LAS u32x4*)(lds + ML_QS + (ch >> 4) * 272 + (ch & 15) * 16) = rq[c2]; *(LAS u32x4*)(lds + ML_KS + (ch >> 4) * 272 + (ch & 15) * 16) = rk[c2]; \
            const int sp = ch & 63, c16 = ch >> 6; const float dsc = __expf(tb_[sp] - M63_); const unsigned w_[4] = {rt[c2].x, rt[c2].y, rt[c2].z, rt[c2].w}; \
            LAS bf16_t* dst = (LAS bf16_t*)(lds + ML_KD + (c16 * 8) * 144 + sp * 2); \
            _Pragma("unroll") for (int q = 0; q < 4; ++q) { dst[(2 * q) * 72] = (bf16_t)f2bf(bf2f(w_[q] & 0xffff) * dsc); dst[(2 * q + 1) * 72] = (bf16_t)f2bf(bf2f(w_[q] >> 16) * dsc); } } \
        _Pragma("unroll") for (int c4 = 0; c4 < 4; ++c4) { const int ch = tid + 512 * c4; *(LAS u32x4*)(lds + ML_VT + (ch >> 3) * 144 + (ch & 7) * 16) = rv[c4]; } } while (0)
        if (c0 < c1) { ML_LOAD(c0); ML_STORE(c0); }
#pragma unroll 1
        for (int c = c0; c < c1; ++c) {
            int zz = 0; asm volatile("" : "+v"(zz));
            LAS unsigned char* const L = lds + zz; LAS float* const scz = (LAS float*)(L + ML_SC);
            LAS float* const sssq = scz + 1024; LAS float* const srs = scz + 1536; LAS float* const sden = scz + 1792; LAS float* const sn = scz + 1856; LAS float* const sgh = scz + 2112; LAS bf16_t* const hb = (LAS bf16_t*)(L + ML_HB);
            const int tok0 = b * SEQ + c * 64;
            const LAS float* tab = scz + (c - c0) * 256;
            LAS float* sncur = sn + ((c - c0) & 1) * 128; LAS float* snnxt = sn + (((c - c0) & 1) ^ 1) * 128;
            __syncthreads();
            const float mprev = tab[194], M63 = tab[195];
            if (!(skip & 1)) {
                const int tb = wid >> 1;
#pragma unroll
                for (int a2 = 0; a2 < 2; ++a2) {
                    const int sa_t = 2 * (wid & 1) + a2;
                    u32x2 o = (u32x2){0u, 0u}; float rsum = 0.f;
                    if (sa_t <= tb) {
                        f32x4 acc = (f32x4){0.f, 0.f, 0.f, 0.f};
#pragma unroll
                        for (int ks = 0; ks < 4; ++ks) {
                            const bf16x8 kf = *(const LAS bf16x8*)(L + ML_KS + (16 * sa_t + fr) * 272 + (ks * 32 + fq * 8) * 2);
                            const bf16x8 qf = *(const LAS bf16x8*)(L + ML_QS + (16 * tb + fr) * 272 + (ks * 32 + fq * 8) * 2);
                            acc = MFMA16(kf, qf, acc);
                        }
                        const int tl = 16 * tb + fr; const float Mt = fmaxf(tab[128 + tl], mprev);
                        float wv[4];
#pragma unroll
                        for (int j = 0; j < 4; ++j) { const int sl = 16 * sa_t + 4 * fq + j; wv[j] = (sl <= tl) ? acc[j] * __expf(tab[sl] - Mt) : 0.f; }
                        o.x = pk2(wv[0], wv[1]); o.y = pk2(wv[2], wv[3]);
                        rsum = (wv[0] + wv[1]) + (wv[2] + wv[3]);
                        rsum += __shfl_xor(rsum, 16); rsum += __shfl_xor(rsum, 32);
                    }
                    *(LAS u32x2*)(L + ML_WS + (16 * tb + fr) * 144 + (16 * sa_t + 4 * fq) * 2) = o;
                    if (fq == 0) srs[sa_t * 64 + 16 * tb + fr] = rsum;
                }
            }
            __syncthreads();
            if (!(skip & 2)) {
                const int tl = tid >> 3, sl = tid & 7;
                const u32x4 qa = *(const LAS u32x4*)(L + ML_QS + tl * 272 + sl * 32), qb = *(const LAS u32x4*)(L + ML_QS + tl * 272 + sl * 32 + 16);
                const unsigned qw[8] = {qa.x, qa.y, qa.z, qa.w, qb.x, qb.y, qb.z, qb.w};
                float p = 0.f;
#pragma unroll
                for (int k = 0; k < 8; ++k) p += bf2f(qw[k] & 0xffff) * sncur[sl * 16 + 2 * k] + bf2f(qw[k] >> 16) * sncur[sl * 16 + 2 * k + 1];
                p += __shfl_xor(p, 1); p += __shfl_xor(p, 2); p += __shfl_xor(p, 4);
                if (sl == 0) sden[tl] = __expf(mprev - fmaxf(tab[128 + tl], mprev)) * p + (srs[tl] + srs[64 + tl]) + (srs[128 + tl] + srs[192 + tl]);
            }
#pragma unroll 1
            for (int tt = 0; tt < ((skip & 4) ? 0 : 4); ++tt) {
                f32x4 num[2];
#pragma unroll
                for (int et = 0; et < 2; ++et) num[et] = (f32x4){0.f, 0.f, 0.f, 0.f};
#pragma unroll
                for (int u = 0; u < 4; ++u) {
                    const s16x4 qlo = *(const LAS s16x4*)(L + ML_QS + (16 * tt + fr) * 272 + (32 * u + 4 * fq) * 2);
                    const s16x4 qhi = *(const LAS s16x4*)(L + ML_QS + (16 * tt + fr) * 272 + (32 * u + 16 + 4 * fq) * 2);
                    const bf16x8 qf = __builtin_shufflevector(qlo, qhi, 0, 1, 2, 3, 4, 5, 6, 7);
#pragma unroll
                    for (int et = 0; et < 2; ++et) {
                        const f32x4 c0v = C[2 * u][et], c1v = C[2 * u + 1][et];
                        u32x4 pb; pb.x = pk2(c0v.x, c0v.y); pb.y = pk2(c0v.z, c0v.w); pb.z = pk2(c1v.x, c1v.y); pb.w = pk2(c1v.z, c1v.w);
                        num[et] = MFMA16(qf, __builtin_bit_cast(bf16x8, pb), num[et]);
                    }
                }
                float scv[4];
#pragma unroll
                for (int j = 0; j < 4; ++j) scv[j] = __expf(mprev - fmaxf(tab[128 + 16 * tt + 4 * fq + j], mprev));
#pragma unroll
                for (int et = 0; et < 2; ++et) { num[et].x *= scv[0]; num[et].y *= scv[1]; num[et].z *= scv[2]; num[et].w *= scv[3]; }
                const int nks = (tt < 2) ? 1 : 2;
                for (int ks = 0; ks < nks; ++ks) {
                    const bf16x8 wf = *(const LAS bf16x8*)(L + ML_WS + (16 * tt + fr) * 144 + (ks * 32 + fq * 8) * 2);
#pragma unroll
                    for (int et = 0; et < 2; ++et) {
                        const bf16x8 vf = *(const LAS bf16x8*)(L + ML_VT + (32 * wid + 16 * et + fr) * 144 + (ks * 32 + fq * 8) * 2);
                        num[et] = MFMA16(wf, vf, num[et]);
                    }
                }
#pragma unroll
                for (int j = 0; j < 4; ++j) {
                    const int tl = 16 * tt + 4 * fq + j;
                    const float h0 = num[0][j], h1 = num[1][j];
                    hb[tl * 264 + 32 * wid + fr] = (bf16_t)f2bf(h0);
                    hb[tl * 264 + 32 * wid + 16 + fr] = (bf16_t)f2bf(h1);
                    float s = h0 * h0 + h1 * h1;
                    s += dpp_f(s, 0xB1); s += dpp_f(s, 0x4E); s += dpp_f(s, 0x141); s += dpp_f(s, 0x140);
                    if (fr == 0) sssq[wid * 64 + tl] = s;
                }
            }
            const float cs = __expf(mprev - M63);
            if (!(skip & 8)) {
#pragma unroll
                for (int dt = 0; dt < 8; ++dt)
#pragma unroll
                    for (int et = 0; et < 2; ++et) { C[dt][et].x *= cs; C[dt][et].y *= cs; C[dt][et].z *= cs; C[dt][et].w *= cs; }
#pragma unroll
                for (int ks = 0; ks < 2; ++ks) {
                    bf16x8 vf[2];
#pragma unroll
                    for (int et = 0; et < 2; ++et) vf[et] = *(const LAS bf16x8*)(L + ML_VT + (32 * wid + 16 * et + fr) * 144 + (ks * 32 + fq * 8) * 2);
#pragma unroll
                    for (int dt = 0; dt < 8; ++dt) {
                        const bf16x8 kf = *(const LAS bf16x8*)(L + ML_KD + (16 * dt + fr) * 144 + (ks * 32 + fq * 8) * 2);
#pragma unroll
                        for (int et = 0; et < 2; ++et) C[dt][et] = MFMA16(kf, vf[et], C[dt][et]);
                    }
                }
            }
            {
                const int dl = tid >> 2, sl = tid & 3;
                const u32x4 ka = *(const LAS u32x4*)(L + ML_KD + dl * 144 + sl * 32), kb = *(const LAS u32x4*)(L + ML_KD + dl * 144 + sl * 32 + 16);
                const unsigned kw[8] = {ka.x, ka.y, ka.z, ka.w, kb.x, kb.y, kb.z, kb.w};
                float p = 0.f;
#pragma unroll
                for (int k = 0; k < 8; ++k) p += bf2f(kw[k] & 0xffff) + bf2f(kw[k] >> 16);
                p += __shfl_xor(p, 1); p += __shfl_xor(p, 2);
                if (sl == 0) snnxt[dl] = cs * sncur[dl] + p;
            }
            __syncthreads();
            if (skip & 16) { if (c + 1 < c1) ML_LOAD(c + 1); } else {
                const int tl = tid >> 3, part = tid & 7;
                u32x4 ovq[4];
#pragma unroll
                for (int q = 0; q < 4; ++q) ovq[q] = *(const u32x4*)(OG + (size_t)(tok0 + tl) * D + h * 256 + (part + 8 * q) * 8);
                if (c + 1 < c1) ML_LOAD(c + 1);
                float tot = 0.f;
#pragma unroll
                for (int w = 0; w < 8; ++w) tot += sssq[w * 64 + tl];
                const float dd = 1.0f / fmaxf(fabsf(sden[tl]), __expf(-(tab[64 + tl] + fmaxf(tab[128 + tl], mprev))));
                const float rinv = dd / sqrtf(tot * dd * dd * (1.0f / 256.0f) + EPS);
#pragma unroll
                for (int q = 0; q < 4; ++q) {
                    const int e0 = (part + 8 * q) * 8;
                    const u32x4 hv = *(const LAS u32x4*)(L + ML_HB + tl * 528 + e0 * 2);
                    const size_t idx = (size_t)(tok0 + tl) * D + h * 256 + e0;
                    const u32x4 ov = ovq[q];
                    const f32x4 g0 = *(const LAS f32x4*)(sgh + e0), g1 = *(const LAS f32x4*)(sgh + e0 + 4);
                    const unsigned hw[4] = {hv.x, hv.y, hv.z, hv.w}, ow[4] = {ov.x, ov.y, ov.z, ov.w};
                    const float gg[8] = {g0.x, g0.y, g0.z, g0.w, g1.x, g1.y, g1.z, g1.w};
                    unsigned r[4];
#pragma unroll
                    for (int k = 0; k < 4; ++k) {
                        const float ha = bf2f(hw[k] & 0xffff), hbv = bf2f(hw[k] >> 16), oa = bf2f(ow[k] & 0xffff), ob = bf2f(ow[k] >> 16);
                        r[k] = pk2(ha * rinv * gg[2 * k] * __builtin_amdgcn_rcpf(1.0f + __expf(-oa)), hbv * rinv * gg[2 * k + 1] * __builtin_amdgcn_rcpf(1.0f + __expf(-ob)));
                    }
                    *(u32x4*)(HS + idx) = (u32x4){r[0], r[1], r[2], r[3]};
                }
            }
            if (c + 1 < c1) ML_STORE(c + 1);
        }
#undef ML_LOAD
#undef ML_STORE
    }
}

DI void convert_moe_layer(int l, bool do13, bool do2, int gw, int NGW, const float* w1, const float* w3, const float* w2, bf16_t* W13, bf16_t* W2, LAS unsigned char* lds, int wid, int lane) {
    LAS float* scr = (LAS float*)(lds + wid * 16640);
    constexpr int I_W1 = 32 * 32 * 4, I_W2 = 32 * 4 * 32;
    if (do13) for (int it = gw; it < 2 * I_W1; it += NGW) {
        const int which = it / I_W1, r = it % I_W1, le = l * NE + r / 128, q = r % 128;
        transpose_item((which ? w3 : w1) + (size_t)le * D * FF, FF, W13 + (size_t)le * 512 * D, D, 64 * (q / 4), 64 * (q % 4), 1 + which, scr, lane); }
    if (do2) for (int it = gw; it < I_W2; it += NGW) {
        const int le = l * NE + it / 128, q = it % 128;
        transpose_item(w2 + (size_t)le * FF * D, D, W2 + (size_t)le * D * FF, FF, 64 * (q / 32), 64 * (q % 32), 0, scr, lane); }
}

__global__ void __launch_bounds__(NTHREADS, 2) fwd_kernel(Args args) {
    extern __shared__ __attribute__((aligned(16))) unsigned char lds_raw[];
    LAS unsigned char* lds = (LAS unsigned char*)lds_raw;
    const int tid = threadIdx.x, lane = tid & 63, wid = __builtin_amdgcn_readfirstlane(tid >> 6);
    unsigned char* ws = args.ws;
    unsigned* ctl = (unsigned*)(ws + WS_CTL);
    volatile LAS unsigned* misc = (volatile LAS unsigned*)(lds + LDS_BYTES - 256);
    if (tid < 16) misc[tid] = 0u;
    __syncthreads();
    XcdBarrier bar; bar.bar = ctl + CW_BAR; bar.x = 0; bar.st = misc;
    const int lo = args.ph_lo, hi = args.ph_hi;
    if (PROBE_A >= 0 && blockIdx.x == 0 && tid == 0) misc[16] = (unsigned)__builtin_amdgcn_s_memrealtime();
    if (hi - lo > 1) bar = xcd_barrier_post(ctl + CW_BAR, misc);
#ifndef PHMASK
#define PHMASK 0xffff
#endif
#define IN(k) (((PHMASK >> (k)) & 1) && lo <= (k) && (k) < hi)
#ifndef XBAR
#define XBAR 0
#endif
#define SEAM(k) do { if (IN(k) && IN((k) + 1)) { xcd_barrier(bar); if ((k) == 5) for (int xb_ = 0; xb_ < XBAR; ++xb_) xcd_barrier(bar); } if (PROBE_A >= 0 && blockIdx.x == 0 && tid == 0) misc[16 + (k) + 1] = (unsigned)__builtin_amdgcn_s_memrealtime(); } while (0)

#define PH(k, ...) { __VA_ARGS__ } if ((REPEAT_MASK >> (k)) & 1) { xcd_barrier(bar); { __VA_ARGS__ } }
#define LZ(z) int z = 0; asm volatile("" : "+s"(z))
#define INP(k) (args.in[k] + z)
#define WSP(type, off) ((type*)(ws + (off) + z))
#define ACT(type, off) ((type*)(ws + WS_ACT + (off) + z))

    PH(0, if (IN(0)) {
        LZ(z);
        const float* sb_w_in = INP(4); const float* sb_w_out = INP(5); const float* ml_w_in = INP(6); const float* ml_w_out = INP(10);
        const float* moe_w1 = INP(15); const float* moe_w3 = INP(16); const float* moe_w2 = INP(17);
        bf16_t* Wsbin = WSP(bf16_t, WS_WSBIN); bf16_t* Wsbout = WSP(bf16_t, WS_WSBOUT); bf16_t* Wmlin = WSP(bf16_t, WS_WMLIN); bf16_t* Wmlout = WSP(bf16_t, WS_WMLOUT);
        bf16_t* W13 = WSP(bf16_t, WS_W13); bf16_t* W2 = WSP(bf16_t, WS_W2);
        LAS float* scr = (LAS float*)(lds + wid * 16640);
        const int gw = blockIdx.x * 8 + wid, NGW = gridDim.x * 8;
        constexpr int I_SBIN = 32 * 96, I_SBOUT = 32 * 32, I_MLIN = 32 * 96, I_MLOUT = 32 * 32;
        constexpr int NITEMS = I_SBIN + I_SBOUT + I_MLIN + I_MLOUT;
        for (int it0 = gw; it0 < NITEMS; it0 += NGW) {
            int r = NITEMS - 1 - it0;
            if (r < I_SBIN) { transpose_item(sb_w_in, 6144, Wsbin, D, 64 * (r / 96), 64 * (r % 96), 0, scr, lane); continue; } r -= I_SBIN;
            if (r < I_SBOUT) { transpose_item(sb_w_out, D, Wsbout, D, 64 * (r / 32), 64 * (r % 32), 0, scr, lane); continue; } r -= I_SBOUT;
            if (r < I_MLIN) { transpose_item(ml_w_in, ML_IN, Wmlin, D, 64 * (r / 96), 64 * (r % 96), 0, scr, lane); continue; } r -= I_MLIN;
            transpose_item(ml_w_out, D, Wmlout, D, 64 * (r / 32), 64 * (r % 32), 0, scr, lane);
        }
        {
            const float* wg = INP(11); const float* we = INP(13); const float* wml = INP(6);
            bf16_t* wr = WSP(bf16_t, WS_WR); bf16_t* wgi = WSP(bf16_t, WS_WG);
            const int gt = blockIdx.x * NTHREADS + tid, NGT = gridDim.x * NTHREADS;
            for (int idx = gt; idx < 2 * 98304 + 32768; idx += NGT) {
                if (idx < 2 * 98304) {
                    const int l = idx / 98304, r = idx % 98304, j = r & 7, ln = (r >> 3) & 63, q = r >> 9, nt = q % 3, ks = q / 3;
                    const int k = 32 * ks + 8 * (ln >> 4) + j, n = 16 * nt + (ln & 15);
                    const float w = (n < 4) ? wg[(size_t)l * D * 4 + k * 4 + n] : ((n < 36) ? we[(size_t)l * D * 32 + k * 32 + (n - 4)] : 0.f);
                    wr[(size_t)l * (WR_BYTES / 2) + r] = (bf16_t)f2bf(w);
                } else {
                    const int r = idx - 2 * 98304, j = r & 7, ln = (r >> 3) & 63, ks = r >> 9;
                    const int k = 32 * ks + 8 * (ln >> 4) + j, n = ln & 15;
                    wgi[r] = (bf16_t)f2bf(wml[(size_t)k * ML_IN + 6144 + n]);
                }
            }
        }
        __syncthreads();
        NormP p{}; p.src = INP(0); p.H = WSP(bf16_t, WS_H); p.g = INP(1);
        norm_phase<0, false>(p, lds, tid, wid, lane);
    })
    SEAM(0);
    PH(1, if (IN(1)) {
        LZ(z);
        bf16_t* H = WSP(bf16_t, WS_H); bf16_t* Wsbin = WSP(bf16_t, WS_WSBIN);
        if (tid == 0) {
            pg8::put_job(lds, 0, H, Wsbin, T, 4096, ACT(bf16_t, A_Q), ACT(bf16_t, A_K), D, 2048, 0.12751743074602467f);
            pg8::put_job(lds, 1, Wsbin + (size_t)4096 * D, H, D, T, ACT(bf16_t, A_VT), ACT(bf16_t, A_VT), T, 1 << 30, 1.0f);
        }
        __syncthreads();
        pg8::Sched S; S.init(lds, 2, gridDim.x, blockIdx.x);
        pg8::EpiBf16 E{S.tab};
        pg8::gemm_phase(lds, S, E);
    })
    SEAM(1);
    PH(2, if (IN(2)) { LZ(z); attn_phase(ACT(bf16_t, A_Q), ACT(bf16_t, A_K), ACT(bf16_t, A_VT), ACT(bf16_t, A_O), lds, tid, wid, lane); })
    SEAM(2);
    PH(3, if (IN(3)) { LZ(z);
        if (tid == 0) pg8::put_job(lds, 0, ACT(bf16_t, A_O), WSP(bf16_t, WS_WSBOUT), T, D, ACT(bf16_t, A_Z0), ACT(bf16_t, A_Z0), D, 1 << 30, 1.0f);
        __syncthreads();
        pg8::Sched S; S.init(lds, 1, gridDim.x, blockIdx.x);
        pg8::EpiBf16 E{S.tab}; pg8::gemm_phase(lds, S, E); })
    SEAM(3);
#if defined(OUTPROJ_PROBE)
    {
        LZ(z);
        if (tid == 0) pg8::put_job(lds, 0, ACT(bf16_t, A_O), WSP(bf16_t, WS_WSBOUT), T, D, nullptr, nullptr, D, 0, 1.0f);
        __syncthreads();
        pg8::Sched S; S.init(lds, 1, gridDim.x, blockIdx.x);
#if OUTPROJ_PROBE == 1
        pg8::EpiNull E; pg8::gemm_phase(lds, S, E);
#else
        pg8::EpiResF32 E{INP(0), ACT(float, A_Q), D}; pg8::gemm_phase(lds, S, E);
#endif
        xcd_barrier(bar);
    }
#endif
#define MOE_PHASES(l, pb) \
    PH(pb, if (IN(pb)) { LZ(z); convert_moe_layer(l, true, false, blockIdx.x * 8 + wid, gridDim.x * 8, INP(15), INP(16), INP(17), WSP(bf16_t, WS_W13), WSP(bf16_t, WS_W2), lds, wid, lane); __syncthreads(); NormP p{}; p.src = (l) ? (const float*)WSP(bf16_t, WS_X) : INP(0); p.Y = (l) ? ACT(bf16_t, A_Z1) : ACT(bf16_t, A_Z0); p.X = WSP(bf16_t, WS_X); p.H = WSP(bf16_t, WS_H); p.g = INP(2) + (l) * D; p.wimg = WSP(bf16_t, WS_WR + (l) * WR_BYTES); p.bg = INP(12) + (l) * 4; \
        p.be = INP(14) + (l) * 32; p.cnt = ctl + CW_CNT + 64 * (l) + z; p.list = ACT(unsigned, A_LIST); p.listw = ACT(float, A_LISTW); \
        if (l) norm_phase<1, true>(p, lds, tid, wid, lane); else norm_phase<1, false>(p, lds, tid, wid, lane); }) \
    SEAM(pb); \
    PH((pb) + 1, if (IN((pb) + 1)) { LZ(z); pg8::moe_table256(ctl + CW_CNT + 64 * (l) + z, lds, tid); \
        pg8::MSched<2> S; S.init(lds, gridDim.x, blockIdx.x); \
        { const int nun = S.total; const int idle = (int)gridDim.x - nun;        \
          if (idle > 0) { if ((int)blockIdx.x >= nun) convert_moe_layer(l, false, true, ((int)blockIdx.x - nun) * 8 + wid, idle * 8, INP(15), INP(16), INP(17), WSP(bf16_t, WS_W13), WSP(bf16_t, WS_W2), lds, wid, lane); } \
          else { convert_moe_layer(l, false, true, blockIdx.x * 8 + wid, gridDim.x * 8, INP(15), INP(16), INP(17), WSP(bf16_t, WS_W13), WSP(bf16_t, WS_W2), lds, wid, lane); __syncthreads(); } } \
        pg8::MOps1 P{WSP(bf16_t, WS_H), WSP(bf16_t, WS_W13) + (size_t)(l) * NE * 512 * D, ACT(unsigned, A_LIST)}; \
        pg8::EpiSwiglu E{ACT(bf16_t, A_HID), ACT(float, A_LISTW)}; \
        pg8::gemm_phase_m<2048>(lds, S, P, E); }) \
    SEAM((pb) + 1); \
    PH((pb) + 2, if (IN((pb) + 2)) { LZ(z); pg8::moe_table256(ctl + CW_CNT + 64 * (l) + z, lds, tid); \
        pg8::MSched<8> S; S.init(lds, gridDim.x, blockIdx.x); \
        pg8::MOps2 P{ACT(bf16_t, A_HID), WSP(bf16_t, WS_W2) + (size_t)(l) * NE * D * FF}; \
        pg8::EpiScatter E{ACT(bf16_t, A_Y), ACT(unsigned, A_LIST)}; \
        pg8::gemm_phase_m<256>(lds, S, P, E); }) \
    SEAM((pb) + 2);
    MOE_PHASES(0, 4)
#if defined(MOE2_PROBE)
    {
        xcd_barrier(bar); LZ(z); pg8::moe_table256(ctl + CW_CNT + z, lds, tid);
        pg8::MSched<8> S; S.init(lds, gridDim.x, blockIdx.x);
        pg8::MOps2 P{ACT(bf16_t, A_HID), WSP(bf16_t, WS_W2)};
#if MOE2_PROBE == 1
        pg8::EpiMNull E; pg8::gemm_phase_m<256>(lds, S, P, E);
#else
        pg8::EpiScatter E{ACT(bf16_t, A_Y), ACT(unsigned, A_LIST)}; pg8::gemm_phase_m<256>(lds, S, P, E);
#endif
        xcd_barrier(bar);
    }
#endif
#if defined(ROUTER2X)
    { xcd_barrier(bar); LZ(z); NormP p{}; p.src = INP(0); p.Y = ACT(bf16_t, A_Z0); p.X = ACT(bf16_t, 96 * MiB); p.H = ACT(bf16_t, A_O); p.g = INP(2); p.wimg = WSP(bf16_t, WS_WR); p.bg = INP(12); p.be = INP(14);
      p.cnt = ctl + CW_CNT + 64 * 2 + z; p.list = ACT(unsigned, 128 * MiB); p.listw = ACT(float, 130 * MiB); norm_phase<1, false>(p, lds, tid, wid, lane); xcd_barrier(bar); }
#endif
    PH(7, if (IN(7)) { LZ(z); NormP p{}; p.X = WSP(bf16_t, WS_X); p.Y = ACT(bf16_t, A_Y); p.H = WSP(bf16_t, WS_H); p.g = INP(1) + D; p.wimg = WSP(bf16_t, WS_WG); p.G = ACT(float, A_G); norm_phase<2, true>(p, lds, tid, wid, lane); })
    SEAM(7);
    PH(8, if (IN(8)) {
        LZ(z);
        bf16_t* H = WSP(bf16_t, WS_H); bf16_t* Wmlin = WSP(bf16_t, WS_WMLIN);
        if (tid == 0) {
            pg8::put_job(lds, 0, H, Wmlin, T, 2048, ACT(bf16_t, A_Q1), ACT(bf16_t, A_K1), 1024, 1024, 0.08838834764831845f);
            pg8::put_job(lds, 1, H, Wmlin + (size_t)4096 * D, T, 2048, ACT(bf16_t, A_OG), ACT(bf16_t, A_OG), D, 1 << 30, 1.0f);
            pg8::put_job(lds, 2, Wmlin + (size_t)2048 * D, H, 2048, T, ACT(bf16_t, A_VT1), ACT(bf16_t, A_VT1), T, 1 << 30, 1.0f);
        }
        __syncthreads();
        pg8::Sched S; S.init(lds, 3, gridDim.x, blockIdx.x);
        pg8::EpiBf16 E{S.tab};
        pg8::gemm_phase(lds, S, E);
    })
    SEAM(8);
    PH(9, if (IN(9)) { LZ(z); mlstm_local(ACT(bf16_t, A_K1), ACT(bf16_t, A_VT1), ACT(float, A_G), INP(7), INP(8), WSP(bf16_t, WS_H), ACT(float, A_NJ), ACT(float, A_SUM), lds, tid, wid, lane); })
    SEAM(9);
    PH(10, if (IN(10)) { LZ(z); mlstm_phase<0>(ACT(bf16_t, A_Q1), ACT(bf16_t, A_K1), ACT(bf16_t, A_VT1), ACT(bf16_t, A_OG), ACT(float, A_G), INP(7), INP(8), INP(9), ACT(bf16_t, A_HS),
        WSP(bf16_t, WS_H), ACT(float, A_NJ), ACT(float, A_SUM), lds, tid, wid, lane); })
    SEAM(10);
#if defined(ML_PROBE)
    {
        LZ(z); mlstm_phase<ML_PROBE>(ACT(bf16_t, A_Q1), ACT(bf16_t, A_K1), ACT(bf16_t, A_VT1), ACT(bf16_t, A_OG), ACT(float, A_G), INP(7), INP(8), INP(9), (bf16_t*)(args.out + z),
            WSP(bf16_t, WS_H), ACT(float, A_NJ), ACT(float, A_SUM), lds, tid, wid, lane, 4); xcd_barrier(bar); }
#endif
    PH(11, if (IN(11)) { LZ(z);
        if (tid == 0) pg8::put_job(lds, 0, ACT(bf16_t, A_HS), WSP(bf16_t, WS_WMLOUT), T, D, ACT(bf16_t, A_Z1), ACT(bf16_t, A_Z1), D, 1 << 30, 1.0f);
        __syncthreads();
        pg8::Sched S; S.init(lds, 1, gridDim.x, blockIdx.x);
        pg8::EpiBf16 E{S.tab}; pg8::gemm_phase(lds, S, E); })
    SEAM(11);
    MOE_PHASES(1, 12)
    PH(15, if (IN(15)) { LZ(z); NormP p{}; p.X = WSP(bf16_t, WS_X); p.Y = ACT(bf16_t, A_Y); p.outf = args.out + z; p.g = INP(3); norm_phase<3, true>(p, lds, tid, wid, lane); })
    if (PROBE_A >= 0 && blockIdx.x == 0 && tid == 0) {
        misc[16 + 16] = (unsigned)__builtin_amdgcn_s_memrealtime();
        const float tA = (float)(misc[16 + PROBE_A + 1] - misc[16 + PROBE_A]) * 0.01f, tB = (PROBE_B >= 0) ? (float)(misc[16 + PROBE_B + 1] - misc[16 + PROBE_B]) * 0.01f : 0.f;
        args.out[0] = (1.0f + tA * 0.02f) * __builtin_powf(10.0f, __builtin_rintf(tB * 0.1f));
    }
#undef IN
#undef SEAM
}

extern "C" void kernel_launch(void* const* d_in, const int* in_sizes, int n_in, void* d_out, int out_size, void* d_ws, size_t ws_size, hipStream_t stream) {
    static int grid = 0;
    if (grid == 0) {
        if (n_in != 18 || out_size != T * D || ws_size < WS_END) { fprintf(stderr, "kernel_launch: unexpected shapes (n_in %d out %d ws %zu need %zu)\n", n_in, out_size, ws_size, (size_t)WS_END); grid = -1; return; }
        int dev = 0, cus = 0, per_cu = 0;
        if (hipGetDevice(&dev) != hipSuccess || hipDeviceGetAttribute(&cus, hipDeviceAttributeMultiprocessorCount, dev) != hipSuccess) { grid = -1; return; }
        if (hipFuncSetAttribute((const void*)fwd_kernel, hipFuncAttributeMaxDynamicSharedMemorySize, LDS_BYTES) != hipSuccess) { fprintf(stderr, "kernel_launch: hipFuncSetAttribute failed\n"); grid = -1; return; }
        if (hipOccupancyMaxActiveBlocksPerMultiprocessor(&per_cu, (const void*)fwd_kernel, NTHREADS, LDS_BYTES) != hipSuccess || per_cu < 1) { fprintf(stderr, "kernel_launch: occupancy query says %d\n", per_cu); per_cu = 1; }
        (void)hipGetLastError();
        grid = cus;
    }
    if (grid < 0) return;
    (void)hipMemsetAsync((char*)d_ws + WS_CTL, 0, CTL_BYTES, stream);
    Args a{};
    for (int i = 0; i < 18; ++i) a.in[i] = (const float*)d_in[i];
    a.out = (float*)d_out; a.ws = (unsigned char*)d_ws;
#if MK_MULTI
    for (int ph = 0; ph < NPHASE; ++ph) { a.ph_lo = ph; a.ph_hi = ph + 1; hipLaunchKernelGGL(fwd_kernel, dim3(grid), dim3(NTHREADS), LDS_BYTES, stream, a); }
#else
    a.ph_lo = 0; a.ph_hi = NPHASE;
    void* kargs[] = {&a};
    hipError_t e = hipLaunchCooperativeKernel((const void*)fwd_kernel, dim3(grid), dim3(NTHREADS), kargs, LDS_BYTES, stream);
    if (e != hipSuccess) fprintf(stderr, "kernel_launch: cooperative launch failed: %s\n", hipGetErrorString(e));
#endif
}
```

```cpp
#include <hip/hip_runtime.h>
#include <cstdio>
#include <cstdint>

#define GAS __attribute__((address_space(1)))
#define LAS __attribute__((address_space(3)))
#define DI __device__ __forceinline__
typedef unsigned short bf16_t;
typedef short bf16x8 __attribute__((ext_vector_type(8)));
typedef short s16x4 __attribute__((ext_vector_type(4)));
typedef float f32x4 __attribute__((ext_vector_type(4)));
typedef unsigned u32x4 __attribute__((ext_vector_type(4)));
typedef unsigned u32x2 __attribute__((ext_vector_type(2)));

#ifndef PROBE_A
#define PROBE_A -1
#define PROBE_B -1
#endif
#ifndef REPEAT_MASK
#define REPEAT_MASK 0
#endif
#ifndef MK_MULTI
#define MK_MULTI 0
#endif

constexpr int T = 8192, D = 2048, SEQ = 2048;
constexpr int SBH = 16;
constexpr int MLH = 8, ML_IN = 6160;
constexpr int NE = 32, FF = 256;
constexpr float EPS = 1e-6f;
constexpr int NPHASE = 16;
constexpr int NTHREADS = 512;
constexpr int LDS_BYTES = 147456;

constexpr size_t MiB = 1u << 20;
constexpr size_t WS_CTL = 0, CTL_BYTES = 128 * 1024;
constexpr size_t WS_WR = 128 * 1024, WR_BYTES = 384 * 1024, WS_WG = 896 * 1024;
constexpr size_t WS_WSBIN = 1 * MiB, WS_WSBOUT = 25 * MiB, WS_WMLIN = 33 * MiB, WS_WMLOUT = 57 * MiB;
constexpr size_t WS_W13 = 65 * MiB, WS_W2 = 193 * MiB;
constexpr size_t WS_X = 257 * MiB, WS_H = 321 * MiB, WS_ACT = 353 * MiB;
constexpr size_t A_Q = 0, A_K = 32 * MiB, A_VT = 64 * MiB, A_O = 96 * MiB;
constexpr size_t A_Q1 = 0, A_K1 = 16 * MiB, A_KT = 32 * MiB, A_VT1 = 48 * MiB, A_OG = 80 * MiB, A_HS = 112 * MiB, A_G = 144 * MiB, A_NJ = 144 * MiB + 524288, A_SUM = 144 * MiB + 524288 + 131072;
constexpr size_t A_HID = 0, A_LIST = 9 * MiB, A_LISTW = 10 * MiB, A_Y = 16 * MiB;
constexpr size_t A_Z0 = 64 * MiB, A_Z1 = 80 * MiB;
constexpr size_t WS_END = WS_ACT + 145 * MiB;
constexpr int CW_BAR = 4096;
constexpr int CW_CNT = 16384;

typedef __bf16 bf16x2_t __attribute__((ext_vector_type(2)));
typedef float f32x2 __attribute__((ext_vector_type(2)));
DI unsigned pk2(float lo, float hi) { const f32x2 v = {lo, hi}; return __builtin_bit_cast(unsigned, __builtin_convertvector(v, bf16x2_t)); }
DI unsigned f2bf(float f) { return pk2(f, 0.f) & 0xffffu; }
DI float bf2f(unsigned short b) { return __builtin_bit_cast(float, ((unsigned)b) << 16); }
template <int CTRL> DI float dpp_t(float v) { return __builtin_bit_cast(float, __builtin_amdgcn_update_dpp(0, __builtin_bit_cast(int, v), CTRL, 0xF, 0xF, false)); }
#define dpp_f(v, ctrl) dpp_t<ctrl>(v)
DI float wave_max(float v) {
    v = fmaxf(v, dpp_f(v, 0xB1)); v = fmaxf(v, dpp_f(v, 0x4E)); v = fmaxf(v, dpp_f(v, 0x141)); v = fmaxf(v, dpp_f(v, 0x140));
    v = fmaxf(v, __shfl_xor(v, 16)); v = fmaxf(v, __shfl_xor(v, 32)); return v;
}
DI float wave_sum(float v) {
#pragma unroll
    for (int o = 1; o < 64; o <<= 1) v += __shfl_xor(v, o);
    return v;
}
#define LDS_WAIT() asm volatile("s_waitcnt lgkmcnt(0)" ::: "memory")
#define VM_WAIT() asm volatile("s_waitcnt vmcnt(0)" ::: "memory")
#define MFMA16(a, b, c) __builtin_amdgcn_mfma_f32_16x16x32_bf16((a), (b), (c), 0, 0, 0)

#define XB_TMO      128
#define XB_XCNT(j)  (256  + 64 * (j))
#define XB_XSUB(j)  (1280 + 64 * (j))
#define XB_XGEN(j)  (2304 + 64 * (j))
#define XB_TOP      3328
#define XB_TOPGEN   3392
#define XCD_BAR_WORDS 3456
#define XB_SPIN_CAP (1u << 18)
DI unsigned xb_ld(unsigned* p)              { return __hip_atomic_load(p, __ATOMIC_RELAXED, __HIP_MEMORY_SCOPE_AGENT); }
DI unsigned xb_add(unsigned* p, unsigned v) { return __hip_atomic_fetch_add(p, v, __ATOMIC_RELAXED, __HIP_MEMORY_SCOPE_AGENT); }
DI unsigned xb_xcc_id() { return (unsigned)__builtin_amdgcn_s_getreg((3 << 11) | 20) & 0xFu; }
#define XB_SPIN(cond, bar) do { unsigned _sp = 0; while (cond) { __builtin_amdgcn_s_sleep(1); \
    if ((++_sp & 255u) == 0u) { if (xb_ld(&(bar)[XB_TMO])) break; if (_sp > XB_SPIN_CAP) { atomicAdd(&(bar)[XB_TMO], 1u); break; } } } } while (0)
struct XcdBarrier { unsigned* bar; unsigned x; volatile LAS unsigned* st; };
DI XcdBarrier xcd_barrier_post(unsigned* bar, volatile LAS unsigned* st) {
    XcdBarrier b; b.bar = bar; b.x = xb_xcc_id(); b.st = st;
    if (threadIdx.x == 0) (void)xb_add(&bar[XB_XCNT(b.x)], 1u);
    return b;
}
DI void xcd_barrier_complete(unsigned* bar, unsigned x, unsigned& nloc, unsigned& nx) {
    const unsigned G = gridDim.x * gridDim.y * gridDim.z;
    unsigned sum, cnt, mine, sp = 0u;
    for (;;) {
        sum = 0u; cnt = 0u; mine = 0u;
#pragma unroll
        for (unsigned j = 0; j < 16; ++j) { const unsigned c = xb_ld(&bar[XB_XCNT(j)]); sum += c; cnt += (c > 0u) ? 1u : 0u; mine = (j == x) ? c : mine; }
        if (sum == G) break;
        __builtin_amdgcn_s_sleep(1);
        if ((++sp & 255u) == 0u) { if (xb_ld(&bar[XB_TMO])) break; if (sp > XB_SPIN_CAP) { atomicAdd(&bar[XB_TMO], 1u); break; } }
    }
    nloc = mine > 0u ? mine : 1u; nx = cnt > 0u ? cnt : 1u;
}
DI void xcd_barrier(const XcdBarrier& b) {
    asm volatile("s_waitcnt vmcnt(0)" ::: "memory");
    __syncthreads();
    if (threadIdx.x == 0) {
        unsigned* bar = b.bar;
        __builtin_amdgcn_s_waitcnt(0);
        unsigned nloc = b.st[0], nx = b.st[1];
        if (nloc == 0u) { xcd_barrier_complete(bar, b.x, nloc, nx); b.st[0] = nloc; b.st[1] = nx; }
        const unsigned old = xb_add(&bar[XB_XSUB(b.x)], 1u);
        const unsigned gen = old / nloc;
        if (old + 1u == (gen + 1u) * nloc) {
            __builtin_amdgcn_fence(__ATOMIC_RELEASE, "agent");
            asm volatile("s_waitcnt vmcnt(0)" ::: "memory");
            const unsigned og = xb_add(&bar[XB_TOP], 1u);
            const unsigned tg = og / nx;
            if (og + 1u == (tg + 1u) * nx) xb_add(&bar[XB_TOPGEN], 1u);
            else XB_SPIN(xb_ld(&bar[XB_TOPGEN]) == tg, bar);
            __builtin_amdgcn_fence(__ATOMIC_ACQUIRE, "agent");
            xb_add(&bar[XB_XGEN(b.x)], 1u);
            asm volatile("s_waitcnt vmcnt(0)" ::: "memory");
        } else {
            XB_SPIN(xb_ld(&bar[XB_XGEN(b.x)]) == gen, bar);
            __builtin_amdgcn_fence(__ATOMIC_ACQUIRE, "agent");
            asm volatile("s_waitcnt vmcnt(0)" ::: "memory");
        }
    }
    __syncthreads();
}

struct Args {
    const float* in[18];
    float* out;
    unsigned char* ws;
    int ph_lo, ph_hi;
};

DI int perm13(int f, int which) { return (f >> 7) * 256 + ((f >> 5) & 3) * 64 + which * 32 + (f & 31); }
DI void transpose_item(const float* W, int ldw, bf16_t* WT, int ldt, int k0, int n0, int mode, LAS float* scr, int lane) {
#pragma unroll 16
    for (int i = 0; i < 64; ++i) scr[i * 65 + lane] = __builtin_nontemporal_load(W + (size_t)(k0 + i) * ldw + n0 + lane);
    LDS_WAIT(); asm volatile("" ::: "memory");
    const int c = lane & 7;
#pragma unroll
    for (int j = 0; j < 8; ++j) {
        const int n = (lane >> 3) + 8 * j; const LAS float* s = scr + (8 * c) * 65 + n;
        u32x4 o; o.x = pk2(s[0 * 65], s[1 * 65]); o.y = pk2(s[2 * 65], s[3 * 65]); o.z = pk2(s[4 * 65], s[5 * 65]); o.w = pk2(s[6 * 65], s[7 * 65]);
        const int nn = n0 + n; const int row = (mode == 0) ? nn : perm13(nn, mode - 1);
        *(u32x4*)(WT + (size_t)row * ldt + k0 + 8 * c) = o;
    }
    LDS_WAIT(); asm volatile("" ::: "memory");
}

struct NormP {
    const float* src; bf16_t* X; const bf16_t* Y; bf16_t* H; float* outf; const float* g;
    const bf16_t* wimg; const float* bg; const float* be;
    unsigned* cnt; unsigned* list; float* listw;
    float* G;
};
template <int MODE, bool XB>
DI void norm_phase(const NormP& p, LAS unsigned char* lds, int tid, int wid, int lane) {
    constexpr int RB_LDB = 4112;
    LAS unsigned char* rb_hi = lds;
    LAS float* part = (LAS float*)(lds + 8 * RB_LDB);
    LAS float* logit = part + 8 * 8 * 48;
    LAS int* pex = (LAS int*)(logit + 512); LAS unsigned* pen = (LAS unsigned*)(pex + 512); LAS float* pwt = (LAS float*)(pen + 512);
    int itn = 0;
    constexpr bool PROJ = (MODE == 1 || MODE == 2);
    const float* xin = p.src;
    const bf16_t* xbn = (MODE <= 1) ? (const bf16_t*)p.src : (const bf16_t*)p.X;
    f32x4 v[8]; u32x2 xb[8], ya[8], yb[8];
    int it = blockIdx.x;
#define NP_LOADV(itx) do { const size_t ro_ = (size_t)((itx) * 8 + wid) * D; _Pragma("unroll") for (int j = 0; j < 8; ++j) { if (XB) xb[j] = *(const u32x2*)(xbn + ro_ + 4 * lane + 256 * j); else v[j] = __builtin_nontemporal_load((const f32x4*)(xin + ro_ + 4 * lane + 256 * j)); } } while (0)
#define NP_LOADY(itx) do { const size_t ro_ = (size_t)((itx) * 8 + wid) * D; _Pragma("unroll") for (int j = 0; j < 8; ++j) { const int c = 4 * lane + 256 * j; \
        if (MODE >= 1) ya[j] = *(const u32x2*)(p.Y + ro_ + c); if (MODE >= 2) yb[j] = *(const u32x2*)(p.Y + (size_t)T * D + ro_ + c); } } while (0)
#define NP_LOAD(itx) do { NP_LOADV(itx); NP_LOADY(itx); } while (0)
    if (it < T / 8) NP_LOAD(it);
    for (; it < T / 8; it += gridDim.x, ++itn) {
        const int row = it * 8 + wid;
        const size_t ro = (size_t)row * D;
        f32x4 gv[8];
#pragma unroll
        for (int j = 0; j < 8; ++j) gv[j] = *(const f32x4*)(p.g + 4 * lane + 256 * j);
        float ss = 0.f;
#pragma unroll
        for (int j = 0; j < 8; ++j) {
            f32x4 x;
            if (XB) { const u32x2 q = xb[j]; x.x = bf2f(q.x & 0xffff); x.y = bf2f(q.x >> 16); x.z = bf2f(q.y & 0xffff); x.w = bf2f(q.y >> 16); } else x = v[j];
            if (MODE >= 1) {
                const u32x2 a = ya[j];
                x.x += bf2f(a.x & 0xffff); x.y += bf2f(a.x >> 16); x.z += bf2f(a.y & 0xffff); x.w += bf2f(a.y >> 16);
                if (MODE >= 2) { const u32x2 b = yb[j]; x.x += bf2f(b.x & 0xffff); x.y += bf2f(b.x >> 16); x.z += bf2f(b.y & 0xffff); x.w += bf2f(b.y >> 16); }
                if (MODE <= 2) { u32x2 o; o.x = pk2(x.x, x.y); o.y = pk2(x.z, x.w); *(u32x2*)(p.X + ro + 4 * lane + 256 * j) = o; }
            }
            v[j] = x;
            ss += (x.x * x.x + x.y * x.y) + (x.z * x.z + x.w * x.w);
        }
        const float rstd = 1.0f / sqrtf(wave_sum(ss) * (1.0f / D) + EPS);
#pragma unroll
        for (int j = 0; j < 8; ++j) {
            const int c = 4 * lane + 256 * j;
            const f32x4 gg = gv[j];
            f32x4 y; y.x = v[j].x * rstd * gg.x; y.y = v[j].y * rstd * gg.y; y.z = v[j].z * rstd * gg.z; y.w = v[j].w * rstd * gg.w;
            if (MODE == 3) *(f32x4*)(p.outf + ro + c) = y;
            else { u32x2 o; o.x = pk2(y.x, y.y); o.y = pk2(y.z, y.w); *(u32x2*)(p.H + ro + c) = o; }
            if (PROJ) *(LAS u32x2*)(rb_hi + wid * RB_LDB + c * 2) = (u32x2){pk2(y.x, y.y), pk2(y.z, y.w)};
        }
        const bool more = it + (int)gridDim.x < T / 8;
        if (!PROJ && more) NP_LOAD(it + gridDim.x);
        if (PROJ) {
            __syncthreads();
            {
                constexpr int NT = (MODE == 1) ? 3 : 1;
                f32x4 pacc[NT];
#pragma unroll
                for (int nt = 0; nt < NT; ++nt) pacc[nt] = (f32x4){0.f, 0.f, 0.f, 0.f};
                const LAS unsigned char* ahi = rb_hi + (lane & 7) * RB_LDB + (lane >> 4) * 16 + wid * 512;
                const bf16_t* wim = p.wimg + (size_t)lane * 8 + (size_t)(8 * wid) * NT * 512;
                bf16x8 w0[4][NT], w1[4][NT];
#define NP_LDW(dst, g) do { _Pragma("unroll") for (int kk = 0; kk < 4; ++kk) _Pragma("unroll") for (int nt = 0; nt < NT; ++nt) dst[kk][nt] = *(const bf16x8*)(wim + (size_t)((4 * (g) + kk) * NT + nt) * 512); } while (0)
#define NP_MM(src, g) do { _Pragma("unroll") for (int kk = 0; kk < 4; ++kk) { const bf16x8 xh = *(const LAS bf16x8*)(ahi + (4 * (g) + kk) * 64); \
        _Pragma("unroll") for (int nt = 0; nt < NT; ++nt) pacc[nt] = MFMA16(xh, src[kk][nt], pacc[nt]); } } while (0)
#define NP_PIN __builtin_amdgcn_sched_barrier(0)
                NP_LDW(w0, 0); NP_LDW(w1, 1); NP_PIN;
                if (more) NP_LOADV(it + gridDim.x);
                NP_PIN; NP_MM(w0, 0); NP_MM(w1, 1); NP_PIN;
#undef NP_PIN
#undef NP_LDW
#undef NP_MM
                if (more) NP_LOADY(it + gridDim.x);
                if (lane < 32) {
#pragma unroll
                    for (int nt = 0; nt < NT; ++nt)
#pragma unroll
                        for (int r = 0; r < 4; ++r) part[(wid * 8 + 4 * (lane >> 4) + r) * 48 + 16 * nt + (lane & 15)] = pacc[nt][r];
                }
            }
            __syncthreads();
            {
                float sl = 0.f;
                if (lane < 48) {
#pragma unroll
                    for (int w = 0; w < 8; ++w) sl += part[(w * 8 + wid) * 48 + lane];
                }
                if (MODE == 2) { if (lane < 16) p.G[(size_t)row * 16 + lane] = sl; }
                else {
                    if (lane < 36) sl += (lane < 4) ? p.bg[lane] : p.be[lane - 4];
                    const float NEG = -3.0e38f;
                    const float gl = (lane < 4) ? sl : NEG;
                    float gm = fmaxf(gl, dpp_f(gl, 0xB1)); gm = fmaxf(gm, dpp_f(gm, 0x4E));
                    gm = __shfl(gm, 0);
                    const int gs = __ffsll((long long)__ballot(lane < 4 && sl == gm)) - 1;
                    float ge = (lane < 4) ? __expf(sl - gm) : 0.f;
                    ge += dpp_f(ge, 0xB1); ge += dpp_f(ge, 0x4E);
                    const float psel = 1.0f / __shfl(ge, 0);
                    const int eb = 4 + 8 * gs;
                    const bool inr = lane >= eb && lane < eb + 8;
                    const float v0 = wave_max(inr ? sl : NEG);
                    const int l0 = __ffsll((long long)__ballot(inr && sl == v0)) - 1;
                    const float v1 = wave_max((inr && lane != l0) ? sl : NEG);
                    const int l1 = __ffsll((long long)__ballot(inr && lane != l0 && sl == v1)) - 1;
                    if (lane == 0) {
                        const float e10 = __expf(v1 - v0); const float w0 = psel / (1.0f + e10), w1 = psel * e10 / (1.0f + e10);
                        const int e0 = gs * 8 + (l0 - eb), e1 = gs * 8 + (l1 - eb);
                        const int sl0 = itn * 16 + wid * 2;
                        pex[sl0] = e0; pen[sl0] = (unsigned)row * 2u; pwt[sl0] = w0;
                        pex[sl0 + 1] = e1; pen[sl0 + 1] = (unsigned)row * 2u + 1u; pwt[sl0 + 1] = w1;
                    }
                }
            }
        }
    }
#undef NP_LOAD
#undef NP_LOADV
#undef NP_LOADY
    if (MODE == 1) {
        __syncthreads();
        if (wid == 0) {
            const int np = itn * 16;
            for (int c0 = 0; c0 < np; c0 += 64) {
                const bool have = c0 + lane < np;
                const int ei = have ? pex[c0 + lane] : -1;
                int cnt_e = 0, rank = 0;
#pragma unroll 4
                for (int e = 0; e < NE; ++e) {
                    const unsigned long long m = __ballot(ei == e);
                    if (lane == e) cnt_e = __popcll(m);
                    if (ei == e) rank = __popcll(m & ((1ull << lane) - 1ull));
                }
                unsigned base = 0u;
                if (lane < NE && cnt_e > 0) base = atomicAdd(p.cnt + lane, (unsigned)cnt_e);
                const unsigned mybase = (unsigned)__shfl((int)base, ei < 0 ? 0 : ei);
                if (have) { const size_t pos = (size_t)ei * T + mybase + rank; p.list[pos] = pen[c0 + lane]; p.listw[pos] = pwt[c0 + lane]; }
            }
        }
        __syncthreads();
    }
}

DI int lds_byte(int r, int c) { const int st = (r >> 4) * 2 + (c >> 5), rr = r & 15, cc = c & 31, ob = rr * 64 + cc * 2; return st * 1024 + (ob ^ (((ob >> 9) & 1) << 5)); }
DI void stage_rc(int b, int& R, int& C) { const int st = b / 1024, sb = b % 1024, swz = sb ^ (((sb >> 9) & 1) << 5); R = (st >> 1) * 16 + swz / 64; C = (st & 1) * 32 + (swz % 64) / 2; }

namespace pg8 {
constexpr int BM = 256, BK = 64, HALF = 128, HTB = HALF * BK * 2, NXCD = 8, WGM = 8, KD = 2048;
DI int perm32(int rho) { const int n = rho >> 4, i = rho & 15; return 8 * (i >> 2) + 4 * n + (i & 3); }
struct Unit { int pm, pn, job; };
struct JobRec { const bf16_t* A; const bf16_t* Bt; bf16_t* o0; bf16_t* o1; int M, N, ld, split; float scale0; int pad[5]; };
constexpr int JOBS_OFF = 139264;
DI void put_job(LAS unsigned char* lds, int j, const bf16_t* A, const bf16_t* Bt, int M, int N, bf16_t* o0, bf16_t* o1, int ld, int split, float scale0) {
    LAS JobRec* r = (LAS JobRec*)(lds + JOBS_OFF) + j;
    r->A = A; r->Bt = Bt; r->o0 = o0; r->o1 = o1; r->M = M; r->N = N; r->ld = ld; r->split = split; r->scale0 = scale0;
}
struct Sched {
    const LAS JobRec* tab; int n0, n1, n2, G, c;
    DI void init(LAS unsigned char* lds, int njobs, int G_, int c_) {
        tab = (const LAS JobRec*)(lds + JOBS_OFF);
        n0 = (tab[0].M / BM) * (tab[0].N / BM); n1 = njobs > 1 ? (tab[1].M / BM) * (tab[1].N / BM) : 0; n2 = njobs > 2 ? (tab[2].M / BM) * (tab[2].N / BM) : 0; G = G_; c = c_; }
    DI bool next(int i, Unit& u) const {
        int L = i * G + c, nwg;
        if (L < n0) { u.job = 0; nwg = n0; }
        else if (L < n0 + n1) { L -= n0; u.job = 1; nwg = n1; }
        else if (L < n0 + n1 + n2) { L -= n0 + n1; u.job = 2; nwg = n2; }
        else return false;
        const int nM = tab[u.job].M / BM, nN = tab[u.job].N / BM;
        int wgid = L; { const int q = nwg / NXCD, r = nwg % NXCD, xcd = wgid % NXCD, off = wgid / NXCD; wgid = (xcd < r ? xcd * (q + 1) : r * (q + 1) + (xcd - r) * q) + off; }
        const int nig = WGM * nN, gid = wgid / nig, fm = gid * WGM, gsz = (nM - fm) < WGM ? (nM - fm) : WGM;
        u.pm = fm + ((wgid % nig) % gsz); u.pn = (wgid % nig) / gsz; return true;
    }
    DI const char* aptr(const Unit& u) const { return (const char*)tab[u.job].A + (size_t)u.pm * (2 * HALF * KD * 2); }
    DI const char* bptr(const Unit& u) const { return (const char*)tab[u.job].Bt + (size_t)u.pn * (2 * HALF * KD * 2); }
};
struct EpiBf16 {
    static constexpr bool PERM = true;
    const LAS JobRec* tab;
    DI void operator()(const f32x4 (&acc)[2][2][4][2], const Unit& u, int wr, int wc, int fr, int fq) const {
        const LAS JobRec* jr = tab + u.job;
        const int ldo = jr->ld, split = jr->split;
        float sc = jr->scale0;
        int colt = u.pn * BM; bf16_t* base = jr->o0;
        if (colt >= split) { colt -= split; base = jr->o1; sc = 1.0f; }
        const int row0 = u.pm * BM + wr * 64 + fr, col0 = colt + wc * 64 + 8 * fq;
#pragma unroll
        for (int ai = 0; ai < 2; ++ai)
#pragma unroll
            for (int m = 0; m < 4; ++m) { bf16_t* rowp = base + (size_t)(row0 + ai * HALF + m * 16) * ldo + col0;
#pragma unroll
                for (int bj = 0; bj < 2; ++bj) { const f32x4 v0 = acc[ai][bj][m][0], v1 = acc[ai][bj][m][1];
                    u32x4 w; w.x = pk2(v0.x * sc, v0.y * sc); w.y = pk2(v0.z * sc, v0.w * sc); w.z = pk2(v1.x * sc, v1.y * sc); w.w = pk2(v1.z * sc, v1.w * sc);
                    *(u32x4*)(rowp + bj * 32) = w; } }
    }
};
struct EpiResF32 {
    static constexpr bool PERM = false;
    const float* base; float* out; int ld;
    DI void operator()(const f32x4 (&acc)[2][2][4][2], const Unit& u, int wr, int wc, int fr, int fq) const {
        const int row0 = u.pm * BM + wr * 64 + fr, col0 = u.pn * BM + wc * 32 + 4 * fq;
#pragma unroll
        for (int ai = 0; ai < 2; ++ai)
#pragma unroll
            for (int m = 0; m < 4; ++m) { const size_t ro = (size_t)(row0 + ai * HALF + m * 16) * ld + col0;
#pragma unroll
                for (int bj = 0; bj < 2; ++bj)
#pragma unroll
                    for (int n = 0; n < 2; ++n) { const f32x4 b = *(const f32x4*)(base + ro + bj * HALF + n * 16); const f32x4 a = acc[ai][bj][m][n];
                        f32x4 o; o.x = a.x + b.x; o.y = a.y + b.y; o.z = a.z + b.z; o.w = a.w + b.w; *(f32x4*)(out + ro + bj * HALF + n * 16) = o; } }
    }
};
struct EpiNull {
    static constexpr bool PERM = false;
    DI void operator()(const f32x4 (&acc)[2][2][4][2], const Unit&, int, int, int, int) const {
#pragma unroll
        for (int ai = 0; ai < 2; ++ai)
#pragma unroll
            for (int bj = 0; bj < 2; ++bj)
#pragma unroll
                for (int m = 0; m < 4; ++m)
#pragma unroll
                    for (int n = 0; n < 2; ++n) asm volatile("" :: "v"(acc[ai][bj][m][n]));
    }
};
template <class Epi>
DI void gemm_phase(LAS unsigned char* lds, const Sched& S, const Epi& E) {
    const int tid = threadIdx.x, wid = __builtin_amdgcn_readfirstlane(tid >> 6), lane = tid & 63, wr = wid >> 2, wc = wid & 3, fr = lane & 15, fq = lane >> 4;
    constexpr int K = KD, nt = K / BK;
    unsigned voffA[2], voffB[2][2];
#pragma unroll
    for (int i = 0; i < 2; ++i) { int R, C; stage_rc(tid * 16 + i * 8192, R, C);
        voffA[i] = (unsigned)(R * K + C) * 2u;
#pragma unroll
        for (int h = 0; h < 2; ++h) { const int Rb = Epi::PERM ? (64 * (R >> 5) + 32 * h + perm32(R & 31)) : (128 * h + R); voffB[h][i] = (unsigned)(Rb * K + C) * 2u; } }
    constexpr size_t kstep = (size_t)(BK * 2);
    constexpr size_t hstep = (size_t)HALF * K * 2;
    const unsigned ldsw = (unsigned)wid * 1024u;
    const int aoff = lds_byte(wr * 64 + fr, fq * 8), boff = lds_byte(wc * 32 + fr, fq * 8);
#define PG8_SA(b, h) (((b) * 2 + (h)) * HTB)
#define PG8_SB(b, h) ((4 + (b) * 2 + (h)) * HTB)
#define PG8_STAGE(bufoff, gbase, voff) do { _Pragma("unroll") for (int _i = 0; _i < 2; ++_i) \
        __builtin_amdgcn_global_load_lds((const GAS unsigned*)((const char*)(gbase) + (voff)[_i]), (LAS unsigned*)(lds + (bufoff) + ldsw + _i * 8192), 16, 0, 0); } while (0)
#define PG8_LDA(dst, b, h) do { _Pragma("unroll") for (int m = 0; m < 4; ++m) _Pragma("unroll") for (int k = 0; k < 2; ++k) dst[m][k] = *(const LAS bf16x8*)(lds + PG8_SA(b, h) + aoff + m * 2048 + k * 1024); } while (0)
#define PG8_LDB(dst, b, h) do { _Pragma("unroll") for (int n = 0; n < 2; ++n) _Pragma("unroll") for (int k = 0; k < 2; ++k) dst[n][k] = *(const LAS bf16x8*)(lds + PG8_SB(b, h) + boff + n * 2048 + k * 1024); } while (0)
#define PG8_MMA(ai, bj, At, Bt) do { __builtin_amdgcn_s_setprio(1); _Pragma("unroll") for (int m = 0; m < 4; ++m) _Pragma("unroll") for (int n = 0; n < 2; ++n) _Pragma("unroll") for (int k = 0; k < 2; ++k) \
        acc[ai][bj][m][n] = __builtin_amdgcn_mfma_f32_16x16x32_bf16(Bt[n][k], At[m][k], acc[ai][bj][m][n], 0, 0, 0); __builtin_amdgcn_s_setprio(0); } while (0)
#define PG8_WAIT_V(n) asm volatile("s_waitcnt vmcnt(" #n ")" ::: "memory")
#define PG8_WAIT_L(n) asm volatile("s_waitcnt lgkmcnt(" #n ")" ::: "memory")
#define PG8_BAR __builtin_amdgcn_s_barrier()
#define PG8_SCHED __builtin_amdgcn_sched_barrier(0)
    Unit cur, nxt; int ui = 0;
    if (!S.next(0, cur)) return;
    f32x4 acc[2][2][4][2];
#pragma unroll
    for (int a = 0; a < 2; ++a)
#pragma unroll
        for (int b = 0; b < 2; ++b)
#pragma unroll
            for (int m = 0; m < 4; ++m)
#pragma unroll
                for (int n = 0; n < 2; ++n) acc[a][b][m][n] = (f32x4){0.f, 0.f, 0.f, 0.f};
    bf16x8 At[4][2], B0[2][2], B1[2][2];
    const char* cA = S.aptr(cur); const char* cB = S.bptr(cur);
    PG8_STAGE(PG8_SB(0, 0), cB, voffB[0]); PG8_STAGE(PG8_SA(0, 0), cA, voffA); PG8_STAGE(PG8_SB(0, 1), cB, voffB[1]); PG8_STAGE(PG8_SA(0, 1), cA + hstep, voffA);
    if (wr == 1) PG8_BAR;
    PG8_WAIT_V(4); PG8_BAR;
    PG8_STAGE(PG8_SB(1, 0), cB + kstep, voffB[0]); PG8_STAGE(PG8_SA(1, 0), cA + kstep, voffA); PG8_STAGE(PG8_SB(1, 1), cB + kstep, voffB[1]);
    PG8_WAIT_V(6); PG8_BAR;
    for (;;) {
        const bool has_next = S.next(ui + 1, nxt);
        const char* nA = has_next ? S.aptr(nxt) : cA; const char* nB = has_next ? S.bptr(nxt) : cB;
        for (int t = 0; t < nt; t += 2) {
            const bool last = (t == nt - 2);
            const char* a1 = cA + (size_t)(t + 1) * kstep;
            const char* a2 = last ? nA : cA + (size_t)(t + 2) * kstep; const char* b2 = last ? nB : cB + (size_t)(t + 2) * kstep;
            const char* a3 = a2 + kstep; const char* b3 = b2 + kstep;
            PG8_LDB(B0, 0, 0); PG8_SCHED; PG8_LDA(At, 0, 0); PG8_STAGE(PG8_SA(1, 1), a1 + hstep, voffA);
            PG8_WAIT_L(8); PG8_BAR; PG8_WAIT_L(0); PG8_MMA(0, 0, At, B0); PG8_BAR; PG8_SCHED;
            PG8_LDB(B1, 0, 1); PG8_STAGE(PG8_SB(0, 0), b2, voffB[0]);
            PG8_BAR; PG8_WAIT_L(0); PG8_MMA(0, 1, At, B1); PG8_BAR;
            PG8_LDA(At, 0, 1); PG8_STAGE(PG8_SA(0, 0), a2, voffA);
            PG8_BAR; PG8_WAIT_L(0); PG8_MMA(1, 0, At, B0); PG8_BAR; PG8_SCHED;
            PG8_STAGE(PG8_SB(0, 1), b2, voffB[1]);
            PG8_WAIT_V(6); PG8_BAR; PG8_MMA(1, 1, At, B1); PG8_BAR;
            PG8_LDB(B0, 1, 0); PG8_SCHED; PG8_LDA(At, 1, 0); PG8_STAGE(PG8_SA(0, 1), a2 + hstep, voffA);
            PG8_WAIT_L(8); PG8_BAR; PG8_WAIT_L(0); PG8_MMA(0, 0, At, B0); PG8_BAR; PG8_SCHED;
            PG8_LDB(B1, 1, 1); PG8_STAGE(PG8_SB(1, 0), b3, voffB[0]);
            PG8_BAR; PG8_WAIT_L(0); PG8_MMA(0, 1, At, B1); PG8_BAR;
            PG8_LDA(At, 1, 1); PG8_STAGE(PG8_SA(1, 0), a3, voffA);
            PG8_BAR; PG8_WAIT_L(0); PG8_MMA(1, 0, At, B0); PG8_BAR; PG8_SCHED;
            PG8_STAGE(PG8_SB(1, 1), b3, voffB[1]);
            PG8_WAIT_V(6); PG8_BAR; PG8_MMA(1, 1, At, B1); PG8_BAR;
        }
        E(acc, cur, wr, wc, fr, fq);
        if (!has_next) break;
#pragma unroll
        for (int a = 0; a < 2; ++a)
#pragma unroll
            for (int b = 0; b < 2; ++b)
#pragma unroll
                for (int m = 0; m < 4; ++m)
#pragma unroll
                    for (int n = 0; n < 2; ++n) acc[a][b][m][n] = (f32x4){0.f, 0.f, 0.f, 0.f};
        cur = nxt; cA = nA; cB = nB; ++ui;
    }
    PG8_WAIT_V(0);
    if (wr == 0) PG8_BAR;
    PG8_BAR;
#undef PG8_SA
#undef PG8_SB
#undef PG8_STAGE
#undef PG8_LDA
#undef PG8_LDB
#undef PG8_MMA
#undef PG8_WAIT_V
#undef PG8_WAIT_L
#undef PG8_BAR
#undef PG8_SCHED
}

struct MUnit { int e, rt, pn, cnt, sbase; };
constexpr int MTAB_OFF = JOBS_OFF + 256;
DI void moe_table256(const unsigned* cntg, LAS unsigned char* lds, int tid) {
    LAS int* ctl = (LAS int*)(lds + MTAB_OFF);
    if (tid < 64) {
        const int c = (tid < NE) ? (int)__hip_atomic_load(cntg + tid, __ATOMIC_RELAXED, __HIP_MEMORY_SCOPE_AGENT) : 0;
        const int n = (c + 255) / 256;
        int pb = c, pt = n;
#pragma unroll
        for (int o = 1; o < 32; o <<= 1) { const int vb = __shfl_up(pb, o), vt = __shfl_up(pt, o); if (tid >= o) { pb += vb; pt += vt; } }
        if (tid < NE) { ctl[tid] = c; ctl[32 + tid] = pb - c; ctl[64 + tid] = pt - n; for (int i = 0; i < n && pt - n + i < 128; ++i) ctl[128 + pt - n + i] = tid; }
        if (tid == NE - 1) ctl[64 + NE] = pt;
    }
    __syncthreads();
}
template <int NPN>
struct MSched {
    const LAS int* ctl; int G, c, total;
    DI void init(LAS unsigned char* lds, int G_, int c_, bool xcd_group = false) { ctl = (const LAS int*)(lds + MTAB_OFF); G = G_; total = ctl[64 + NE] * NPN;
        c = (xcd_group && (G_ % 8 == 0)) ? (c_ % 8) * (G_ / 8) + c_ / 8 : c_; }
    DI bool next(int i, MUnit& u) const {
        const int L = i * G + c; if (L >= total) return false;
        const int rtg = L / NPN; u.pn = L % NPN;
        const int e = ctl[128 + rtg];
        u.e = e; u.rt = rtg - ctl[64 + e]; u.cnt = ctl[e]; u.sbase = ctl[32 + e]; return true;
    }
};
struct MOps1 {
    const bf16_t* H; const bf16_t* W; const unsigned* list;
    DI const char* abase(const MUnit&) const { return (const char*)H; }
    DI void aoffs(const MUnit& u, int R0, int C0, int R1, int C1, unsigned (&o)[2][2]) const {
#pragma unroll
        for (int h = 0; h < 2; ++h) {
            const int ra = u.rt * 256 + h * 128 + R0, rb = u.rt * 256 + h * 128 + R1;
            const unsigned ta = list[(size_t)u.e * T + (ra < u.cnt ? ra : u.cnt - 1)] >> 1, tb = list[(size_t)u.e * T + (rb < u.cnt ? rb : u.cnt - 1)] >> 1;
            o[h][0] = (ta * (unsigned)D + (unsigned)C0) * 2u; o[h][1] = (tb * (unsigned)D + (unsigned)C1) * 2u;
        }
    }
    DI const char* bptr(const MUnit& u) const { return (const char*)(W + ((size_t)u.e * 512 + u.pn * 256) * D); }
};
struct MOps2 {
    const bf16_t* hid; const bf16_t* W;
    DI const char* abase(const MUnit& u) const { return (const char*)(hid + (size_t)(u.sbase + u.rt * 256) * FF); }
    DI void aoffs(const MUnit&, int R0, int C0, int R1, int C1, unsigned (&o)[2][2]) const {
#pragma unroll
        for (int h = 0; h < 2; ++h) { o[h][0] = (unsigned)((h * 128 + R0) * FF + C0) * 2u; o[h][1] = (unsigned)((h * 128 + R1) * FF + C1) * 2u; }
    }
    DI const char* bptr(const MUnit& u) const { return (const char*)(W + ((size_t)u.e * D + u.pn * 256) * FF); }
};
constexpr int MROW_OFF = 131072;
struct EpiSwiglu {
    bf16_t* hid; const float* listw;
    DI void prep(const MUnit& u, LAS unsigned char* lds, int par, int tid) const {
        if (tid < 256) { const int r = u.rt * 256 + tid;
            __builtin_amdgcn_global_load_lds((const GAS unsigned*)(listw + (size_t)u.e * T + (r < u.cnt ? r : u.cnt - 1)), (LAS unsigned*)(lds + MROW_OFF + par * 1024 + (tid >> 6) * 256), 4, 0, 0); }
    }
    DI void operator()(const f32x4 (&acc)[2][2][4][2], const MUnit& u, int wr, int wc, int fr, int fq, const LAS unsigned char* lds, int par) const {
#pragma unroll
        for (int ai = 0; ai < 2; ++ai)
#pragma unroll
            for (int m = 0; m < 4; ++m) {
                const int r = u.rt * 256 + ai * HALF + wr * 64 + m * 16 + fr;
                if (r < u.cnt) {
                    const float gw = ((const LAS float*)(lds + MROW_OFF))[par * 256 + ai * HALF + wr * 64 + m * 16 + fr];
                    unsigned o[4];
#pragma unroll
                    for (int n = 0; n < 2; ++n) { const f32x4 g = acc[ai][0][m][n], uu = acc[ai][1][m][n]; float hv[4];
#pragma unroll
                        for (int j = 0; j < 4; ++j) hv[j] = g[j] / (1.0f + __expf(-g[j])) * uu[j] * gw;
                        o[2 * n] = pk2(hv[0], hv[1]); o[2 * n + 1] = pk2(hv[2], hv[3]); }
                    *(u32x4*)(hid + (size_t)(u.sbase + r) * FF + u.pn * 128 + wc * 32 + 8 * fq) = (u32x4){o[0], o[1], o[2], o[3]};
                }
            }
    }
};
struct EpiScatter {
    bf16_t* Y; const unsigned* list;
    DI void prep(const MUnit& u, LAS unsigned char* lds, int par, int tid) const {
        if (tid < 256) { const int r = u.rt * 256 + tid;
            __builtin_amdgcn_global_load_lds((const GAS unsigned*)(list + (size_t)u.e * T + (r < u.cnt ? r : u.cnt - 1)), (LAS unsigned*)(lds + MROW_OFF + par * 1024 + (tid >> 6) * 256), 4, 0, 0); }
    }
    DI void operator()(const f32x4 (&acc)[2][2][4][2], const MUnit& u, int wr, int wc, int fr, int fq, const LAS unsigned char* lds, int par) const {
#pragma unroll
        for (int ai = 0; ai < 2; ++ai)
#pragma unroll
            for (int m = 0; m < 4; ++m) {
                const int r = u.rt * 256 + ai * HALF + wr * 64 + m * 16 + fr;
                if (r < u.cnt) {
                    const unsigned ent = ((const LAS unsigned*)(lds + MROW_OFF))[par * 256 + ai * HALF + wr * 64 + m * 16 + fr];
                    bf16_t* yrow = Y + ((size_t)(ent & 1u) * T + (ent >> 1)) * D + u.pn * 256 + wc * 64 + 8 * fq;
#pragma unroll
                    for (int bj = 0; bj < 2; ++bj) { const f32x4 v0 = acc[ai][bj][m][0], v1 = acc[ai][bj][m][1];
                        __builtin_nontemporal_store(((u32x4){pk2(v0.x, v0.y), pk2(v0.z, v0.w), pk2(v1.x, v1.y), pk2(v1.z, v1.w)}), (u32x4*)(yrow + bj * 32)); }
                }
            }
    }
};
struct EpiMNull {
    DI void prep(const MUnit&, LAS unsigned char*, int, int) const {}
    DI void operator()(const f32x4 (&acc)[2][2][4][2], const MUnit&, int, int, int, int, const LAS unsigned char*, int) const {
#pragma unroll
        for (int ai = 0; ai < 2; ++ai)
#pragma unroll
            for (int bj = 0; bj < 2; ++bj)
#pragma unroll
                for (int m = 0; m < 4; ++m)
#pragma unroll
                    for (int n = 0; n < 2; ++n) asm volatile("" :: "v"(acc[ai][bj][m][n]));
    }
};
template <int K, class Sched, class Ops, class Epi>
DI void gemm_phase_m(LAS unsigned char* lds, const Sched& S, const Ops& P, const Epi& E) {
    const int tid = threadIdx.x, wid = __builtin_amdgcn_readfirstlane(tid >> 6), lane = tid & 63, wr = wid >> 2, wc = wid & 3, fr = lane & 15, fq = lane >> 4;
    constexpr int nt = K / BK;
    int R0, C0, R1, C1; stage_rc(tid * 16, R0, C0); stage_rc(tid * 16 + 8192, R1, C1);
    unsigned voffB[2][2];
#pragma unroll
    for (int h = 0; h < 2; ++h) { voffB[h][0] = (unsigned)((64 * (R0 >> 5) + 32 * h + perm32(R0 & 31)) * K + C0) * 2u; voffB[h][1] = (unsigned)((64 * (R1 >> 5) + 32 * h + perm32(R1 & 31)) * K + C1) * 2u; }
    constexpr size_t kstep = (size_t)(BK * 2);
    constexpr size_t hstep = (size_t)HALF * K * 2;
    const unsigned ldsw = (unsigned)wid * 1024u;
    const int aoff = lds_byte(wr * 64 + fr, fq * 8), boff = lds_byte(wc * 32 + fr, fq * 8);
#define PG8_SA(b, h) (((b) * 2 + (h)) * HTB)
#define PG8_SB(b, h) ((4 + (b) * 2 + (h)) * HTB)
#define PG8_STAGEB(bufoff, gbase, h) do { _Pragma("unroll") for (int _i = 0; _i < 2; ++_i) \
        __builtin_amdgcn_global_load_lds((const GAS unsigned*)((const char*)(gbase) + voffB[h][_i]), (LAS unsigned*)(lds + (bufoff) + ldsw + _i * 8192), 16, 0, 0); } while (0)
#define PG8_STAGEA(bufoff, bb, pp, h, koff) do { _Pragma("unroll") for (int _i = 0; _i < 2; ++_i) \
        __builtin_amdgcn_global_load_lds((const GAS unsigned*)((bb) + (koff) + (pp)[h][_i]), (LAS unsigned*)(lds + (bufoff) + ldsw + _i * 8192), 16, 0, 0); } while (0)
#define PG8_LDA(dst, b, h) do { _Pragma("unroll") for (int m = 0; m < 4; ++m) _Pragma("unroll") for (int k = 0; k < 2; ++k) dst[m][k] = *(const LAS bf16x8*)(lds + PG8_SA(b, h) + aoff + m * 2048 + k * 1024); } while (0)
#define PG8_LDB(dst, b, h) do { _Pragma("unroll") for (int n = 0; n < 2; ++n) _Pragma("unroll") for (int k = 0; k < 2; ++k) dst[n][k] = *(const LAS bf16x8*)(lds + PG8_SB(b, h) + boff + n * 2048 + k * 1024); } while (0)
#define PG8_MMA(ai, bj, At, Bt) do { __builtin_amdgcn_s_setprio(1); _Pragma("unroll") for (int m = 0; m < 4; ++m) _Pragma("unroll") for (int n = 0; n < 2; ++n) _Pragma("unroll") for (int k = 0; k < 2; ++k) \
        acc[ai][bj][m][n] = __builtin_amdgcn_mfma_f32_16x16x32_bf16(Bt[n][k], At[m][k], acc[ai][bj][m][n], 0, 0, 0); __builtin_amdgcn_s_setprio(0); } while (0)
#define PG8_WAIT_V(n) asm volatile("s_waitcnt vmcnt(" #n ")" ::: "memory")
#define PG8_WAIT_L(n) asm volatile("s_waitcnt lgkmcnt(" #n ")" ::: "memory")
#define PG8_BAR __builtin_amdgcn_s_barrier()
#define PG8_SCHED __builtin_amdgcn_sched_barrier(0)
    MUnit cur, nxt; int ui = 0;
    if (!S.next(0, cur)) return;
    f32x4 acc[2][2][4][2];
#pragma unroll
    for (int a = 0; a < 2; ++a)
#pragma unroll
        for (int b = 0; b < 2; ++b)
#pragma unroll
            for (int m = 0; m < 4; ++m)
#pragma unroll
                for (int n = 0; n < 2; ++n) acc[a][b][m][n] = (f32x4){0.f, 0.f, 0.f, 0.f};
    bf16x8 At[4][2], B0[2][2], B1[2][2];
    unsigned pA[2][2], qA[2][2];
    P.aoffs(cur, R0, C0, R1, C1, pA);
    const char* cAb = P.abase(cur);
    E.prep(cur, lds, 0, tid);
    const char* cB = P.bptr(cur);
    PG8_STAGEB(PG8_SB(0, 0), cB, 0); PG8_STAGEA(PG8_SA(0, 0), cAb, pA, 0, 0); PG8_STAGEB(PG8_SB(0, 1), cB, 1); PG8_STAGEA(PG8_SA(0, 1), cAb, pA, 1, 0);
    if (wr == 1) PG8_BAR;
    PG8_WAIT_V(4); PG8_BAR;
    PG8_STAGEB(PG8_SB(1, 0), cB + kstep, 0); PG8_STAGEA(PG8_SA(1, 0), cAb, pA, 0, kstep); PG8_STAGEB(PG8_SB(1, 1), cB + kstep, 1);
    PG8_WAIT_V(6); PG8_BAR;
    for (;;) {
        const bool has_next = S.next(ui + 1, nxt);
        const char* nB = cB; const char* nAb = cAb;
#pragma unroll
        for (int h = 0; h < 2; ++h) { qA[h][0] = pA[h][0]; qA[h][1] = pA[h][1]; }
        if (has_next) { P.aoffs(nxt, R0, C0, R1, C1, qA); nAb = P.abase(nxt); nB = P.bptr(nxt); E.prep(nxt, lds, (ui + 1) % 3, tid); }
#pragma unroll 1
        for (int t = 0; t < nt; t += 2) {
            const bool last = (t == nt - 2);
            const size_t k1 = (size_t)(t + 1) * kstep;
            const size_t k2 = last ? 0 : (size_t)(t + 2) * kstep, k3 = k2 + kstep;
            const char* b2 = last ? nB : cB + k2; const char* b3 = b2 + kstep;
            const char* a2 = last ? nAb : cAb;
            unsigned o2[2][2];
#pragma unroll
            for (int h = 0; h < 2; ++h) { o2[h][0] = last ? qA[h][0] : pA[h][0]; o2[h][1] = last ? qA[h][1] : pA[h][1]; }
            PG8_LDB(B0, 0, 0); PG8_SCHED; PG8_LDA(At, 0, 0); PG8_STAGEA(PG8_SA(1, 1), cAb, pA, 1, k1);
            PG8_WAIT_L(8); PG8_BAR; PG8_WAIT_L(0); PG8_MMA(0, 0, At, B0); PG8_BAR; PG8_SCHED;
            PG8_LDB(B1, 0, 1); PG8_STAGEB(PG8_SB(0, 0), b2, 0);
            PG8_BAR; PG8_WAIT_L(0); PG8_MMA(0, 1, At, B1); PG8_BAR;
            PG8_LDA(At, 0, 1); PG8_STAGEA(PG8_SA(0, 0), a2, o2, 0, k2);
            PG8_BAR; PG8_WAIT_L(0); PG8_MMA(1, 0, At, B0); PG8_BAR; PG8_SCHED;
            PG8_STAGEB(PG8_SB(0, 1), b2, 1);
            PG8_WAIT_V(6); PG8_BAR; PG8_MMA(1, 1, At, B1); PG8_BAR;
            PG8_LDB(B0, 1, 0); PG8_SCHED; PG8_LDA(At, 1, 0); PG8_STAGEA(PG8_SA(0, 1), a2, o2, 1, k2);
            PG8_WAIT_L(8); PG8_BAR; PG8_WAIT_L(0); PG8_MMA(0, 0, At, B0); PG8_BAR; PG8_SCHED;
            PG8_LDB(B1, 1, 1); PG8_STAGEB(PG8_SB(1, 0), b3, 0);
            PG8_BAR; PG8_WAIT_L(0); PG8_MMA(0, 1, At, B1); PG8_BAR;
            PG8_LDA(At, 1, 1); PG8_STAGEA(PG8_SA(1, 0), a2, o2, 0, k3);
            PG8_BAR; PG8_WAIT_L(0); PG8_MMA(1, 0, At, B0); PG8_BAR; PG8_SCHED;
            PG8_STAGEB(PG8_SB(1, 1), b3, 1);
            PG8_WAIT_V(6); PG8_BAR; PG8_MMA(1, 1, At, B1); PG8_BAR;
        }
        E(acc, cur, wr, wc, fr, fq, lds, ui % 3);
        if (!has_next) break;
#pragma unroll
        for (int a = 0; a < 2; ++a)
#pragma unroll
            for (int b = 0; b < 2; ++b)
#pragma unroll
                for (int m = 0; m < 4; ++m)
#pragma unroll
                    for (int n = 0; n < 2; ++n) acc[a][b][m][n] = (f32x4){0.f, 0.f, 0.f, 0.f};
        cur = nxt; cB = nB; cAb = nAb; ++ui;
#pragma unroll
        for (int h = 0; h < 2; ++h) { pA[h][0] = qA[h][0]; pA[h][1] = qA[h][1]; }
    }
    PG8_WAIT_V(0);
    if (wr == 0) PG8_BAR;
    PG8_BAR;
#undef PG8_SA
#undef PG8_SB
#undef PG8_STAGEA
#undef PG8_STAGEB
#undef PG8_LDA
#undef PG8_LDB
#undef PG8_MMA
#undef PG8_WAIT_V
#undef PG8_WAIT_L
#undef PG8_BAR
#undef PG8_SCHED
}
}

constexpr int AT_K0 = 0, AT_V0 = 17408, AT_KVB = 35840, AT_FL = 71680, AT_QS = 71936;
DI void attn_phase(const bf16_t* Qb, const bf16_t* Kb, const bf16_t* Vt, bf16_t* O, LAS unsigned char* lds, int tid, int wid, int lane) {
    const int fr = lane & 15, fq = lane >> 4;
    LAS int* flags = (LAS int*)(lds + AT_FL);
    for (int bx = blockIdx.x; bx < 512; bx += gridDim.x) {
        const int rnd = bx >> 8, pos = bx & 255;
        const int qb = (rnd & 1) ? (pos >> 6) : (7 - (pos >> 6));
        const int bh = pos & 63, b = bh >> 4, h = bh & 15;
        const int t0 = qb * 256;
        __syncthreads();
        const int kr0 = tid >> 4, kc = tid & 15, vr0 = tid >> 3, vc = tid & 7;
        const bf16_t* kg = Kb + (size_t)(b * SEQ + kr0) * D + h * 128 + kc * 8;
        const bf16_t* vg = Vt + (size_t)(h * 128 + vr0) * T + b * SEQ + vc * 8;
        u32x4 pk0, pk1, pv0, pv1;
        int s0 = t0 + 192;
        pk0 = *(const u32x4*)(kg + (size_t)s0 * D); pk1 = *(const u32x4*)(kg + (size_t)(s0 + 32) * D);
        pv0 = *(const u32x4*)(vg + s0); pv1 = *(const u32x4*)(vg + (size_t)64 * T + s0);
#pragma unroll
        for (int c8 = 0; c8 < 8; ++c8) {
            const int c = tid + 512 * c8, row = c >> 4, c16 = c & 15;
            *(LAS u32x4*)(lds + AT_QS + row * 272 + c16 * 16) = *(const u32x4*)(Qb + (size_t)(b * SEQ + t0 + row) * D + h * 128 + c16 * 8);
        }
        {
            LAS unsigned char* kb_ = lds + AT_K0; LAS unsigned char* vb_ = lds + AT_V0;
            *(LAS u32x4*)(kb_ + kr0 * 272 + kc * 16) = pk0; *(LAS u32x4*)(kb_ + (kr0 + 32) * 272 + kc * 16) = pk1;
            *(LAS u32x4*)(vb_ + vr0 * 144 + vc * 16) = pv0; *(LAS u32x4*)(vb_ + (vr0 + 64) * 144 + vc * 16) = pv1;
            const int s1 = s0 - 64;
            pk0 = *(const u32x4*)(kg + (size_t)s1 * D); pk1 = *(const u32x4*)(kg + (size_t)(s1 + 32) * D); pv0 = *(const u32x4*)(vg + s1); pv1 = *(const u32x4*)(vg + (size_t)64 * T + s1);
        }
        __syncthreads();
        f32x4 oacc[2][8];
#pragma unroll
        for (int r = 0; r < 2; ++r)
#pragma unroll
            for (int n = 0; n < 8; ++n) oacc[r][n] = (f32x4){0.f, 0.f, 0.f, 0.f};
        float Rrun[2] = {1.f, 1.f};
        bool wave_alive = true;
        int it = 0;
        for (;; ++it, s0 -= 64) {
            int zz = 0; asm volatile("" : "+v"(zz));
            const LAS unsigned char* kb_ = lds + zz + AT_K0 + (it & 1) * AT_KVB; const LAS unsigned char* vb_ = lds + zz + AT_V0 + (it & 1) * AT_KVB;
            const bool wave_on = (s0 < t0 + 32 * wid + 31) && wave_alive;
            if (wave_on) {
            f32x4 sacc[2][4];
#pragma unroll
            for (int r = 0; r < 2; ++r)
#pragma unroll
                for (int n = 0; n < 4; ++n) sacc[r][n] = (f32x4){0.f, 0.f, 0.f, 0.f};
#pragma unroll
            for (int ks = 0; ks < 4; ++ks) {
                const bf16x8 qa0 = *(const LAS bf16x8*)(lds + zz + AT_QS + (32 * wid + fr) * 272 + (ks * 32 + fq * 8) * 2);
                const bf16x8 qa1 = *(const LAS bf16x8*)(lds + zz + AT_QS + (32 * wid + 16 + fr) * 272 + (ks * 32 + fq * 8) * 2);
#pragma unroll
                for (int n = 0; n < 4; ++n) {
                    const bf16x8 kf = *(const LAS bf16x8*)(kb_ + (16 * n + fr) * 272 + (ks * 32 + fq * 8) * 2);
                    sacc[0][n] = MFMA16(kf, qa0, sacc[0][n]);
                    sacc[1][n] = MFMA16(kf, qa1, sacc[1][n]);
                }
            }
            unsigned ap[2][4][2];
            const int sb = s0 + 4 * fq;
#pragma unroll
            for (int r = 0; r < 2; ++r) {
                const int tq = t0 + 32 * wid + 16 * r + fr;
                float apart[4][4], gprod[4];
#pragma unroll
                for (int n = 0; n < 4; ++n) {
                    float run = 1.f;
#pragma unroll
                    for (int j = 3; j >= 0; --j) {
                        const float zz = ((sb + 16 * n + j) < tq) ? fminf(sacc[r][n][j], 80.f) : -200.f;
                        const float p2 = __builtin_amdgcn_exp2f(zz);
                        const float om = __builtin_amdgcn_rcpf(1.0f + p2);
                        apart[n][j] = p2 * om * run;
                        run *= om;
                    }
                    gprod[n] = run;
                }
                float offs[4]; float acc_after = 1.f;
#pragma unroll
                for (int n = 3; n >= 0; --n) {
                    const float bq = __shfl_xor(gprod[n], 16); const float s01 = gprod[n] * bq; const float oth = __shfl_xor(s01, 32);
                    offs[n] = Rrun[r] * acc_after * (((fq & 1) == 0) ? bq : 1.f) * ((fq < 2) ? oth : 1.f);
                    acc_after *= s01 * oth;
                }
                Rrun[r] *= acc_after;
#pragma unroll
                for (int n = 0; n < 4; ++n) { ap[r][n][0] = pk2(apart[n][0] * offs[n], apart[n][1] * offs[n]); ap[r][n][1] = pk2(apart[n][2] * offs[n], apart[n][3] * offs[n]); }
            }
#pragma unroll
            for (int u = 0; u < 2; ++u) {
                const bf16x8 aa0 = __builtin_bit_cast(bf16x8, ((u32x4){ap[0][2 * u][0], ap[0][2 * u][1], ap[0][2 * u + 1][0], ap[0][2 * u + 1][1]}));
                const bf16x8 aa1 = __builtin_bit_cast(bf16x8, ((u32x4){ap[1][2 * u][0], ap[1][2 * u][1], ap[1][2 * u + 1][0], ap[1][2 * u + 1][1]}));
#pragma unroll
                for (int n = 0; n < 8; ++n) {
                    const s16x4 vlo = *(const LAS s16x4*)(vb_ + (16 * n + fr) * 144 + (32 * u + 4 * fq) * 2);
                    const s16x4 vhi = *(const LAS s16x4*)(vb_ + (16 * n + fr) * 144 + (32 * u + 16 + 4 * fq) * 2);
                    const bf16x8 vf = __builtin_shufflevector(vlo, vhi, 0, 1, 2, 3, 4, 5, 6, 7);
                    oacc[0][n] = MFMA16(vf, aa0, oacc[0][n]);
                    oacc[1][n] = MFMA16(vf, aa1, oacc[1][n]);
                }
            }
            }
            const int sn1 = s0 - 64, sn2 = s0 - 128;
            wave_alive = __any(fmaxf(Rrun[0], Rrun[1]) > 0.f);
            if (lane == 0) flags[(it & 1) * 8 + wid] = wave_alive ? 1 : 0;
            if (sn1 >= 0) {
                LAS unsigned char* kn = lds + AT_K0 + ((it + 1) & 1) * AT_KVB; LAS unsigned char* vn = lds + AT_V0 + ((it + 1) & 1) * AT_KVB;
                *(LAS u32x4*)(kn + kr0 * 272 + kc * 16) = pk0; *(LAS u32x4*)(kn + (kr0 + 32) * 272 + kc * 16) = pk1;
                *(LAS u32x4*)(vn + vr0 * 144 + vc * 16) = pv0; *(LAS u32x4*)(vn + (vr0 + 64) * 144 + vc * 16) = pv1;
                if (sn2 >= 0) { pk0 = *(const u32x4*)(kg + (size_t)sn2 * D); pk1 = *(const u32x4*)(kg + (size_t)(sn2 + 32) * D); pv0 = *(const u32x4*)(vg + sn2); pv1 = *(const u32x4*)(vg + (size_t)64 * T + sn2); }
            }
            __syncthreads();
            if (sn1 < 0) break;
            int any_alive = 0;
#pragma unroll
            for (int w = 0; w < 8; ++w) any_alive |= flags[(it & 1) * 8 + w];
            if (!any_alive) break;
        }
#pragma unroll
        for (int r = 0; r < 2; ++r) {
            bf16_t* orow = O + (size_t)(b * SEQ + t0 + 32 * wid + 16 * r + fr) * D + h * 128 + 4 * fq;
#pragma unroll
            for (int n = 0; n < 8; ++n) { u32x2 o; o.x = pk2(oacc[r][n].x, oacc[r][n].y); o.y = pk2(oacc[r][n].z, oacc[r][n].w); *(u32x2*)(orow + 16 * n) = o; }
        }
    }
}

constexpr int ML_QS = 0, ML_KS = 17408, ML_KD = 34816, ML_VT = 53248, ML_WS = 90112, ML_HB = 99328, ML_SC = 133120;
DI float ml_tab(LAS float* tab, float gi, float gf, float mprev, int lane) {
    const float flog = fminf(gf, 0.f) - __logf(1.0f + __expf(-fabsf(gf)));
    float bb = flog;
#pragma unroll
    for (int o = 1; o < 64; o <<= 1) { const float v = __shfl_up(bb, o); if (lane >= o) bb += v; }
    const float a = gi - bb;
    float pm = a;
#pragma unroll
    for (int o = 1; o < 64; o <<= 1) { const float v = __shfl_up(pm, o); if (lane >= o) pm = fmaxf(pm, v); }
    const float amax = __shfl(pm, 63), bL = __shfl(bb, 63);
    const float Mx = fmaxf(mprev, amax);
    tab[lane] = a; tab[64 + lane] = bb; tab[128 + lane] = fmaxf(pm, mprev);
    if (lane == 0) { tab[192] = mprev; tab[193] = Mx; }
    return bL + Mx;
}
constexpr int MLA_KD = 0, MLA_SC = 69632;
DI void mlstm_local(const bf16_t* K1, const bf16_t* VT, const float* G, const float* b_i, const float* b_f, bf16_t* KV, float* NJ, float* SUM,
                    LAS unsigned char* lds, int tid, int wid, int lane) {
    const int fr = lane & 15, fq = lane >> 4;
    LAS float* sa = (LAS float*)(lds + MLA_SC); LAS float* swsum = sa + 256; LAS float* swmax = sa + 264;
    for (int unit0 = blockIdx.x; unit0 < 256; unit0 += gridDim.x) {
        const int unit = (gridDim.x == 256) ? (unit0 & 7) * 32 + (unit0 >> 3) : unit0;
        const int J = unit & 7, bh = unit >> 3, b = bh >> 3, h = bh & 7;
        if (J == 7) continue;
        const int tok0 = b * SEQ + J * 256;
        __syncthreads();
        float a = 0.f, bb = 0.f;
        if (tid < 256) {
            const size_t g0 = (size_t)(tok0 + tid) * 16;
            const float gi = G[g0 + h] + b_i[h], gf = G[g0 + 8 + h] + b_f[h];
            const float flog = fminf(gf, 0.f) - __logf(1.0f + __expf(-fabsf(gf)));
            bb = flog;
#pragma unroll
            for (int o = 1; o < 64; o <<= 1) { const float v = __shfl_up(bb, o); if (lane >= o) bb += v; }
            if (lane == 63) swsum[wid] = bb;
        }
        __syncthreads();
        if (tid < 256) {
            float off = 0.f;
            for (int w = 0; w < 4; ++w) off += (w < wid) ? swsum[w] : 0.f;
            bb += off;
            const size_t g0 = (size_t)(tok0 + tid) * 16;
            a = (G[g0 + h] + b_i[h]) - bb;
            float mx = a;
#pragma unroll
            for (int o = 1; o < 64; o <<= 1) mx = fmaxf(mx, __shfl_xor(mx, o));
            if (lane == 0) swmax[wid] = mx;
            sa[tid] = a;
        }
        __syncthreads();
        const float amax = fmaxf(fmaxf(swmax[0], swmax[1]), fmaxf(swmax[2], swmax[3]));
        if (tid == 255) { SUM[unit * 2] = amax; SUM[unit * 2 + 1] = bb; }
        bf16x8 vfa[8][2];
#pragma unroll
        for (int ks = 0; ks < 8; ++ks)
#pragma unroll
            for (int et = 0; et < 2; ++et) vfa[ks][et] = *(const bf16x8*)(VT + (size_t)(h * 256 + 32 * wid + 16 * et + fr) * T + tok0 + ks * 32 + fq * 8);
#pragma unroll 2
        for (int c8i = 0; c8i < 8; ++c8i) {
            const int ch = tid + 512 * c8i, sp = ch & 255, c16 = ch >> 8;
            const u32x4 v = *(const u32x4*)(K1 + (size_t)(tok0 + sp) * 1024 + h * 128 + c16 * 8);
            const float dsc = __expf(sa[sp] - amax);
            const unsigned w[4] = {v.x, v.y, v.z, v.w};
            LAS bf16_t* dst = (LAS bf16_t*)(lds + MLA_KD + (c16 * 8) * 528 + sp * 2);
#pragma unroll
            for (int q = 0; q < 4; ++q) { dst[(2 * q) * 264] = (bf16_t)f2bf(bf2f(w[q] & 0xffff) * dsc); dst[(2 * q + 1) * 264] = (bf16_t)f2bf(bf2f(w[q] >> 16) * dsc); }
        }
        __syncthreads();
        f32x4 C[8][2];
#pragma unroll
        for (int dt = 0; dt < 8; ++dt)
#pragma unroll
            for (int et = 0; et < 2; ++et) C[dt][et] = (f32x4){0.f, 0.f, 0.f, 0.f};
#pragma unroll
        for (int ks = 0; ks < 8; ++ks) {
#pragma unroll
            for (int dt = 0; dt < 8; ++dt) {
                const bf16x8 kf = *(const LAS bf16x8*)(lds + MLA_KD + (16 * dt + fr) * 528 + (ks * 32 + fq * 8) * 2);
#pragma unroll
                for (int et = 0; et < 2; ++et) C[dt][et] = MFMA16(kf, vfa[ks][et], C[dt][et]);
            }
        }
        bf16_t* kv = KV + (size_t)unit * 32768;
#pragma unroll
        for (int dt = 0; dt < 8; ++dt)
#pragma unroll
            for (int et = 0; et < 2; ++et) { u32x2 o; o.x = pk2(C[dt][et].x, C[dt][et].y); o.y = pk2(C[dt][et].z, C[dt][et].w); *(u32x2*)(kv + (size_t)(32 * wid + 16 * et + fr) * 128 + 16 * dt + 4 * fq) = o; }
        {
            const int dl = tid >> 2, sl = tid & 3;
            float p = 0.f;
#pragma unroll
            for (int i = 0; i < 8; ++i) {
                const u32x4 kq = *(const LAS u32x4*)(lds + MLA_KD + dl * 528 + sl * 128 + i * 16);
                p += (bf2f(kq.x & 0xffff) + bf2f(kq.x >> 16)) + (bf2f(kq.y & 0xffff) + bf2f(kq.y >> 16)) + (bf2f(kq.z & 0xffff) + bf2f(kq.z >> 16)) + (bf2f(kq.w & 0xffff) + bf2f(kq.w >> 16));
            }
            p += __shfl_xor(p, 1); p += __shfl_xor(p, 2);
            if (sl == 0) NJ[unit * 128 + dl] = p;
        }
    }
}
template <int skip>
DI void mlstm_phase(const bf16_t* Q1, const bf16_t* K1, const bf16_t* VT, const bf16_t* OG, const float* G, const float* b_i, const float* b_f,
                    const float* g_head, bf16_t* HS, const bf16_t* KV, const float* NJ, const float* SUM, LAS unsigned char* lds, int tid, int wid, int lane, int nsteps = 4) {
    const int fr = lane & 15, fq = lane >> 4;
    LAS float* sc = (LAS float*)(lds + ML_SC); LAS float* sssq = sc + 1024; LAS float* srs = sc + 1536; LAS float* sden = sc + 1792; LAS float* sn = sc + 1856; LAS float* sgh = sc + 2112; LAS float* scf = sc + 2368;
    LAS bf16_t* hb = (LAS bf16_t*)(lds + ML_HB);
    for (int unit0 = blockIdx.x; unit0 < 256; unit0 += gridDim.x) {
        const int unit = (gridDim.x == 256) ? (unit0 & 7) * 32 + (unit0 >> 3) : unit0;
        const int J = unit & 7, bh = unit >> 3, b = bh >> 3, h = bh & 7;
        const int c0 = 4 * J, c1 = c0 + nsteps;
        __syncthreads();
        if (wid < 4) {
            LAS float* tab = sc + wid * 256;
            const size_t g0 = (size_t)(b * SEQ + (c0 + wid) * 64 + lane) * 16;
            const float gi = G[g0 + h] + b_i[h], gf = G[g0 + 8 + h] + b_f[h];
            const float flog = fminf(gf, 0.f) - __logf(1.0f + __expf(-fabsf(gf)));
            float bb = flog;
#pragma unroll
            for (int o = 1; o < 64; o <<= 1) { const float v = __shfl_up(bb, o); if (lane >= o) bb += v; }
            const float a = gi - bb;
            float pm = a;
#pragma unroll
            for (int o = 1; o < 64; o <<= 1) { const float v = __shfl_up(pm, o); if (lane >= o) pm = fmaxf(pm, v); }
            tab[lane] = a; tab[64 + lane] = bb; tab[128 + lane] = pm;
            if (lane == 63) { tab[192] = pm; tab[193] = bb; }
        }
        if (tid >= 448 && tid < 462) scf[8 + tid - 448] = SUM[bh * 16 + tid - 448];
        __syncthreads();
        if (tid == 0) {
            float cf[7]; float m0 = 0.f;
#pragma unroll
            for (int jp = 0; jp < 7; ++jp) {
                cf[jp] = 0.f;
                if (jp < J) {
                    const float am = scf[8 + 2 * jp], bl = scf[9 + 2 * jp];
                    const float M63 = fmaxf(m0, am), csj = __expf(m0 - M63);
#pragma unroll
                    for (int i = 0; i < 7; ++i) if (i < jp) cf[i] *= csj;
                    cf[jp] = __expf(am - M63);
                    m0 = bl + M63;
                }
            }
#pragma unroll
            for (int jp = 0; jp < 7; ++jp) scf[jp] = cf[jp];
            scf[7] = m0;
        }
        __syncthreads();
        const float m0 = scf[7];
        f32x4 C[8][2];
#pragma unroll
        for (int dt = 0; dt < 8; ++dt)
#pragma unroll
            for (int et = 0; et < 2; ++et) C[dt][et] = (f32x4){0.f, 0.f, 0.f, 0.f};
        float n0 = 0.f;
#pragma unroll 1
        for (int jp = 0; jp < J; ++jp) {
            const bf16_t* kv = KV + (size_t)(bh * 8 + jp) * 32768; const float cf = scf[jp];
#pragma unroll
            for (int dt = 0; dt < 8; ++dt)
#pragma unroll
                for (int et = 0; et < 2; ++et) { const u32x2 v = *(const u32x2*)(kv + (size_t)(32 * wid + 16 * et + fr) * 128 + 16 * dt + 4 * fq);
                    C[dt][et].x += cf * bf2f(v.x & 0xffff); C[dt][et].y += cf * bf2f(v.x >> 16); C[dt][et].z += cf * bf2f(v.y & 0xffff); C[dt][et].w += cf * bf2f(v.y >> 16); }
            if (tid < 128) n0 += cf * NJ[(bh * 8 + jp) * 128 + tid];
        }
        if (tid < 128) sn[tid] = n0;
        if (tid >= 256) sgh[tid - 256] = g_head[h * 256 + tid - 256];
        __syncthreads();
        if (tid == 0) { float m = m0; for (int cc = 0; cc < 4; ++cc) { LAS float* tab = sc + cc * 256; const float M63 = fmaxf(m, tab[192]); tab[194] = m; tab[195] = M63; m = tab[193] + M63; } }
        __syncthreads();
        u32x4 rq[2], rk[2], rt[2], rv[4];
#define ML_LOAD(cc) do { const int tk_ = b * SEQ + (cc) * 64; _Pragma("unroll") for (int c2 = 0; c2 < 2; ++c2) { const int ch = tid + 512 * c2; \
            rq[c2] = *(const u32x4*)(Q1 + (size_t)(tk_ + (ch >> 4)) * 1024 + h * 128 + (ch & 15) * 8); rk[c2] = *(const u32x4*)(K1 + (size_t)(tk_ + (ch >> 4)) * 1024 + h * 128 + (ch & 15) * 8); \
            rt[c2] = *(const u32x4*)(K1 + (size_t)(tk_ + (ch & 63)) * 1024 + h * 128 + (ch >> 6) * 8); } \
        _Pragma("unroll") for (int c4 = 0; c4 < 4; ++c4) { const int ch = tid + 512 * c4; rv[c4] = *(const u32x4*)(VT + (size_t)(h * 256 + (ch >> 3)) * T + tk_ + (ch & 7) * 8); } } while (0)
#define ML_STORE(cc) do { const LAS float* tb_ = sc + ((cc) - c0) * 256; const float M63_ = tb_[195]; _Pragma("unroll") for (int c2 = 0; c2 < 2; ++c2) { const int ch = tid + 512 * c2; \
            *(LAS u32x4*)(lds + ML_QS + (ch >> 4) * 272 + (ch & 15) * 16) = rq[c2]; *(LAS u32x4*)(lds + ML_KS + (ch >> 4) * 272 + (ch & 15) * 16) = rk[c2]; \
            const int sp = ch & 63, c16 = ch >> 6; const float dsc = __expf(tb_[sp] - M63_); const unsigned w_[4] = {rt[c2].x, rt[c2].y, rt[c2].z, rt[c2].w}; \
            LAS bf16_t* dst = (LAS bf16_t*)(lds + ML_KD + (c16 * 8) * 144 + sp * 2); \
            _Pragma("unroll") for (int q = 0; q < 4; ++q) { dst[(2 * q) * 72] = (bf16_t)f2bf(bf2f(w_[q] & 0xffff) * dsc); dst[(2 * q + 1) * 72] = (bf16_t)f2bf(bf2f(w_[q] >> 16) * dsc); } } \
        _Pragma("unroll") for (int c4 = 0; c4 < 4; ++c4) { const int ch = tid + 512 * c4; *(LAS u32x4*)(lds + ML_VT + (ch >> 3) * 144 + (ch & 7) * 16) = rv[c4]; } } while (0)
        if (c0 < c1) { ML_LOAD(c0); ML_STORE(c0); }
#pragma unroll 1
        for (int c = c0; c < c1; ++c) {
            int zz = 0; asm volatile("" : "+v"(zz));
            LAS unsigned char* const L = lds + zz; LAS float* const scz = (LAS float*)(L + ML_SC);
            LAS float* const sssq = scz + 1024; LAS float* const srs = scz + 1536; LAS float* const sden = scz + 1792; LAS float* const sn = scz + 1856; LAS float* const sgh = scz + 2112; LAS bf16_t* const hb = (LAS bf16_t*)(L + ML_HB);
            const int tok0 = b * SEQ + c * 64;
            const LAS float* tab = scz + (c - c0) * 256;
            LAS float* sncur = sn + ((c - c0) & 1) * 128; LAS float* snnxt = sn + (((c - c0) & 1) ^ 1) * 128;
            __syncthreads();
            const float mprev = tab[194], M63 = tab[195];
            if (!(skip & 1)) {
                const int tb = wid >> 1;
#pragma unroll
                for (int a2 = 0; a2 < 2; ++a2) {
                    const int sa_t = 2 * (wid & 1) + a2;
                    u32x2 o = (u32x2){0u, 0u}; float rsum = 0.f;
                    if (sa_t <= tb) {
                        f32x4 acc = (f32x4){0.f, 0.f, 0.f, 0.f};
#pragma unroll
                        for (int ks = 0; ks < 4; ++ks) {
                            const bf16x8 kf = *(const LAS bf16x8*)(L + ML_KS + (16 * sa_t + fr) * 272 + (ks * 32 + fq * 8) * 2);
                            const bf16x8 qf = *(const LAS bf16x8*)(L + ML_QS + (16 * tb + fr) * 272 + (ks * 32 + fq * 8) * 2);
                            acc = MFMA16(kf, qf, acc);
                        }
                        const int tl = 16 * tb + fr; const float Mt = fmaxf(tab[128 + tl], mprev);
                        float wv[4];
#pragma unroll
                        for (int j = 0; j < 4; ++j) { const int sl = 16 * sa_t + 4 * fq + j; wv[j] = (sl <= tl) ? acc[j] * __expf(tab[sl] - Mt) : 0.f; }
                        o.x = pk2(wv[0], wv[1]); o.y = pk2(wv[2], wv[3]);
                        rsum = (wv[0] + wv[1]) + (wv[2] + wv[3]);
                        rsum += __shfl_xor(rsum, 16); rsum += __shfl_xor(rsum, 32);
                    }
                    *(LAS u32x2*)(L + ML_WS + (16 * tb + fr) * 144 + (16 * sa_t + 4 * fq) * 2) = o;
                    if (fq == 0) srs[sa_t * 64 + 16 * tb + fr] = rsum;
                }
            }
            __syncthreads();
            if (!(skip & 2)) {
                const int tl = tid >> 3, sl = tid & 7;
                const u32x4 qa = *(const LAS u32x4*)(L + ML_QS + tl * 272 + sl * 32), qb = *(const LAS u32x4*)(L + ML_QS + tl * 272 + sl * 32 + 16);
                const unsigned qw[8] = {qa.x, qa.y, qa.z, qa.w, qb.x, qb.y, qb.z, qb.w};
                float p = 0.f;
#pragma unroll
                for (int k = 0; k < 8; ++k) p += bf2f(qw[k] & 0xffff) * sncur[sl * 16 + 2 * k] + bf2f(qw[k] >> 16) * sncur[sl * 16 + 2 * k + 1];
                p += __shfl_xor(p, 1); p += __shfl_xor(p, 2); p += __shfl_xor(p, 4);
                if (sl == 0) sden[tl] = __expf(mprev - fmaxf(tab[128 + tl], mprev)) * p + (srs[tl] + srs[64 + tl]) + (srs[128 + tl] + srs[192 + tl]);
            }
#pragma unroll 1
            for (int tt = 0; tt < ((skip & 4) ? 0 : 4); ++tt) {
                f32x4 num[2];
#pragma unroll
                for (int et = 0; et < 2; ++et) num[et] = (f32x4){0.f, 0.f, 0.f, 0.f};
#pragma unroll
                for (int u = 0; u < 4; ++u) {
                    const s16x4 qlo = *(const LAS s16x4*)(L + ML_QS + (16 * tt + fr) * 272 + (32 * u + 4 * fq) * 2);
                    const s16x4 qhi = *(const LAS s16x4*)(L + ML_QS + (16 * tt + fr) * 272 + (32 * u + 16 + 4 * fq) * 2);
                    const bf16x8 qf = __builtin_shufflevector(qlo, qhi, 0, 1, 2, 3, 4, 5, 6, 7);
#pragma unroll
                    for (int et = 0; et < 2; ++et) {
                        const f32x4 c0v = C[2 * u][et], c1v = C[2 * u + 1][et];
                        u32x4 pb; pb.x = pk2(c0v.x, c0v.y); pb.y = pk2(c0v.z, c0v.w); pb.z = pk2(c1v.x, c1v.y); pb.w = pk2(c1v.z, c1v.w);
                        num[et] = MFMA16(qf, __builtin_bit_cast(bf16x8, pb), num[et]);
                    }
                }
                float scv[4];
#pragma unroll
                for (int j = 0; j < 4; ++j) scv[j] = __expf(mprev - fmaxf(tab[128 + 16 * tt + 4 * fq + j], mprev));
#pragma unroll
                for (int et = 0; et < 2; ++et) { num[et].x *= scv[0]; num[et].y *= scv[1]; num[et].z *= scv[2]; num[et].w *= scv[3]; }
                const int nks = (tt < 2) ? 1 : 2;
                for (int ks = 0; ks < nks; ++ks) {
                    const bf16x8 wf = *(const LAS bf16x8*)(L + ML_WS + (16 * tt + fr) * 144 + (ks * 32 + fq * 8) * 2);
#pragma unroll
                    for (int et = 0; et < 2; ++et) {
                        const bf16x8 vf = *(const LAS bf16x8*)(L + ML_VT + (32 * wid + 16 * et + fr) * 144 + (ks * 32 + fq * 8) * 2);
                        num[et] = MFMA16(wf, vf, num[et]);
                    }
                }
#pragma unroll
                for (int j = 0; j < 4; ++j) {
                    const int tl = 16 * tt + 4 * fq + j;
                    const float h0 = num[0][j], h1 = num[1][j];
                    hb[tl * 264 + 32 * wid + fr] = (bf16_t)f2bf(h0);
                    hb[tl * 264 + 32 * wid + 16 + fr] = (bf16_t)f2bf(h1);
                    float s = h0 * h0 + h1 * h1;
                    s += dpp_f(s, 0xB1); s += dpp_f(s, 0x4E); s += dpp_f(s, 0x141); s += dpp_f(s, 0x140);
                    if (fr == 0) sssq[wid * 64 + tl] = s;
                }
            }
            const float cs = __expf(mprev - M63);
            if (!(skip & 8)) {
#pragma unroll
                for (int dt = 0; dt < 8; ++dt)
#pragma unroll
                    for (int et = 0; et < 2; ++et) { C[dt][et].x *= cs; C[dt][et].y *= cs; C[dt][et].z *= cs; C[dt][et].w *= cs; }
#pragma unroll
                for (int ks = 0; ks < 2; ++ks) {
                    bf16x8 vf[2];
#pragma unroll
                    for (int et = 0; et < 2; ++et) vf[et] = *(const LAS bf16x8*)(L + ML_VT + (32 * wid + 16 * et + fr) * 144 + (ks * 32 + fq * 8) * 2);
#pragma unroll
                    for (int dt = 0; dt < 8; ++dt) {
                        const bf16x8 kf = *(const LAS bf16x8*)(L + ML_KD + (16 * dt + fr) * 144 + (ks * 32 + fq * 8) * 2);
#pragma unroll
                        for (int et = 0; et < 2; ++et) C[dt][et] = MFMA16(kf, vf[et], C[dt][et]);
                    }
                }
            }
            {
                const int dl = tid >> 2, sl = tid & 3;
                const u32x4 ka = *(const LAS u32x4*)(L + ML_KD + dl * 144 + sl * 32), kb = *(const LAS u32x4*)(L + ML_KD + dl * 144 + sl * 32 + 16);
                const unsigned kw[8] = {ka.x, ka.y, ka.z, ka.w, kb.x, kb.y, kb.z, kb.w};
                float p = 0.f;
#pragma unroll
                for (int k = 0; k < 8; ++k) p += bf2f(kw[k] & 0xffff) + bf2f(kw[k] >> 16);
                p += __shfl_xor(p, 1); p += __shfl_xor(p, 2);
                if (sl == 0) snnxt[dl] = cs * sncur[dl] + p;
            }
            __syncthreads();
            if (skip & 16) { if (c + 1 < c1) ML_LOAD(c + 1); } else {
                const int tl = tid >> 3, part = tid & 7;
                u32x4 ovq[4];
#pragma unroll
                for (int q = 0; q < 4; ++q) ovq[q] = *(const u32x4*)(OG + (size_t)(tok0 + tl) * D + h * 256 + (part + 8 * q) * 8);
                if (c + 1 < c1) ML_LOAD(c + 1);
                float tot = 0.f;
#pragma unroll
                for (int w = 0; w < 8; ++w) tot += sssq[w * 64 + tl];
                const float dd = 1.0f / fmaxf(fabsf(sden[tl]), __expf(-(tab[64 + tl] + fmaxf(tab[128 + tl], mprev))));
                const float rinv = dd / sqrtf(tot * dd * dd * (1.0f / 256.0f) + EPS);
#pragma unroll
                for (int q = 0; q < 4; ++q) {
                    const int e0 = (part + 8 * q) * 8;
                    const u32x4 hv = *(const LAS u32x4*)(L + ML_HB + tl * 528 + e0 * 2);
                    const size_t idx = (size_t)(tok0 + tl) * D + h * 256 + e0;
                    const u32x4 ov = ovq[q];
                    const f32x4 g0 = *(const LAS f32x4*)(sgh + e0), g1 = *(const LAS f32x4*)(sgh + e0 + 4);
                    const unsigned hw[4] = {hv.x, hv.y, hv.z, hv.w}, ow[4] = {ov.x, ov.y, ov.z, ov.w};
                    const float gg[8] = {g0.x, g0.y, g0.z, g0.w, g1.x, g1.y, g1.z, g1.w};
                    unsigned r[4];
#pragma unroll
                    for (int k = 0; k < 4; ++k) {
                        const float ha = bf2f(hw[k] & 0xffff), hbv = bf2f(hw[k] >> 16), oa = bf2f(ow[k] & 0xffff), ob = bf2f(ow[k] >> 16);
                        r[k] = pk2(ha * rinv * gg[2 * k] * __builtin_amdgcn_rcpf(1.0f + __expf(-oa)), hbv * rinv * gg[2 * k + 1] * __builtin_amdgcn_rcpf(1.0f + __expf(-ob)));
                    }
                    *(u32x4*)(HS + idx) = (u32x4){r[0], r[1], r[2], r[3]};
                }
            }
            if (c + 1 < c1) ML_STORE(c + 1);
        }
#undef ML_LOAD
#undef ML_STORE
    }
}

DI void convert_moe_layer(int l, bool do13, bool do2, int gw, int NGW, const float* w1, const float* w3, const float* w2, bf16_t* W13, bf16_t* W2, LAS unsigned char* lds, int wid, int lane) {
    LAS float* scr = (LAS float*)(lds + wid * 16640);
    constexpr int I_W1 = 32 * 32 * 4, I_W2 = 32 * 4 * 32;
    if (do13) for (int it = gw; it < 2 * I_W1; it += NGW) {
        const int which = it / I_W1, r = it % I_W1, le = l * NE + r / 128, q = r % 128;
        transpose_item((which ? w3 : w1) + (size_t)le * D * FF, FF, W13 + (size_t)le * 512 * D, D, 64 * (q / 4), 64 * (q % 4), 1 + which, scr, lane); }
    if (do2) for (int it = gw; it < I_W2; it += NGW) {
        const int le = l * NE + it / 128, q = it % 128;
        transpose_item(w2 + (size_t)le * FF * D, D, W2 + (size_t)le * D * FF, FF, 64 * (q / 32), 64 * (q % 32), 0, scr, lane); }
}

__global__ void __launch_bounds__(NTHREADS, 2) fwd_kernel(Args args) {
    extern __shared__ __attribute__((aligned(16))) unsigned char lds_raw[];
    LAS unsigned char* lds = (LAS unsigned char*)lds_raw;
    const int tid = threadIdx.x, lane = tid & 63, wid = __builtin_amdgcn_readfirstlane(tid >> 6);
    unsigned char* ws = args.ws;
    unsigned* ctl = (unsigned*)(ws + WS_CTL);
    volatile LAS unsigned* misc = (volatile LAS unsigned*)(lds + LDS_BYTES - 256);
    if (tid < 16) misc[tid] = 0u;
    __syncthreads();
    XcdBarrier bar; bar.bar = ctl + CW_BAR; bar.x = 0; bar.st = misc;
    const int lo = args.ph_lo, hi = args.ph_hi;
    if (PROBE_A >= 0 && blockIdx.x == 0 && tid == 0) misc[16] = (unsigned)__builtin_amdgcn_s_memrealtime();
    if (hi - lo > 1) bar = xcd_barrier_post(ctl + CW_BAR, misc);
#ifndef PHMASK
#define PHMASK 0xffff
#endif
#define IN(k) (((PHMASK >> (k)) & 1) && lo <= (k) && (k) < hi)
#ifndef XBAR
#define XBAR 0
#endif
#define SEAM(k) do { if (IN(k) && IN((k) + 1)) { xcd_barrier(bar); if ((k) == 5) for (int xb_ = 0; xb_ < XBAR; ++xb_) xcd_barrier(bar); } if (PROBE_A >= 0 && blockIdx.x == 0 && tid == 0) misc[16 + (k) + 1] = (unsigned)__builtin_amdgcn_s_memrealtime(); } while (0)

#define PH(k, ...) { __VA_ARGS__ } if ((REPEAT_MASK >> (k)) & 1) { xcd_barrier(bar); { __VA_ARGS__ } }
#define LZ(z) int z = 0; asm volatile("" : "+s"(z))
#define INP(k) (args.in[k] + z)
#define WSP(type, off) ((type*)(ws + (off) + z))
#define ACT(type, off) ((type*)(ws + WS_ACT + (off) + z))

    PH(0, if (IN(0)) {
        LZ(z);
        const float* sb_w_in = INP(4); const float* sb_w_out = INP(5); const float* ml_w_in = INP(6); const float* ml_w_out = INP(10);
        const float* moe_w1 = INP(15); const float* moe_w3 = INP(16); const float* moe_w2 = INP(17);
        bf16_t* Wsbin = WSP(bf16_t, WS_WSBIN); bf16_t* Wsbout = WSP(bf16_t, WS_WSBOUT); bf16_t* Wmlin = WSP(bf16_t, WS_WMLIN); bf16_t* Wmlout = WSP(bf16_t, WS_WMLOUT);
        bf16_t* W13 = WSP(bf16_t, WS_W13); bf16_t* W2 = WSP(bf16_t, WS_W2);
        LAS float* scr = (LAS float*)(lds + wid * 16640);
        const int gw = blockIdx.x * 8 + wid, NGW = gridDim.x * 8;
        constexpr int I_SBIN = 32 * 96, I_SBOUT = 32 * 32, I_MLIN = 32 * 96, I_MLOUT = 32 * 32;
        constexpr int NITEMS = I_SBIN + I_SBOUT + I_MLIN + I_MLOUT;
        for (int it0 = gw; it0 < NITEMS; it0 += NGW) {
            int r = NITEMS - 1 - it0;
            if (r < I_SBIN) { transpose_item(sb_w_in, 6144, Wsbin, D, 64 * (r / 96), 64 * (r % 96), 0, scr, lane); continue; } r -= I_SBIN;
            if (r < I_SBOUT) { transpose_item(sb_w_out, D, Wsbout, D, 64 * (r / 32), 64 * (r % 32), 0, scr, lane); continue; } r -= I_SBOUT;
            if (r < I_MLIN) { transpose_item(ml_w_in, ML_IN, Wmlin, D, 64 * (r / 96), 64 * (r % 96), 0, scr, lane); continue; } r -= I_MLIN;
            transpose_item(ml_w_out, D, Wmlout, D, 64 * (r / 32), 64 * (r % 32), 0, scr, lane);
        }
        {
            const float* wg = INP(11); const float* we = INP(13); const float* wml = INP(6);
            bf16_t* wr = WSP(bf16_t, WS_WR); bf16_t* wgi = WSP(bf16_t, WS_WG);
            const int gt = blockIdx.x * NTHREADS + tid, NGT = gridDim.x * NTHREADS;
            for (int idx = gt; idx < 2 * 98304 + 32768; idx += NGT) {
                if (idx < 2 * 98304) {
                    const int l = idx / 98304, r = idx % 98304, j = r & 7, ln = (r >> 3) & 63, q = r >> 9, nt = q % 3, ks = q / 3;
                    const int k = 32 * ks + 8 * (ln >> 4) + j, n = 16 * nt + (ln & 15);
                    const float w = (n < 4) ? wg[(size_t)l * D * 4 + k * 4 + n] : ((n < 36) ? we[(size_t)l * D * 32 + k * 32 + (n - 4)] : 0.f);
                    wr[(size_t)l * (WR_BYTES / 2) + r] = (bf16_t)f2bf(w);
                } else {
                    const int r = idx - 2 * 98304, j = r & 7, ln = (r >> 3) & 63, ks = r >> 9;
                    const int k = 32 * ks + 8 * (ln >> 4) + j, n = ln & 15;
                    wgi[r] = (bf16_t)f2bf(wml[(size_t)k * ML_IN + 6144 + n]);
                }
            }
        }
        __syncthreads();
        NormP p{}; p.src = INP(0); p.H = WSP(bf16_t, WS_H); p.g = INP(1);
        norm_phase<0, false>(p, lds, tid, wid, lane);
    })
    SEAM(0);
    PH(1, if (IN(1)) {
        LZ(z);
        bf16_t* H = WSP(bf16_t, WS_H); bf16_t* Wsbin = WSP(bf16_t, WS_WSBIN);
        if (tid == 0) {
            pg8::put_job(lds, 0, H, Wsbin, T, 4096, ACT(bf16_t, A_Q), ACT(bf16_t, A_K), D, 2048, 0.12751743074602467f);
            pg8::put_job(lds, 1, Wsbin + (size_t)4096 * D, H, D, T, ACT(bf16_t, A_VT), ACT(bf16_t, A_VT), T, 1 << 30, 1.0f);
        }
        __syncthreads();
        pg8::Sched S; S.init(lds, 2, gridDim.x, blockIdx.x);
        pg8::EpiBf16 E{S.tab};
        pg8::gemm_phase(lds, S, E);
    })
    SEAM(1);
    PH(2, if (IN(2)) { LZ(z); attn_phase(ACT(bf16_t, A_Q), ACT(bf16_t, A_K), ACT(bf16_t, A_VT), ACT(bf16_t, A_O), lds, tid, wid, lane); })
    SEAM(2);
    PH(3, if (IN(3)) { LZ(z);
        if (tid == 0) pg8::put_job(lds, 0, ACT(bf16_t, A_O), WSP(bf16_t, WS_WSBOUT), T, D, ACT(bf16_t, A_Z0), ACT(bf16_t, A_Z0), D, 1 << 30, 1.0f);
        __syncthreads();
        pg8::Sched S; S.init(lds, 1, gridDim.x, blockIdx.x);
        pg8::EpiBf16 E{S.tab}; pg8::gemm_phase(lds, S, E); })
    SEAM(3);
#if defined(OUTPROJ_PROBE)
    {
        LZ(z);
        if (tid == 0) pg8::put_job(lds, 0, ACT(bf16_t, A_O), WSP(bf16_t, WS_WSBOUT), T, D, nullptr, nullptr, D, 0, 1.0f);
        __syncthreads();
        pg8::Sched S; S.init(lds, 1, gridDim.x, blockIdx.x);
#if OUTPROJ_PROBE == 1
        pg8::EpiNull E; pg8::gemm_phase(lds, S, E);
#else
        pg8::EpiResF32 E{INP(0), ACT(float, A_Q), D}; pg8::gemm_phase(lds, S, E);
#endif
        xcd_barrier(bar);
    }
#endif
#define MOE_PHASES(l, pb) \
    PH(pb, if (IN(pb)) { LZ(z); convert_moe_layer(l, true, false, blockIdx.x * 8 + wid, gridDim.x * 8, INP(15), INP(16), INP(17), WSP(bf16_t, WS_W13), WSP(bf16_t, WS_W2), lds, wid, lane); __syncthreads(); NormP p{}; p.src = (l) ? (const float*)WSP(bf16_t, WS_X) : INP(0); p.Y = (l) ? ACT(bf16_t, A_Z1) : ACT(bf16_t, A_Z0); p.X = WSP(bf16_t, WS_X); p.H = WSP(bf16_t, WS_H); p.g = INP(2) + (l) * D; p.wimg = WSP(bf16_t, WS_WR + (l) * WR_BYTES); p.bg = INP(12) + (l) * 4; \
        p.be = INP(14) + (l) * 32; p.cnt = ctl + CW_CNT + 64 * (l) + z; p.list = ACT(unsigned, A_LIST); p.listw = ACT(float, A_LISTW); \
        if (l) norm_phase<1, true>(p, lds, tid, wid, lane); else norm_phase<1, false>(p, lds, tid, wid, lane); }) \
    SEAM(pb); \
    PH((pb) + 1, if (IN((pb) + 1)) { LZ(z); pg8::moe_table256(ctl + CW_CNT + 64 * (l) + z, lds, tid); \
        pg8::MSched<2> S; S.init(lds, gridDim.x, blockIdx.x, true); \
        { const int nun = S.total; const int idle = (int)gridDim.x - nun;        \
          if (idle > 0) { if (S.c >= nun) convert_moe_layer(l, false, true, (S.c - nun) * 8 + wid, idle * 8, INP(15), INP(16), INP(17), WSP(bf16_t, WS_W13), WSP(bf16_t, WS_W2), lds, wid, lane); } \
          else { convert_moe_layer(l, false, true, blockIdx.x * 8 + wid, gridDim.x * 8, INP(15), INP(16), INP(17), WSP(bf16_t, WS_W13), WSP(bf16_t, WS_W2), lds, wid, lane); __syncthreads(); } } \
        pg8::MOps1 P{WSP(bf16_t, WS_H), WSP(bf16_t, WS_W13) + (size_t)(l) * NE * 512 * D, ACT(unsigned, A_LIST)}; \
        pg8::EpiSwiglu E{ACT(bf16_t, A_HID), ACT(float, A_LISTW)}; \
        pg8::gemm_phase_m<2048>(lds, S, P, E); }) \
    SEAM((pb) + 1); \
    PH((pb) + 2, if (IN((pb) + 2)) { LZ(z); pg8::moe_table256(ctl + CW_CNT + 64 * (l) + z, lds, tid); \
        pg8::MSched<8> S; S.init(lds, gridDim.x, blockIdx.x, true); \
        pg8::MOps2 P{ACT(bf16_t, A_HID), WSP(bf16_t, WS_W2) + (size_t)(l) * NE * D * FF}; \
        pg8::EpiScatter E{ACT(bf16_t, A_Y), ACT(unsigned, A_LIST)}; \
        pg8::gemm_phase_m<256>(lds, S, P, E); }) \
    SEAM((pb) + 2);
    MOE_PHASES(0, 4)
#if defined(MOE2_PROBE)
    {
        xcd_barrier(bar); LZ(z); pg8::moe_table256(ctl + CW_CNT + z, lds, tid);
        pg8::MSched<8> S; S.init(lds, gridDim.x, blockIdx.x);
        pg8::MOps2 P{ACT(bf16_t, A_HID), WSP(bf16_t, WS_W2)};
#if MOE2_PROBE == 1
        pg8::EpiMNull E; pg8::gemm_phase_m<256>(lds, S, P, E);
#else
        pg8::EpiScatter E{ACT(bf16_t, A_Y), ACT(unsigned, A_LIST)}; pg8::gemm_phase_m<256>(lds, S, P, E);
#endif
        xcd_barrier(bar);
    }
#endif
#if defined(ROUTER2X)
    { xcd_barrier(bar); LZ(z); NormP p{}; p.src = INP(0); p.Y = ACT(bf16_t, A_Z0); p.X = ACT(bf16_t, 96 * MiB); p.H = ACT(bf16_t, A_O); p.g = INP(2); p.wimg = WSP(bf16_t, WS_WR); p.bg = INP(12); p.be = INP(14);
      p.cnt = ctl + CW_CNT + 64 * 2 + z; p.list = ACT(unsigned, 128 * MiB); p.listw = ACT(float, 130 * MiB); norm_phase<1, false>(p, lds, tid, wid, lane); xcd_barrier(bar); }
#endif
    PH(7, if (IN(7)) { LZ(z); NormP p{}; p.X = WSP(bf16_t, WS_X); p.Y = ACT(bf16_t, A_Y); p.H = WSP(bf16_t, WS_H); p.g = INP(1) + D; p.wimg = WSP(bf16_t, WS_WG); p.G = ACT(float, A_G); norm_phase<2, true>(p, lds, tid, wid, lane); })
    SEAM(7);
    PH(8, if (IN(8)) {
        LZ(z);
        bf16_t* H = WSP(bf16_t, WS_H); bf16_t* Wmlin = WSP(bf16_t, WS_WMLIN);
        if (tid == 0) {
            pg8::put_job(lds, 0, H, Wmlin, T, 2048, ACT(bf16_t, A_Q1), ACT(bf16_t, A_K1), 1024, 1024, 0.08838834764831845f);
            pg8::put_job(lds, 1, H, Wmlin + (size_t)4096 * D, T, 2048, ACT(bf16_t, A_OG), ACT(bf16_t, A_OG), D, 1 << 30, 1.0f);
            pg8::put_job(lds, 2, Wmlin + (size_t)2048 * D, H, 2048, T, ACT(bf16_t, A_VT1), ACT(bf16_t, A_VT1), T, 1 << 30, 1.0f);
        }
        __syncthreads();
        pg8::Sched S; S.init(lds, 3, gridDim.x, blockIdx.x);
        pg8::EpiBf16 E{S.tab};
        pg8::gemm_phase(lds, S, E);
    })
    SEAM(8);
    PH(9, if (IN(9)) { LZ(z); mlstm_local(ACT(bf16_t, A_K1), ACT(bf16_t, A_VT1), ACT(float, A_G), INP(7), INP(8), WSP(bf16_t, WS_H), ACT(float, A_NJ), ACT(float, A_SUM), lds, tid, wid, lane); })
    SEAM(9);
    PH(10, if (IN(10)) { LZ(z); mlstm_phase<0>(ACT(bf16_t, A_Q1), ACT(bf16_t, A_K1), ACT(bf16_t, A_VT1), ACT(bf16_t, A_OG), ACT(float, A_G), INP(7), INP(8), INP(9), ACT(bf16_t, A_HS),
        WSP(bf16_t, WS_H), ACT(float, A_NJ), ACT(float, A_SUM), lds, tid, wid, lane); })
    SEAM(10);
#if defined(ML_PROBE)
    {
        LZ(z); mlstm_phase<ML_PROBE>(ACT(bf16_t, A_Q1), ACT(bf16_t, A_K1), ACT(bf16_t, A_VT1), ACT(bf16_t, A_OG), ACT(float, A_G), INP(7), INP(8), INP(9), (bf16_t*)(args.out + z),
            WSP(bf16_t, WS_H), ACT(float, A_NJ), ACT(float, A_SUM), lds, tid, wid, lane, 4); xcd_barrier(bar); }
#endif
    PH(11, if (IN(11)) { LZ(z);
        if (tid == 0) pg8::put_job(lds, 0, ACT(bf16_t, A_HS), WSP(bf16_t, WS_WMLOUT), T, D, ACT(bf16_t, A_Z1), ACT(bf16_t, A_Z1), D, 1 << 30, 1.0f);
        __syncthreads();
        pg8::Sched S; S.init(lds, 1, gridDim.x, blockIdx.x);
        pg8::EpiBf16 E{S.tab}; pg8::gemm_phase(lds, S, E); })
    SEAM(11);
    MOE_PHASES(1, 12)
    PH(15, if (IN(15)) { LZ(z); NormP p{}; p.X = WSP(bf16_t, WS_X); p.Y = ACT(bf16_t, A_Y); p.outf = args.out + z; p.g = INP(3); norm_phase<3, true>(p, lds, tid, wid, lane); })
    if (PROBE_A >= 0 && blockIdx.x == 0 && tid == 0) {
        misc[16 + 16] = (unsigned)__builtin_amdgcn_s_memrealtime();
        const float tA = (float)(misc[16 + PROBE_A + 1] - misc[16 + PROBE_A]) * 0.01f, tB = (PROBE_B >= 0) ? (float)(misc[16 + PROBE_B + 1] - misc[16 + PROBE_B]) * 0.01f : 0.f;
        args.out[0] = (1.0f + tA * 0.02f) * __builtin_powf(10.0f, __builtin_rintf(tB * 0.1f));
    }
#undef IN
#undef SEAM
}

extern "C" void kernel_launch(void* const* d_in, const int* in_sizes, int n_in, void* d_out, int out_size, void* d_ws, size_t ws_size, hipStream_t stream) {
    static int grid = 0;
    if (grid == 0) {
        if (n_in != 18 || out_size != T * D || ws_size < WS_END) { fprintf(stderr, "kernel_launch: unexpected shapes (n_in %d out %d ws %zu need %zu)\n", n_in, out_size, ws_size, (size_t)WS_END); grid = -1; return; }
        int dev = 0, cus = 0, per_cu = 0;
        if (hipGetDevice(&dev) != hipSuccess || hipDeviceGetAttribute(&cus, hipDeviceAttributeMultiprocessorCount, dev) != hipSuccess) { grid = -1; return; }
        if (hipFuncSetAttribute((const void*)fwd_kernel, hipFuncAttributeMaxDynamicSharedMemorySize, LDS_BYTES) != hipSuccess) { fprintf(stderr, "kernel_launch: hipFuncSetAttribute failed\n"); grid = -1; return; }
        if (hipOccupancyMaxActiveBlocksPerMultiprocessor(&per_cu, (const void*)fwd_kernel, NTHREADS, LDS_BYTES) != hipSuccess || per_cu < 1) { fprintf(stderr, "kernel_launch: occupancy query says %d\n", per_cu); per_cu = 1; }
        (void)hipGetLastError();
        grid = cus;
    }
    if (grid < 0) return;
    (void)hipMemsetAsync((char*)d_ws + WS_CTL, 0, CTL_BYTES, stream);
    Args a{};
    for (int i = 0; i < 18; ++i) a.in[i] = (const float*)d_in[i];
    a.out = (float*)d_out; a.ws = (unsigned char*)d_ws;
#if MK_MULTI
    for (int ph = 0; ph < NPHASE; ++ph) { a.ph_lo = ph; a.ph_hi = ph + 1; hipLaunchKernelGGL(fwd_kernel, dim3(grid), dim3(NTHREADS), LDS_BYTES, stream, a); }
#else
    a.ph_lo = 0; a.ph_hi = NPHASE;
    void* kargs[] = {&a};
    hipError_t e = hipLaunchCooperativeKernel((const void*)fwd_kernel, dim3(grid), dim3(NTHREADS), kargs, LDS_BYTES, stream);
    if (e != hipSuccess) fprintf(stderr, "kernel_launch: cooperative launch failed: %s\n", hipGetErrorString(e));
#endif
}
```

```cpp
#include <hip/hip_runtime.h>
#include <cstdio>
#include <cstdint>

#define GAS __attribute__((address_space(1)))
#define LAS __attribute__((address_space(3)))
#define DI __device__ __forceinline__
typedef unsigned short bf16_t;
typedef short bf16x8 __attribute__((ext_vector_type(8)));
typedef short s16x4 __attribute__((ext_vector_type(4)));
typedef float f32x4 __attribute__((ext_vector_type(4)));
typedef unsigned u32x4 __attribute__((ext_vector_type(4)));
typedef unsigned u32x2 __attribute__((ext_vector_type(2)));

#ifndef PROBE_A
#define PROBE_A -1
#define PROBE_B -1
#endif
#ifndef REPEAT_MASK
#define REPEAT_MASK 0
#endif
#ifndef MK_MULTI
#define MK_MULTI 0
#endif

constexpr int T = 8192, D = 2048, SEQ = 2048;
constexpr int SBH = 16;
constexpr int MLH = 8, ML_IN = 6160;
constexpr int NE = 32, FF = 256;
constexpr float EPS = 1e-6f;
constexpr int NPHASE = 16;
constexpr int NTHREADS = 512;
constexpr int LDS_BYTES = 147456;

constexpr size_t MiB = 1u << 20;
constexpr size_t WS_CTL = 0, CTL_BYTES = 128 * 1024;
constexpr size_t WS_WR = 128 * 1024, WR_BYTES = 384 * 1024, WS_WG = 896 * 1024;
constexpr size_t WS_WSBIN = 1 * MiB, WS_WSBOUT = 25 * MiB, WS_WMLIN = 33 * MiB, WS_WMLOUT = 57 * MiB;
constexpr size_t WS_W13 = 65 * MiB, WS_W2 = 193 * MiB;
constexpr size_t WS_X = 257 * MiB, WS_H = 321 * MiB, WS_ACT = 353 * MiB;
constexpr size_t A_Q = 0, A_K = 32 * MiB, A_VT = 64 * MiB, A_O = 96 * MiB;
constexpr size_t A_Q1 = 0, A_K1 = 16 * MiB, A_KT = 32 * MiB, A_VT1 = 48 * MiB, A_OG = 80 * MiB, A_HS = 112 * MiB, A_G = 144 * MiB, A_NJ = 144 * MiB + 524288, A_SUM = 144 * MiB + 524288 + 131072;
constexpr size_t A_HID = 0, A_LIST = 9 * MiB, A_LISTW = 10 * MiB, A_Y = 16 * MiB;
constexpr size_t A_Z0 = 64 * MiB, A_Z1 = 80 * MiB;
constexpr size_t WS_END = WS_ACT + 145 * MiB;
constexpr int CW_BAR = 4096;
constexpr int CW_CNT = 16384;

typedef __bf16 bf16x2_t __attribute__((ext_vector_type(2)));
typedef float f32x2 __attribute__((ext_vector_type(2)));
DI unsigned pk2(float lo, float hi) { const f32x2 v = {lo, hi}; return __builtin_bit_cast(unsigned, __builtin_convertvector(v, bf16x2_t)); }
DI unsigned f2bf(float f) { return pk2(f, 0.f) & 0xffffu; }
DI float bf2f(unsigned short b) { return __builtin_bit_cast(float, ((unsigned)b) << 16); }
template <int CTRL> DI float dpp_t(float v) { return __builtin_bit_cast(float, __builtin_amdgcn_update_dpp(0, __builtin_bit_cast(int, v), CTRL, 0xF, 0xF, false)); }
#define dpp_f(v, ctrl) dpp_t<ctrl>(v)
DI float wave_max(float v) {
    v = fmaxf(v, dpp_f(v, 0xB1)); v = fmaxf(v, dpp_f(v, 0x4E)); v = fmaxf(v, dpp_f(v, 0x141)); v = fmaxf(v, dpp_f(v, 0x140));
    v = fmaxf(v, __shfl_xor(v, 16)); v = fmaxf(v, __shfl_xor(v, 32)); return v;
}
DI float wave_sum(float v) {
#pragma unroll
    for (int o = 1; o < 64; o <<= 1) v += __shfl_xor(v, o);
    return v;
}
#define LDS_WAIT() asm volatile("s_waitcnt lgkmcnt(0)" ::: "memory")
#define VM_WAIT() asm volatile("s_waitcnt vmcnt(0)" ::: "memory")
#define MFMA16(a, b, c) __builtin_amdgcn_mfma_f32_16x16x32_bf16((a), (b), (c), 0, 0, 0)

#define XB_TMO      128
#define XB_XCNT(j)  (256  + 64 * (j))
#define XB_XSUB(j)  (1280 + 64 * (j))
#define XB_XGEN(j)  (2304 + 64 * (j))
#define XB_TOP      3328
#define XB_TOPGEN   3392
#define XCD_BAR_WORDS 3456
#define XB_SPIN_CAP (1u << 18)
DI unsigned xb_ld(unsigned* p)              { return __hip_atomic_load(p, __ATOMIC_RELAXED, __HIP_MEMORY_SCOPE_AGENT); }
DI unsigned xb_add(unsigned* p, unsigned v) { return __hip_atomic_fetch_add(p, v, __ATOMIC_RELAXED, __HIP_MEMORY_SCOPE_AGENT); }
DI unsigned xb_xcc_id() { return (unsigned)__builtin_amdgcn_s_getreg((3 << 11) | 20) & 0xFu; }
#define XB_SPIN(cond, bar) do { unsigned _sp = 0; while (cond) { __builtin_amdgcn_s_sleep(1); \
    if ((++_sp & 255u) == 0u) { if (xb_ld(&(bar)[XB_TMO])) break; if (_sp > XB_SPIN_CAP) { atomicAdd(&(bar)[XB_TMO], 1u); break; } } } } while (0)
struct XcdBarrier { unsigned* bar; unsigned x; volatile LAS unsigned* st; };
DI XcdBarrier xcd_barrier_post(unsigned* bar, volatile LAS unsigned* st) {
    XcdBarrier b; b.bar = bar; b.x = xb_xcc_id(); b.st = st;
    if (threadIdx.x == 0) (void)xb_add(&bar[XB_XCNT(b.x)], 1u);
    return b;
}
DI void xcd_barrier_complete(unsigned* bar, unsigned x, unsigned& nloc, unsigned& nx) {
    const unsigned G = gridDim.x * gridDim.y * gridDim.z;
    unsigned sum, cnt, mine, sp = 0u;
    for (;;) {
        sum = 0u; cnt = 0u; mine = 0u;
#pragma unroll
        for (unsigned j = 0; j < 16; ++j) { const unsigned c = xb_ld(&bar[XB_XCNT(j)]); sum += c; cnt += (c > 0u) ? 1u : 0u; mine = (j == x) ? c : mine; }
        if (sum == G) break;
        __builtin_amdgcn_s_sleep(1);
        if ((++sp & 255u) == 0u) { if (xb_ld(&bar[XB_TMO])) break; if (sp > XB_SPIN_CAP) { atomicAdd(&bar[XB_TMO], 1u); break; } }
    }
    nloc = mine > 0u ? mine : 1u; nx = cnt > 0u ? cnt : 1u;
}
DI void xcd_barrier(const XcdBarrier& b) {
    asm volatile("s_waitcnt vmcnt(0)" ::: "memory");
    __syncthreads();
    if (threadIdx.x == 0) {
        unsigned* bar = b.bar;
        __builtin_amdgcn_s_waitcnt(0);
        unsigned nloc = b.st[0], nx = b.st[1];
        if (nloc == 0u) { xcd_barrier_complete(bar, b.x, nloc, nx); b.st[0] = nloc; b.st[1] = nx; }
        const unsigned old = xb_add(&bar[XB_XSUB(b.x)], 1u);
        const unsigned gen = old / nloc;
        if (old + 1u == (gen + 1u) * nloc) {
            __builtin_amdgcn_fence(__ATOMIC_RELEASE, "agent");
            asm volatile("s_waitcnt vmcnt(0)" ::: "memory");
            const unsigned og = xb_add(&bar[XB_TOP], 1u);
            const unsigned tg = og / nx;
            if (og + 1u == (tg + 1u) * nx) xb_add(&bar[XB_TOPGEN], 1u);
            else XB_SPIN(xb_ld(&bar[XB_TOPGEN]) == tg, bar);
            __builtin_amdgcn_fence(__ATOMIC_ACQUIRE, "agent");
            xb_add(&bar[XB_XGEN(b.x)], 1u);
            asm volatile("s_waitcnt vmcnt(0)" ::: "memory");
        } else {
            XB_SPIN(xb_ld(&bar[XB_XGEN(b.x)]) == gen, bar);
            __builtin_amdgcn_fence(__ATOMIC_ACQUIRE, "agent");
            asm volatile("s_waitcnt vmcnt(0)" ::: "memory");
        }
    }
    __syncthreads();
}

struct Args {
    const float* in[18];
    float* out;
    unsigned char* ws;
    int ph_lo, ph_hi;
};

DI int perm13(int f, int which) { return (f >> 7) * 256 + ((f >> 5) & 3) * 64 + which * 32 + (f & 31); }
template <bool DEEP = false>
DI void transpose_item(const float* W, int ldw, bf16_t* WT, int ldt, int k0, int n0, int mode, LAS float* scr, int lane) {
    if (DEEP) {
        float wv[64];
#pragma unroll
        for (int i = 0; i < 64; ++i) wv[i] = __builtin_nontemporal_load(W + (size_t)(k0 + i) * ldw + n0 + lane);
#pragma unroll
        for (int i = 0; i < 64; ++i) scr[i * 65 + lane] = wv[i];
    } else {
#pragma unroll 16
        for (int i = 0; i < 64; ++i) scr[i * 65 + lane] = __builtin_nontemporal_load(W + (size_t)(k0 + i) * ldw + n0 + lane);
    }
    LDS_WAIT(); asm volatile("" ::: "memory");
    const int c = lane & 7;
#pragma unroll
    for (int j = 0; j < 8; ++j) {
        const int n = (lane >> 3) + 8 * j; const LAS float* s = scr + (8 * c) * 65 + n;
        u32x4 o; o.x = pk2(s[0 * 65], s[1 * 65]); o.y = pk2(s[2 * 65], s[3 * 65]); o.z = pk2(s[4 * 65], s[5 * 65]); o.w = pk2(s[6 * 65], s[7 * 65]);
        const int nn = n0 + n; const int row = (mode == 0) ? nn : perm13(nn, mode - 1);
        *(u32x4*)(WT + (size_t)row * ldt + k0 + 8 * c) = o;
    }
    LDS_WAIT(); asm volatile("" ::: "memory");
}

struct NormP {
    const float* src; bf16_t* X; const bf16_t* Y; bf16_t* H; float* outf; const float* g;
    const bf16_t* wimg; const float* bg; const float* be;
    unsigned* cnt; unsigned* list; float* listw;
    float* G;
};
template <int MODE, bool XB>
DI void norm_phase(const NormP& p, LAS unsigned char* lds, int tid, int wid, int lane) {
    constexpr int RB_LDB = 4112;
    LAS unsigned char* rb_hi = lds;
    LAS float* part = (LAS float*)(lds + 8 * RB_LDB);
    LAS float* logit = part + 8 * 8 * 48;
    LAS int* pex = (LAS int*)(logit + 512); LAS unsigned* pen = (LAS unsigned*)(pex + 512); LAS float* pwt = (LAS float*)(pen + 512);
    int itn = 0;
    constexpr bool PROJ = (MODE == 1 || MODE == 2);
    const float* xin = p.src;
    const bf16_t* xbn = (MODE <= 1) ? (const bf16_t*)p.src : (const bf16_t*)p.X;
    f32x4 v[8]; u32x2 xb[8], ya[8], yb[8];
    int it = blockIdx.x;
#define NP_LOADV(itx) do { const size_t ro_ = (size_t)((itx) * 8 + wid) * D; _Pragma("unroll") for (int j = 0; j < 8; ++j) { if (XB) xb[j] = *(const u32x2*)(xbn + ro_ + 4 * lane + 256 * j); else v[j] = __builtin_nontemporal_load((const f32x4*)(xin + ro_ + 4 * lane + 256 * j)); } } while (0)
#define NP_LOADY(itx) do { const size_t ro_ = (size_t)((itx) * 8 + wid) * D; _Pragma("unroll") for (int j = 0; j < 8; ++j) { const int c = 4 * lane + 256 * j; \
        if (MODE >= 1) ya[j] = *(const u32x2*)(p.Y + ro_ + c); if (MODE >= 2) yb[j] = *(const u32x2*)(p.Y + (size_t)T * D + ro_ + c); } } while (0)
#define NP_LOAD(itx) do { NP_LOADV(itx); NP_LOADY(itx); } while (0)
    if (it < T / 8) NP_LOAD(it);
    for (; it < T / 8; it += gridDim.x, ++itn) {
        const int row = it * 8 + wid;
        const size_t ro = (size_t)row * D;
        f32x4 gv[8];
#pragma unroll
        for (int j = 0; j < 8; ++j) gv[j] = *(const f32x4*)(p.g + 4 * lane + 256 * j);
        float ss = 0.f;
#pragma unroll
        for (int j = 0; j < 8; ++j) {
            f32x4 x;
            if (XB) { const u32x2 q = xb[j]; x.x = bf2f(q.x & 0xffff); x.y = bf2f(q.x >> 16); x.z = bf2f(q.y & 0xffff); x.w = bf2f(q.y >> 16); } else x = v[j];
            if (MODE >= 1) {
                const u32x2 a = ya[j];
                x.x += bf2f(a.x & 0xffff); x.y += bf2f(a.x >> 16); x.z += bf2f(a.y & 0xffff); x.w += bf2f(a.y >> 16);
                if (MODE >= 2) { const u32x2 b = yb[j]; x.x += bf2f(b.x & 0xffff); x.y += bf2f(b.x >> 16); x.z += bf2f(b.y & 0xffff); x.w += bf2f(b.y >> 16); }
                if (MODE <= 2) { u32x2 o; o.x = pk2(x.x, x.y); o.y = pk2(x.z, x.w); *(u32x2*)(p.X + ro + 4 * lane + 256 * j) = o; }
            }
            v[j] = x;
            ss += (x.x * x.x + x.y * x.y) + (x.z * x.z + x.w * x.w);
        }
        const float rstd = 1.0f / sqrtf(wave_sum(ss) * (1.0f / D) + EPS);
#pragma unroll
        for (int j = 0; j < 8; ++j) {
            const int c = 4 * lane + 256 * j;
            const f32x4 gg = gv[j];
            f32x4 y; y.x = v[j].x * rstd * gg.x; y.y = v[j].y * rstd * gg.y; y.z = v[j].z * rstd * gg.z; y.w = v[j].w * rstd * gg.w;
            if (MODE == 3) *(f32x4*)(p.outf + ro + c) = y;
            else { u32x2 o; o.x = pk2(y.x, y.y); o.y = pk2(y.z, y.w); *(u32x2*)(p.H + ro + c) = o; }
            if (PROJ) *(LAS u32x2*)(rb_hi + wid * RB_LDB + c * 2) = (u32x2){pk2(y.x, y.y), pk2(y.z, y.w)};
        }
        const bool more = it + (int)gridDim.x < T / 8;
        if (!PROJ && more) NP_LOAD(it + gridDim.x);
        if (PROJ) {
            __syncthreads();
            {
                constexpr int NT = (MODE == 1) ? 3 : 1;
                f32x4 pacc[NT];
#pragma unroll
                for (int nt = 0; nt < NT; ++nt) pacc[nt] = (f32x4){0.f, 0.f, 0.f, 0.f};
                const LAS unsigned char* ahi = rb_hi + (lane & 7) * RB_LDB + (lane >> 4) * 16 + wid * 512;
                const bf16_t* wim = p.wimg + (size_t)lane * 8 + (size_t)(8 * wid) * NT * 512;
                bf16x8 w0[4][NT], w1[4][NT];
#define NP_LDW(dst, g) do { _Pragma("unroll") for (int kk = 0; kk < 4; ++kk) _Pragma("unroll") for (int nt = 0; nt < NT; ++nt) dst[kk][nt] = *(const bf16x8*)(wim + (size_t)((4 * (g) + kk) * NT + nt) * 512); } while (0)
#define NP_MM(src, g) do { _Pragma("unroll") for (int kk = 0; kk < 4; ++kk) { const bf16x8 xh = *(const LAS bf16x8*)(ahi + (4 * (g) + kk) * 64); \
        _Pragma("unroll") for (int nt = 0; nt < NT; ++nt) pacc[nt] = MFMA16(xh, src[kk][nt], pacc[nt]); } } while (0)
#define NP_PIN __builtin_amdgcn_sched_barrier(0)
                NP_LDW(w0, 0); NP_LDW(w1, 1); NP_PIN;
                if (more) NP_LOADV(it + gridDim.x);
                NP_PIN; NP_MM(w0, 0); NP_MM(w1, 1); NP_PIN;
#undef NP_PIN
#undef NP_LDW
#undef NP_MM
                if (more) NP_LOADY(it + gridDim.x);
                if (lane < 32) {
#pragma unroll
                    for (int nt = 0; nt < NT; ++nt)
#pragma unroll
                        for (int r = 0; r < 4; ++r) part[(wid * 8 + 4 * (lane >> 4) + r) * 48 + 16 * nt + (lane & 15)] = pacc[nt][r];
                }
            }
            __syncthreads();
            {
                float sl = 0.f;
                if (lane < 48) {
#pragma unroll
                    for (int w = 0; w < 8; ++w) sl += part[(w * 8 + wid) * 48 + lane];
                }
                if (MODE == 2) { if (lane < 16) p.G[(size_t)row * 16 + lane] = sl; }
                else {
                    if (lane < 36) sl += (lane < 4) ? p.bg[lane] : p.be[lane - 4];
                    const float NEG = -3.0e38f;
                    const float gl = (lane < 4) ? sl : NEG;
                    float gm = fmaxf(gl, dpp_f(gl, 0xB1)); gm = fmaxf(gm, dpp_f(gm, 0x4E));
                    gm = __shfl(gm, 0);
                    const int gs = __ffsll((long long)__ballot(lane < 4 && sl == gm)) - 1;
                    float ge = (lane < 4) ? __expf(sl - gm) : 0.f;
                    ge += dpp_f(ge, 0xB1); ge += dpp_f(ge, 0x4E);
                    const float psel = 1.0f / __shfl(ge, 0);
                    const int eb = 4 + 8 * gs;
                    const bool inr = lane >= eb && lane < eb + 8;
                    const float v0 = wave_max(inr ? sl : NEG);
                    const int l0 = __ffsll((long long)__ballot(inr && sl == v0)) - 1;
                    const float v1 = wave_max((inr && lane != l0) ? sl : NEG);
                    const int l1 = __ffsll((long long)__ballot(inr && lane != l0 && sl == v1)) - 1;
                    if (lane == 0) {
                        const float e10 = __expf(v1 - v0); const float w0 = psel / (1.0f + e10), w1 = psel * e10 / (1.0f + e10);
                        const int e0 = gs * 8 + (l0 - eb), e1 = gs * 8 + (l1 - eb);
                        const int sl0 = itn * 16 + wid * 2;
                        pex[sl0] = e0; pen[sl0] = (unsigned)row * 2u; pwt[sl0] = w0;
                        pex[sl0 + 1] = e1; pen[sl0 + 1] = (unsigned)row * 2u + 1u; pwt[sl0 + 1] = w1;
                    }
                }
            }
        }
    }
#undef NP_LOAD
#undef NP_LOADV
#undef NP_LOADY
    if (MODE == 1) {
        __syncthreads();
        if (wid == 0) {
            const int np = itn * 16;
            for (int c0 = 0; c0 < np; c0 += 64) {
                const bool have = c0 + lane < np;
                const int ei = have ? pex[c0 + lane] : -1;
                int cnt_e = 0, rank = 0;
#pragma unroll 4
                for (int e = 0; e < NE; ++e) {
                    const unsigned long long m = __ballot(ei == e);
                    if (lane == e) cnt_e = __popcll(m);
                    if (ei == e) rank = __popcll(m & ((1ull << lane) - 1ull));
                }
                unsigned base = 0u;
                if (lane < NE && cnt_e > 0) base = atomicAdd(p.cnt + lane, (unsigned)cnt_e);
                const unsigned mybase = (unsigned)__shfl((int)base, ei < 0 ? 0 : ei);
                if (have) { const size_t pos = (size_t)ei * T + mybase + rank; p.list[pos] = pen[c0 + lane]; p.listw[pos] = pwt[c0 + lane]; }
            }
        }
        __syncthreads();
    }
}

DI int lds_byte(int r, int c) { const int st = (r >> 4) * 2 + (c >> 5), rr = r & 15, cc = c & 31, ob = rr * 64 + cc * 2; return st * 1024 + (ob ^ (((ob >> 9) & 1) << 5)); }
DI void stage_rc(int b, int& R, int& C) { const int st = b / 1024, sb = b % 1024, swz = sb ^ (((sb >> 9) & 1) << 5); R = (st >> 1) * 16 + swz / 64; C = (st & 1) * 32 + (swz % 64) / 2; }

namespace pg8 {
constexpr int BM = 256, BK = 64, HALF = 128, HTB = HALF * BK * 2, NXCD = 8, WGM = 8, KD = 2048;
DI int perm32(int rho) { const int n = rho >> 4, i = rho & 15; return 8 * (i >> 2) + 4 * n + (i & 3); }
struct Unit { int pm, pn, job; };
struct JobRec { const bf16_t* A; const bf16_t* Bt; bf16_t* o0; bf16_t* o1; int M, N, ld, split; float scale0; int pad[5]; };
constexpr int JOBS_OFF = 139264;
DI void put_job(LAS unsigned char* lds, int j, const bf16_t* A, const bf16_t* Bt, int M, int N, bf16_t* o0, bf16_t* o1, int ld, int split, float scale0) {
    LAS JobRec* r = (LAS JobRec*)(lds + JOBS_OFF) + j;
    r->A = A; r->Bt = Bt; r->o0 = o0; r->o1 = o1; r->M = M; r->N = N; r->ld = ld; r->split = split; r->scale0 = scale0;
}
struct Sched {
    const LAS JobRec* tab; int n0, n1, n2, G, c;
    DI void init(LAS unsigned char* lds, int njobs, int G_, int c_) {
        tab = (const LAS JobRec*)(lds + JOBS_OFF);
        n0 = (tab[0].M / BM) * (tab[0].N / BM); n1 = njobs > 1 ? (tab[1].M / BM) * (tab[1].N / BM) : 0; n2 = njobs > 2 ? (tab[2].M / BM) * (tab[2].N / BM) : 0; G = G_; c = c_; }
    DI bool next(int i, Unit& u) const {
        int L = i * G + c, nwg;
        if (L < n0) { u.job = 0; nwg = n0; }
        else if (L < n0 + n1) { L -= n0; u.job = 1; nwg = n1; }
        else if (L < n0 + n1 + n2) { L -= n0 + n1; u.job = 2; nwg = n2; }
        else return false;
        const int nM = tab[u.job].M / BM, nN = tab[u.job].N / BM;
        int wgid = L; { const int q = nwg / NXCD, r = nwg % NXCD, xcd = wgid % NXCD, off = wgid / NXCD; wgid = (xcd < r ? xcd * (q + 1) : r * (q + 1) + (xcd - r) * q) + off; }
        const int nig = WGM * nN, gid = wgid / nig, fm = gid * WGM, gsz = (nM - fm) < WGM ? (nM - fm) : WGM;
        u.pm = fm + ((wgid % nig) % gsz); u.pn = (wgid % nig) / gsz; return true;
    }
    DI const char* aptr(const Unit& u) const { return (const char*)tab[u.job].A + (size_t)u.pm * (2 * HALF * KD * 2); }
    DI const char* bptr(const Unit& u) const { return (const char*)tab[u.job].Bt + (size_t)u.pn * (2 * HALF * KD * 2); }
};
struct EpiBf16 {
    static constexpr bool PERM = true;
    const LAS JobRec* tab;
    DI void operator()(const f32x4 (&acc)[2][2][4][2], const Unit& u, int wr, int wc, int fr, int fq) const {
        const LAS JobRec* jr = tab + u.job;
        const int ldo = jr->ld, split = jr->split;
        float sc = jr->scale0;
        int colt = u.pn * BM; bf16_t* base = jr->o0;
        if (colt >= split) { colt -= split; base = jr->o1; sc = 1.0f; }
        const int row0 = u.pm * BM + wr * 64 + fr, col0 = colt + wc * 64 + 8 * fq;
#pragma unroll
        for (int ai = 0; ai < 2; ++ai)
#pragma unroll
            for (int m = 0; m < 4; ++m) { bf16_t* rowp = base + (size_t)(row0 + ai * HALF + m * 16) * ldo + col0;
#pragma unroll
                for (int bj = 0; bj < 2; ++bj) { const f32x4 v0 = acc[ai][bj][m][0], v1 = acc[ai][bj][m][1];
                    u32x4 w; w.x = pk2(v0.x * sc, v0.y * sc); w.y = pk2(v0.z * sc, v0.w * sc); w.z = pk2(v1.x * sc, v1.y * sc); w.w = pk2(v1.z * sc, v1.w * sc);
                    *(u32x4*)(rowp + bj * 32) = w; } }
    }
};
struct EpiResF32 {
    static constexpr bool PERM = false;
    const float* base; float* out; int ld;
    DI void operator()(const f32x4 (&acc)[2][2][4][2], const Unit& u, int wr, int wc, int fr, int fq) const {
        const int row0 = u.pm * BM + wr * 64 + fr, col0 = u.pn * BM + wc * 32 + 4 * fq;
#pragma unroll
        for (int ai = 0; ai < 2; ++ai)
#pragma unroll
            for (int m = 0; m < 4; ++m) { const size_t ro = (size_t)(row0 + ai * HALF + m * 16) * ld + col0;
#pragma unroll
                for (int bj = 0; bj < 2; ++bj)
#pragma unroll
                    for (int n = 0; n < 2; ++n) { const f32x4 b = *(const f32x4*)(base + ro + bj * HALF + n * 16); const f32x4 a = acc[ai][bj][m][n];
                        f32x4 o; o.x = a.x + b.x; o.y = a.y + b.y; o.z = a.z + b.z; o.w = a.w + b.w; *(f32x4*)(out + ro + bj * HALF + n * 16) = o; } }
    }
};
struct EpiNull {
    static constexpr bool PERM = false;
    DI void operator()(const f32x4 (&acc)[2][2][4][2], const Unit&, int, int, int, int) const {
#pragma unroll
        for (int ai = 0; ai < 2; ++ai)
#pragma unroll
            for (int bj = 0; bj < 2; ++bj)
#pragma unroll
                for (int m = 0; m < 4; ++m)
#pragma unroll
                    for (int n = 0; n < 2; ++n) asm volatile("" :: "v"(acc[ai][bj][m][n]));
    }
};
template <class Epi>
DI void gemm_phase(LAS unsigned char* lds, const Sched& S, const Epi& E) {
    const int tid = threadIdx.x, wid = __builtin_amdgcn_readfirstlane(tid >> 6), lane = tid & 63, wr = wid >> 2, wc = wid & 3, fr = lane & 15, fq = lane >> 4;
    constexpr int K = KD, nt = K / BK;
    unsigned voffA[2], voffB[2][2];
#pragma unroll
    for (int i = 0; i < 2; ++i) { int R, C; stage_rc(tid * 16 + i * 8192, R, C);
        voffA[i] = (unsigned)(R * K + C) * 2u;
#pragma unroll
        for (int h = 0; h < 2; ++h) { const int Rb = Epi::PERM ? (64 * (R >> 5) + 32 * h + perm32(R & 31)) : (128 * h + R); voffB[h][i] = (unsigned)(Rb * K + C) * 2u; } }
    constexpr size_t kstep = (size_t)(BK * 2);
    constexpr size_t hstep = (size_t)HALF * K * 2;
    const unsigned ldsw = (unsigned)wid * 1024u;
    const int aoff = lds_byte(wr * 64 + fr, fq * 8), boff = lds_byte(wc * 32 + fr, fq * 8);
#define PG8_SA(b, h) (((b) * 2 + (h)) * HTB)
#define PG8_SB(b, h) ((4 + (b) * 2 + (h)) * HTB)
#define PG8_STAGE(bufoff, gbase, voff) do { _Pragma("unroll") for (int _i = 0; _i < 2; ++_i) \
        __builtin_amdgcn_global_load_lds((const GAS unsigned*)((const char*)(gbase) + (voff)[_i]), (LAS unsigned*)(lds + (bufoff) + ldsw + _i * 8192), 16, 0, 0); } while (0)
#define PG8_LDA(dst, b, h) do { _Pragma("unroll") for (int m = 0; m < 4; ++m) _Pragma("unroll") for (int k = 0; k < 2; ++k) dst[m][k] = *(const LAS bf16x8*)(lds + PG8_SA(b, h) + aoff + m * 2048 + k * 1024); } while (0)
#define PG8_LDB(dst, b, h) do { _Pragma("unroll") for (int n = 0; n < 2; ++n) _Pragma("unroll") for (int k = 0; k < 2; ++k) dst[n][k] = *(const LAS bf16x8*)(lds + PG8_SB(b, h) + boff + n * 2048 + k * 1024); } while (0)
#define PG8_MMA(ai, bj, At, Bt) do { __builtin_amdgcn_s_setprio(1); _Pragma("unroll") for (int m = 0; m < 4; ++m) _Pragma("unroll") for (int n = 0; n < 2; ++n) _Pragma("unroll") for (int k = 0; k < 2; ++k) \
        acc[ai][bj][m][n] = __builtin_amdgcn_mfma_f32_16x16x32_bf16(Bt[n][k], At[m][k], acc[ai][bj][m][n], 0, 0, 0); __builtin_amdgcn_s_setprio(0); } while (0)
#define PG8_WAIT_V(n) asm volatile("s_waitcnt vmcnt(" #n ")" ::: "memory")
#define PG8_WAIT_L(n) asm volatile("s_waitcnt lgkmcnt(" #n ")" ::: "memory")
#define PG8_BAR __builtin_amdgcn_s_barrier()
#define PG8_SCHED __builtin_amdgcn_sched_barrier(0)
    Unit cur, nxt; int ui = 0;
    if (!S.next(0, cur)) return;
    f32x4 acc[2][2][4][2];
#pragma unroll
    for (int a = 0; a < 2; ++a)
#pragma unroll
        for (int b = 0; b < 2; ++b)
#pragma unroll
            for (int m = 0; m < 4; ++m)
#pragma unroll
                for (int n = 0; n < 2; ++n) acc[a][b][m][n] = (f32x4){0.f, 0.f, 0.f, 0.f};
    bf16x8 At[4][2], B0[2][2], B1[2][2];
    const char* cA = S.aptr(cur); const char* cB = S.bptr(cur);
    PG8_STAGE(PG8_SB(0, 0), cB, voffB[0]); PG8_STAGE(PG8_SA(0, 0), cA, voffA); PG8_STAGE(PG8_SB(0, 1), cB, voffB[1]); PG8_STAGE(PG8_SA(0, 1), cA + hstep, voffA);
    if (wr == 1) PG8_BAR;
    PG8_WAIT_V(4); PG8_BAR;
    PG8_STAGE(PG8_SB(1, 0), cB + kstep, voffB[0]); PG8_STAGE(PG8_SA(1, 0), cA + kstep, voffA); PG8_STAGE(PG8_SB(1, 1), cB + kstep, voffB[1]);
    PG8_WAIT_V(6); PG8_BAR;
    for (;;) {
        const bool has_next = S.next(ui + 1, nxt);
        const char* nA = has_next ? S.aptr(nxt) : cA; const char* nB = has_next ? S.bptr(nxt) : cB;
        for (int t = 0; t < nt; t += 2) {
            const bool last = (t == nt - 2);
            const char* a1 = cA + (size_t)(t + 1) * kstep;
            const char* a2 = last ? nA : cA + (size_t)(t + 2) * kstep; const char* b2 = last ? nB : cB + (size_t)(t + 2) * kstep;
            const char* a3 = a2 + kstep; const char* b3 = b2 + kstep;
            PG8_LDB(B0, 0, 0); PG8_SCHED; PG8_LDA(At, 0, 0); PG8_STAGE(PG8_SA(1, 1), a1 + hstep, voffA);
            PG8_WAIT_L(8); PG8_BAR; PG8_WAIT_L(0); PG8_MMA(0, 0, At, B0); PG8_BAR; PG8_SCHED;
            PG8_LDB(B1, 0, 1); PG8_STAGE(PG8_SB(0, 0), b2, voffB[0]);
            PG8_BAR; PG8_WAIT_L(0); PG8_MMA(0, 1, At, B1); PG8_BAR;
            PG8_LDA(At, 0, 1); PG8_STAGE(PG8_SA(0, 0), a2, voffA);
            PG8_BAR; PG8_WAIT_L(0); PG8_MMA(1, 0, At, B0); PG8_BAR; PG8_SCHED;
            PG8_STAGE(PG8_SB(0, 1), b2, voffB[1]);
            PG8_WAIT_V(6); PG8_BAR; PG8_MMA(1, 1, At, B1); PG8_BAR;
            PG8_LDB(B0, 1, 0); PG8_SCHED; PG8_LDA(At, 1, 0); PG8_STAGE(PG8_SA(0, 1), a2 + hstep, voffA);
            PG8_WAIT_L(8); PG8_BAR; PG8_WAIT_L(0); PG8_MMA(0, 0, At, B0); PG8_BAR; PG8_SCHED;
            PG8_LDB(B1, 1, 1); PG8_STAGE(PG8_SB(1, 0), b3, voffB[0]);
            PG8_BAR; PG8_WAIT_L(0); PG8_MMA(0, 1, At, B1); PG8_BAR;
            PG8_LDA(At, 1, 1); PG8_STAGE(PG8_SA(1, 0), a3, voffA);
            PG8_BAR; PG8_WAIT_L(0); PG8_MMA(1, 0, At, B0); PG8_BAR; PG8_SCHED;
            PG8_STAGE(PG8_SB(1, 1), b3, voffB[1]);
            PG8_WAIT_V(6); PG8_BAR; PG8_MMA(1, 1, At, B1); PG8_BAR;
        }
        E(acc, cur, wr, wc, fr, fq);
        if (!has_next) break;
#pragma unroll
        for (int a = 0; a < 2; ++a)
#pragma unroll
            for (int b = 0; b < 2; ++b)
#pragma unroll
                for (int m = 0; m < 4; ++m)
#pragma unroll
                    for (int n = 0; n < 2; ++n) acc[a][b][m][n] = (f32x4){0.f, 0.f, 0.f, 0.f};
        cur = nxt; cA = nA; cB = nB; ++ui;
    }
    PG8_WAIT_V(0);
    if (wr == 0) PG8_BAR;
    PG8_BAR;
#undef PG8_SA
#undef PG8_SB
#undef PG8_STAGE
#undef PG8_LDA
#undef PG8_LDB
#undef PG8_MMA
#undef PG8_WAIT_V
#undef PG8_WAIT_L
#undef PG8_BAR
#undef PG8_SCHED
}

struct MUnit { int e, rt, pn, cnt, sbase; };
constexpr int MTAB_OFF = JOBS_OFF + 256;
DI void moe_table256(const unsigned* cntg, LAS unsigned char* lds, int tid) {
    LAS int* ctl = (LAS int*)(lds + MTAB_OFF);
    if (tid < 64) {
        const int c = (tid < NE) ? (int)__hip_atomic_load(cntg + tid, __ATOMIC_RELAXED, __HIP_MEMORY_SCOPE_AGENT) : 0;
        const int n = (c + 255) / 256;
        int pb = c, pt = n;
#pragma unroll
        for (int o = 1; o < 32; o <<= 1) { const int vb = __shfl_up(pb, o), vt = __shfl_up(pt, o); if (tid >= o) { pb += vb; pt += vt; } }
        if (tid < NE) { ctl[tid] = c; ctl[32 + tid] = pb - c; ctl[64 + tid] = pt - n; for (int i = 0; i < n && pt - n + i < 128; ++i) ctl[128 + pt - n + i] = tid; }
        if (tid == NE - 1) ctl[64 + NE] = pt;
    }
    __syncthreads();
}
template <int NPN>
struct MSched {
    const LAS int* ctl; int G, c, total;
    DI void init(LAS unsigned char* lds, int G_, int c_, bool xcd_group = false) { ctl = (const LAS int*)(lds + MTAB_OFF); G = G_; total = ctl[64 + NE] * NPN;
        c = (xcd_group && (G_ % 8 == 0)) ? (c_ % 8) * (G_ / 8) + c_ / 8 : c_; }
    DI bool next(int i, MUnit& u) const {
        const int L = i * G + c; if (L >= total) return false;
        const int rtg = L / NPN; u.pn = L % NPN;
        const int e = ctl[128 + rtg];
        u.e = e; u.rt = rtg - ctl[64 + e]; u.cnt = ctl[e]; u.sbase = ctl[32 + e]; return true;
    }
};
struct MOps1 {
    const bf16_t* H; const bf16_t* W; const unsigned* list;
    DI const char* abase(const MUnit&) const { return (const char*)H; }
    DI void aoffs(const MUnit& u, int R0, int C0, int R1, int C1, unsigned (&o)[2][2]) const {
#pragma unroll
        for (int h = 0; h < 2; ++h) {
            const int ra = u.rt * 256 + h * 128 + R0, rb = u.rt * 256 + h * 128 + R1;
            const unsigned ta = list[(size_t)u.e * T + (ra < u.cnt ? ra : u.cnt - 1)] >> 1, tb = list[(size_t)u.e * T + (rb < u.cnt ? rb : u.cnt - 1)] >> 1;
            o[h][0] = (ta * (unsigned)D + (unsigned)C0) * 2u; o[h][1] = (tb * (unsigned)D + (unsigned)C1) * 2u;
        }
    }
    DI const char* bptr(const MUnit& u) const { return (const char*)(W + ((size_t)u.e * 512 + u.pn * 256) * D); }
};
struct MOps2 {
    const bf16_t* hid; const bf16_t* W;
    DI const char* abase(const MUnit& u) const { return (const char*)(hid + (size_t)(u.sbase + u.rt * 256) * FF); }
    DI void aoffs(const MUnit&, int R0, int C0, int R1, int C1, unsigned (&o)[2][2]) const {
#pragma unroll
        for (int h = 0; h < 2; ++h) { o[h][0] = (unsigned)((h * 128 + R0) * FF + C0) * 2u; o[h][1] = (unsigned)((h * 128 + R1) * FF + C1) * 2u; }
    }
    DI const char* bptr(const MUnit& u) const { return (const char*)(W + ((size_t)u.e * D + u.pn * 256) * FF); }
};
constexpr int MROW_OFF = 131072;
struct EpiSwiglu {
    bf16_t* hid; const float* listw;
    DI void prep(const MUnit& u, LAS unsigned char* lds, int par, int tid) const {
        if (tid < 256) { const int r = u.rt * 256 + tid;
            __builtin_amdgcn_global_load_lds((const GAS unsigned*)(listw + (size_t)u.e * T + (r < u.cnt ? r : u.cnt - 1)), (LAS unsigned*)(lds + MROW_OFF + par * 1024 + (tid >> 6) * 256), 4, 0, 0); }
    }
    DI void operator()(const f32x4 (&acc)[2][2][4][2], const MUnit& u, int wr, int wc, int fr, int fq, const LAS unsigned char* lds, int par) const {
#pragma unroll
        for (int ai = 0; ai < 2; ++ai)
#pragma unroll
            for (int m = 0; m < 4; ++m) {
                const int r = u.rt * 256 + ai * HALF + wr * 64 + m * 16 + fr;
                if (r < u.cnt) {
                    const float gw = ((const LAS float*)(lds + MROW_OFF))[par * 256 + ai * HALF + wr * 64 + m * 16 + fr];
                    unsigned o[4];
#pragma unroll
                    for (int n = 0; n < 2; ++n) { const f32x4 g = acc[ai][0][m][n], uu = acc[ai][1][m][n]; float hv[4];
#pragma unroll
                        for (int j = 0; j < 4; ++j) hv[j] = g[j] / (1.0f + __expf(-g[j])) * uu[j] * gw;
                        o[2 * n] = pk2(hv[0], hv[1]); o[2 * n + 1] = pk2(hv[2], hv[3]); }
                    *(u32x4*)(hid + (size_t)(u.sbase + r) * FF + u.pn * 128 + wc * 32 + 8 * fq) = (u32x4){o[0], o[1], o[2], o[3]};
                }
            }
    }
};
struct EpiScatter {
    bf16_t* Y; const unsigned* list;
    DI void prep(const MUnit& u, LAS unsigned char* lds, int par, int tid) const {
        if (tid < 256) { const int r = u.rt * 256 + tid;
            __builtin_amdgcn_global_load_lds((const GAS unsigned*)(list + (size_t)u.e * T + (r < u.cnt ? r : u.cnt - 1)), (LAS unsigned*)(lds + MROW_OFF + par * 1024 + (tid >> 6) * 256), 4, 0, 0); }
    }
    DI void operator()(const f32x4 (&acc)[2][2][4][2], const MUnit& u, int wr, int wc, int fr, int fq, const LAS unsigned char* lds, int par) const {
#pragma unroll
        for (int ai = 0; ai < 2; ++ai)
#pragma unroll
            for (int m = 0; m < 4; ++m) {
                const int r = u.rt * 256 + ai * HALF + wr * 64 + m * 16 + fr;
                if (r < u.cnt) {
                    const unsigned ent = ((const LAS unsigned*)(lds + MROW_OFF))[par * 256 + ai * HALF + wr * 64 + m * 16 + fr];
                    bf16_t* yrow = Y + ((size_t)(ent & 1u) * T + (ent >> 1)) * D + u.pn * 256 + wc * 64 + 8 * fq;
#pragma unroll
                    for (int bj = 0; bj < 2; ++bj) { const f32x4 v0 = acc[ai][bj][m][0], v1 = acc[ai][bj][m][1];
                        __builtin_nontemporal_store(((u32x4){pk2(v0.x, v0.y), pk2(v0.z, v0.w), pk2(v1.x, v1.y), pk2(v1.z, v1.w)}), (u32x4*)(yrow + bj * 32)); }
                }
            }
    }
};
struct EpiMNull {
    DI void prep(const MUnit&, LAS unsigned char*, int, int) const {}
    DI void operator()(const f32x4 (&acc)[2][2][4][2], const MUnit&, int, int, int, int, const LAS unsigned char*, int) const {
#pragma unroll
        for (int ai = 0; ai < 2; ++ai)
#pragma unroll
            for (int bj = 0; bj < 2; ++bj)
#pragma unroll
                for (int m = 0; m < 4; ++m)
#pragma unroll
                    for (int n = 0; n < 2; ++n) asm volatile("" :: "v"(acc[ai][bj][m][n]));
    }
};
template <int K, class Sched, class Ops, class Epi>
DI void gemm_phase_m(LAS unsigned char* lds, const Sched& S, const Ops& P, const Epi& E) {
    const int tid = threadIdx.x, wid = __builtin_amdgcn_readfirstlane(tid >> 6), lane = tid & 63, wr = wid >> 2, wc = wid & 3, fr = lane & 15, fq = lane >> 4;
    constexpr int nt = K / BK;
    int R0, C0, R1, C1; stage_rc(tid * 16, R0, C0); stage_rc(tid * 16 + 8192, R1, C1);
    unsigned voffB[2][2];
#pragma unroll
    for (int h = 0; h < 2; ++h) { voffB[h][0] = (unsigned)((64 * (R0 >> 5) + 32 * h + perm32(R0 & 31)) * K + C0) * 2u; voffB[h][1] = (unsigned)((64 * (R1 >> 5) + 32 * h + perm32(R1 & 31)) * K + C1) * 2u; }
    constexpr size_t kstep = (size_t)(BK * 2);
    constexpr size_t hstep = (size_t)HALF * K * 2;
    const unsigned ldsw = (unsigned)wid * 1024u;
    const int aoff = lds_byte(wr * 64 + fr, fq * 8), boff = lds_byte(wc * 32 + fr, fq * 8);
#define PG8_SA(b, h) (((b) * 2 + (h)) * HTB)
#define PG8_SB(b, h) ((4 + (b) * 2 + (h)) * HTB)
#define PG8_STAGEB(bufoff, gbase, h) do { _Pragma("unroll") for (int _i = 0; _i < 2; ++_i) \
        __builtin_amdgcn_global_load_lds((const GAS unsigned*)((const char*)(gbase) + voffB[h][_i]), (LAS unsigned*)(lds + (bufoff) + ldsw + _i * 8192), 16, 0, 0); } while (0)
#define PG8_STAGEA(bufoff, bb, pp, h, koff) do { _Pragma("unroll") for (int _i = 0; _i < 2; ++_i) \
        __builtin_amdgcn_global_load_lds((const GAS unsigned*)((bb) + (koff) + (pp)[h][_i]), (LAS unsigned*)(lds + (bufoff) + ldsw + _i * 8192), 16, 0, 0); } while (0)
#define PG8_LDA(dst, b, h) do { _Pragma("unroll") for (int m = 0; m < 4; ++m) _Pragma("unroll") for (int k = 0; k < 2; ++k) dst[m][k] = *(const LAS bf16x8*)(lds + PG8_SA(b, h) + aoff + m * 2048 + k * 1024); } while (0)
#define PG8_LDB(dst, b, h) do { _Pragma("unroll") for (int n = 0; n < 2; ++n) _Pragma("unroll") for (int k = 0; k < 2; ++k) dst[n][k] = *(const LAS bf16x8*)(lds + PG8_SB(b, h) + boff + n * 2048 + k * 1024); } while (0)
#define PG8_MMA(ai, bj, At, Bt) do { __builtin_amdgcn_s_setprio(1); _Pragma("unroll") for (int m = 0; m < 4; ++m) _Pragma("unroll") for (int n = 0; n < 2; ++n) _Pragma("unroll") for (int k = 0; k < 2; ++k) \
        acc[ai][bj][m][n] = __builtin_amdgcn_mfma_f32_16x16x32_bf16(Bt[n][k], At[m][k], acc[ai][bj][m][n], 0, 0, 0); __builtin_amdgcn_s_setprio(0); } while (0)
#define PG8_WAIT_V(n) asm volatile("s_waitcnt vmcnt(" #n ")" ::: "memory")
#define PG8_WAIT_L(n) asm volatile("s_waitcnt lgkmcnt(" #n ")" ::: "memory")
#define PG8_BAR __builtin_amdgcn_s_barrier()
#define PG8_SCHED __builtin_amdgcn_sched_barrier(0)
    MUnit cur, nxt; int ui = 0;
    if (!S.next(0, cur)) return;
    f32x4 acc[2][2][4][2];
#pragma unroll
    for (int a = 0; a < 2; ++a)
#pragma unroll
        for (int b = 0; b < 2; ++b)
#pragma unroll
            for (int m = 0; m < 4; ++m)
#pragma unroll
                for (int n = 0; n < 2; ++n) acc[a][b][m][n] = (f32x4){0.f, 0.f, 0.f, 0.f};
    bf16x8 At[4][2], B0[2][2], B1[2][2];
    unsigned pA[2][2], qA[2][2];
    P.aoffs(cur, R0, C0, R1, C1, pA);
    const char* cAb = P.abase(cur);
    E.prep(cur, lds, 0, tid);
    const char* cB = P.bptr(cur);
    PG8_STAGEB(PG8_SB(0, 0), cB, 0); PG8_STAGEA(PG8_SA(0, 0), cAb, pA, 0, 0); PG8_STAGEB(PG8_SB(0, 1), cB, 1); PG8_STAGEA(PG8_SA(0, 1), cAb, pA, 1, 0);
    if (wr == 1) PG8_BAR;
    PG8_WAIT_V(4); PG8_BAR;
    PG8_STAGEB(PG8_SB(1, 0), cB + kstep, 0); PG8_STAGEA(PG8_SA(1, 0), cAb, pA, 0, kstep); PG8_STAGEB(PG8_SB(1, 1), cB + kstep, 1);
    PG8_WAIT_V(6); PG8_BAR;
    for (;;) {
        const bool has_next = S.next(ui + 1, nxt);
        const char* nB = cB; const char* nAb = cAb;
#pragma unroll
        for (int h = 0; h < 2; ++h) { qA[h][0] = pA[h][0]; qA[h][1] = pA[h][1]; }
        if (has_next) { P.aoffs(nxt, R0, C0, R1, C1, qA); nAb = P.abase(nxt); nB = P.bptr(nxt); E.prep(nxt, lds, (ui + 1) % 3, tid); }
#pragma unroll 1
        for (int t = 0; t < nt; t += 2) {
            const bool last = (t == nt - 2);
            const size_t k1 = (size_t)(t + 1) * kstep;
            const size_t k2 = last ? 0 : (size_t)(t + 2) * kstep, k3 = k2 + kstep;
            const char* b2 = last ? nB : cB + k2; const char* b3 = b2 + kstep;
            const char* a2 = last ? nAb : cAb;
            unsigned o2[2][2];
#pragma unroll
            for (int h = 0; h < 2; ++h) { o2[h][0] = last ? qA[h][0] : pA[h][0]; o2[h][1] = last ? qA[h][1] : pA[h][1]; }
            PG8_LDB(B0, 0, 0); PG8_SCHED; PG8_LDA(At, 0, 0); PG8_STAGEA(PG8_SA(1, 1), cAb, pA, 1, k1);
            PG8_WAIT_L(8); PG8_BAR; PG8_WAIT_L(0); PG8_MMA(0, 0, At, B0); PG8_BAR; PG8_SCHED;
            PG8_LDB(B1, 0, 1); PG8_STAGEB(PG8_SB(0, 0), b2, 0);
            PG8_BAR; PG8_WAIT_L(0); PG8_MMA(0, 1, At, B1); PG8_BAR;
            PG8_LDA(At, 0, 1); PG8_STAGEA(PG8_SA(0, 0), a2, o2, 0, k2);
            PG8_BAR; PG8_WAIT_L(0); PG8_MMA(1, 0, At, B0); PG8_BAR; PG8_SCHED;
            PG8_STAGEB(PG8_SB(0, 1), b2, 1);
            PG8_WAIT_V(6); PG8_BAR; PG8_MMA(1, 1, At, B1); PG8_BAR;
            PG8_LDB(B0, 1, 0); PG8_SCHED; PG8_LDA(At, 1, 0); PG8_STAGEA(PG8_SA(0, 1), a2, o2, 1, k2);
            PG8_WAIT_L(8); PG8_BAR; PG8_WAIT_L(0); PG8_MMA(0, 0, At, B0); PG8_BAR; PG8_SCHED;
            PG8_LDB(B1, 1, 1); PG8_STAGEB(PG8_SB(1, 0), b3, 0);
            PG8_BAR; PG8_WAIT_L(0); PG8_MMA(0, 1, At, B1); PG8_BAR;
            PG8_LDA(At, 1, 1); PG8_STAGEA(PG8_SA(1, 0), a2, o2, 0, k3);
            PG8_BAR; PG8_WAIT_L(0); PG8_MMA(1, 0, At, B0); PG8_BAR; PG8_SCHED;
            PG8_STAGEB(PG8_SB(1, 1), b3, 1);
            PG8_WAIT_V(6); PG8_BAR; PG8_MMA(1, 1, At, B1); PG8_BAR;
        }
        E(acc, cur, wr, wc, fr, fq, lds, ui % 3);
        if (!has_next) break;
#pragma unroll
        for (int a = 0; a < 2; ++a)
#pragma unroll
            for (int b = 0; b < 2; ++b)
#pragma unroll
                for (int m = 0; m < 4; ++m)
#pragma unroll
                    for (int n = 0; n < 2; ++n) acc[a][b][m][n] = (f32x4){0.f, 0.f, 0.f, 0.f};
        cur = nxt; cB = nB; cAb = nAb; ++ui;
#pragma unroll
        for (int h = 0; h < 2; ++h) { pA[h][0] = qA[h][0]; pA[h][1] = qA[h][1]; }
    }
    PG8_WAIT_V(0);
    if (wr == 0) PG8_BAR;
    PG8_BAR;
#undef PG8_SA
#undef PG8_SB
#undef PG8_STAGEA
#undef PG8_STAGEB
#undef PG8_LDA
#undef PG8_LDB
#undef PG8_MMA
#undef PG8_WAIT_V
#undef PG8_WAIT_L
#undef PG8_BAR
#undef PG8_SCHED
}
}

constexpr int AT_K0 = 0, AT_V0 = 17408, AT_KVB = 35840, AT_FL = 71680, AT_QS = 71936;
DI void attn_phase(const bf16_t* Qb, const bf16_t* Kb, const bf16_t* Vt, bf16_t* O, LAS unsigned char* lds, int tid, int wid, int lane) {
    const int fr = lane & 15, fq = lane >> 4;
    LAS int* flags = (LAS int*)(lds + AT_FL);
    for (int bx = blockIdx.x; bx < 512; bx += gridDim.x) {
        const int rnd = bx >> 8, pos = bx & 255;
        const int qb = (rnd & 1) ? (pos >> 6) : (7 - (pos >> 6));
        const int bh = pos & 63, b = bh >> 4, h = bh & 15;
        const int t0 = qb * 256;
        __syncthreads();
        const int kr0 = tid >> 4, kc = tid & 15, vr0 = tid >> 3, vc = tid & 7;
        const bf16_t* kg = Kb + (size_t)(b * SEQ + kr0) * D + h * 128 + kc * 8;
        const bf16_t* vg = Vt + (size_t)(h * 128 + vr0) * T + b * SEQ + vc * 8;
        u32x4 pk0, pk1, pv0, pv1;
        int s0 = t0 + 192;
        pk0 = *(const u32x4*)(kg + (size_t)s0 * D); pk1 = *(const u32x4*)(kg + (size_t)(s0 + 32) * D);
        pv0 = *(const u32x4*)(vg + s0); pv1 = *(const u32x4*)(vg + (size_t)64 * T + s0);
#pragma unroll
        for (int c8 = 0; c8 < 8; ++c8) {
            const int c = tid + 512 * c8, row = c >> 4, c16 = c & 15;
            *(LAS u32x4*)(lds + AT_QS + row * 272 + c16 * 16) = *(const u32x4*)(Qb + (size_t)(b * SEQ + t0 + row) * D + h * 128 + c16 * 8);
        }
        {
            LAS unsigned char* kb_ = lds + AT_K0; LAS unsigned char* vb_ = lds + AT_V0;
            *(LAS u32x4*)(kb_ + kr0 * 272 + kc * 16) = pk0; *(LAS u32x4*)(kb_ + (kr0 + 32) * 272 + kc * 16) = pk1;
            *(LAS u32x4*)(vb_ + vr0 * 144 + vc * 16) = pv0; *(LAS u32x4*)(vb_ + (vr0 + 64) * 144 + vc * 16) = pv1;
            const int s1 = s0 - 64;
            pk0 = *(const u32x4*)(kg + (size_t)s1 * D); pk1 = *(const u32x4*)(kg + (size_t)(s1 + 32) * D); pv0 = *(const u32x4*)(vg + s1); pv1 = *(const u32x4*)(vg + (size_t)64 * T + s1);
        }
        __syncthreads();
        f32x4 oacc[2][8];
#pragma unroll
        for (int r = 0; r < 2; ++r)
#pragma unroll
            for (int n = 0; n < 8; ++n) oacc[r][n] = (f32x4){0.f, 0.f, 0.f, 0.f};
        float Rrun[2] = {1.f, 1.f};
        bool wave_alive = true;
        int it = 0;
        for (;; ++it, s0 -= 64) {
            int zz = 0; asm volatile("" : "+v"(zz));
            const LAS unsigned char* kb_ = lds + zz + AT_K0 + (it & 1) * AT_KVB; const LAS unsigned char* vb_ = lds + zz + AT_V0 + (it & 1) * AT_KVB;
            const bool wave_on = (s0 < t0 + 32 * wid + 31) && wave_alive;
            if (wave_on) {
            f32x4 sacc[2][4];
#pragma unroll
            for (int r = 0; r < 2; ++r)
#pragma unroll
                for (int n = 0; n < 4; ++n) sacc[r][n] = (f32x4){0.f, 0.f, 0.f, 0.f};
#pragma unroll
            for (int ks = 0; ks < 4; ++ks) {
                const bf16x8 qa0 = *(const LAS bf16x8*)(lds + zz + AT_QS + (32 * wid + fr) * 272 + (ks * 32 + fq * 8) * 2);
                const bf16x8 qa1 = *(const LAS bf16x8*)(lds + zz + AT_QS + (32 * wid + 16 + fr) * 272 + (ks * 32 + fq * 8) * 2);
#pragma unroll
                for (int n = 0; n < 4; ++n) {
                    const bf16x8 kf = *(const LAS bf16x8*)(kb_ + (16 * n + fr) * 272 + (ks * 32 + fq * 8) * 2);
                    sacc[0][n] = MFMA16(kf, qa0, sacc[0][n]);
                    sacc[1][n] = MFMA16(kf, qa1, sacc[1][n]);
                }
            }
            unsigned ap[2][4][2];
            const int sb = s0 + 4 * fq;
#pragma unroll
            for (int r = 0; r < 2; ++r) {
                const int tq = t0 + 32 * wid + 16 * r + fr;
                float apart[4][4], gprod[4];
#pragma unroll
                for (int n = 0; n < 4; ++n) {
                    float run = 1.f;
#pragma unroll
                    for (int j = 3; j >= 0; --j) {
                        const float zz = ((sb + 16 * n + j) < tq) ? fminf(sacc[r][n][j], 80.f) : -200.f;
                        const float p2 = __builtin_amdgcn_exp2f(zz);
                        const float om = __builtin_amdgcn_rcpf(1.0f + p2);
                        apart[n][j] = p2 * om * run;
                        run *= om;
                    }
                    gprod[n] = run;
                }
                float offs[4]; float acc_after = 1.f;
#pragma unroll
                for (int n = 3; n >= 0; --n) {
                    const float bq = __shfl_xor(gprod[n], 16); const float s01 = gprod[n] * bq; const float oth = __shfl_xor(s01, 32);
                    offs[n] = Rrun[r] * acc_after * (((fq & 1) == 0) ? bq : 1.f) * ((fq < 2) ? oth : 1.f);
                    acc_after *= s01 * oth;
                }
                Rrun[r] *= acc_after;
#pragma unroll
                for (int n = 0; n < 4; ++n) { ap[r][n][0] = pk2(apart[n][0] * offs[n], apart[n][1] * offs[n]); ap[r][n][1] = pk2(apart[n][2] * offs[n], apart[n][3] * offs[n]); }
            }
#pragma unroll
            for (int u = 0; u < 2; ++u) {
                const bf16x8 aa0 = __builtin_bit_cast(bf16x8, ((u32x4){ap[0][2 * u][0], ap[0][2 * u][1], ap[0][2 * u + 1][0], ap[0][2 * u + 1][1]}));
                const bf16x8 aa1 = __builtin_bit_cast(bf16x8, ((u32x4){ap[1][2 * u][0], ap[1][2 * u][1], ap[1][2 * u + 1][0], ap[1][2 * u + 1][1]}));
#pragma unroll
                for (int n = 0; n < 8; ++n) {
                    const s16x4 vlo = *(const LAS s16x4*)(vb_ + (16 * n + fr) * 144 + (32 * u + 4 * fq) * 2);
                    const s16x4 vhi = *(const LAS s16x4*)(vb_ + (16 * n + fr) * 144 + (32 * u + 16 + 4 * fq) * 2);
                    const bf16x8 vf = __builtin_shufflevector(vlo, vhi, 0, 1, 2, 3, 4, 5, 6, 7);
                    oacc[0][n] = MFMA16(vf, aa0, oacc[0][n]);
                    oacc[1][n] = MFMA16(vf, aa1, oacc[1][n]);
                }
            }
            }
            const int sn1 = s0 - 64, sn2 = s0 - 128;
            wave_alive = __any(fmaxf(Rrun[0], Rrun[1]) > 0.f);
            if (lane == 0) flags[(it & 1) * 8 + wid] = wave_alive ? 1 : 0;
            if (sn1 >= 0) {
                LAS unsigned char* kn = lds + AT_K0 + ((it + 1) & 1) * AT_KVB; LAS unsigned char* vn = lds + AT_V0 + ((it + 1) & 1) * AT_KVB;
                *(LAS u32x4*)(kn + kr0 * 272 + kc * 16) = pk0; *(LAS u32x4*)(kn + (kr0 + 32) * 272 + kc * 16) = pk1;
                *(LAS u32x4*)(vn + vr0 * 144 + vc * 16) = pv0; *(LAS u32x4*)(vn + (vr0 + 64) * 144 + vc * 16) = pv1;
                if (sn2 >= 0) { pk0 = *(const u32x4*)(kg + (size_t)sn2 * D); pk1 = *(const u32x4*)(kg + (size_t)(sn2 + 32) * D); pv0 = *(const u32x4*)(vg + sn2); pv1 = *(const u32x4*)(vg + (size_t)64 * T + sn2); }
            }
            __syncthreads();
            if (sn1 < 0) break;
            int any_alive = 0;
#pragma unroll
            for (int w = 0; w < 8; ++w) any_alive |= flags[(it & 1) * 8 + w];
            if (!any_alive) break;
        }
#pragma unroll
        for (int r = 0; r < 2; ++r) {
            bf16_t* orow = O + (size_t)(b * SEQ + t0 + 32 * wid + 16 * r + fr) * D + h * 128 + 4 * fq;
#pragma unroll
            for (int n = 0; n < 8; ++n) { u32x2 o; o.x = pk2(oacc[r][n].x, oacc[r][n].y); o.y = pk2(oacc[r][n].z, oacc[r][n].w); *(u32x2*)(orow + 16 * n) = o; }
        }
    }
}

constexpr int ML_QS = 0, ML_KS = 17408, ML_KD = 34816, ML_VT = 53248, ML_WS = 90112, ML_HB = 99328, ML_SC = 133120;
DI float ml_tab(LAS float* tab, float gi, float gf, float mprev, int lane) {
    const float flog = fminf(gf, 0.f) - __logf(1.0f + __expf(-fabsf(gf)));
    float bb = flog;
#pragma unroll
    for (int o = 1; o < 64; o <<= 1) { const float v = __shfl_up(bb, o); if (lane >= o) bb += v; }
    const float a = gi - bb;
    float pm = a;
#pragma unroll
    for (int o = 1; o < 64; o <<= 1) { const float v = __shfl_up(pm, o); if (lane >= o) pm = fmaxf(pm, v); }
    const float amax = __shfl(pm, 63), bL = __shfl(bb, 63);
    const float Mx = fmaxf(mprev, amax);
    tab[lane] = a; tab[64 + lane] = bb; tab[128 + lane] = fmaxf(pm, mprev);
    if (lane == 0) { tab[192] = mprev; tab[193] = Mx; }
    return bL + Mx;
}
constexpr int MLA_KD = 0, MLA_SC = 69632;
DI void mlstm_local(const bf16_t* K1, const bf16_t* VT, const float* G, const float* b_i, const float* b_f, bf16_t* KV, float* NJ, float* SUM,
                    LAS unsigned char* lds, int tid, int wid, int lane) {
    const int fr = lane & 15, fq = lane >> 4;
    LAS float* sa = (LAS float*)(lds + MLA_SC); LAS float* swsum = sa + 256; LAS float* swmax = sa + 264;
    for (int unit0 = blockIdx.x; unit0 < 256; unit0 += gridDim.x) {
        const int unit = (gridDim.x == 256) ? (unit0 & 7) * 32 + (unit0 >> 3) : unit0;
        const int J = unit & 7, bh = unit >> 3, b = bh >> 3, h = bh & 7;
        if (J == 7) continue;
        const int tok0 = b * SEQ + J * 256;
        __syncthreads();
        float a = 0.f, bb = 0.f;
        if (tid < 256) {
            const size_t g0 = (size_t)(tok0 + tid) * 16;
            const float gi = G[g0 + h] + b_i[h], gf = G[g0 + 8 + h] + b_f[h];
            const float flog = fminf(gf, 0.f) - __logf(1.0f + __expf(-fabsf(gf)));
            bb = flog;
#pragma unroll
            for (int o = 1; o < 64; o <<= 1) { const float v = __shfl_up(bb, o); if (lane >= o) bb += v; }
            if (lane == 63) swsum[wid] = bb;
        }
        __syncthreads();
        if (tid < 256) {
            float off = 0.f;
            for (int w = 0; w < 4; ++w) off += (w < wid) ? swsum[w] : 0.f;
            bb += off;
            const size_t g0 = (size_t)(tok0 + tid) * 16;
            a = (G[g0 + h] + b_i[h]) - bb;
            float mx = a;
#pragma unroll
            for (int o = 1; o < 64; o <<= 1) mx = fmaxf(mx, __shfl_xor(mx, o));
            if (lane == 0) swmax[wid] = mx;
            sa[tid] = a;
        }
        __syncthreads();
        const float amax = fmaxf(fmaxf(swmax[0], swmax[1]), fmaxf(swmax[2], swmax[3]));
        if (tid == 255) { SUM[unit * 2] = amax; SUM[unit * 2 + 1] = bb; }
        bf16x8 vfa[8][2];
#pragma unroll
        for (int ks = 0; ks < 8; ++ks)
#pragma unroll
            for (int et = 0; et < 2; ++et) vfa[ks][et] = *(const bf16x8*)(VT + (size_t)(h * 256 + 32 * wid + 16 * et + fr) * T + tok0 + ks * 32 + fq * 8);
#pragma unroll 2
        for (int c8i = 0; c8i < 8; ++c8i) {
            const int ch = tid + 512 * c8i, sp = ch & 255, c16 = ch >> 8;
            const u32x4 v = *(const u32x4*)(K1 + (size_t)(tok0 + sp) * 1024 + h * 128 + c16 * 8);
            const float dsc = __expf(sa[sp] - amax);
            const unsigned w[4] = {v.x, v.y, v.z, v.w};
            LAS bf16_t* dst = (LAS bf16_t*)(lds + MLA_KD + (c16 * 8) * 528 + sp * 2);
#pragma unroll
            for (int q = 0; q < 4; ++q) { dst[(2 * q) * 264] = (bf16_t)f2bf(bf2f(w[q] & 0xffff) * dsc); dst[(2 * q + 1) * 264] = (bf16_t)f2bf(bf2f(w[q] >> 16) * dsc); }
        }
        __syncthreads();
        f32x4 C[8][2];
#pragma unroll
        for (int dt = 0; dt < 8; ++dt)
#pragma unroll
            for (int et = 0; et < 2; ++et) C[dt][et] = (f32x4){0.f, 0.f, 0.f, 0.f};
#pragma unroll
        for (int ks = 0; ks < 8; ++ks) {
#pragma unroll
            for (int dt = 0; dt < 8; ++dt) {
                const bf16x8 kf = *(const LAS bf16x8*)(lds + MLA_KD + (16 * dt + fr) * 528 + (ks * 32 + fq * 8) * 2);
#pragma unroll
                for (int et = 0; et < 2; ++et) C[dt][et] = MFMA16(kf, vfa[ks][et], C[dt][et]);
            }
        }
        bf16_t* kv = KV + (size_t)unit * 32768;
#pragma unroll
        for (int dt = 0; dt < 8; ++dt)
#pragma unroll
            for (int et = 0; et < 2; ++et) { u32x2 o; o.x = pk2(C[dt][et].x, C[dt][et].y); o.y = pk2(C[dt][et].z, C[dt][et].w); *(u32x2*)(kv + (size_t)(32 * wid + 16 * et + fr) * 128 + 16 * dt + 4 * fq) = o; }
        {
            const int dl = tid >> 2, sl = tid & 3;
            float p = 0.f;
#pragma unroll
            for (int i = 0; i < 8; ++i) {
                const u32x4 kq = *(const LAS u32x4*)(lds + MLA_KD + dl * 528 + sl * 128 + i * 16);
                p += (bf2f(kq.x & 0xffff) + bf2f(kq.x >> 16)) + (bf2f(kq.y & 0xffff) + bf2f(kq.y >> 16)) + (bf2f(kq.z & 0xffff) + bf2f(kq.z >> 16)) + (bf2f(kq.w & 0xffff) + bf2f(kq.w >> 16));
            }
            p += __shfl_xor(p, 1); p += __shfl_xor(p, 2);
            if (sl == 0) NJ[unit * 128 + dl] = p;
        }
    }
}
template <int skip>
DI void mlstm_phase(const bf16_t* Q1, const bf16_t* K1, const bf16_t* VT, const bf16_t* OG, const float* G, const float* b_i, const float* b_f,
                    const float* g_head, bf16_t* HS, const bf16_t* KV, const float* NJ, const float* SUM, LAS unsigned char* lds, int tid, int wid, int lane, int nsteps = 4) {
    const int fr = lane & 15, fq = lane >> 4;
    LAS float* sc = (LAS float*)(lds + ML_SC); LAS float* sssq = sc + 1024; LAS float* srs = sc + 1536; LAS float* sden = sc + 1792; LAS float* sn = sc + 1856; LAS float* sgh = sc + 2112; LAS float* scf = sc + 2368;
    LAS bf16_t* hb = (LAS bf16_t*)(lds + ML_HB);
    for (int unit0 = blockIdx.x; unit0 < 256; unit0 += gridDim.x) {
        const int unit = (gridDim.x == 256) ? (unit0 & 7) * 32 + (unit0 >> 3) : unit0;
        const int J = unit & 7, bh = unit >> 3, b = bh >> 3, h = bh & 7;
        const int c0 = 4 * J, c1 = c0 + nsteps;
        __syncthreads();
        if (wid < 4) {
            LAS float* tab = sc + wid * 256;
            const size_t g0 = (size_t)(b * SEQ + (c0 + wid) * 64 + lane) * 16;
            const float gi = G[g0 + h] + b_i[h], gf = G[g0 + 8 + h] + b_f[h];
            const float flog = fminf(gf, 0.f) - __logf(1.0f + __expf(-fabsf(gf)));
            float bb = flog;
#pragma unroll
            for (int o = 1; o < 64; o <<= 1) { const float v = __shfl_up(bb, o); if (lane >= o) bb += v; }
            const float a = gi - bb;
            float pm = a;
#pragma unroll
            for (int o = 1; o < 64; o <<= 1) { const float v = __shfl_up(pm, o); if (lane >= o) pm = fmaxf(pm, v); }
            tab[lane] = a; tab[64 + lane] = bb; tab[128 + lane] = pm;
            if (lane == 63) { tab[192] = pm; tab[193] = bb; }
        }
        if (tid >= 448 && tid < 462) scf[8 + tid - 448] = SUM[bh * 16 + tid - 448];
        __syncthreads();
        if (tid == 0) {
            float cf[7]; float m0 = 0.f;
#pragma unroll
            for (int jp = 0; jp < 7; ++jp) {
                cf[jp] = 0.f;
                if (jp < J) {
                    const float am = scf[8 + 2 * jp], bl = scf[9 + 2 * jp];
                    const float M63 = fmaxf(m0, am), csj = __expf(m0 - M63);
#pragma unroll
                    for (int i = 0; i < 7; ++i) if (i < jp) cf[i] *= csj;
                    cf[jp] = __expf(am - M63);
                    m0 = bl + M63;
                }
            }
#pragma unroll
            for (int jp = 0; jp < 7; ++jp) scf[jp] = cf[jp];
            scf[7] = m0;
        }
        __syncthreads();
        const float m0 = scf[7];
        f32x4 C[8][2];
#pragma unroll
        for (int dt = 0; dt < 8; ++dt)
#pragma unroll
            for (int et = 0; et < 2; ++et) C[dt][et] = (f32x4){0.f, 0.f, 0.f, 0.f};
        float n0 = 0.f;
#pragma unroll 1
        for (int jp = 0; jp < J; ++jp) {
            const bf16_t* kv = KV + (size_t)(bh * 8 + jp) * 32768; const float cf = scf[jp];
#pragma unroll
            for (int dt = 0; dt < 8; ++dt)
#pragma unroll
                for (int et = 0; et < 2; ++et) { const u32x2 v = *(const u32x2*)(kv + (size_t)(32 * wid + 16 * et + fr) * 128 + 16 * dt + 4 * fq);
                    C[dt][et].x += cf * bf2f(v.x & 0xffff); C[dt][et].y += cf * bf2f(v.x >> 16); C[dt][et].z += cf * bf2f(v.y & 0xffff); C[dt][et].w += cf * bf2f(v.y >> 16); }
            if (tid < 128) n0 += cf * NJ[(bh * 8 + jp) * 128 + tid];
        }
        if (tid < 128) sn[tid] = n0;
        if (tid >= 256) sgh[tid - 256] = g_head[h * 256 + tid - 256];
        __syncthreads();
        if (tid == 0) { float m = m0; for (int cc = 0; cc < 4; ++cc) { LAS float* tab = sc + cc * 256; const float M63 = fmaxf(m, tab[192]); tab[194] = m; tab[195] = M63; m = tab[193] + M63; } }
        __syncthreads();
        u32x4 rq[2], rk[2], rt[2], rv[4];
#define ML_LOAD(cc) do { const int tk_ = b * SEQ + (cc) * 64; _Pragma("unroll") for (int c2 = 0; c2 < 2; ++c2) { const int ch = tid + 512 * c2; \
            rq[c2] = *(const u32x4*)(Q1 + (size_t)(tk_ + (ch >> 4)) * 1024 + h * 128 + (ch & 15) * 8); rk[c2] = *(const u32x4*)(K1 + (size_t)(tk_ + (ch >> 4)) * 1024 + h * 128 + (ch & 15) * 8); \
            rt[c2] = *(const u32x4*)(K1 + (size_t)(tk_ + (ch & 63)) * 1024 + h * 128 + (ch >> 6) * 8); } \
        _Pragma("unroll") for (int c4 = 0; c4 < 4; ++c4) { const int ch = tid + 512 * c4; rv[c4] = *(const u32x4*)(VT + (size_t)(h * 256 + (ch >> 3)) * T + tk_ + (ch & 7) * 8); } } while (0)
#define ML_STORE(cc) do { const LAS float* tb_ = sc + ((cc) - c0) * 256; const float M63_ = tb_[195]; _Pragma("unroll") for (int c2 = 0; c2 < 2; ++c2) { const int ch = tid + 512 * c2; \
            *(LAS u32x4*)(lds + ML_QS + (ch >> 4) * 272 + (ch & 15) * 16) = rq[c2]; *(LAS u32x4*)(lds + ML_KS + (ch >> 4) * 272 + (ch & 15) * 16) = rk[c2]; \
            const int sp = ch & 63, c16 = ch >> 6; const float dsc = __expf(tb_[sp] - M63_); const unsigned w_[4] = {rt[c2].x, rt[c2].y, rt[c2].z, rt[c2].w}; \
            LAS bf16_t* dst = (LAS bf16_t*)(lds + ML_KD + (c16 * 8) * 144 + sp * 2); \
            _Pragma("unroll") for (int q = 0; q < 4; ++q) { dst[(2 * q) * 72] = (bf16_t)f2bf(bf2f(w_[q] & 0xffff) * dsc); dst[(2 * q + 1) * 72] = (bf16_t)f2bf(bf2f(w_[q] >> 16) * dsc); } } \
        _Pragma("unroll") for (int c4 = 0; c4 < 4; ++c4) { const int ch = tid + 512 * c4; *(LAS u32x4*)(lds + ML_VT + (ch >> 3) * 144 + (ch & 7) * 16) = rv[c4]; } } while (0)
        if (c0 < c1) { ML_LOAD(c0); ML_STORE(c0); }
#pragma unroll 1
        for (int c = c0; c < c1; ++c) {
            int zz = 0; asm volatile("" : "+v"(zz));
            LAS unsigned char* const L = lds + zz; LAS float* const scz = (LAS float*)(L + ML_SC);
            LAS float* const sssq = scz + 1024; LAS float* const srs = scz + 1536; LAS float* const sden = scz + 1792; LAS float* const sn = scz + 1856; LAS float* const sgh = scz + 2112; LAS bf16_t* const hb = (LAS bf16_t*)(L + ML_HB);
            const int tok0 = b * SEQ + c * 64;
            const LAS float* tab = scz + (c - c0) * 256;
            LAS float* sncur = sn + ((c - c0) & 1) * 128; LAS float* snnxt = sn + (((c - c0) & 1) ^ 1) * 128;
            __syncthreads();
            const float mprev = tab[194], M63 = tab[195];
            if (!(skip & 1)) {
                const int tb = wid >> 1;
#pragma unroll
                for (int a2 = 0; a2 < 2; ++a2) {
                    const int sa_t = 2 * (wid & 1) + a2;
                    u32x2 o = (u32x2){0u, 0u}; float rsum = 0.f;
                    if (sa_t <= tb) {
                        f32x4 acc = (f32x4){0.f, 0.f, 0.f, 0.f};
#pragma unroll
                        for (int ks = 0; ks < 4; ++ks) {
                            const bf16x8 kf = *(const LAS bf16x8*)(L + ML_KS + (16 * sa_t + fr) * 272 + (ks * 32 + fq * 8) * 2);
                            const bf16x8 qf = *(const LAS bf16x8*)(L + ML_QS + (16 * tb + fr) * 272 + (ks * 32 + fq * 8) * 2);
                            acc = MFMA16(kf, qf, acc);
                        }
                        const int tl = 16 * tb + fr; const float Mt = fmaxf(tab[128 + tl], mprev);
                        float wv[4];
#pragma unroll
                        for (int j = 0; j < 4; ++j) { const int sl = 16 * sa_t + 4 * fq + j; wv[j] = (sl <= tl) ? acc[j] * __expf(tab[sl] - Mt) : 0.f; }
                        o.x = pk2(wv[0], wv[1]); o.y = pk2(wv[2], wv[3]);
                        rsum = (wv[0] + wv[1]) + (wv[2] + wv[3]);
                        rsum += __shfl_xor(rsum, 16); rsum += __shfl_xor(rsum, 32);
                    }
                    *(LAS u32x2*)(L + ML_WS + (16 * tb + fr) * 144 + (16 * sa_t + 4 * fq) * 2) = o;
                    if (fq == 0) srs[sa_t * 64 + 16 * tb + fr] = rsum;
                }
            }
            __syncthreads();
            if (!(skip & 2)) {
                const int tl = tid >> 3, sl = tid & 7;
                const u32x4 qa = *(const LAS u32x4*)(L + ML_QS + tl * 272 + sl * 32), qb = *(const LAS u32x4*)(L + ML_QS + tl * 272 + sl * 32 + 16);
                const unsigned qw[8] = {qa.x, qa.y, qa.z, qa.w, qb.x, qb.y, qb.z, qb.w};
                float p = 0.f;
#pragma unroll
                for (int k = 0; k < 8; ++k) p += bf2f(qw[k] & 0xffff) * sncur[sl * 16 + 2 * k] + bf2f(qw[k] >> 16) * sncur[sl * 16 + 2 * k + 1];
                p += __shfl_xor(p, 1); p += __shfl_xor(p, 2); p += __shfl_xor(p, 4);
                if (sl == 0) sden[tl] = __expf(mprev - fmaxf(tab[128 + tl], mprev)) * p + (srs[tl] + srs[64 + tl]) + (srs[128 + tl] + srs[192 + tl]);
            }
#pragma unroll 1
            for (int tt = 0; tt < ((skip & 4) ? 0 : 4); ++tt) {
                f32x4 num[2];
#pragma unroll
                for (int et = 0; et < 2; ++et) num[et] = (f32x4){0.f, 0.f, 0.f, 0.f};
#pragma unroll
                for (int u = 0; u < 4; ++u) {
                    const s16x4 qlo = *(const LAS s16x4*)(L + ML_QS + (16 * tt + fr) * 272 + (32 * u + 4 * fq) * 2);
                    const s16x4 qhi = *(const LAS s16x4*)(L + ML_QS + (16 * tt + fr) * 272 + (32 * u + 16 + 4 * fq) * 2);
                    const bf16x8 qf = __builtin_shufflevector(qlo, qhi, 0, 1, 2, 3, 4, 5, 6, 7);
#pragma unroll
                    for (int et = 0; et < 2; ++et) {
                        const f32x4 c0v = C[2 * u][et], c1v = C[2 * u + 1][et];
                        u32x4 pb; pb.x = pk2(c0v.x, c0v.y); pb.y = pk2(c0v.z, c0v.w); pb.z = pk2(c1v.x, c1v.y); pb.w = pk2(c1v.z, c1v.w);
                        num[et] = MFMA16(qf, __builtin_bit_cast(bf16x8, pb), num[et]);
                    }
                }
                float scv[4];
#pragma unroll
                for (int j = 0; j < 4; ++j) scv[j] = __expf(mprev - fmaxf(tab[128 + 16 * tt + 4 * fq + j], mprev));
#pragma unroll
                for (int et = 0; et < 2; ++et) { num[et].x *= scv[0]; num[et].y *= scv[1]; num[et].z *= scv[2]; num[et].w *= scv[3]; }
                const int nks = (tt < 2) ? 1 : 2;
                for (int ks = 0; ks < nks; ++ks) {
                    const bf16x8 wf = *(const LAS bf16x8*)(L + ML_WS + (16 * tt + fr) * 144 + (ks * 32 + fq * 8) * 2);
#pragma unroll
                    for (int et = 0; et < 2; ++et) {
                        const bf16x8 vf = *(const LAS bf16x8*)(L + ML_VT + (32 * wid + 16 * et + fr) * 144 + (ks * 32 + fq * 8) * 2);
                        num[et] = MFMA16(wf, vf, num[et]);
                    }
                }
#pragma unroll
                for (int j = 0; j < 4; ++j) {
                    const int tl = 16 * tt + 4 * fq + j;
                    const float h0 = num[0][j], h1 = num[1][j];
                    hb[tl * 264 + 32 * wid + fr] = (bf16_t)f2bf(h0);
                    hb[tl * 264 + 32 * wid + 16 + fr] = (bf16_t)f2bf(h1);
                    float s = h0 * h0 + h1 * h1;
                    s += dpp_f(s, 0xB1); s += dpp_f(s, 0x4E); s += dpp_f(s, 0x141); s += dpp_f(s, 0x140);
                    if (fr == 0) sssq[wid * 64 + tl] = s;
                }
            }
            const float cs = __expf(mprev - M63);
            if (!(skip & 8)) {
#pragma unroll
                for (int dt = 0; dt < 8; ++dt)
#pragma unroll
                    for (int et = 0; et < 2; ++et) { C[dt][et].x *= cs; C[dt][et].y *= cs; C[dt][et].z *= cs; C[dt][et].w *= cs; }
#pragma unroll
                for (int ks = 0; ks < 2; ++ks) {
                    bf16x8 vf[2];
#pragma unroll
                    for (int et = 0; et < 2; ++et) vf[et] = *(const LAS bf16x8*)(L + ML_VT + (32 * wid + 16 * et + fr) * 144 + (ks * 32 + fq * 8) * 2);
#pragma unroll
                    for (int dt = 0; dt < 8; ++dt) {
                        const bf16x8 kf = *(const LAS bf16x8*)(L + ML_KD + (16 * dt + fr) * 144 + (ks * 32 + fq * 8) * 2);
#pragma unroll
                        for (int et = 0; et < 2; ++et) C[dt][et] = MFMA16(kf, vf[et], C[dt][et]);
                    }
                }
            }
            {
                const int dl = tid >> 2, sl = tid & 3;
                const u32x4 ka = *(const LAS u32x4*)(L + ML_KD + dl * 144 + sl * 32), kb = *(const LAS u32x4*)(L + ML_KD + dl * 144 + sl * 32 + 16);
                const unsigned kw[8] = {ka.x, ka.y, ka.z, ka.w, kb.x, kb.y, kb.z, kb.w};
                float p = 0.f;
#pragma unroll
                for (int k = 0; k < 8; ++k) p += bf2f(kw[k] & 0xffff) + bf2f(kw[k] >> 16);
                p += __shfl_xor(p, 1); p += __shfl_xor(p, 2);
                if (sl == 0) snnxt[dl] = cs * sncur[dl] + p;
            }
            __syncthreads();
            if (skip & 16) { if (c + 1 < c1) ML_LOAD(c + 1); } else {
                const int tl = tid >> 3, part = tid & 7;
                u32x4 ovq[4];
#pragma unroll
                for (int q = 0; q < 4; ++q) ovq[q] = *(const u32x4*)(OG + (size_t)(tok0 + tl) * D + h * 256 + (part + 8 * q) * 8);
                if (c + 1 < c1) ML_LOAD(c + 1);
                float tot = 0.f;
#pragma unroll
                for (int w = 0; w < 8; ++w) tot += sssq[w * 64 + tl];
                const float dd = 1.0f / fmaxf(fabsf(sden[tl]), __expf(-(tab[64 + tl] + fmaxf(tab[128 + tl], mprev))));
                const float rinv = dd / sqrtf(tot * dd * dd * (1.0f / 256.0f) + EPS);
#pragma unroll
                for (int q = 0; q < 4; ++q) {
                    const int e0 = (part + 8 * q) * 8;
                    const u32x4 hv = *(const LAS u32x4*)(L + ML_HB + tl * 528 + e0 * 2);
                    const size_t idx = (size_t)(tok0 + tl) * D + h * 256 + e0;
                    const u32x4 ov = ovq[q];
                    const f32x4 g0 = *(const LAS f32x4*)(sgh + e0), g1 = *(const LAS f32x4*)(sgh + e0 + 4);
                    const unsigned hw[4] = {hv.x, hv.y, hv.z, hv.w}, ow[4] = {ov.x, ov.y, ov.z, ov.w};
                    const float gg[8] = {g0.x, g0.y, g0.z, g0.w, g1.x, g1.y, g1.z, g1.w};
                    unsigned r[4];
#pragma unroll
                    for (int k = 0; k < 4; ++k) {
                        const float ha = bf2f(hw[k] & 0xffff), hbv = bf2f(hw[k] >> 16), oa = bf2f(ow[k] & 0xffff), ob = bf2f(ow[k] >> 16);
                        r[k] = pk2(ha * rinv * gg[2 * k] * __builtin_amdgcn_rcpf(1.0f + __expf(-oa)), hbv * rinv * gg[2 * k + 1] * __builtin_amdgcn_rcpf(1.0f + __expf(-ob)));
                    }
                    *(u32x4*)(HS + idx) = (u32x4){r[0], r[1], r[2], r[3]};
                }
            }
            if (c + 1 < c1) ML_STORE(c + 1);
        }
#undef ML_LOAD
#undef ML_STORE
    }
}

constexpr int W13_PRE = 2048;
template <bool DEEP>
DI void convert_moe_layer(int l, bool do13, bool do2, int gw, int NGW, int lo13, int hi13, const float* w1, const float* w3, const float* w2, bf16_t* W13, bf16_t* W2, LAS unsigned char* lds, int wid, int lane) {
    LAS float* scr = (LAS float*)(lds + wid * 16640);
    constexpr int I_W1 = 32 * 32 * 4, I_W2 = 32 * 4 * 32;
    if (do2) for (int it = gw; it < I_W2; it += NGW) {
        const int le = l * NE + it / 128, q = it % 128;
        transpose_item<DEEP>(w2 + (size_t)le * FF * D, D, W2 + (size_t)le * D * FF, FF, 64 * (q / 32), 64 * (q % 32), 0, scr, lane); }
    if (do13) for (int it = lo13 + gw; it < (hi13 < 2 * I_W1 ? hi13 : 2 * I_W1); it += NGW) {
        const int which = it / I_W1, r = it % I_W1, le = l * NE + r / 128, q = r % 128;
        transpose_item<DEEP>((which ? w3 : w1) + (size_t)le * D * FF, FF, W13 + (size_t)le * 512 * D, D, 64 * (q / 4), 64 * (q % 4), 1 + which, scr, lane); }
}

__global__ void __launch_bounds__(NTHREADS, 2) fwd_kernel(Args args) {
    extern __shared__ __attribute__((aligned(16))) unsigned char lds_raw[];
    LAS unsigned char* lds = (LAS unsigned char*)lds_raw;
    const int tid = threadIdx.x, lane = tid & 63, wid = __builtin_amdgcn_readfirstlane(tid >> 6);
    unsigned char* ws = args.ws;
    unsigned* ctl = (unsigned*)(ws + WS_CTL);
    volatile LAS unsigned* misc = (volatile LAS unsigned*)(lds + LDS_BYTES - 256);
    if (tid < 16) misc[tid] = 0u;
    __syncthreads();
    XcdBarrier bar; bar.bar = ctl + CW_BAR; bar.x = 0; bar.st = misc;
    const int lo = args.ph_lo, hi = args.ph_hi;
    if (PROBE_A >= 0 && blockIdx.x == 0 && tid == 0) misc[16] = (unsigned)__builtin_amdgcn_s_memrealtime();
    if (hi - lo > 1) bar = xcd_barrier_post(ctl + CW_BAR, misc);
#ifndef PHMASK
#define PHMASK 0xffff
#endif
#define IN(k) (((PHMASK >> (k)) & 1) && lo <= (k) && (k) < hi)
#ifndef XBAR
#define XBAR 0
#endif
#define SEAM(k) do { if (IN(k) && IN((k) + 1)) { xcd_barrier(bar); if ((k) == 5) for (int xb_ = 0; xb_ < XBAR; ++xb_) xcd_barrier(bar); } if (PROBE_A >= 0 && blockIdx.x == 0 && tid == 0) misc[16 + (k) + 1] = (unsigned)__builtin_amdgcn_s_memrealtime(); } while (0)

#define PH(k, ...) { __VA_ARGS__ } if ((REPEAT_MASK >> (k)) & 1) { xcd_barrier(bar); { __VA_ARGS__ } }
#define LZ(z) int z = 0; asm volatile("" : "+s"(z))
#define INP(k) (args.in[k] + z)
#define WSP(type, off) ((type*)(ws + (off) + z))
#define ACT(type, off) ((type*)(ws + WS_ACT + (off) + z))

    PH(0, if (IN(0)) {
        LZ(z);
        const float* sb_w_in = INP(4); const float* sb_w_out = INP(5); const float* ml_w_in = INP(6); const float* ml_w_out = INP(10);
        const float* moe_w1 = INP(15); const float* moe_w3 = INP(16); const float* moe_w2 = INP(17);
        bf16_t* Wsbin = WSP(bf16_t, WS_WSBIN); bf16_t* Wsbout = WSP(bf16_t, WS_WSBOUT); bf16_t* Wmlin = WSP(bf16_t, WS_WMLIN); bf16_t* Wmlout = WSP(bf16_t, WS_WMLOUT);
        bf16_t* W13 = WSP(bf16_t, WS_W13); bf16_t* W2 = WSP(bf16_t, WS_W2);
        LAS float* scr = (LAS float*)(lds + wid * 16640);
        const int gw = blockIdx.x * 8 + wid, NGW = gridDim.x * 8;
        constexpr int I_SBIN = 32 * 96, I_SBOUT = 32 * 32, I_MLIN = 32 * 96, I_MLOUT = 32 * 32;
        constexpr int NITEMS = I_SBIN + I_SBOUT + I_MLIN + I_MLOUT;
        for (int it0 = gw; it0 < NITEMS; it0 += NGW) {
            int r = NITEMS - 1 - it0;
            if (r < I_SBIN) { transpose_item(sb_w_in, 6144, Wsbin, D, 64 * (r / 96), 64 * (r % 96), 0, scr, lane); continue; } r -= I_SBIN;
            if (r < I_SBOUT) { transpose_item(sb_w_out, D, Wsbout, D, 64 * (r / 32), 64 * (r % 32), 0, scr, lane); continue; } r -= I_SBOUT;
            if (r < I_MLIN) { transpose_item(ml_w_in, ML_IN, Wmlin, D, 64 * (r / 96), 64 * (r % 96), 0, scr, lane); continue; } r -= I_MLIN;
            transpose_item(ml_w_out, D, Wmlout, D, 64 * (r / 32), 64 * (r % 32), 0, scr, lane);
        }
        {
            const float* wg = INP(11); const float* we = INP(13); const float* wml = INP(6);
            bf16_t* wr = WSP(bf16_t, WS_WR); bf16_t* wgi = WSP(bf16_t, WS_WG);
            const int gt = blockIdx.x * NTHREADS + tid, NGT = gridDim.x * NTHREADS;
            for (int idx = gt; idx < 2 * 98304 + 32768; idx += NGT) {
                if (idx < 2 * 98304) {
                    const int l = idx / 98304, r = idx % 98304, j = r & 7, ln = (r >> 3) & 63, q = r >> 9, nt = q % 3, ks = q / 3;
                    const int k = 32 * ks + 8 * (ln >> 4) + j, n = 16 * nt + (ln & 15);
                    const float w = (n < 4) ? wg[(size_t)l * D * 4 + k * 4 + n] : ((n < 36) ? we[(size_t)l * D * 32 + k * 32 + (n - 4)] : 0.f);
                    wr[(size_t)l * (WR_BYTES / 2) + r] = (bf16_t)f2bf(w);
                } else {
                    const int r = idx - 2 * 98304, j = r & 7, ln = (r >> 3) & 63, ks = r >> 9;
                    const int k = 32 * ks + 8 * (ln >> 4) + j, n = ln & 15;
                    wgi[r] = (bf16_t)f2bf(wml[(size_t)k * ML_IN + 6144 + n]);
                }
            }
        }
        __syncthreads();
        NormP p{}; p.src = INP(0); p.H = WSP(bf16_t, WS_H); p.g = INP(1);
        norm_phase<0, false>(p, lds, tid, wid, lane);
    })
    SEAM(0);
    PH(1, if (IN(1)) {
        LZ(z);
        bf16_t* H = WSP(bf16_t, WS_H); bf16_t* Wsbin = WSP(bf16_t, WS_WSBIN);
        if (tid == 0) {
            pg8::put_job(lds, 0, H, Wsbin, T, 4096, ACT(bf16_t, A_Q), ACT(bf16_t, A_K), D, 2048, 0.12751743074602467f);
            pg8::put_job(lds, 1, Wsbin + (size_t)4096 * D, H, D, T, ACT(bf16_t, A_VT), ACT(bf16_t, A_VT), T, 1 << 30, 1.0f);
        }
        __syncthreads();
        pg8::Sched S; S.init(lds, 2, gridDim.x, blockIdx.x);
        pg8::EpiBf16 E{S.tab};
        pg8::gemm_phase(lds, S, E);
    })
    SEAM(1);
    PH(2, if (IN(2)) { LZ(z); attn_phase(ACT(bf16_t, A_Q), ACT(bf16_t, A_K), ACT(bf16_t, A_VT), ACT(bf16_t, A_O), lds, tid, wid, lane); })
    SEAM(2);
    PH(3, if (IN(3)) { LZ(z);
        if (tid == 0) pg8::put_job(lds, 0, ACT(bf16_t, A_O), WSP(bf16_t, WS_WSBOUT), T, D, ACT(bf16_t, A_Z0), ACT(bf16_t, A_Z0), D, 1 << 30, 1.0f);
        __syncthreads();
        pg8::Sched S; S.init(lds, 1, gridDim.x, blockIdx.x);
        pg8::EpiBf16 E{S.tab}; pg8::gemm_phase(lds, S, E); })
    SEAM(3);
#if defined(OUTPROJ_PROBE)
    {
        LZ(z);
        if (tid == 0) pg8::put_job(lds, 0, ACT(bf16_t, A_O), WSP(bf16_t, WS_WSBOUT), T, D, nullptr, nullptr, D, 0, 1.0f);
        __syncthreads();
        pg8::Sched S; S.init(lds, 1, gridDim.x, blockIdx.x);
#if OUTPROJ_PROBE == 1
        pg8::EpiNull E; pg8::gemm_phase(lds, S, E);
#else
        pg8::EpiResF32 E{INP(0), ACT(float, A_Q), D}; pg8::gemm_phase(lds, S, E);
#endif
        xcd_barrier(bar);
    }
#endif
#define MOE_PHASES(l, pb) \
    PH(pb, if (IN(pb)) { LZ(z); convert_moe_layer<false>(l, true, false, blockIdx.x * 8 + wid, gridDim.x * 8, (l) ? W13_PRE : 0, 1 << 30, INP(15), INP(16), INP(17), WSP(bf16_t, WS_W13), WSP(bf16_t, WS_W2), lds, wid, lane); __syncthreads(); NormP p{}; p.src = (l) ? (const float*)WSP(bf16_t, WS_X) : INP(0); p.Y = (l) ? ACT(bf16_t, A_Z1) : ACT(bf16_t, A_Z0); p.X = WSP(bf16_t, WS_X); p.H = WSP(bf16_t, WS_H); p.g = INP(2) + (l) * D; p.wimg = WSP(bf16_t, WS_WR + (l) * WR_BYTES); p.bg = INP(12) + (l) * 4; \
        p.be = INP(14) + (l) * 32; p.cnt = ctl + CW_CNT + 64 * (l) + z; p.list = ACT(unsigned, A_LIST); p.listw = ACT(float, A_LISTW); \
        if (l) norm_phase<1, true>(p, lds, tid, wid, lane); else norm_phase<1, false>(p, lds, tid, wid, lane); }) \
    SEAM(pb); \
    PH((pb) + 1, if (IN((pb) + 1)) { LZ(z); pg8::moe_table256(ctl + CW_CNT + 64 * (l) + z, lds, tid); \
        pg8::MSched<2> S; S.init(lds, gridDim.x, blockIdx.x, true); \
        { const int nun = S.total; const int idle = (int)gridDim.x - nun;        \
          if (idle > 0) { if (S.c >= nun) { convert_moe_layer<true>(l, false, true, (S.c - nun) * 8 + wid, idle * 8, 0, 0, INP(15), INP(16), INP(17), WSP(bf16_t, WS_W13), WSP(bf16_t, WS_W2), lds, wid, lane); \
              if ((l) == 0) convert_moe_layer<true>(1, true, false, (S.c - nun) * 8 + wid, idle * 8, 0, W13_PRE, INP(15), INP(16), INP(17), WSP(bf16_t, WS_W13), WSP(bf16_t, WS_W2), lds, wid, lane); } } \
          else { convert_moe_layer<false>(l, false, true, blockIdx.x * 8 + wid, gridDim.x * 8, 0, 0, INP(15), INP(16), INP(17), WSP(bf16_t, WS_W13), WSP(bf16_t, WS_W2), lds, wid, lane); \
                 if ((l) == 0) convert_moe_layer<false>(1, true, false, blockIdx.x * 8 + wid, gridDim.x * 8, 0, W13_PRE, INP(15), INP(16), INP(17), WSP(bf16_t, WS_W13), WSP(bf16_t, WS_W2), lds, wid, lane); __syncthreads(); } } \
        pg8::MOps1 P{WSP(bf16_t, WS_H), WSP(bf16_t, WS_W13) + (size_t)(l) * NE * 512 * D, ACT(unsigned, A_LIST)}; \
        pg8::EpiSwiglu E{ACT(bf16_t, A_HID), ACT(float, A_LISTW)}; \
        pg8::gemm_phase_m<2048>(lds, S, P, E); }) \
    SEAM((pb) + 1); \
    PH((pb) + 2, if (IN((pb) + 2)) { LZ(z); pg8::moe_table256(ctl + CW_CNT + 64 * (l) + z, lds, tid); \
        pg8::MSched<8> S; S.init(lds, gridDim.x, blockIdx.x, true); \
        pg8::MOps2 P{ACT(bf16_t, A_HID), WSP(bf16_t, WS_W2) + (size_t)(l) * NE * D * FF}; \
        pg8::EpiScatter E{ACT(bf16_t, A_Y), ACT(unsigned, A_LIST)}; \
        pg8::gemm_phase_m<256>(lds, S, P, E); }) \
    SEAM((pb) + 2);
    MOE_PHASES(0, 4)
#if defined(MOE2_PROBE)
    {
        xcd_barrier(bar); LZ(z); pg8::moe_table256(ctl + CW_CNT + z, lds, tid);
        pg8::MSched<8> S; S.init(lds, gridDim.x, blockIdx.x);
        pg8::MOps2 P{ACT(bf16_t, A_HID), WSP(bf16_t, WS_W2)};
#if MOE2_PROBE == 1
        pg8::EpiMNull E; pg8::gemm_phase_m<256>(lds, S, P, E);
#else
        pg8::EpiScatter E{ACT(bf16_t, A_Y), ACT(unsigned, A_LIST)}; pg8::gemm_phase_m<256>(lds, S, P, E);
#endif
        xcd_barrier(bar);
    }
#endif
#if defined(ROUTER2X)
    { xcd_barrier(bar); LZ(z); NormP p{}; p.src = INP(0); p.Y = ACT(bf16_t, A_Z0); p.X = ACT(bf16_t, 96 * MiB); p.H = ACT(bf16_t, A_O); p.g = INP(2); p.wimg = WSP(bf16_t, WS_WR); p.bg = INP(12); p.be = INP(14);
      p.cnt = ctl + CW_CNT + 64 * 2 + z; p.list = ACT(unsigned, 128 * MiB); p.listw = ACT(float, 130 * MiB); norm_phase<1, false>(p, lds, tid, wid, lane); xcd_barrier(bar); }
#endif
    PH(7, if (IN(7)) { LZ(z); NormP p{}; p.X = WSP(bf16_t, WS_X); p.Y = ACT(bf16_t, A_Y); p.H = WSP(bf16_t, WS_H); p.g = INP(1) + D; p.wimg = WSP(bf16_t, WS_WG); p.G = ACT(float, A_G); norm_phase<2, true>(p, lds, tid, wid, lane); })
    SEAM(7);
    PH(8, if (IN(8)) {
        LZ(z);
        bf16_t* H = WSP(bf16_t, WS_H); bf16_t* Wmlin = WSP(bf16_t, WS_WMLIN);
        if (tid == 0) {
            pg8::put_job(lds, 0, H, Wmlin, T, 2048, ACT(bf16_t, A_Q1), ACT(bf16_t, A_K1), 1024, 1024, 0.08838834764831845f);
            pg8::put_job(lds, 1, H, Wmlin + (size_t)4096 * D, T, 2048, ACT(bf16_t, A_OG), ACT(bf16_t, A_OG), D, 1 << 30, 1.0f);
            pg8::put_job(lds, 2, Wmlin + (size_t)2048 * D, H, 2048, T, ACT(bf16_t, A_VT1), ACT(bf16_t, A_VT1), T, 1 << 30, 1.0f);
        }
        __syncthreads();
        pg8::Sched S; S.init(lds, 3, gridDim.x, blockIdx.x);
        pg8::EpiBf16 E{S.tab};
        pg8::gemm_phase(lds, S, E);
    })
    SEAM(8);
    PH(9, if (IN(9)) { LZ(z); mlstm_local(ACT(bf16_t, A_K1), ACT(bf16_t, A_VT1), ACT(float, A_G), INP(7), INP(8), WSP(bf16_t, WS_H), ACT(float, A_NJ), ACT(float, A_SUM), lds, tid, wid, lane); })
    SEAM(9);
    PH(10, if (IN(10)) { LZ(z); mlstm_phase<0>(ACT(bf16_t, A_Q1), ACT(bf16_t, A_K1), ACT(bf16_t, A_VT1), ACT(bf16_t, A_OG), ACT(float, A_G), INP(7), INP(8), INP(9), ACT(bf16_t, A_HS),
        WSP(bf16_t, WS_H), ACT(float, A_NJ), ACT(float, A_SUM), lds, tid, wid, lane); })
    SEAM(10);
#if defined(ML_PROBE)
    {
        LZ(z); mlstm_phase<ML_PROBE>(ACT(bf16_t, A_Q1), ACT(bf16_t, A_K1), ACT(bf16_t, A_VT1), ACT(bf16_t, A_OG), ACT(float, A_G), INP(7), INP(8), INP(9), (bf16_t*)(args.out + z),
            WSP(bf16_t, WS_H), ACT(float, A_NJ), ACT(float, A_SUM), lds, tid, wid, lane, 4); xcd_barrier(bar); }
#endif
    PH(11, if (IN(11)) { LZ(z);
        if (tid == 0) pg8::put_job(lds, 0, ACT(bf16_t, A_HS), WSP(bf16_t, WS_WMLOUT), T, D, ACT(bf16_t, A_Z1), ACT(bf16_t, A_Z1), D, 1 << 30, 1.0f);
        __syncthreads();
        pg8::Sched S; S.init(lds, 1, gridDim.x, blockIdx.x);
        pg8::EpiBf16 E{S.tab}; pg8::gemm_phase(lds, S, E); })
    SEAM(11);
    MOE_PHASES(1, 12)
    PH(15, if (IN(15)) { LZ(z); NormP p{}; p.X = WSP(bf16_t, WS_X); p.Y = ACT(bf16_t, A_Y); p.outf = args.out + z; p.g = INP(3); norm_phase<3, true>(p, lds, tid, wid, lane); })
    if (PROBE_A >= 0 && blockIdx.x == 0 && tid == 0) {
        misc[16 + 16] = (unsigned)__builtin_amdgcn_s_memrealtime();
        const float tA = (float)(misc[16 + PROBE_A + 1] - misc[16 + PROBE_A]) * 0.01f, tB = (PROBE_B >= 0) ? (float)(misc[16 + PROBE_B + 1] - misc[16 + PROBE_B]) * 0.01f : 0.f;
        args.out[0] = (1.0f + tA * 0.02f) * __builtin_powf(10.0f, __builtin_rintf(tB * 0.1f));
    }
#undef IN
#undef SEAM
}

extern "C" void kernel_launch(void* const* d_in, const int* in_sizes, int n_in, void* d_out, int out_size, void* d_ws, size_t ws_size, hipStream_t stream) {
    static int grid = 0;
    if (grid == 0) {
        if (n_in != 18 || out_size != T * D || ws_size < WS_END) { fprintf(stderr, "kernel_launch: unexpected shapes (n_in %d out %d ws %zu need %zu)\n", n_in, out_size, ws_size, (size_t)WS_END); grid = -1; return; }
        int dev = 0, cus = 0, per_cu = 0;
        if (hipGetDevice(&dev) != hipSuccess || hipDeviceGetAttribute(&cus, hipDeviceAttributeMultiprocessorCount, dev) != hipSuccess) { grid = -1; return; }
        if (hipFuncSetAttribute((const void*)fwd_kernel, hipFuncAttributeMaxDynamicSharedMemorySize, LDS_BYTES) != hipSuccess) { fprintf(stderr, "kernel_launch: hipFuncSetAttribute failed\n"); grid = -1; return; }
        if (hipOccupancyMaxActiveBlocksPerMultiprocessor(&per_cu, (const void*)fwd_kernel, NTHREADS, LDS_BYTES) != hipSuccess || per_cu < 1) { fprintf(stderr, "kernel_launch: occupancy query says %d\n", per_cu); per_cu = 1; }
        (void)hipGetLastError();
        grid = cus;
    }
    if (grid < 0) return;
    (void)hipMemsetAsync((char*)d_ws + WS_CTL, 0, CTL_BYTES, stream);
    Args a{};
    for (int i = 0; i < 18; ++i) a.in[i] = (const float*)d_in[i];
    a.out = (float*)d_out; a.ws = (unsigned char*)d_ws;
#if MK_MULTI
    for (int ph = 0; ph < NPHASE; ++ph) { a.ph_lo = ph; a.ph_hi = ph + 1; hipLaunchKernelGGL(fwd_kernel, dim3(grid), dim3(NTHREADS), LDS_BYTES, stream, a); }
#else
    a.ph_lo = 0; a.ph_hi = NPHASE;
    void* kargs[] = {&a};
    hipError_t e = hipLaunchCooperativeKernel((const void*)fwd_kernel, dim3(grid), dim3(NTHREADS), kargs, LDS_BYTES, stream);
    if (e != hipSuccess) fprintf(stderr, "kernel_launch: cooperative launch failed: %s\n", hipGetErrorString(e));
#endif
}
```

```cpp
#include <hip/hip_runtime.h>
#include <cstdio>
#include <cstdint>

#define GAS __attribute__((address_space(1)))
#define LAS __attribute__((address_space(3)))
#define DI __device__ __forceinline__
typedef unsigned short bf16_t;
typedef short bf16x8 __attribute__((ext_vector_type(8)));
typedef short s16x4 __attribute__((ext_vector_type(4)));
typedef float f32x4 __attribute__((ext_vector_type(4)));
typedef unsigned u32x4 __attribute__((ext_vector_type(4)));
typedef unsigned u32x2 __attribute__((ext_vector_type(2)));

#ifndef PROBE_A
#define PROBE_A -1
#define PROBE_B -1
#endif
#ifndef REPEAT_MASK
#define REPEAT_MASK 0
#endif
#ifndef MK_MULTI
#define MK_MULTI 0
#endif

constexpr int T = 8192, D = 2048, SEQ = 2048;
constexpr int SBH = 16;
constexpr int MLH = 8, ML_IN = 6160;
constexpr int NE = 32, FF = 256;
constexpr float EPS = 1e-6f;
constexpr int NPHASE = 16;
constexpr int NTHREADS = 512;
constexpr int LDS_BYTES = 147456;

constexpr size_t MiB = 1u << 20;
constexpr size_t WS_CTL = 0, CTL_BYTES = 128 * 1024;
constexpr size_t WS_WR = 128 * 1024, WR_BYTES = 384 * 1024, WS_WG = 896 * 1024;
constexpr size_t WS_WSBIN = 1 * MiB, WS_WSBOUT = 25 * MiB, WS_WMLIN = 33 * MiB, WS_WMLOUT = 57 * MiB;
constexpr size_t WS_W13 = 65 * MiB, WS_W2 = 193 * MiB;
constexpr size_t WS_X = 257 * MiB, WS_H = 321 * MiB, WS_ACT = 353 * MiB;
constexpr size_t A_Q = 0, A_K = 32 * MiB, A_VT = 64 * MiB, A_O = 96 * MiB;
constexpr size_t A_Q1 = 0, A_K1 = 16 * MiB, A_KT = 32 * MiB, A_VT1 = 48 * MiB, A_OG = 80 * MiB, A_HS = 112 * MiB, A_G = 144 * MiB, A_NJ = 144 * MiB + 524288, A_SUM = 144 * MiB + 524288 + 131072;
constexpr size_t A_HID = 0, A_LIST = 9 * MiB, A_LISTW = 10 * MiB, A_Y = 16 * MiB;
constexpr size_t A_Z0 = 64 * MiB, A_Z1 = 80 * MiB;
constexpr size_t WS_END = WS_ACT + 145 * MiB;
constexpr int CW_BAR = 4096;
constexpr int CW_CNT = 16384;

typedef __bf16 bf16x2_t __attribute__((ext_vector_type(2)));
typedef float f32x2 __attribute__((ext_vector_type(2)));
DI unsigned pk2(float lo, float hi) { const f32x2 v = {lo, hi}; return __builtin_bit_cast(unsigned, __builtin_convertvector(v, bf16x2_t)); }
DI unsigned f2bf(float f) { return pk2(f, 0.f) & 0xffffu; }
DI float bf2f(unsigned short b) { return __builtin_bit_cast(float, ((unsigned)b) << 16); }
template <int CTRL> DI float dpp_t(float v) { return __builtin_bit_cast(float, __builtin_amdgcn_update_dpp(0, __builtin_bit_cast(int, v), CTRL, 0xF, 0xF, false)); }
#define dpp_f(v, ctrl) dpp_t<ctrl>(v)
DI float wave_max(float v) {
    v = fmaxf(v, dpp_f(v, 0xB1)); v = fmaxf(v, dpp_f(v, 0x4E)); v = fmaxf(v, dpp_f(v, 0x141)); v = fmaxf(v, dpp_f(v, 0x140));
    v = fmaxf(v, __shfl_xor(v, 16)); v = fmaxf(v, __shfl_xor(v, 32)); return v;
}
DI float wave_sum(float v) {
#pragma unroll
    for (int o = 1; o < 64; o <<= 1) v += __shfl_xor(v, o);
    return v;
}
#define LDS_WAIT() asm volatile("s_waitcnt lgkmcnt(0)" ::: "memory")
#define VM_WAIT() asm volatile("s_waitcnt vmcnt(0)" ::: "memory")
#define MFMA16(a, b, c) __builtin_amdgcn_mfma_f32_16x16x32_bf16((a), (b), (c), 0, 0, 0)

#define XB_TMO      128
#define XB_XCNT(j)  (256  + 64 * (j))
#define XB_XSUB(j)  (1280 + 64 * (j))
#define XB_XGEN(j)  (2304 + 64 * (j))
#define XB_TOP      3328
#define XB_TOPGEN   3392
#define XCD_BAR_WORDS 3456
#define XB_SPIN_CAP (1u << 18)
DI unsigned xb_ld(unsigned* p)              { return __hip_atomic_load(p, __ATOMIC_RELAXED, __HIP_MEMORY_SCOPE_AGENT); }
DI unsigned xb_add(unsigned* p, unsigned v) { return __hip_atomic_fetch_add(p, v, __ATOMIC_RELAXED, __HIP_MEMORY_SCOPE_AGENT); }
DI unsigned xb_xcc_id() { return (unsigned)__builtin_amdgcn_s_getreg((3 << 11) | 20) & 0xFu; }
#define XB_SPIN(cond, bar) do { unsigned _sp = 0; while (cond) { __builtin_amdgcn_s_sleep(1); \
    if ((++_sp & 255u) == 0u) { if (xb_ld(&(bar)[XB_TMO])) break; if (_sp > XB_SPIN_CAP) { atomicAdd(&(bar)[XB_TMO], 1u); break; } } } } while (0)
struct XcdBarrier { unsigned* bar; unsigned x; volatile LAS unsigned* st; };
DI XcdBarrier xcd_barrier_post(unsigned* bar, volatile LAS unsigned* st) {
    XcdBarrier b; b.bar = bar; b.x = xb_xcc_id(); b.st = st;
    if (threadIdx.x == 0) (void)xb_add(&bar[XB_XCNT(b.x)], 1u);
    return b;
}
DI void xcd_barrier_complete(unsigned* bar, unsigned x, unsigned& nloc, unsigned& nx) {
    const unsigned G = gridDim.x * gridDim.y * gridDim.z;
    unsigned sum, cnt, mine, sp = 0u;
    for (;;) {
        sum = 0u; cnt = 0u; mine = 0u;
#pragma unroll
        for (unsigned j = 0; j < 16; ++j) { const unsigned c = xb_ld(&bar[XB_XCNT(j)]); sum += c; cnt += (c > 0u) ? 1u : 0u; mine = (j == x) ? c : mine; }
        if (sum == G) break;
        __builtin_amdgcn_s_sleep(1);
        if ((++sp & 255u) == 0u) { if (xb_ld(&bar[XB_TMO])) break; if (sp > XB_SPIN_CAP) { atomicAdd(&bar[XB_TMO], 1u); break; } }
    }
    nloc = mine > 0u ? mine : 1u; nx = cnt > 0u ? cnt : 1u;
}
DI void xcd_barrier(const XcdBarrier& b) {
    asm volatile("s_waitcnt vmcnt(0)" ::: "memory");
    __syncthreads();
    if (threadIdx.x == 0) {
        unsigned* bar = b.bar;
        __builtin_amdgcn_s_waitcnt(0);
        unsigned nloc = b.st[0], nx = b.st[1];
        if (nloc == 0u) { xcd_barrier_complete(bar, b.x, nloc, nx); b.st[0] = nloc; b.st[1] = nx; }
        const unsigned old = xb_add(&bar[XB_XSUB(b.x)], 1u);
        const unsigned gen = old / nloc;
        if (old + 1u == (gen + 1u) * nloc) {
            __builtin_amdgcn_fence(__ATOMIC_RELEASE, "agent");
            asm volatile("s_waitcnt vmcnt(0)" ::: "memory");
            const unsigned og = xb_add(&bar[XB_TOP], 1u);
            const unsigned tg = og / nx;
            if (og + 1u == (tg + 1u) * nx) xb_add(&bar[XB_TOPGEN], 1u);
            else XB_SPIN(xb_ld(&bar[XB_TOPGEN]) == tg, bar);
            __builtin_amdgcn_fence(__ATOMIC_ACQUIRE, "agent");
            xb_add(&bar[XB_XGEN(b.x)], 1u);
            asm volatile("s_waitcnt vmcnt(0)" ::: "memory");
        } else {
            XB_SPIN(xb_ld(&bar[XB_XGEN(b.x)]) == gen, bar);
            __builtin_amdgcn_fence(__ATOMIC_ACQUIRE, "agent");
            asm volatile("s_waitcnt vmcnt(0)" ::: "memory");
        }
    }
    __syncthreads();
}

struct Args {
    const float* in[18];
    float* out;
    unsigned char* ws;
    int ph_lo, ph_hi;
};

DI int perm13(int f, int which) { return (f >> 7) * 256 + ((f >> 5) & 3) * 64 + which * 32 + (f & 31); }
template <bool DEEP = false>
DI void transpose_item(const float* W, int ldw, bf16_t* WT, int ldt, int k0, int n0, int mode, LAS float* scr, int lane) {
    if (DEEP) {
        float wv[64];
#pragma unroll
        for (int i = 0; i < 64; ++i) wv[i] = __builtin_nontemporal_load(W + (size_t)(k0 + i) * ldw + n0 + lane);
#pragma unroll
        for (int i = 0; i < 64; ++i) scr[i * 65 + lane] = wv[i];
    } else {
#pragma unroll 16
        for (int i = 0; i < 64; ++i) scr[i * 65 + lane] = __builtin_nontemporal_load(W + (size_t)(k0 + i) * ldw + n0 + lane);
    }
    LDS_WAIT(); asm volatile("" ::: "memory");
    const int c = lane & 7;
#pragma unroll
    for (int j = 0; j < 8; ++j) {
        const int n = (lane >> 3) + 8 * j; const LAS float* s = scr + (8 * c) * 65 + n;
        u32x4 o; o.x = pk2(s[0 * 65], s[1 * 65]); o.y = pk2(s[2 * 65], s[3 * 65]); o.z = pk2(s[4 * 65], s[5 * 65]); o.w = pk2(s[6 * 65], s[7 * 65]);
        const int nn = n0 + n; const int row = (mode == 0) ? nn : perm13(nn, mode - 1);
        *(u32x4*)(WT + (size_t)row * ldt + k0 + 8 * c) = o;
    }
    LDS_WAIT(); asm volatile("" ::: "memory");
}

struct NormP {
    const float* src; bf16_t* X; const bf16_t* Y; bf16_t* H; float* outf; const float* g;
    const bf16_t* wimg; const float* bg; const float* be;
    unsigned* cnt; unsigned* list; float* listw;
    float* G;
};
template <int MODE, bool XB>
DI void norm_phase(const NormP& p, LAS unsigned char* lds, int tid, int wid, int lane) {
    constexpr int RB_LDB = 4112;
    LAS unsigned char* rb_hi = lds;
    LAS float* part = (LAS float*)(lds + 8 * RB_LDB);
    LAS float* logit = part + 8 * 8 * 48;
    LAS int* pex = (LAS int*)(logit + 512); LAS unsigned* pen = (LAS unsigned*)(pex + 512); LAS float* pwt = (LAS float*)(pen + 512);
    int itn = 0;
    constexpr bool PROJ = (MODE == 1 || MODE == 2);
    const float* xin = p.src;
    const bf16_t* xbn = (MODE <= 1) ? (const bf16_t*)p.src : (const bf16_t*)p.X;
    f32x4 v[8]; u32x2 xb[8], ya[8], yb[8];
    int it = blockIdx.x;
#define NP_LOADV(itx) do { const size_t ro_ = (size_t)((itx) * 8 + wid) * D; _Pragma("unroll") for (int j = 0; j < 8; ++j) { if (XB) xb[j] = *(const u32x2*)(xbn + ro_ + 4 * lane + 256 * j); else v[j] = __builtin_nontemporal_load((const f32x4*)(xin + ro_ + 4 * lane + 256 * j)); } } while (0)
#define NP_LOADY(itx) do { const size_t ro_ = (size_t)((itx) * 8 + wid) * D; _Pragma("unroll") for (int j = 0; j < 8; ++j) { const int c = 4 * lane + 256 * j; \
        if (MODE >= 1) ya[j] = *(const u32x2*)(p.Y + ro_ + c); if (MODE >= 2) yb[j] = *(const u32x2*)(p.Y + (size_t)T * D + ro_ + c); } } while (0)
#define NP_LOAD(itx) do { NP_LOADV(itx); NP_LOADY(itx); } while (0)
    if (it < T / 8) NP_LOAD(it);
    for (; it < T / 8; it += gridDim.x, ++itn) {
        const int row = it * 8 + wid;
        const size_t ro = (size_t)row * D;
        f32x4 gv[8];
#pragma unroll
        for (int j = 0; j < 8; ++j) gv[j] = *(const f32x4*)(p.g + 4 * lane + 256 * j);
        float ss = 0.f;
#pragma unroll
        for (int j = 0; j < 8; ++j) {
            f32x4 x;
            if (XB) { const u32x2 q = xb[j]; x.x = bf2f(q.x & 0xffff); x.y = bf2f(q.x >> 16); x.z = bf2f(q.y & 0xffff); x.w = bf2f(q.y >> 16); } else x = v[j];
            if (MODE >= 1) {
                const u32x2 a = ya[j];
                x.x += bf2f(a.x & 0xffff); x.y += bf2f(a.x >> 16); x.z += bf2f(a.y & 0xffff); x.w += bf2f(a.y >> 16);
                if (MODE >= 2) { const u32x2 b = yb[j]; x.x += bf2f(b.x & 0xffff); x.y += bf2f(b.x >> 16); x.z += bf2f(b.y & 0xffff); x.w += bf2f(b.y >> 16); }
                if (MODE <= 2) { u32x2 o; o.x = pk2(x.x, x.y); o.y = pk2(x.z, x.w); *(u32x2*)(p.X + ro + 4 * lane + 256 * j) = o; }
            }
            v[j] = x;
            ss += (x.x * x.x + x.y * x.y) + (x.z * x.z + x.w * x.w);
        }
        const float rstd = 1.0f / sqrtf(wave_sum(ss) * (1.0f / D) + EPS);
#pragma unroll
        for (int j = 0; j < 8; ++j) {
            const int c = 4 * lane + 256 * j;
            const f32x4 gg = gv[j];
            f32x4 y; y.x = v[j].x * rstd * gg.x; y.y = v[j].y * rstd * gg.y; y.z = v[j].z * rstd * gg.z; y.w = v[j].w * rstd * gg.w;
            if (MODE == 3) *(f32x4*)(p.outf + ro + c) = y;
            else { u32x2 o; o.x = pk2(y.x, y.y); o.y = pk2(y.z, y.w); *(u32x2*)(p.H + ro + c) = o; }
            if (PROJ) *(LAS u32x2*)(rb_hi + wid * RB_LDB + c * 2) = (u32x2){pk2(y.x, y.y), pk2(y.z, y.w)};
        }
        const bool more = it + (int)gridDim.x < T / 8;
        if (!PROJ && more) NP_LOAD(it + gridDim.x);
        if (PROJ) {
            __syncthreads();
            {
                constexpr int NT = (MODE == 1) ? 3 : 1;
                f32x4 pacc[NT];
#pragma unroll
                for (int nt = 0; nt < NT; ++nt) pacc[nt] = (f32x4){0.f, 0.f, 0.f, 0.f};
                const LAS unsigned char* ahi = rb_hi + (lane & 7) * RB_LDB + (lane >> 4) * 16 + wid * 512;
                const bf16_t* wim = p.wimg + (size_t)lane * 8 + (size_t)(8 * wid) * NT * 512;
                bf16x8 w0[4][NT], w1[4][NT];
#define NP_LDW(dst, g) do { _Pragma("unroll") for (int kk = 0; kk < 4; ++kk) _Pragma("unroll") for (int nt = 0; nt < NT; ++nt) dst[kk][nt] = *(const bf16x8*)(wim + (size_t)((4 * (g) + kk) * NT + nt) * 512); } while (0)
#define NP_MM(src, g) do { _Pragma("unroll") for (int kk = 0; kk < 4; ++kk) { const bf16x8 xh = *(const LAS bf16x8*)(ahi + (4 * (g) + kk) * 64); \
        _Pragma("unroll") for (int nt = 0; nt < NT; ++nt) pacc[nt] = MFMA16(xh, src[kk][nt], pacc[nt]); } } while (0)
#define NP_PIN __builtin_amdgcn_sched_barrier(0)
                NP_LDW(w0, 0); NP_LDW(w1, 1); NP_PIN;
                if (more) NP_LOADV(it + gridDim.x);
                NP_PIN; NP_MM(w0, 0); NP_MM(w1, 1); NP_PIN;
#undef NP_PIN
#undef NP_LDW
#undef NP_MM
                if (more) NP_LOADY(it + gridDim.x);
                if (lane < 32) {
#pragma unroll
                    for (int nt = 0; nt < NT; ++nt)
#pragma unroll
                        for (int r = 0; r < 4; ++r) part[(wid * 8 + 4 * (lane >> 4) + r) * 48 + 16 * nt + (lane & 15)] = pacc[nt][r];
                }
            }
            __syncthreads();
            {
                float sl = 0.f;
                if (lane < 48) {
#pragma unroll
                    for (int w = 0; w < 8; ++w) sl += part[(w * 8 + wid) * 48 + lane];
                }
                if (MODE == 2) { if (lane < 16) p.G[(size_t)row * 16 + lane] = sl; }
                else {
                    if (lane < 36) sl += (lane < 4) ? p.bg[lane] : p.be[lane - 4];
                    const float NEG = -3.0e38f;
                    const float gl = (lane < 4) ? sl : NEG;
                    float gm = fmaxf(gl, dpp_f(gl, 0xB1)); gm = fmaxf(gm, dpp_f(gm, 0x4E));
                    gm = __shfl(gm, 0);
                    const int gs = __ffsll((long long)__ballot(lane < 4 && sl == gm)) - 1;
                    float ge = (lane < 4) ? __expf(sl - gm) : 0.f;
                    ge += dpp_f(ge, 0xB1); ge += dpp_f(ge, 0x4E);
                    const float psel = 1.0f / __shfl(ge, 0);
                    const int eb = 4 + 8 * gs;
                    const bool inr = lane >= eb && lane < eb + 8;
                    const float v0 = wave_max(inr ? sl : NEG);
                    const int l0 = __ffsll((long long)__ballot(inr && sl == v0)) - 1;
                    const float v1 = wave_max((inr && lane != l0) ? sl : NEG);
                    const int l1 = __ffsll((long long)__ballot(inr && lane != l0 && sl == v1)) - 1;
                    if (lane == 0) {
                        const float e10 = __expf(v1 - v0); const float w0 = psel / (1.0f + e10), w1 = psel * e10 / (1.0f + e10);
                        const int e0 = gs * 8 + (l0 - eb), e1 = gs * 8 + (l1 - eb);
                        const int sl0 = itn * 16 + wid * 2;
                        pex[sl0] = e0; pen[sl0] = (unsigned)row * 2u; pwt[sl0] = w0;
                        pex[sl0 + 1] = e1; pen[sl0 + 1] = (unsigned)row * 2u + 1u; pwt[sl0 + 1] = w1;
                    }
                }
            }
        }
    }
#undef NP_LOAD
#undef NP_LOADV
#undef NP_LOADY
    if (MODE == 1) {
        __syncthreads();
        if (wid == 0) {
            const int np = itn * 16;
            for (int c0 = 0; c0 < np; c0 += 64) {
                const bool have = c0 + lane < np;
                const int ei = have ? pex[c0 + lane] : -1;
                int cnt_e = 0, rank = 0;
#pragma unroll 4
                for (int e = 0; e < NE; ++e) {
                    const unsigned long long m = __ballot(ei == e);
                    if (lane == e) cnt_e = __popcll(m);
                    if (ei == e) rank = __popcll(m & ((1ull << lane) - 1ull));
                }
                unsigned base = 0u;
                if (lane < NE && cnt_e > 0) base = atomicAdd(p.cnt + lane, (unsigned)cnt_e);
                const unsigned mybase = (unsigned)__shfl((int)base, ei < 0 ? 0 : ei);
                if (have) { const size_t pos = (size_t)ei * T + mybase + rank; p.list[pos] = pen[c0 + lane]; p.listw[pos] = pwt[c0 + lane]; }
            }
        }
        __syncthreads();
    }
}

DI int lds_byte(int r, int c) { const int st = (r >> 4) * 2 + (c >> 5), rr = r & 15, cc = c & 31, ob = rr * 64 + cc * 2; return st * 1024 + (ob ^ (((ob >> 9) & 1) << 5)); }
DI void stage_rc(int b, int& R, int& C) { const int st = b / 1024, sb = b % 1024, swz = sb ^ (((sb >> 9) & 1) << 5); R = (st >> 1) * 16 + swz / 64; C = (st & 1) * 32 + (swz % 64) / 2; }

namespace pg8 {
constexpr int BM = 256, BK = 64, HALF = 128, HTB = HALF * BK * 2, NXCD = 8, WGM = 8, KD = 2048;
DI int perm32(int rho) { const int n = rho >> 4, i = rho & 15; return 8 * (i >> 2) + 4 * n + (i & 3); }
struct Unit { int pm, pn, job; };
struct JobRec { const bf16_t* A; const bf16_t* Bt; bf16_t* o0; bf16_t* o1; int M, N, ld, split; float scale0; int pad[5]; };
constexpr int JOBS_OFF = 139264;
DI void put_job(LAS unsigned char* lds, int j, const bf16_t* A, const bf16_t* Bt, int M, int N, bf16_t* o0, bf16_t* o1, int ld, int split, float scale0) {
    LAS JobRec* r = (LAS JobRec*)(lds + JOBS_OFF) + j;
    r->A = A; r->Bt = Bt; r->o0 = o0; r->o1 = o1; r->M = M; r->N = N; r->ld = ld; r->split = split; r->scale0 = scale0;
}
struct Sched {
    const LAS JobRec* tab; int n0, n1, n2, G, c;
    DI void init(LAS unsigned char* lds, int njobs, int G_, int c_) {
        tab = (const LAS JobRec*)(lds + JOBS_OFF);
        n0 = (tab[0].M / BM) * (tab[0].N / BM); n1 = njobs > 1 ? (tab[1].M / BM) * (tab[1].N / BM) : 0; n2 = njobs > 2 ? (tab[2].M / BM) * (tab[2].N / BM) : 0; G = G_; c = c_; }
    DI bool next(int i, Unit& u) const {
        int L = i * G + c, nwg;
        if (L < n0) { u.job = 0; nwg = n0; }
        else if (L < n0 + n1) { L -= n0; u.job = 1; nwg = n1; }
        else if (L < n0 + n1 + n2) { L -= n0 + n1; u.job = 2; nwg = n2; }
        else return false;
        const int nM = tab[u.job].M / BM, nN = tab[u.job].N / BM;
        int wgid = L; { const int q = nwg / NXCD, r = nwg % NXCD, xcd = wgid % NXCD, off = wgid / NXCD; wgid = (xcd < r ? xcd * (q + 1) : r * (q + 1) + (xcd - r) * q) + off; }
        const int nig = WGM * nN, gid = wgid / nig, fm = gid * WGM, gsz = (nM - fm) < WGM ? (nM - fm) : WGM;
        u.pm = fm + ((wgid % nig) % gsz); u.pn = (wgid % nig) / gsz; return true;
    }
    DI const char* aptr(const Unit& u) const { return (const char*)tab[u.job].A + (size_t)u.pm * (2 * HALF * KD * 2); }
    DI const char* bptr(const Unit& u) const { return (const char*)tab[u.job].Bt + (size_t)u.pn * (2 * HALF * KD * 2); }
};
struct EpiBf16 {
    static constexpr bool PERM = true;
    const LAS JobRec* tab;
    DI void operator()(const f32x4 (&acc)[2][2][4][2], const Unit& u, int wr, int wc, int fr, int fq) const {
        const LAS JobRec* jr = tab + u.job;
        const int ldo = jr->ld, split = jr->split;
        float sc = jr->scale0;
        int colt = u.pn * BM; bf16_t* base = jr->o0;
        if (colt >= split) { colt -= split; base = jr->o1; sc = 1.0f; }
        const int row0 = u.pm * BM + wr * 64 + fr, col0 = colt + wc * 64 + 8 * fq;
#pragma unroll
        for (int ai = 0; ai < 2; ++ai)
#pragma unroll
            for (int m = 0; m < 4; ++m) { bf16_t* rowp = base + (size_t)(row0 + ai * HALF + m * 16) * ldo + col0;
#pragma unroll
                for (int bj = 0; bj < 2; ++bj) { const f32x4 v0 = acc[ai][bj][m][0], v1 = acc[ai][bj][m][1];
                    u32x4 w; w.x = pk2(v0.x * sc, v0.y * sc); w.y = pk2(v0.z * sc, v0.w * sc); w.z = pk2(v1.x * sc, v1.y * sc); w.w = pk2(v1.z * sc, v1.w * sc);
                    *(u32x4*)(rowp + bj * 32) = w; } }
    }
};
struct EpiResF32 {
    static constexpr bool PERM = false;
    const float* base; float* out; int ld;
    DI void operator()(const f32x4 (&acc)[2][2][4][2], const Unit& u, int wr, int wc, int fr, int fq) const {
        const int row0 = u.pm * BM + wr * 64 + fr, col0 = u.pn * BM + wc * 32 + 4 * fq;
#pragma unroll
        for (int ai = 0; ai < 2; ++ai)
#pragma unroll
            for (int m = 0; m < 4; ++m) { const size_t ro = (size_t)(row0 + ai * HALF + m * 16) * ld + col0;
#pragma unroll
                for (int bj = 0; bj < 2; ++bj)
#pragma unroll
                    for (int n = 0; n < 2; ++n) { const f32x4 b = *(const f32x4*)(base + ro + bj * HALF + n * 16); const f32x4 a = acc[ai][bj][m][n];
                        f32x4 o; o.x = a.x + b.x; o.y = a.y + b.y; o.z = a.z + b.z; o.w = a.w + b.w; *(f32x4*)(out + ro + bj * HALF + n * 16) = o; } }
    }
};
struct EpiNull {
    static constexpr bool PERM = false;
    DI void operator()(const f32x4 (&acc)[2][2][4][2], const Unit&, int, int, int, int) const {
#pragma unroll
        for (int ai = 0; ai < 2; ++ai)
#pragma unroll
            for (int bj = 0; bj < 2; ++bj)
#pragma unroll
                for (int m = 0; m < 4; ++m)
#pragma unroll
                    for (int n = 0; n < 2; ++n) asm volatile("" :: "v"(acc[ai][bj][m][n]));
    }
};
template <class Epi>
DI void gemm_phase(LAS unsigned char* lds, const Sched& S, const Epi& E) {
    const int tid = threadIdx.x, wid = __builtin_amdgcn_readfirstlane(tid >> 6), lane = tid & 63, wr = wid >> 2, wc = wid & 3, fr = lane & 15, fq = lane >> 4;
    constexpr int K = KD, nt = K / BK;
    unsigned voffA[2], voffB[2][2];
#pragma unroll
    for (int i = 0; i < 2; ++i) { int R, C; stage_rc(tid * 16 + i * 8192, R, C);
        voffA[i] = (unsigned)(R * K + C) * 2u;
#pragma unroll
        for (int h = 0; h < 2; ++h) { const int Rb = Epi::PERM ? (64 * (R >> 5) + 32 * h + perm32(R & 31)) : (128 * h + R); voffB[h][i] = (unsigned)(Rb * K + C) * 2u; } }
    constexpr size_t kstep = (size_t)(BK * 2);
    constexpr size_t hstep = (size_t)HALF * K * 2;
    const unsigned ldsw = (unsigned)wid * 1024u;
    const int aoff = lds_byte(wr * 64 + fr, fq * 8), boff = lds_byte(wc * 32 + fr, fq * 8);
#define PG8_SA(b, h) (((b) * 2 + (h)) * HTB)
#define PG8_SB(b, h) ((4 + (b) * 2 + (h)) * HTB)
#define PG8_STAGE(bufoff, gbase, voff) do { _Pragma("unroll") for (int _i = 0; _i < 2; ++_i) \
        __builtin_amdgcn_global_load_lds((const GAS unsigned*)((const char*)(gbase) + (voff)[_i]), (LAS unsigned*)(lds + (bufoff) + ldsw + _i * 8192), 16, 0, 0); } while (0)
#define PG8_LDA(dst, b, h) do { _Pragma("unroll") for (int m = 0; m < 4; ++m) _Pragma("unroll") for (int k = 0; k < 2; ++k) dst[m][k] = *(const LAS bf16x8*)(lds + PG8_SA(b, h) + aoff + m * 2048 + k * 1024); } while (0)
#define PG8_LDB(dst, b, h) do { _Pragma("unroll") for (int n = 0; n < 2; ++n) _Pragma("unroll") for (int k = 0; k < 2; ++k) dst[n][k] = *(const LAS bf16x8*)(lds + PG8_SB(b, h) + boff + n * 2048 + k * 1024); } while (0)
#define PG8_MMA(ai, bj, At, Bt) do { __builtin_amdgcn_s_setprio(1); _Pragma("unroll") for (int m = 0; m < 4; ++m) _Pragma("unroll") for (int n = 0; n < 2; ++n) _Pragma("unroll") for (int k = 0; k < 2; ++k) \
        acc[ai][bj][m][n] = __builtin_amdgcn_mfma_f32_16x16x32_bf16(Bt[n][k], At[m][k], acc[ai][bj][m][n], 0, 0, 0); __builtin_amdgcn_s_setprio(0); } while (0)
#define PG8_WAIT_V(n) asm volatile("s_waitcnt vmcnt(" #n ")" ::: "memory")
#define PG8_WAIT_L(n) asm volatile("s_waitcnt lgkmcnt(" #n ")" ::: "memory")
#define PG8_BAR __builtin_amdgcn_s_barrier()
#define PG8_SCHED __builtin_amdgcn_sched_barrier(0)
    Unit cur, nxt; int ui = 0;
    if (!S.next(0, cur)) return;
    f32x4 acc[2][2][4][2];
#pragma unroll
    for (int a = 0; a < 2; ++a)
#pragma unroll
        for (int b = 0; b < 2; ++b)
#pragma unroll
            for (int m = 0; m < 4; ++m)
#pragma unroll
                for (int n = 0; n < 2; ++n) acc[a][b][m][n] = (f32x4){0.f, 0.f, 0.f, 0.f};
    bf16x8 At[4][2], B0[2][2], B1[2][2];
    const char* cA = S.aptr(cur); const char* cB = S.bptr(cur);
    PG8_STAGE(PG8_SB(0, 0), cB, voffB[0]); PG8_STAGE(PG8_SA(0, 0), cA, voffA); PG8_STAGE(PG8_SB(0, 1), cB, voffB[1]); PG8_STAGE(PG8_SA(0, 1), cA + hstep, voffA);
    if (wr == 1) PG8_BAR;
    PG8_WAIT_V(4); PG8_BAR;
    PG8_STAGE(PG8_SB(1, 0), cB + kstep, voffB[0]); PG8_STAGE(PG8_SA(1, 0), cA + kstep, voffA); PG8_STAGE(PG8_SB(1, 1), cB + kstep, voffB[1]);
    PG8_WAIT_V(6); PG8_BAR;
    for (;;) {
        const bool has_next = S.next(ui + 1, nxt);
        const char* nA = has_next ? S.aptr(nxt) : cA; const char* nB = has_next ? S.bptr(nxt) : cB;
        for (int t = 0; t < nt; t += 2) {
            const bool last = (t == nt - 2);
            const char* a1 = cA + (size_t)(t + 1) * kstep;
            const char* a2 = last ? nA : cA + (size_t)(t + 2) * kstep; const char* b2 = last ? nB : cB + (size_t)(t + 2) * kstep;
            const char* a3 = a2 + kstep; const char* b3 = b2 + kstep;
            PG8_LDB(B0, 0, 0); PG8_SCHED; PG8_LDA(At, 0, 0); PG8_STAGE(PG8_SA(1, 1), a1 + hstep, voffA);
            PG8_WAIT_L(8); PG8_BAR; PG8_WAIT_L(0); PG8_MMA(0, 0, At, B0); PG8_BAR; PG8_SCHED;
            PG8_LDB(B1, 0, 1); PG8_STAGE(PG8_SB(0, 0), b2, voffB[0]);
            PG8_BAR; PG8_WAIT_L(0); PG8_MMA(0, 1, At, B1); PG8_BAR;
            PG8_LDA(At, 0, 1); PG8_STAGE(PG8_SA(0, 0), a2, voffA);
            PG8_BAR; PG8_WAIT_L(0); PG8_MMA(1, 0, At, B0); PG8_BAR; PG8_SCHED;
            PG8_STAGE(PG8_SB(0, 1), b2, voffB[1]);
            PG8_WAIT_V(6); PG8_BAR; PG8_MMA(1, 1, At, B1); PG8_BAR;
            PG8_LDB(B0, 1, 0); PG8_SCHED; PG8_LDA(At, 1, 0); PG8_STAGE(PG8_SA(0, 1), a2 + hstep, voffA);
            PG8_WAIT_L(8); PG8_BAR; PG8_WAIT_L(0); PG8_MMA(0, 0, At, B0); PG8_BAR; PG8_SCHED;
            PG8_LDB(B1, 1, 1); PG8_STAGE(PG8_SB(1, 0), b3, voffB[0]);
            PG8_BAR; PG8_WAIT_L(0); PG8_MMA(0, 1, At, B1); PG8_BAR;
            PG8_LDA(At, 1, 1); PG8_STAGE(PG8_SA(1, 0), a3, voffA);
            PG8_BAR; PG8_WAIT_L(0); PG8_MMA(1, 0, At, B0); PG8_BAR; PG8_SCHED;
            PG8_STAGE(PG8_SB(1, 1), b3, voffB[1]);
            PG8_WAIT_V(6); PG8_BAR; PG8_MMA(1, 1, At, B1); PG8_BAR;
        }
        E(acc, cur, wr, wc, fr, fq);
        if (!has_next) break;
#pragma unroll
        for (int a = 0; a < 2; ++a)
#pragma unroll
            for (int b = 0; b < 2; ++b)
#pragma unroll
                for (int m = 0; m < 4; ++m)
#pragma unroll
                    for (int n = 0; n < 2; ++n) acc[a][b][m][n] = (f32x4){0.f, 0.f, 0.f, 0.f};
        cur = nxt; cA = nA; cB = nB; ++ui;
    }
    PG8_WAIT_V(0);
    if (wr == 0) PG8_BAR;
    PG8_BAR;
#undef PG8_SA
#undef PG8_SB
#undef PG8_STAGE
#undef PG8_LDA
#undef PG8_LDB
#undef PG8_MMA
#undef PG8_WAIT_V
#undef PG8_WAIT_L
#undef PG8_BAR
#undef PG8_SCHED
}

struct MUnit { int e, rt, pn, cnt, sbase; };
constexpr int MTAB_OFF = JOBS_OFF + 256;
DI void moe_table256(const unsigned* cntg, LAS unsigned char* lds, int tid) {
    LAS int* ctl = (LAS int*)(lds + MTAB_OFF);
    if (tid < 64) {
        const int c = (tid < NE) ? (int)__hip_atomic_load(cntg + tid, __ATOMIC_RELAXED, __HIP_MEMORY_SCOPE_AGENT) : 0;
        const int n = (c + 255) / 256;
        int pb = c, pt = n;
#pragma unroll
        for (int o = 1; o < 32; o <<= 1) { const int vb = __shfl_up(pb, o), vt = __shfl_up(pt, o); if (tid >= o) { pb += vb; pt += vt; } }
        if (tid < NE) { ctl[tid] = c; ctl[32 + tid] = pb - c; ctl[64 + tid] = pt - n; for (int i = 0; i < n && pt - n + i < 128; ++i) ctl[128 + pt - n + i] = tid; }
        if (tid == NE - 1) ctl[64 + NE] = pt;
    }
    __syncthreads();
}
template <int NPN>
struct MSched {
    const LAS int* ctl; int G, c, total;
    DI void init(LAS unsigned char* lds, int G_, int c_, bool xcd_group = false) { ctl = (const LAS int*)(lds + MTAB_OFF); G = G_; total = ctl[64 + NE] * NPN;
        c = (xcd_group && (G_ % 8 == 0)) ? (c_ % 8) * (G_ / 8) + c_ / 8 : c_; }
    DI bool next(int i, MUnit& u) const {
        const int L = i * G + c; if (L >= total) return false;
        const int rtg = L / NPN; u.pn = L % NPN;
        const int e = ctl[128 + rtg];
        u.e = e; u.rt = rtg - ctl[64 + e]; u.cnt = ctl[e]; u.sbase = ctl[32 + e]; return true;
    }
};
struct MOps1 {
    const bf16_t* H; const bf16_t* W; const unsigned* list;
    DI const char* abase(const MUnit&) const { return (const char*)H; }
    DI void aoffs(const MUnit& u, int R0, int C0, int R1, int C1, unsigned (&o)[2][2]) const {
#pragma unroll
        for (int h = 0; h < 2; ++h) {
            const int ra = u.rt * 256 + h * 128 + R0, rb = u.rt * 256 + h * 128 + R1;
            const unsigned ta = list[(size_t)u.e * T + (ra < u.cnt ? ra : u.cnt - 1)] >> 1, tb = list[(size_t)u.e * T + (rb < u.cnt ? rb : u.cnt - 1)] >> 1;
            o[h][0] = (ta * (unsigned)D + (unsigned)C0) * 2u; o[h][1] = (tb * (unsigned)D + (unsigned)C1) * 2u;
        }
    }
    DI const char* bptr(const MUnit& u) const { return (const char*)(W + ((size_t)u.e * 512 + u.pn * 256) * D); }
};
struct MOps2 {
    const bf16_t* hid; const bf16_t* W;
    DI const char* abase(const MUnit& u) const { return (const char*)(hid + (size_t)(u.sbase + u.rt * 256) * FF); }
    DI void aoffs(const MUnit&, int R0, int C0, int R1, int C1, unsigned (&o)[2][2]) const {
#pragma unroll
        for (int h = 0; h < 2; ++h) { o[h][0] = (unsigned)((h * 128 + R0) * FF + C0) * 2u; o[h][1] = (unsigned)((h * 128 + R1) * FF + C1) * 2u; }
    }
    DI const char* bptr(const MUnit& u) const { return (const char*)(W + ((size_t)u.e * D + u.pn * 256) * FF); }
};
constexpr int MROW_OFF = 131072;
struct EpiSwiglu {
    bf16_t* hid; const float* listw;
    DI void prep(const MUnit& u, LAS unsigned char* lds, int par, int tid) const {
        if (tid < 256) { const int r = u.rt * 256 + tid;
            __builtin_amdgcn_global_load_lds((const GAS unsigned*)(listw + (size_t)u.e * T + (r < u.cnt ? r : u.cnt - 1)), (LAS unsigned*)(lds + MROW_OFF + par * 1024 + (tid >> 6) * 256), 4, 0, 0); }
    }
    DI void operator()(const f32x4 (&acc)[2][2][4][2], const MUnit& u, int wr, int wc, int fr, int fq, const LAS unsigned char* lds, int par) const {
#pragma unroll
        for (int ai = 0; ai < 2; ++ai)
#pragma unroll
            for (int m = 0; m < 4; ++m) {
                const int r = u.rt * 256 + ai * HALF + wr * 64 + m * 16 + fr;
                if (r < u.cnt) {
                    const float gw = ((const LAS float*)(lds + MROW_OFF))[par * 256 + ai * HALF + wr * 64 + m * 16 + fr];
                    unsigned o[4];
#pragma unroll
                    for (int n = 0; n < 2; ++n) { const f32x4 g = acc[ai][0][m][n], uu = acc[ai][1][m][n]; float hv[4];
#pragma unroll
                        for (int j = 0; j < 4; ++j) hv[j] = g[j] / (1.0f + __expf(-g[j])) * uu[j] * gw;
                        o[2 * n] = pk2(hv[0], hv[1]); o[2 * n + 1] = pk2(hv[2], hv[3]); }
                    *(u32x4*)(hid + (size_t)(u.sbase + r) * FF + u.pn * 128 + wc * 32 + 8 * fq) = (u32x4){o[0], o[1], o[2], o[3]};
                }
            }
    }
};
struct EpiScatter {
    bf16_t* Y; const unsigned* list;
    DI void prep(const MUnit& u, LAS unsigned char* lds, int par, int tid) const {
        if (tid < 256) { const int r = u.rt * 256 + tid;
            __builtin_amdgcn_global_load_lds((const GAS unsigned*)(list + (size_t)u.e * T + (r < u.cnt ? r : u.cnt - 1)), (LAS unsigned*)(lds + MROW_OFF + par * 1024 + (tid >> 6) * 256), 4, 0, 0); }
    }
    DI void operator()(const f32x4 (&acc)[2][2][4][2], const MUnit& u, int wr, int wc, int fr, int fq, const LAS unsigned char* lds, int par) const {
#pragma unroll
        for (int ai = 0; ai < 2; ++ai)
#pragma unroll
            for (int m = 0; m < 4; ++m) {
                const int r = u.rt * 256 + ai * HALF + wr * 64 + m * 16 + fr;
                if (r < u.cnt) {
                    const unsigned ent = ((const LAS unsigned*)(lds + MROW_OFF))[par * 256 + ai * HALF + wr * 64 + m * 16 + fr];
                    bf16_t* yrow = Y + ((size_t)(ent & 1u) * T + (ent >> 1)) * D + u.pn * 256 + wc * 64 + 8 * fq;
#pragma unroll
                    for (int bj = 0; bj < 2; ++bj) { const f32x4 v0 = acc[ai][bj][m][0], v1 = acc[ai][bj][m][1];
                        __builtin_nontemporal_store(((u32x4){pk2(v0.x, v0.y), pk2(v0.z, v0.w), pk2(v1.x, v1.y), pk2(v1.z, v1.w)}), (u32x4*)(yrow + bj * 32)); }
                }
            }
    }
};
struct EpiMNull {
    DI void prep(const MUnit&, LAS unsigned char*, int, int) const {}
    DI void operator()(const f32x4 (&acc)[2][2][4][2], const MUnit&, int, int, int, int, const LAS unsigned char*, int) const {
#pragma unroll
        for (int ai = 0; ai < 2; ++ai)
#pragma unroll
            for (int bj = 0; bj < 2; ++bj)
#pragma unroll
                for (int m = 0; m < 4; ++m)
#pragma unroll
                    for (int n = 0; n < 2; ++n) asm volatile("" :: "v"(acc[ai][bj][m][n]));
    }
};
template <int K, class Sched, class Ops, class Epi>
DI void gemm_phase_m(LAS unsigned char* lds, const Sched& S, const Ops& P, const Epi& E) {
    const int tid = threadIdx.x, wid = __builtin_amdgcn_readfirstlane(tid >> 6), lane = tid & 63, wr = wid >> 2, wc = wid & 3, fr = lane & 15, fq = lane >> 4;
    constexpr int nt = K / BK;
    int R0, C0, R1, C1; stage_rc(tid * 16, R0, C0); stage_rc(tid * 16 + 8192, R1, C1);
    unsigned voffB[2][2];
#pragma unroll
    for (int h = 0; h < 2; ++h) { voffB[h][0] = (unsigned)((64 * (R0 >> 5) + 32 * h + perm32(R0 & 31)) * K + C0) * 2u; voffB[h][1] = (unsigned)((64 * (R1 >> 5) + 32 * h + perm32(R1 & 31)) * K + C1) * 2u; }
    constexpr size_t kstep = (size_t)(BK * 2);
    constexpr size_t hstep = (size_t)HALF * K * 2;
    const unsigned ldsw = (unsigned)wid * 1024u;
    const int aoff = lds_byte(wr * 64 + fr, fq * 8), boff = lds_byte(wc * 32 + fr, fq * 8);
#define PG8_SA(b, h) (((b) * 2 + (h)) * HTB)
#define PG8_SB(b, h) ((4 + (b) * 2 + (h)) * HTB)
#define PG8_STAGEB(bufoff, gbase, h) do { _Pragma("unroll") for (int _i = 0; _i < 2; ++_i) \
        __builtin_amdgcn_global_load_lds((const GAS unsigned*)((const char*)(gbase) + voffB[h][_i]), (LAS unsigned*)(lds + (bufoff) + ldsw + _i * 8192), 16, 0, 0); } while (0)
#define PG8_STAGEA(bufoff, bb, pp, h, koff) do { _Pragma("unroll") for (int _i = 0; _i < 2; ++_i) \
        __builtin_amdgcn_global_load_lds((const GAS unsigned*)((bb) + (koff) + (pp)[h][_i]), (LAS unsigned*)(lds + (bufoff) + ldsw + _i * 8192), 16, 0, 0); } while (0)
#define PG8_LDA(dst, b, h) do { _Pragma("unroll") for (int m = 0; m < 4; ++m) _Pragma("unroll") for (int k = 0; k < 2; ++k) dst[m][k] = *(const LAS bf16x8*)(lds + PG8_SA(b, h) + aoff + m * 2048 + k * 1024); } while (0)
#define PG8_LDB(dst, b, h) do { _Pragma("unroll") for (int n = 0; n < 2; ++n) _Pragma("unroll") for (int k = 0; k < 2; ++k) dst[n][k] = *(const LAS bf16x8*)(lds + PG8_SB(b, h) + boff + n * 2048 + k * 1024); } while (0)
#define PG8_MMA(ai, bj, At, Bt) do { __builtin_amdgcn_s_setprio(1); _Pragma("unroll") for (int m = 0; m < 4; ++m) _Pragma("unroll") for (int n = 0; n < 2; ++n) _Pragma("unroll") for (int k = 0; k < 2; ++k) \
        acc[ai][bj][m][n] = __builtin_amdgcn_mfma_f32_16x16x32_bf16(Bt[n][k], At[m][k], acc[ai][bj][m][n], 0, 0, 0); __builtin_amdgcn_s_setprio(0); } while (0)
#define PG8_WAIT_V(n) asm volatile("s_waitcnt vmcnt(" #n ")" ::: "memory")
#define PG8_WAIT_L(n) asm volatile("s_waitcnt lgkmcnt(" #n ")" ::: "memory")
#define PG8_BAR __builtin_amdgcn_s_barrier()
#define PG8_SCHED __builtin_amdgcn_sched_barrier(0)
    MUnit cur, nxt; int ui = 0;
    if (!S.next(0, cur)) return;
    f32x4 acc[2][2][4][2];
#pragma unroll
    for (int a = 0; a < 2; ++a)
#pragma unroll
        for (int b = 0; b < 2; ++b)
#pragma unroll
            for (int m = 0; m < 4; ++m)
#pragma unroll
                for (int n = 0; n < 2; ++n) acc[a][b][m][n] = (f32x4){0.f, 0.f, 0.f, 0.f};
    bf16x8 At[4][2], B0[2][2], B1[2][2];
    unsigned pA[2][2], qA[2][2];
    P.aoffs(cur, R0, C0, R1, C1, pA);
    const char* cAb = P.abase(cur);
    E.prep(cur, lds, 0, tid);
    const char* cB = P.bptr(cur);
    PG8_STAGEB(PG8_SB(0, 0), cB, 0); PG8_STAGEA(PG8_SA(0, 0), cAb, pA, 0, 0); PG8_STAGEB(PG8_SB(0, 1), cB, 1); PG8_STAGEA(PG8_SA(0, 1), cAb, pA, 1, 0);
    if (wr == 1) PG8_BAR;
    PG8_WAIT_V(4); PG8_BAR;
    PG8_STAGEB(PG8_SB(1, 0), cB + kstep, 0); PG8_STAGEA(PG8_SA(1, 0), cAb, pA, 0, kstep); PG8_STAGEB(PG8_SB(1, 1), cB + kstep, 1);
    PG8_WAIT_V(6); PG8_BAR;
    for (;;) {
        const bool has_next = S.next(ui + 1, nxt);
        const char* nB = cB; const char* nAb = cAb;
#pragma unroll
        for (int h = 0; h < 2; ++h) { qA[h][0] = pA[h][0]; qA[h][1] = pA[h][1]; }
        if (has_next) { P.aoffs(nxt, R0, C0, R1, C1, qA); nAb = P.abase(nxt); nB = P.bptr(nxt); E.prep(nxt, lds, (ui + 1) % 3, tid); }
#pragma unroll 1
        for (int t = 0; t < nt; t += 2) {
            const bool last = (t == nt - 2);
            const size_t k1 = (size_t)(t + 1) * kstep;
            const size_t k2 = last ? 0 : (size_t)(t + 2) * kstep, k3 = k2 + kstep;
            const char* b2 = last ? nB : cB + k2; const char* b3 = b2 + kstep;
            const char* a2 = last ? nAb : cAb;
            unsigned o2[2][2];
#pragma unroll
            for (int h = 0; h < 2; ++h) { o2[h][0] = last ? qA[h][0] : pA[h][0]; o2[h][1] = last ? qA[h][1] : pA[h][1]; }
            PG8_LDB(B0, 0, 0); PG8_SCHED; PG8_LDA(At, 0, 0); PG8_STAGEA(PG8_SA(1, 1), cAb, pA, 1, k1);
            PG8_WAIT_L(8); PG8_BAR; PG8_WAIT_L(0); PG8_MMA(0, 0, At, B0); PG8_BAR; PG8_SCHED;
            PG8_LDB(B1, 0, 1); PG8_STAGEB(PG8_SB(0, 0), b2, 0);
            PG8_BAR; PG8_WAIT_L(0); PG8_MMA(0, 1, At, B1); PG8_BAR;
            PG8_LDA(At, 0, 1); PG8_STAGEA(PG8_SA(0, 0), a2, o2, 0, k2);
            PG8_BAR; PG8_WAIT_L(0); PG8_MMA(1, 0, At, B0); PG8_BAR; PG8_SCHED;
            PG8_STAGEB(PG8_SB(0, 1), b2, 1);
            PG8_WAIT_V(6); PG8_BAR; PG8_MMA(1, 1, At, B1); PG8_BAR;
            PG8_LDB(B0, 1, 0); PG8_SCHED; PG8_LDA(At, 1, 0); PG8_STAGEA(PG8_SA(0, 1), a2, o2, 1, k2);
            PG8_WAIT_L(8); PG8_BAR; PG8_WAIT_L(0); PG8_MMA(0, 0, At, B0); PG8_BAR; PG8_SCHED;
            PG8_LDB(B1, 1, 1); PG8_STAGEB(PG8_SB(1, 0), b3, 0);
            PG8_BAR; PG8_WAIT_L(0); PG8_MMA(0, 1, At, B1); PG8_BAR;
            PG8_LDA(At, 1, 1); PG8_STAGEA(PG8_SA(1, 0), a2, o2, 0, k3);
            PG8_BAR; PG8_WAIT_L(0); PG8_MMA(1, 0, At, B0); PG8_BAR; PG8_SCHED;
            PG8_STAGEB(PG8_SB(1, 1), b3, 1);
            PG8_WAIT_V(6); PG8_BAR; PG8_MMA(1, 1, At, B1); PG8_BAR;
        }
        E(acc, cur, wr, wc, fr, fq, lds, ui % 3);
        if (!has_next) break;
#pragma unroll
        for (int a = 0; a < 2; ++a)
#pragma unroll
            for (int b = 0; b < 2; ++b)
#pragma unroll
                for (int m = 0; m < 4; ++m)
#pragma unroll
                    for (int n = 0; n < 2; ++n) acc[a][b][m][n] = (f32x4){0.f, 0.f, 0.f, 0.f};
        cur = nxt; cB = nB; cAb = nAb; ++ui;
#pragma unroll
        for (int h = 0; h < 2; ++h) { pA[h][0] = qA[h][0]; pA[h][1] = qA[h][1]; }
    }
    PG8_WAIT_V(0);
    if (wr == 0) PG8_BAR;
    PG8_BAR;
#undef PG8_SA
#undef PG8_SB
#undef PG8_STAGEA
#undef PG8_STAGEB
#undef PG8_LDA
#undef PG8_LDB
#undef PG8_MMA
#undef PG8_WAIT_V
#undef PG8_WAIT_L
#undef PG8_BAR
#undef PG8_SCHED
}
}

constexpr int AT_K0 = 0, AT_V0 = 17408, AT_KVB = 35840, AT_FL = 71680, AT_QS = 71936;
DI void attn_phase(const bf16_t* Qb, const bf16_t* Kb, const bf16_t* Vt, bf16_t* O, LAS unsigned char* lds, int tid, int wid, int lane) {
    const int fr = lane & 15, fq = lane >> 4;
    LAS int* flags = (LAS int*)(lds + AT_FL);
    for (int bx = blockIdx.x; bx < 512; bx += gridDim.x) {
        const int rnd = bx >> 8, pos = bx & 255;
        const int qb = (rnd & 1) ? (pos >> 6) : (7 - (pos >> 6));
        const int bh = pos & 63, b = bh >> 4, h = bh & 15;
        const int t0 = qb * 256;
        __syncthreads();
        const int kr0 = tid >> 4, kc = tid & 15, vr0 = tid >> 3, vc = tid & 7;
        const bf16_t* kg = Kb + (size_t)(b * SEQ + kr0) * D + h * 128 + kc * 8;
        const bf16_t* vg = Vt + (size_t)(h * 128 + vr0) * T + b * SEQ + vc * 8;
        u32x4 pk0, pk1, pv0, pv1;
        int s0 = t0 + 192;
        pk0 = *(const u32x4*)(kg + (size_t)s0 * D); pk1 = *(const u32x4*)(kg + (size_t)(s0 + 32) * D);
        pv0 = *(const u32x4*)(vg + s0); pv1 = *(const u32x4*)(vg + (size_t)64 * T + s0);
#pragma unroll
        for (int c8 = 0; c8 < 8; ++c8) {
            const int c = tid + 512 * c8, row = c >> 4, c16 = c & 15;
            *(LAS u32x4*)(lds + AT_QS + row * 272 + c16 * 16) = *(const u32x4*)(Qb + (size_t)(b * SEQ + t0 + row) * D + h * 128 + c16 * 8);
        }
        {
            LAS unsigned char* kb_ = lds + AT_K0; LAS unsigned char* vb_ = lds + AT_V0;
            *(LAS u32x4*)(kb_ + kr0 * 272 + kc * 16) = pk0; *(LAS u32x4*)(kb_ + (kr0 + 32) * 272 + kc * 16) = pk1;
            *(LAS u32x4*)(vb_ + vr0 * 144 + vc * 16) = pv0; *(LAS u32x4*)(vb_ + (vr0 + 64) * 144 + vc * 16) = pv1;
            const int s1 = s0 - 64;
            pk0 = *(const u32x4*)(kg + (size_t)s1 * D); pk1 = *(const u32x4*)(kg + (size_t)(s1 + 32) * D); pv0 = *(const u32x4*)(vg + s1); pv1 = *(const u32x4*)(vg + (size_t)64 * T + s1);
        }
        __syncthreads();
        f32x4 oacc[2][8];
#pragma unroll
        for (int r = 0; r < 2; ++r)
#pragma unroll
            for (int n = 0; n < 8; ++n) oacc[r][n] = (f32x4){0.f, 0.f, 0.f, 0.f};
        float Rrun[2] = {1.f, 1.f};
        bool wave_alive = true;
        int it = 0;
        for (;; ++it, s0 -= 64) {
            int zz = 0; asm volatile("" : "+v"(zz));
            const LAS unsigned char* kb_ = lds + zz + AT_K0 + (it & 1) * AT_KVB; const LAS unsigned char* vb_ = lds + zz + AT_V0 + (it & 1) * AT_KVB;
            const bool wave_on = (s0 < t0 + 32 * wid + 31) && wave_alive;
            if (wave_on) {
            f32x4 sacc[2][4];
#pragma unroll
            for (int r = 0; r < 2; ++r)
#pragma unroll
                for (int n = 0; n < 4; ++n) sacc[r][n] = (f32x4){0.f, 0.f, 0.f, 0.f};
#pragma unroll
            for (int ks = 0; ks < 4; ++ks) {
                const bf16x8 qa0 = *(const LAS bf16x8*)(lds + zz + AT_QS + (32 * wid + fr) * 272 + (ks * 32 + fq * 8) * 2);
                const bf16x8 qa1 = *(const LAS bf16x8*)(lds + zz + AT_QS + (32 * wid + 16 + fr) * 272 + (ks * 32 + fq * 8) * 2);
#pragma unroll
                for (int n = 0; n < 4; ++n) {
                    const bf16x8 kf = *(const LAS bf16x8*)(kb_ + (16 * n + fr) * 272 + (ks * 32 + fq * 8) * 2);
                    sacc[0][n] = MFMA16(kf, qa0, sacc[0][n]);
                    sacc[1][n] = MFMA16(kf, qa1, sacc[1][n]);
                }
            }
            unsigned ap[2][4][2];
            const int sb = s0 + 4 * fq;
#pragma unroll
            for (int r = 0; r < 2; ++r) {
                const int tq = t0 + 32 * wid + 16 * r + fr;
                float apart[4][4], gprod[4];
#pragma unroll
                for (int n = 0; n < 4; ++n) {
                    float run = 1.f;
#pragma unroll
                    for (int j = 3; j >= 0; --j) {
                        const float zz = ((sb + 16 * n + j) < tq) ? fminf(sacc[r][n][j], 80.f) : -200.f;
                        const float p2 = __builtin_amdgcn_exp2f(zz);
                        const float om = __builtin_amdgcn_rcpf(1.0f + p2);
                        apart[n][j] = p2 * om * run;
                        run *= om;
                    }
                    gprod[n] = run;
                }
                float offs[4]; float acc_after = 1.f;
#pragma unroll
                for (int n = 3; n >= 0; --n) {
                    const float bq = __shfl_xor(gprod[n], 16); const float s01 = gprod[n] * bq; const float oth = __shfl_xor(s01, 32);
                    offs[n] = Rrun[r] * acc_after * (((fq & 1) == 0) ? bq : 1.f) * ((fq < 2) ? oth : 1.f);
                    acc_after *= s01 * oth;
                }
                Rrun[r] *= acc_after;
#pragma unroll
                for (int n = 0; n < 4; ++n) { ap[r][n][0] = pk2(apart[n][0] * offs[n], apart[n][1] * offs[n]); ap[r][n][1] = pk2(apart[n][2] * offs[n], apart[n][3] * offs[n]); }
            }
#pragma unroll
            for (int u = 0; u < 2; ++u) {
                const bf16x8 aa0 = __builtin_bit_cast(bf16x8, ((u32x4){ap[0][2 * u][0], ap[0][2 * u][1], ap[0][2 * u + 1][0], ap[0][2 * u + 1][1]}));
                const bf16x8 aa1 = __builtin_bit_cast(bf16x8, ((u32x4){ap[1][2 * u][0], ap[1][2 * u][1], ap[1][2 * u + 1][0], ap[1][2 * u + 1][1]}));
#pragma unroll
                for (int n = 0; n < 8; ++n) {
                    const s16x4 vlo = *(const LAS s16x4*)(vb_ + (16 * n + fr) * 144 + (32 * u + 4 * fq) * 2);
                    const s16x4 vhi = *(const LAS s16x4*)(vb_ + (16 * n + fr) * 144 + (32 * u + 16 + 4 * fq) * 2);
                    const bf16x8 vf = __builtin_shufflevector(vlo, vhi, 0, 1, 2, 3, 4, 5, 6, 7);
                    oacc[0][n] = MFMA16(vf, aa0, oacc[0][n]);
                    oacc[1][n] = MFMA16(vf, aa1, oacc[1][n]);
                }
            }
            }
            const int sn1 = s0 - 64, sn2 = s0 - 128;
            wave_alive = __any(fmaxf(Rrun[0], Rrun[1]) > 0.f);
            if (lane == 0) flags[(it & 1) * 8 + wid] = wave_alive ? 1 : 0;
            if (sn1 >= 0) {
                LAS unsigned char* kn = lds + AT_K0 + ((it + 1) & 1) * AT_KVB; LAS unsigned char* vn = lds + AT_V0 + ((it + 1) & 1) * AT_KVB;
                *(LAS u32x4*)(kn + kr0 * 272 + kc * 16) = pk0; *(LAS u32x4*)(kn + (kr0 + 32) * 272 + kc * 16) = pk1;
                *(LAS u32x4*)(vn + vr0 * 144 + vc * 16) = pv0; *(LAS u32x4*)(vn + (vr0 + 64) * 144 + vc * 16) = pv1;
                if (sn2 >= 0) { pk0 = *(const u32x4*)(kg + (size_t)sn2 * D); pk1 = *(const u32x4*)(kg + (size_t)(sn2 + 32) * D); pv0 = *(const u32x4*)(vg + sn2); pv1 = *(const u32x4*)(vg + (size_t)64 * T + sn2); }
            }
            __syncthreads();
            if (sn1 < 0) break;
            int any_alive = 0;
#pragma unroll
            for (int w = 0; w < 8; ++w) any_alive |= flags[(it & 1) * 8 + w];
            if (!any_alive) break;
        }
#pragma unroll
        for (int r = 0; r < 2; ++r) {
            bf16_t* orow = O + (size_t)(b * SEQ + t0 + 32 * wid + 16 * r + fr) * D + h * 128 + 4 * fq;
#pragma unroll
            for (int n = 0; n < 8; ++n) { u32x2 o; o.x = pk2(oacc[r][n].x, oacc[r][n].y); o.y = pk2(oacc[r][n].z, oacc[r][n].w); *(u32x2*)(orow + 16 * n) = o; }
        }
    }
}

constexpr int ML_QS = 0, ML_KS = 17408, ML_KD = 34816, ML_VT = 53248, ML_WS = 90112, ML_HB = 99328, ML_SC = 133120;
DI float ml_tab(LAS float* tab, float gi, float gf, float mprev, int lane) {
    const float flog = fminf(gf, 0.f) - __logf(1.0f + __expf(-fabsf(gf)));
    float bb = flog;
#pragma unroll
    for (int o = 1; o < 64; o <<= 1) { const float v = __shfl_up(bb, o); if (lane >= o) bb += v; }
    const float a = gi - bb;
    float pm = a;
#pragma unroll
    for (int o = 1; o < 64; o <<= 1) { const float v = __shfl_up(pm, o); if (lane >= o) pm = fmaxf(pm, v); }
    const float amax = __shfl(pm, 63), bL = __shfl(bb, 63);
    const float Mx = fmaxf(mprev, amax);
    tab[lane] = a; tab[64 + lane] = bb; tab[128 + lane] = fmaxf(pm, mprev);
    if (lane == 0) { tab[192] = mprev; tab[193] = Mx; }
    return bL + Mx;
}
constexpr int MLA_KD = 0, MLA_SC = 69632;
DI void mlstm_local(const bf16_t* K1, const bf16_t* VT, const float* G, const float* b_i, const float* b_f, bf16_t* KV, float* NJ, float* SUM,
                    LAS unsigned char* lds, int tid, int wid, int lane) {
    const int fr = lane & 15, fq = lane >> 4;
    LAS float* sa = (LAS float*)(lds + MLA_SC); LAS float* swsum = sa + 256; LAS float* swmax = sa + 264;
    for (int unit0 = blockIdx.x; unit0 < 256; unit0 += gridDim.x) {
        const int unit = (gridDim.x == 256) ? (unit0 & 7) * 32 + (unit0 >> 3) : unit0;
        const int J = unit & 7, bh = unit >> 3, b = bh >> 3, h = bh & 7;
        if (J == 7) continue;
        const int tok0 = b * SEQ + J * 256;
        __syncthreads();
        float a = 0.f, bb = 0.f;
        if (tid < 256) {
            const size_t g0 = (size_t)(tok0 + tid) * 16;
            const float gi = G[g0 + h] + b_i[h], gf = G[g0 + 8 + h] + b_f[h];
            const float flog = fminf(gf, 0.f) - __logf(1.0f + __expf(-fabsf(gf)));
            bb = flog;
#pragma unroll
            for (int o = 1; o < 64; o <<= 1) { const float v = __shfl_up(bb, o); if (lane >= o) bb += v; }
            if (lane == 63) swsum[wid] = bb;
        }
        __syncthreads();
        if (tid < 256) {
            float off = 0.f;
            for (int w = 0; w < 4; ++w) off += (w < wid) ? swsum[w] : 0.f;
            bb += off;
            const size_t g0 = (size_t)(tok0 + tid) * 16;
            a = (G[g0 + h] + b_i[h]) - bb;
            float mx = a;
#pragma unroll
            for (int o = 1; o < 64; o <<= 1) mx = fmaxf(mx, __shfl_xor(mx, o));
            if (lane == 0) swmax[wid] = mx;
            sa[tid] = a;
        }
        __syncthreads();
        const float amax = fmaxf(fmaxf(swmax[0], swmax[1]), fmaxf(swmax[2], swmax[3]));
        if (tid == 255) { SUM[unit * 2] = amax; SUM[unit * 2 + 1] = bb; }
        bf16x8 vfa[8][2];
#pragma unroll
        for (int ks = 0; ks < 8; ++ks)
#pragma unroll
            for (int et = 0; et < 2; ++et) vfa[ks][et] = *(const bf16x8*)(VT + (size_t)(h * 256 + 32 * wid + 16 * et + fr) * T + tok0 + ks * 32 + fq * 8);
#pragma unroll 2
        for (int c8i = 0; c8i < 8; ++c8i) {
            const int ch = tid + 512 * c8i, sp = ch & 255, c16 = ch >> 8;
            const u32x4 v = *(const u32x4*)(K1 + (size_t)(tok0 + sp) * 1024 + h * 128 + c16 * 8);
            const float dsc = __expf(sa[sp] - amax);
            const unsigned w[4] = {v.x, v.y, v.z, v.w};
            LAS bf16_t* dst = (LAS bf16_t*)(lds + MLA_KD + (c16 * 8) * 528 + sp * 2);
#pragma unroll
            for (int q = 0; q < 4; ++q) { dst[(2 * q) * 264] = (bf16_t)f2bf(bf2f(w[q] & 0xffff) * dsc); dst[(2 * q + 1) * 264] = (bf16_t)f2bf(bf2f(w[q] >> 16) * dsc); }
        }
        __syncthreads();
        f32x4 C[8][2];
#pragma unroll
        for (int dt = 0; dt < 8; ++dt)
#pragma unroll
            for (int et = 0; et < 2; ++et) C[dt][et] = (f32x4){0.f, 0.f, 0.f, 0.f};
#pragma unroll
        for (int ks = 0; ks < 8; ++ks) {
#pragma unroll
            for (int dt = 0; dt < 8; ++dt) {
                const bf16x8 kf = *(const LAS bf16x8*)(lds + MLA_KD + (16 * dt + fr) * 528 + (ks * 32 + fq * 8) * 2);
#pragma unroll
                for (int et = 0; et < 2; ++et) C[dt][et] = MFMA16(kf, vfa[ks][et], C[dt][et]);
            }
        }
        bf16_t* kv = KV + (size_t)unit * 32768;
#pragma unroll
        for (int dt = 0; dt < 8; ++dt)
#pragma unroll
            for (int et = 0; et < 2; ++et) { u32x2 o; o.x = pk2(C[dt][et].x, C[dt][et].y); o.y = pk2(C[dt][et].z, C[dt][et].w); *(u32x2*)(kv + (size_t)(32 * wid + 16 * et + fr) * 128 + 16 * dt + 4 * fq) = o; }
        {
            const int dl = tid >> 2, sl = tid & 3;
            float p = 0.f;
#pragma unroll
            for (int i = 0; i < 8; ++i) {
                const u32x4 kq = *(const LAS u32x4*)(lds + MLA_KD + dl * 528 + sl * 128 + i * 16);
                p += (bf2f(kq.x & 0xffff) + bf2f(kq.x >> 16)) + (bf2f(kq.y & 0xffff) + bf2f(kq.y >> 16)) + (bf2f(kq.z & 0xffff) + bf2f(kq.z >> 16)) + (bf2f(kq.w & 0xffff) + bf2f(kq.w >> 16));
            }
            p += __shfl_xor(p, 1); p += __shfl_xor(p, 2);
            if (sl == 0) NJ[unit * 128 + dl] = p;
        }
    }
}
template <int skip>
DI void mlstm_phase(const bf16_t* Q1, const bf16_t* K1, const bf16_t* VT, const bf16_t* OG, const float* G, const float* b_i, const float* b_f,
                    const float* g_head, bf16_t* HS, const bf16_t* KV, const float* NJ, const float* SUM, LAS unsigned char* lds, int tid, int wid, int lane, int nsteps = 4) {
    const int fr = lane & 15, fq = lane >> 4;
    LAS float* sc = (LAS float*)(lds + ML_SC); LAS float* sssq = sc + 1024; LAS float* srs = sc + 1536; LAS float* sden = sc + 1792; LAS float* sn = sc + 1856; LAS float* sgh = sc + 2112; LAS float* scf = sc + 2368;
    LAS bf16_t* hb = (LAS bf16_t*)(lds + ML_HB);
    for (int unit0 = blockIdx.x; unit0 < 256; unit0 += gridDim.x) {
        const int unit = (gridDim.x == 256) ? (unit0 & 7) * 32 + (unit0 >> 3) : unit0;
        const int J = unit & 7, bh = unit >> 3, b = bh >> 3, h = bh & 7;
        const int c0 = 4 * J, c1 = c0 + nsteps;
        __syncthreads();
        if (wid < 4) {
            LAS float* tab = sc + wid * 256;
            const size_t g0 = (size_t)(b * SEQ + (c0 + wid) * 64 + lane) * 16;
            const float gi = G[g0 + h] + b_i[h], gf = G[g0 + 8 + h] + b_f[h];
            const float flog = fminf(gf, 0.f) - __logf(1.0f + __expf(-fabsf(gf)));
            float bb = flog;
#pragma unroll
            for (int o = 1; o < 64; o <<= 1) { const float v = __shfl_up(bb, o); if (lane >= o) bb += v; }
            const float a = gi - bb;
            float pm = a;
#pragma unroll
            for (int o = 1; o < 64; o <<= 1) { const float v = __shfl_up(pm, o); if (lane >= o) pm = fmaxf(pm, v); }
            tab[lane] = a; tab[64 + lane] = bb; tab[128 + lane] = pm;
            if (lane == 63) { tab[192] = pm; tab[193] = bb; }
        }
        if (tid >= 448 && tid < 462) scf[8 + tid - 448] = SUM[bh * 16 + tid - 448];
        __syncthreads();
        if (tid == 0) {
            float cf[7]; float m0 = 0.f;
#pragma unroll
            for (int jp = 0; jp < 7; ++jp) {
                cf[jp] = 0.f;
                if (jp < J) {
                    const float am = scf[8 + 2 * jp], bl = scf[9 + 2 * jp];
                    const float M63 = fmaxf(m0, am), csj = __expf(m0 - M63);
#pragma unroll
                    for (int i = 0; i < 7; ++i) if (i < jp) cf[i] *= csj;
                    cf[jp] = __expf(am - M63);
                    m0 = bl + M63;
                }
            }
#pragma unroll
            for (int jp = 0; jp < 7; ++jp) scf[jp] = cf[jp];
            scf[7] = m0;
        }
        __syncthreads();
        const float m0 = scf[7];
        f32x4 C[8][2];
#pragma unroll
        for (int dt = 0; dt < 8; ++dt)
#pragma unroll
            for (int et = 0; et < 2; ++et) C[dt][et] = (f32x4){0.f, 0.f, 0.f, 0.f};
        float n0 = 0.f;
#pragma unroll 1
        for (int jp = 0; jp < J; ++jp) {
            const bf16_t* kv = KV + (size_t)(bh * 8 + jp) * 32768; const float cf = scf[jp];
#pragma unroll
            for (int dt = 0; dt < 8; ++dt)
#pragma unroll
                for (int et = 0; et < 2; ++et) { const u32x2 v = *(const u32x2*)(kv + (size_t)(32 * wid + 16 * et + fr) * 128 + 16 * dt + 4 * fq);
                    C[dt][et].x += cf * bf2f(v.x & 0xffff); C[dt][et].y += cf * bf2f(v.x >> 16); C[dt][et].z += cf * bf2f(v.y & 0xffff); C[dt][et].w += cf * bf2f(v.y >> 16); }
            if (tid < 128) n0 += cf * NJ[(bh * 8 + jp) * 128 + tid];
        }
        if (tid < 128) sn[tid] = n0;
        if (tid >= 256) sgh[tid - 256] = g_head[h * 256 + tid - 256];
        __syncthreads();
        if (tid == 0) { float m = m0; for (int cc = 0; cc < 4; ++cc) { LAS float* tab = sc + cc * 256; const float M63 = fmaxf(m, tab[192]); tab[194] = m; tab[195] = M63; m = tab[193] + M63; } }
        __syncthreads();
        u32x4 rq[2], rk[2], rt[2], rv[4];
#define ML_LOAD(cc) do { const int tk_ = b * SEQ + (cc) * 64; _Pragma("unroll") for (int c2 = 0; c2 < 2; ++c2) { const int ch = tid + 512 * c2; \
            rq[c2] = *(const u32x4*)(Q1 + (size_t)(tk_ + (ch >> 4)) * 1024 + h * 128 + (ch & 15) * 8); rk[c2] = *(const u32x4*)(K1 + (size_t)(tk_ + (ch >> 4)) * 1024 + h * 128 + (ch & 15) * 8); \
            rt[c2] = *(const u32x4*)(K1 + (size_t)(tk_ + (ch & 63)) * 1024 + h * 128 + (ch >> 6) * 8); } \
        _Pragma("unroll") for (int c4 = 0; c4 < 4; ++c4) { const int ch = tid + 512 * c4; rv[c4] = *(const u32x4*)(VT + (size_t)(h * 256 + (ch >> 3)) * T + tk_ + (ch & 7) * 8); } } while (0)
#define ML_STORE(cc) do { const LAS float* tb_ = sc + ((cc) - c0) * 256; const float M63_ = tb_[195]; _Pragma("unroll") for (int c2 = 0; c2 < 2; ++c2) { const int ch = tid + 512 * c2; \
            *(LAS u32x4*)(lds + ML_QS + (ch >> 4) * 272 + (ch & 15) * 16) = rq[c2]; *(LAS u32x4*)(lds + ML_KS + (ch >> 4) * 272 + (ch & 15) * 16) = rk[c2]; \
            const int sp = ch & 63, c16 = ch >> 6; const float dsc = __expf(tb_[sp] - M63_); const unsigned w_[4] = {rt[c2].x, rt[c2].y, rt[c2].z, rt[c2].w}; \
            LAS bf16_t* dst = (LAS bf16_t*)(lds + ML_KD + (c16 * 8) * 144 + sp * 2); \
            _Pragma("unroll") for (int q = 0; q < 4; ++q) { dst[(2 * q) * 72] = (bf16_t)f2bf(bf2f(w_[q] & 0xffff) * dsc); dst[(2 * q + 1) * 72] = (bf16_t)f2bf(bf2f(w_[q] >> 16) * dsc); } } \
        _Pragma("unroll") for (int c4 = 0; c4 < 4; ++c4) { const int ch = tid + 512 * c4; *(LAS u32x4*)(lds + ML_VT + (ch >> 3) * 144 + (ch & 7) * 16) = rv[c4]; } } while (0)
        if (c0 < c1) { ML_LOAD(c0); ML_STORE(c0); }
#pragma unroll 1
        for (int c = c0; c < c1; ++c) {
            int zz = 0; asm volatile("" : "+v"(zz));
            LAS unsigned char* const L = lds + zz; LAS float* const scz = (LAS float*)(L + ML_SC);
            LAS float* const sssq = scz + 1024; LAS float* const srs = scz + 1536; LAS float* const sden = scz + 1792; LAS float* const sn = scz + 1856; LAS float* const sgh = scz + 2112; LAS bf16_t* const hb = (LAS bf16_t*)(L + ML_HB);
            const int tok0 = b * SEQ + c * 64;
            const LAS float* tab = scz + (c - c0) * 256;
            LAS float* sncur = sn + ((c - c0) & 1) * 128; LAS float* snnxt = sn + (((c - c0) & 1) ^ 1) * 128;
            __syncthreads();
            const float mprev = tab[194], M63 = tab[195];
            if (!(skip & 1)) {
                const int tb = wid >> 1;
#pragma unroll
                for (int a2 = 0; a2 < 2; ++a2) {
                    const int sa_t = 2 * (wid & 1) + a2;
                    u32x2 o = (u32x2){0u, 0u}; float rsum = 0.f;
                    if (sa_t <= tb) {
                        f32x4 acc = (f32x4){0.f, 0.f, 0.f, 0.f};
#pragma unroll
                        for (int ks = 0; ks < 4; ++ks) {
                            const bf16x8 kf = *(const LAS bf16x8*)(L + ML_KS + (16 * sa_t + fr) * 272 + (ks * 32 + fq * 8) * 2);
                            const bf16x8 qf = *(const LAS bf16x8*)(L + ML_QS + (16 * tb + fr) * 272 + (ks * 32 + fq * 8) * 2);
                            acc = MFMA16(kf, qf, acc);
                        }
                        const int tl = 16 * tb + fr; const float Mt = fmaxf(tab[128 + tl], mprev);
                        float wv[4];
#pragma unroll
                        for (int j = 0; j < 4; ++j) { const int sl = 16 * sa_t + 4 * fq + j; wv[j] = (sl <= tl) ? acc[j] * __expf(tab[sl] - Mt) : 0.f; }
                        o.x = pk2(wv[0], wv[1]); o.y = pk2(wv[2], wv[3]);
                        rsum = (wv[0] + wv[1]) + (wv[2] + wv[3]);
                        rsum += __shfl_xor(rsum, 16); rsum += __shfl_xor(rsum, 32);
                    }
                    *(LAS u32x2*)(L + ML_WS + (16 * tb + fr) * 144 + (16 * sa_t + 4 * fq) * 2) = o;
                    if (fq == 0) srs[sa_t * 64 + 16 * tb + fr] = rsum;
                }
            }
            __syncthreads();
            if (!(skip & 2)) {
                const int tl = tid >> 3, sl = tid & 7;
                const u32x4 qa = *(const LAS u32x4*)(L + ML_QS + tl * 272 + sl * 32), qb = *(const LAS u32x4*)(L + ML_QS + tl * 272 + sl * 32 + 16);
                const unsigned qw[8] = {qa.x, qa.y, qa.z, qa.w, qb.x, qb.y, qb.z, qb.w};
                float p = 0.f;
#pragma unroll
                for (int k = 0; k < 8; ++k) p += bf2f(qw[k] & 0xffff) * sncur[sl * 16 + 2 * k] + bf2f(qw[k] >> 16) * sncur[sl * 16 + 2 * k + 1];
                p += __shfl_xor(p, 1); p += __shfl_xor(p, 2); p += __shfl_xor(p, 4);
                if (sl == 0) sden[tl] = __expf(mprev - fmaxf(tab[128 + tl], mprev)) * p + (srs[tl] + srs[64 + tl]) + (srs[128 + tl] + srs[192 + tl]);
            }
#pragma unroll 1
            for (int tt = 0; tt < ((skip & 4) ? 0 : 4); ++tt) {
                f32x4 num[2];
#pragma unroll
                for (int et = 0; et < 2; ++et) num[et] = (f32x4){0.f, 0.f, 0.f, 0.f};
#pragma unroll
                for (int u = 0; u < 4; ++u) {
                    const s16x4 qlo = *(const LAS s16x4*)(L + ML_QS + (16 * tt + fr) * 272 + (32 * u + 4 * fq) * 2);
                    const s16x4 qhi = *(const LAS s16x4*)(L + ML_QS + (16 * tt + fr) * 272 + (32 * u + 16 + 4 * fq) * 2);
                    const bf16x8 qf = __builtin_shufflevector(qlo, qhi, 0, 1, 2, 3, 4, 5, 6, 7);
#pragma unroll
                    for (int et = 0; et < 2; ++et) {
                        const f32x4 c0v = C[2 * u][et], c1v = C[2 * u + 1][et];
                        u32x4 pb; pb.x = pk2(c0v.x, c0v.y); pb.y = pk2(c0v.z, c0v.w); pb.z = pk2(c1v.x, c1v.y); pb.w = pk2(c1v.z, c1v.w);
                        num[et] = MFMA16(qf, __builtin_bit_cast(bf16x8, pb), num[et]);
                    }
                }
                float scv[4];
#pragma unroll
                for (int j = 0; j < 4; ++j) scv[j] = __expf(mprev - fmaxf(tab[128 + 16 * tt + 4 * fq + j], mprev));
#pragma unroll
                for (int et = 0; et < 2; ++et) { num[et].x *= scv[0]; num[et].y *= scv[1]; num[et].z *= scv[2]; num[et].w *= scv[3]; }
                const int nks = (tt < 2) ? 1 : 2;
                for (int ks = 0; ks < nks; ++ks) {
                    const bf16x8 wf = *(const LAS bf16x8*)(L + ML_WS + (16 * tt + fr) * 144 + (ks * 32 + fq * 8) * 2);
#pragma unroll
                    for (int et = 0; et < 2; ++et) {
                        const bf16x8 vf = *(const LAS bf16x8*)(L + ML_VT + (32 * wid + 16 * et + fr) * 144 + (ks * 32 + fq * 8) * 2);
                        num[et] = MFMA16(wf, vf, num[et]);
                    }
                }
#pragma unroll
                for (int j = 0; j < 4; ++j) {
                    const int tl = 16 * tt + 4 * fq + j;
                    const float h0 = num[0][j], h1 = num[1][j];
                    hb[tl * 264 + 32 * wid + fr] = (bf16_t)f2bf(h0);
                    hb[tl * 264 + 32 * wid + 16 + fr] = (bf16_t)f2bf(h1);
                    float s = h0 * h0 + h1 * h1;
                    s += dpp_f(s, 0xB1); s += dpp_f(s, 0x4E); s += dpp_f(s, 0x141); s += dpp_f(s, 0x140);
                    if (fr == 0) sssq[wid * 64 + tl] = s;
                }
            }
            const float cs = __expf(mprev - M63);
            if (!(skip & 8)) {
#pragma unroll
                for (int dt = 0; dt < 8; ++dt)
#pragma unroll
                    for (int et = 0; et < 2; ++et) { C[dt][et].x *= cs; C[dt][et].y *= cs; C[dt][et].z *= cs; C[dt][et].w *= cs; }
#pragma unroll
                for (int ks = 0; ks < 2; ++ks) {
                    bf16x8 vf[2];
#pragma unroll
                    for (int et = 0; et < 2; ++et) vf[et] = *(const LAS bf16x8*)(L + ML_VT + (32 * wid + 16 * et + fr) * 144 + (ks * 32 + fq * 8) * 2);
#pragma unroll
                    for (int dt = 0; dt < 8; ++dt) {
                        const bf16x8 kf = *(const LAS bf16x8*)(L + ML_KD + (16 * dt + fr) * 144 + (ks * 32 + fq * 8) * 2);
#pragma unroll
                        for (int et = 0; et < 2; ++et) C[dt][et] = MFMA16(kf, vf[et], C[dt][et]);
                    }
                }
            }
            {
                const int dl = tid >> 2, sl = tid & 3;
                const u32x4 ka = *(const LAS u32x4*)(L + ML_KD + dl * 144 + sl * 32), kb = *(const LAS u32x4*)(L + ML_KD + dl * 144 + sl * 32 + 16);
                const unsigned kw[8] = {ka.x, ka.y, ka.z, ka.w, kb.x, kb.y, kb.z, kb.w};
                float p = 0.f;
#pragma unroll
                for (int k = 0; k < 8; ++k) p += bf2f(kw[k] & 0xffff) + bf2f(kw[k] >> 16);
                p += __shfl_xor(p, 1); p += __shfl_xor(p, 2);
                if (sl == 0) snnxt[dl] = cs * sncur[dl] + p;
            }
            __syncthreads();
            if (skip & 16) { if (c + 1 < c1) ML_LOAD(c + 1); } else {
                const int tl = tid >> 3, part = tid & 7;
                u32x4 ovq[4];
#pragma unroll
                for (int q = 0; q < 4; ++q) ovq[q] = *(const u32x4*)(OG + (size_t)(tok0 + tl) * D + h * 256 + (part + 8 * q) * 8);
                if (c + 1 < c1) ML_LOAD(c + 1);
                float tot = 0.f;
#pragma unroll
                for (int w = 0; w < 8; ++w) tot += sssq[w * 64 + tl];
                const float dd = 1.0f / fmaxf(fabsf(sden[tl]), __expf(-(tab[64 + tl] + fmaxf(tab[128 + tl], mprev))));
                const float rinv = dd / sqrtf(tot * dd * dd * (1.0f / 256.0f) + EPS);
#pragma unroll
                for (int q = 0; q < 4; ++q) {
                    const int e0 = (part + 8 * q) * 8;
                    const u32x4 hv = *(const LAS u32x4*)(L + ML_HB + tl * 528 + e0 * 2);
                    const size_t idx = (size_t)(tok0 + tl) * D + h * 256 + e0;
                    const u32x4 ov = ovq[q];
                    const f32x4 g0 = *(const LAS f32x4*)(sgh + e0), g1 = *(const LAS f32x4*)(sgh + e0 + 4);
                    const unsigned hw[4] = {hv.x, hv.y, hv.z, hv.w}, ow[4] = {ov.x, ov.y, ov.z, ov.w};
                    const float gg[8] = {g0.x, g0.y, g0.z, g0.w, g1.x, g1.y, g1.z, g1.w};
                    unsigned r[4];
#pragma unroll
                    for (int k = 0; k < 4; ++k) {
                        const float ha = bf2f(hw[k] & 0xffff), hbv = bf2f(hw[k] >> 16), oa = bf2f(ow[k] & 0xffff), ob = bf2f(ow[k] >> 16);
                        r[k] = pk2(ha * rinv * gg[2 * k] * __builtin_amdgcn_rcpf(1.0f + __expf(-oa)), hbv * rinv * gg[2 * k + 1] * __builtin_amdgcn_rcpf(1.0f + __expf(-ob)));
                    }
                    *(u32x4*)(HS + idx) = (u32x4){r[0], r[1], r[2], r[3]};
                }
            }
            if (c + 1 < c1) ML_STORE(c + 1);
        }
#undef ML_LOAD
#undef ML_STORE
    }
}

constexpr int W13_PRE = 2048;
#define P10_Q(J) ((J) == 0 ? 6 : (J) == 1 ? 5 : (J) <= 3 ? 4 : (J) == 4 ? 3 : (J) == 5 ? 2 : 0)
#define P10_PRE(J) ((J) == 0 ? 0 : (J) == 1 ? 6 : (J) == 2 ? 11 : (J) == 3 ? 15 : (J) == 4 ? 19 : (J) == 5 ? 22 : 24)
constexpr int W13_P10 = 24 * 256;
template <bool DEEP>
DI void convert_moe_layer(int l, bool do13, bool do2, int gw, int NGW, int lo13, int hi13, const float* w1, const float* w3, const float* w2, bf16_t* W13, bf16_t* W2, LAS unsigned char* lds, int wid, int lane) {
    LAS float* scr = (LAS float*)(lds + wid * 16640);
    constexpr int I_W1 = 32 * 32 * 4, I_W2 = 32 * 4 * 32;
    if (do2) for (int it = gw; it < I_W2; it += NGW) {
        const int le = l * NE + it / 128, q = it % 128;
        transpose_item<DEEP>(w2 + (size_t)le * FF * D, D, W2 + (size_t)le * D * FF, FF, 64 * (q / 32), 64 * (q % 32), 0, scr, lane); }
    if (do13) for (int it = lo13 + gw; it < (hi13 < 2 * I_W1 ? hi13 : 2 * I_W1); it += NGW) {
        const int which = it / I_W1, r = it % I_W1, le = l * NE + r / 128, q = r % 128;
        transpose_item<DEEP>((which ? w3 : w1) + (size_t)le * D * FF, FF, W13 + (size_t)le * 512 * D, D, 64 * (q / 4), 64 * (q % 4), 1 + which, scr, lane); }
}

__global__ void __launch_bounds__(NTHREADS, 2) fwd_kernel(Args args) {
    extern __shared__ __attribute__((aligned(16))) unsigned char lds_raw[];
    LAS unsigned char* lds = (LAS unsigned char*)lds_raw;
    const int tid = threadIdx.x, lane = tid & 63, wid = __builtin_amdgcn_readfirstlane(tid >> 6);
    unsigned char* ws = args.ws;
    unsigned* ctl = (unsigned*)(ws + WS_CTL);
    volatile LAS unsigned* misc = (volatile LAS unsigned*)(lds + LDS_BYTES - 256);
    if (tid < 16) misc[tid] = 0u;
    __syncthreads();
    XcdBarrier bar; bar.bar = ctl + CW_BAR; bar.x = 0; bar.st = misc;
    const int lo = args.ph_lo, hi = args.ph_hi;
    if (PROBE_A >= 0 && blockIdx.x == 0 && tid == 0) misc[16] = (unsigned)__builtin_amdgcn_s_memrealtime();
    if (hi - lo > 1) bar = xcd_barrier_post(ctl + CW_BAR, misc);
#ifndef PHMASK
#define PHMASK 0xffff
#endif
#define IN(k) (((PHMASK >> (k)) & 1) && lo <= (k) && (k) < hi)
#ifndef XBAR
#define XBAR 0
#endif
#define SEAM(k) do { if (IN(k) && IN((k) + 1)) { xcd_barrier(bar); if ((k) == 5) for (int xb_ = 0; xb_ < XBAR; ++xb_) xcd_barrier(bar); } if (PROBE_A >= 0 && blockIdx.x == 0 && tid == 0) misc[16 + (k) + 1] = (unsigned)__builtin_amdgcn_s_memrealtime(); } while (0)

#define PH(k, ...) { __VA_ARGS__ } if ((REPEAT_MASK >> (k)) & 1) { xcd_barrier(bar); { __VA_ARGS__ } }
#define LZ(z) int z = 0; asm volatile("" : "+s"(z))
#define INP(k) (args.in[k] + z)
#define WSP(type, off) ((type*)(ws + (off) + z))
#define ACT(type, off) ((type*)(ws + WS_ACT + (off) + z))

    PH(0, if (IN(0)) {
        LZ(z);
        const float* sb_w_in = INP(4); const float* sb_w_out = INP(5); const float* ml_w_in = INP(6); const float* ml_w_out = INP(10);
        const float* moe_w1 = INP(15); const float* moe_w3 = INP(16); const float* moe_w2 = INP(17);
        bf16_t* Wsbin = WSP(bf16_t, WS_WSBIN); bf16_t* Wsbout = WSP(bf16_t, WS_WSBOUT); bf16_t* Wmlin = WSP(bf16_t, WS_WMLIN); bf16_t* Wmlout = WSP(bf16_t, WS_WMLOUT);
        bf16_t* W13 = WSP(bf16_t, WS_W13); bf16_t* W2 = WSP(bf16_t, WS_W2);
        LAS float* scr = (LAS float*)(lds + wid * 16640);
        const int gw = blockIdx.x * 8 + wid, NGW = gridDim.x * 8;
        constexpr int I_SBIN = 32 * 96, I_SBOUT = 32 * 32, I_MLIN = 32 * 96, I_MLOUT = 32 * 32;
        constexpr int NITEMS = I_SBIN + I_SBOUT + I_MLIN + I_MLOUT;
        for (int it0 = gw; it0 < NITEMS; it0 += NGW) {
            int r = NITEMS - 1 - it0;
            if (r < I_SBIN) { transpose_item(sb_w_in, 6144, Wsbin, D, 64 * (r / 96), 64 * (r % 96), 0, scr, lane); continue; } r -= I_SBIN;
            if (r < I_SBOUT) { transpose_item(sb_w_out, D, Wsbout, D, 64 * (r / 32), 64 * (r % 32), 0, scr, lane); continue; } r -= I_SBOUT;
            if (r < I_MLIN) { transpose_item(ml_w_in, ML_IN, Wmlin, D, 64 * (r / 96), 64 * (r % 96), 0, scr, lane); continue; } r -= I_MLIN;
            transpose_item(ml_w_out, D, Wmlout, D, 64 * (r / 32), 64 * (r % 32), 0, scr, lane);
        }
        {
            const float* wg = INP(11); const float* we = INP(13); const float* wml = INP(6);
            bf16_t* wr = WSP(bf16_t, WS_WR); bf16_t* wgi = WSP(bf16_t, WS_WG);
            const int gt = blockIdx.x * NTHREADS + tid, NGT = gridDim.x * NTHREADS;
            for (int idx = gt; idx < 2 * 98304 + 32768; idx += NGT) {
                if (idx < 2 * 98304) {
                    const int l = idx / 98304, r = idx % 98304, j = r & 7, ln = (r >> 3) & 63, q = r >> 9, nt = q % 3, ks = q / 3;
                    const int k = 32 * ks + 8 * (ln >> 4) + j, n = 16 * nt + (ln & 15);
                    const float w = (n < 4) ? wg[(size_t)l * D * 4 + k * 4 + n] : ((n < 36) ? we[(size_t)l * D * 32 + k * 32 + (n - 4)] : 0.f);
                    wr[(size_t)l * (WR_BYTES / 2) + r] = (bf16_t)f2bf(w);
                } else {
                    const int r = idx - 2 * 98304, j = r & 7, ln = (r >> 3) & 63, ks = r >> 9;
                    const int k = 32 * ks + 8 * (ln >> 4) + j, n = ln & 15;
                    wgi[r] = (bf16_t)f2bf(wml[(size_t)k * ML_IN + 6144 + n]);
                }
            }
        }
        __syncthreads();
        NormP p{}; p.src = INP(0); p.H = WSP(bf16_t, WS_H); p.g = INP(1);
        norm_phase<0, false>(p, lds, tid, wid, lane);
    })
    SEAM(0);
    PH(1, if (IN(1)) {
        LZ(z);
        bf16_t* H = WSP(bf16_t, WS_H); bf16_t* Wsbin = WSP(bf16_t, WS_WSBIN);
        if (tid == 0) {
            pg8::put_job(lds, 0, H, Wsbin, T, 4096, ACT(bf16_t, A_Q), ACT(bf16_t, A_K), D, 2048, 0.12751743074602467f);
            pg8::put_job(lds, 1, Wsbin + (size_t)4096 * D, H, D, T, ACT(bf16_t, A_VT), ACT(bf16_t, A_VT), T, 1 << 30, 1.0f);
        }
        __syncthreads();
        pg8::Sched S; S.init(lds, 2, gridDim.x, blockIdx.x);
        pg8::EpiBf16 E{S.tab};
        pg8::gemm_phase(lds, S, E);
    })
    SEAM(1);
    PH(2, if (IN(2)) { LZ(z); attn_phase(ACT(bf16_t, A_Q), ACT(bf16_t, A_K), ACT(bf16_t, A_VT), ACT(bf16_t, A_O), lds, tid, wid, lane); })
    SEAM(2);
    PH(3, if (IN(3)) { LZ(z);
        if (tid == 0) pg8::put_job(lds, 0, ACT(bf16_t, A_O), WSP(bf16_t, WS_WSBOUT), T, D, ACT(bf16_t, A_Z0), ACT(bf16_t, A_Z0), D, 1 << 30, 1.0f);
        __syncthreads();
        pg8::Sched S; S.init(lds, 1, gridDim.x, blockIdx.x);
        pg8::EpiBf16 E{S.tab}; pg8::gemm_phase(lds, S, E); })
    SEAM(3);
#if defined(OUTPROJ_PROBE)
    {
        LZ(z);
        if (tid == 0) pg8::put_job(lds, 0, ACT(bf16_t, A_O), WSP(bf16_t, WS_WSBOUT), T, D, nullptr, nullptr, D, 0, 1.0f);
        __syncthreads();
        pg8::Sched S; S.init(lds, 1, gridDim.x, blockIdx.x);
#if OUTPROJ_PROBE == 1
        pg8::EpiNull E; pg8::gemm_phase(lds, S, E);
#else
        pg8::EpiResF32 E{INP(0), ACT(float, A_Q), D}; pg8::gemm_phase(lds, S, E);
#endif
        xcd_barrier(bar);
    }
#endif
#define MOE_PHASES(l, pb) \
    PH(pb, if (IN(pb)) { LZ(z); convert_moe_layer<false>(l, true, false, blockIdx.x * 8 + wid, gridDim.x * 8, (l) ? W13_PRE + (gridDim.x == 256 ? W13_P10 : 0) : 0, 1 << 30, INP(15), INP(16), INP(17), WSP(bf16_t, WS_W13), WSP(bf16_t, WS_W2), lds, wid, lane); __syncthreads(); NormP p{}; p.src = (l) ? (const float*)WSP(bf16_t, WS_X) : INP(0); p.Y = (l) ? ACT(bf16_t, A_Z1) : ACT(bf16_t, A_Z0); p.X = WSP(bf16_t, WS_X); p.H = WSP(bf16_t, WS_H); p.g = INP(2) + (l) * D; p.wimg = WSP(bf16_t, WS_WR + (l) * WR_BYTES); p.bg = INP(12) + (l) * 4; \
        p.be = INP(14) + (l) * 32; p.cnt = ctl + CW_CNT + 64 * (l) + z; p.list = ACT(unsigned, A_LIST); p.listw = ACT(float, A_LISTW); \
        if (l) norm_phase<1, true>(p, lds, tid, wid, lane); else norm_phase<1, false>(p, lds, tid, wid, lane); }) \
    SEAM(pb); \
    PH((pb) + 1, if (IN((pb) + 1)) { LZ(z); pg8::moe_table256(ctl + CW_CNT + 64 * (l) + z, lds, tid); \
        pg8::MSched<2> S; S.init(lds, gridDim.x, blockIdx.x, true); \
        { const int nun = S.total; const int idle = (int)gridDim.x - nun;        \
          if (idle > 0) { if (S.c >= nun) { convert_moe_layer<true>(l, false, true, (S.c - nun) * 8 + wid, idle * 8, 0, 0, INP(15), INP(16), INP(17), WSP(bf16_t, WS_W13), WSP(bf16_t, WS_W2), lds, wid, lane); \
              if ((l) == 0) convert_moe_layer<true>(1, true, false, (S.c - nun) * 8 + wid, idle * 8, 0, W13_PRE, INP(15), INP(16), INP(17), WSP(bf16_t, WS_W13), WSP(bf16_t, WS_W2), lds, wid, lane); } } \
          else { convert_moe_layer<false>(l, false, true, blockIdx.x * 8 + wid, gridDim.x * 8, 0, 0, INP(15), INP(16), INP(17), WSP(bf16_t, WS_W13), WSP(bf16_t, WS_W2), lds, wid, lane); \
                 if ((l) == 0) convert_moe_layer<false>(1, true, false, blockIdx.x * 8 + wid, gridDim.x * 8, 0, W13_PRE, INP(15), INP(16), INP(17), WSP(bf16_t, WS_W13), WSP(bf16_t, WS_W2), lds, wid, lane); __syncthreads(); } } \
        pg8::MOps1 P{WSP(bf16_t, WS_H), WSP(bf16_t, WS_W13) + (size_t)(l) * NE * 512 * D, ACT(unsigned, A_LIST)}; \
        pg8::EpiSwiglu E{ACT(bf16_t, A_HID), ACT(float, A_LISTW)}; \
        pg8::gemm_phase_m<2048>(lds, S, P, E); }) \
    SEAM((pb) + 1); \
    PH((pb) + 2, if (IN((pb) + 2)) { LZ(z); pg8::moe_table256(ctl + CW_CNT + 64 * (l) + z, lds, tid); \
        pg8::MSched<8> S; S.init(lds, gridDim.x, blockIdx.x, true); \
        pg8::MOps2 P{ACT(bf16_t, A_HID), WSP(bf16_t, WS_W2) + (size_t)(l) * NE * D * FF}; \
        pg8::EpiScatter E{ACT(bf16_t, A_Y), ACT(unsigned, A_LIST)}; \
        pg8::gemm_phase_m<256>(lds, S, P, E); }) \
    SEAM((pb) + 2);
    MOE_PHASES(0, 4)
#if defined(MOE2_PROBE)
    {
        xcd_barrier(bar); LZ(z); pg8::moe_table256(ctl + CW_CNT + z, lds, tid);
        pg8::MSched<8> S; S.init(lds, gridDim.x, blockIdx.x);
        pg8::MOps2 P{ACT(bf16_t, A_HID), WSP(bf16_t, WS_W2)};
#if MOE2_PROBE == 1
        pg8::EpiMNull E; pg8::gemm_phase_m<256>(lds, S, P, E);
#else
        pg8::EpiScatter E{ACT(bf16_t, A_Y), ACT(unsigned, A_LIST)}; pg8::gemm_phase_m<256>(lds, S, P, E);
#endif
        xcd_barrier(bar);
    }
#endif
#if defined(ROUTER2X)
    { xcd_barrier(bar); LZ(z); NormP p{}; p.src = INP(0); p.Y = ACT(bf16_t, A_Z0); p.X = ACT(bf16_t, 96 * MiB); p.H = ACT(bf16_t, A_O); p.g = INP(2); p.wimg = WSP(bf16_t, WS_WR); p.bg = INP(12); p.be = INP(14);
      p.cnt = ctl + CW_CNT + 64 * 2 + z; p.list = ACT(unsigned, 128 * MiB); p.listw = ACT(float, 130 * MiB); norm_phase<1, false>(p, lds, tid, wid, lane); xcd_barrier(bar); }
#endif
    PH(7, if (IN(7)) { LZ(z); NormP p{}; p.X = WSP(bf16_t, WS_X); p.Y = ACT(bf16_t, A_Y); p.H = WSP(bf16_t, WS_H); p.g = INP(1) + D; p.wimg = WSP(bf16_t, WS_WG); p.G = ACT(float, A_G); norm_phase<2, true>(p, lds, tid, wid, lane); })
    SEAM(7);
    PH(8, if (IN(8)) {
        LZ(z);
        bf16_t* H = WSP(bf16_t, WS_H); bf16_t* Wmlin = WSP(bf16_t, WS_WMLIN);
        if (tid == 0) {
            pg8::put_job(lds, 0, H, Wmlin, T, 2048, ACT(bf16_t, A_Q1), ACT(bf16_t, A_K1), 1024, 1024, 0.08838834764831845f);
            pg8::put_job(lds, 1, H, Wmlin + (size_t)4096 * D, T, 2048, ACT(bf16_t, A_OG), ACT(bf16_t, A_OG), D, 1 << 30, 1.0f);
            pg8::put_job(lds, 2, Wmlin + (size_t)2048 * D, H, 2048, T, ACT(bf16_t, A_VT1), ACT(bf16_t, A_VT1), T, 1 << 30, 1.0f);
        }
        __syncthreads();
        pg8::Sched S; S.init(lds, 3, gridDim.x, blockIdx.x);
        pg8::EpiBf16 E{S.tab};
        pg8::gemm_phase(lds, S, E);
    })
    SEAM(8);
    PH(9, if (IN(9)) { LZ(z); mlstm_local(ACT(bf16_t, A_K1), ACT(bf16_t, A_VT1), ACT(float, A_G), INP(7), INP(8), WSP(bf16_t, WS_H), ACT(float, A_NJ), ACT(float, A_SUM), lds, tid, wid, lane); })
    SEAM(9);
    PH(10, if (IN(10)) { LZ(z); mlstm_phase<0>(ACT(bf16_t, A_Q1), ACT(bf16_t, A_K1), ACT(bf16_t, A_VT1), ACT(bf16_t, A_OG), ACT(float, A_G), INP(7), INP(8), INP(9), ACT(bf16_t, A_HS),
        WSP(bf16_t, WS_H), ACT(float, A_NJ), ACT(float, A_SUM), lds, tid, wid, lane);
        if (gridDim.x == 256) {
            const int J = (blockIdx.x >> 3) & 7, q = P10_Q(J), pre = P10_PRE(J);
            if (q) { __syncthreads(); convert_moe_layer<true>(1, true, false, ((blockIdx.x & 7) * 4 + (blockIdx.x >> 6)) * 8 + wid, 256, W13_PRE + pre * 256, W13_PRE + (pre + q) * 256, INP(15), INP(16), INP(17), WSP(bf16_t, WS_W13), WSP(bf16_t, WS_W2), lds, wid, lane); } } })
    SEAM(10);
#if defined(ML_PROBE)
    {
        LZ(z); mlstm_phase<ML_PROBE>(ACT(bf16_t, A_Q1), ACT(bf16_t, A_K1), ACT(bf16_t, A_VT1), ACT(bf16_t, A_OG), ACT(float, A_G), INP(7), INP(8), INP(9), (bf16_t*)(args.out + z),
            WSP(bf16_t, WS_H), ACT(float, A_NJ), ACT(float, A_SUM), lds, tid, wid, lane, 4); xcd_barrier(bar); }
#endif
    PH(11, if (IN(11)) { LZ(z);
        if (tid == 0) pg8::put_job(lds, 0, ACT(bf16_t, A_HS), WSP(bf16_t, WS_WMLOUT), T, D, ACT(bf16_t, A_Z1), ACT(bf16_t, A_Z1), D, 1 << 30, 1.0f);
        __syncthreads();
        pg8::Sched S; S.init(lds, 1, gridDim.x, blockIdx.x);
        pg8::EpiBf16 E{S.tab}; pg8::gemm_phase(lds, S, E); })
    SEAM(11);
    MOE_PHASES(1, 12)
    PH(15, if (IN(15)) { LZ(z); NormP p{}; p.X = WSP(bf16_t, WS_X); p.Y = ACT(bf16_t, A_Y); p.outf = args.out + z; p.g = INP(3); norm_phase<3, true>(p, lds, tid, wid, lane); })
    if (PROBE_A >= 0 && blockIdx.x == 0 && tid == 0) {
        misc[16 + 16] = (unsigned)__builtin_amdgcn_s_memrealtime();
        const float tA = (float)(misc[16 + PROBE_A + 1] - misc[16 + PROBE_A]) * 0.01f, tB = (PROBE_B >= 0) ? (float)(misc[16 + PROBE_B + 1] - misc[16 + PROBE_B]) * 0.01f : 0.f;
        args.out[0] = (1.0f + tA * 0.02f) * __builtin_powf(10.0f, __builtin_rintf(tB * 0.1f));
    }
#undef IN
#undef SEAM
}

extern "C" void kernel_launch(void* const* d_in, const int* in_sizes, int n_in, void* d_out, int out_size, void* d_ws, size_t ws_size, hipStream_t stream) {
    static int grid = 0;
    if (grid == 0) {
        if (n_in != 18 || out_size != T * D || ws_size < WS_END) { fprintf(stderr, "kernel_launch: unexpected shapes (n_in %d out %d ws %zu need %zu)\n", n_in, out_size, ws_size, (size_t)WS_END); grid = -1; return; }
        int dev = 0, cus = 0, per_cu = 0;
        if (hipGetDevice(&dev) != hipSuccess || hipDeviceGetAttribute(&cus, hipDeviceAttributeMultiprocessorCount, dev) != hipSuccess) { grid = -1; return; }
        if (hipFuncSetAttribute((const void*)fwd_kernel, hipFuncAttributeMaxDynamicSharedMemorySize, LDS_BYTES) != hipSuccess) { fprintf(stderr, "kernel_launch: hipFuncSetAttribute failed\n"); grid = -1; return; }
        if (hipOccupancyMaxActiveBlocksPerMultiprocessor(&per_cu, (const void*)fwd_kernel, NTHREADS, LDS_BYTES) != hipSuccess || per_cu < 1) { fprintf(stderr, "kernel_launch: occupancy query says %d\n", per_cu); per_cu = 1; }
        (void)hipGetLastError();
        grid = cus;
    }
    if (grid < 0) return;
    (void)hipMemsetAsync((char*)d_ws + WS_CTL, 0, CTL_BYTES, stream);
    Args a{};
    for (int i = 0; i < 18; ++i) a.in[i] = (const float*)d_in[i];
    a.out = (float*)d_out; a.ws = (unsigned char*)d_ws;
#if MK_MULTI
    for (int ph = 0; ph < NPHASE; ++ph) { a.ph_lo = ph; a.ph_hi = ph + 1; hipLaunchKernelGGL(fwd_kernel, dim3(grid), dim3(NTHREADS), LDS_BYTES, stream, a); }
#else
    a.ph_lo = 0; a.ph_hi = NPHASE;
    void* kargs[] = {&a};
    hipError_t e = hipLaunchCooperativeKernel((const void*)fwd_kernel, dim3(grid), dim3(NTHREADS), kargs, LDS_BYTES, stream);
    if (e != hipSuccess) fprintf(stderr, "kernel_launch: cooperative launch failed: %s\n", hipGetErrorString(e));
#endif
}
```

```cpp
#include <hip/hip_runtime.h>
#include <cstdio>
#include <cstdint>

#define GAS __attribute__((address_space(1)))
#define LAS __attribute__((address_space(3)))
#define DI __device__ __forceinline__
typedef unsigned short bf16_t;
typedef short bf16x8 __attribute__((ext_vector_type(8)));
typedef short s16x4 __attribute__((ext_vector_type(4)));
typedef float f32x4 __attribute__((ext_vector_type(4)));
typedef unsigned u32x4 __attribute__((ext_vector_type(4)));
typedef unsigned u32x2 __attribute__((ext_vector_type(2)));

#ifndef PROBE_A
#define PROBE_A -1
#define PROBE_B -1
#endif
#ifndef REPEAT_MASK
#define REPEAT_MASK 0
#endif
#ifndef MK_MULTI
#define MK_MULTI 0
#endif

constexpr int T = 8192, D = 2048, SEQ = 2048;
constexpr int SBH = 16;
constexpr int MLH = 8, ML_IN = 6160;
constexpr int NE = 32, FF = 256;
constexpr float EPS = 1e-6f;
constexpr int NPHASE = 16;
constexpr int NTHREADS = 512;
constexpr int LDS_BYTES = 147456;

constexpr size_t MiB = 1u << 20;
constexpr size_t WS_CTL = 0, CTL_BYTES = 128 * 1024;
constexpr size_t WS_WR = 128 * 1024, WR_BYTES = 384 * 1024, WS_WG = 896 * 1024;
constexpr size_t WS_WSBIN = 1 * MiB, WS_WSBOUT = 25 * MiB, WS_WMLIN = 33 * MiB, WS_WMLOUT = 57 * MiB;
constexpr size_t WS_W13 = 65 * MiB, WS_W2 = 193 * MiB;
constexpr size_t WS_X = 257 * MiB, WS_H = 321 * MiB, WS_ACT = 353 * MiB;
constexpr size_t A_Q = 0, A_K = 32 * MiB, A_VT = 64 * MiB, A_O = 96 * MiB;
constexpr size_t A_Q1 = 0, A_K1 = 16 * MiB, A_KT = 32 * MiB, A_VT1 = 48 * MiB, A_OG = 80 * MiB, A_HS = 112 * MiB, A_G = 144 * MiB, A_NJ = 144 * MiB + 524288, A_SUM = 144 * MiB + 524288 + 131072;
constexpr size_t A_HID = 0, A_LIST = 9 * MiB, A_LISTW = 10 * MiB, A_Y = 16 * MiB;
constexpr size_t A_Z0 = 64 * MiB, A_Z1 = 80 * MiB;
constexpr size_t WS_END = WS_ACT + 145 * MiB;
constexpr int CW_BAR = 4096;
constexpr int CW_CNT = 16384;

typedef __bf16 bf16x2_t __attribute__((ext_vector_type(2)));
typedef float f32x2 __attribute__((ext_vector_type(2)));
DI unsigned pk2(float lo, float hi) { const f32x2 v = {lo, hi}; return __builtin_bit_cast(unsigned, __builtin_convertvector(v, bf16x2_t)); }
DI unsigned f2bf(float f) { return pk2(f, 0.f) & 0xffffu; }
DI float bf2f(unsigned short b) { return __builtin_bit_cast(float, ((unsigned)b) << 16); }
template <int CTRL> DI float dpp_t(float v) { return __builtin_bit_cast(float, __builtin_amdgcn_update_dpp(0, __builtin_bit_cast(int, v), CTRL, 0xF, 0xF, false)); }
#define dpp_f(v, ctrl) dpp_t<ctrl>(v)
DI float wave_max(float v) {
    v = fmaxf(v, dpp_f(v, 0xB1)); v = fmaxf(v, dpp_f(v, 0x4E)); v = fmaxf(v, dpp_f(v, 0x141)); v = fmaxf(v, dpp_f(v, 0x140));
    v = fmaxf(v, __shfl_xor(v, 16)); v = fmaxf(v, __shfl_xor(v, 32)); return v;
}
DI float wave_sum(float v) {
#pragma unroll
    for (int o = 1; o < 64; o <<= 1) v += __shfl_xor(v, o);
    return v;
}
#define LDS_WAIT() asm volatile("s_waitcnt lgkmcnt(0)" ::: "memory")
#define VM_WAIT() asm volatile("s_waitcnt vmcnt(0)" ::: "memory")
#define MFMA16(a, b, c) __builtin_amdgcn_mfma_f32_16x16x32_bf16((a), (b), (c), 0, 0, 0)

#define XB_TMO      128
#define XB_XCNT(j)  (256  + 64 * (j))
#define XB_XSUB(j)  (1280 + 64 * (j))
#define XB_XGEN(j)  (2304 + 64 * (j))
#define XB_TOP      3328
#define XB_TOPGEN   3392
#define XCD_BAR_WORDS 3456
#define XB_SPIN_CAP (1u << 18)
DI unsigned xb_ld(unsigned* p)              { return __hip_atomic_load(p, __ATOMIC_RELAXED, __HIP_MEMORY_SCOPE_AGENT); }
DI unsigned xb_add(unsigned* p, unsigned v) { return __hip_atomic_fetch_add(p, v, __ATOMIC_RELAXED, __HIP_MEMORY_SCOPE_AGENT); }
DI unsigned xb_xcc_id() { return (unsigned)__builtin_amdgcn_s_getreg((3 << 11) | 20) & 0xFu; }
#define XB_SPIN(cond, bar) do { unsigned _sp = 0; while (cond) { __builtin_amdgcn_s_sleep(1); \
    if ((++_sp & 255u) == 0u) { if (xb_ld(&(bar)[XB_TMO])) break; if (_sp > XB_SPIN_CAP) { atomicAdd(&(bar)[XB_TMO], 1u); break; } } } } while (0)
struct XcdBarrier { unsigned* bar; unsigned x; volatile LAS unsigned* st; };
DI XcdBarrier xcd_barrier_post(unsigned* bar, volatile LAS unsigned* st) {
    XcdBarrier b; b.bar = bar; b.x = xb_xcc_id(); b.st = st;
    if (threadIdx.x == 0) (void)xb_add(&bar[XB_XCNT(b.x)], 1u);
    return b;
}
DI void xcd_barrier_complete(unsigned* bar, unsigned x, unsigned& nloc, unsigned& nx) {
    const unsigned G = gridDim.x * gridDim.y * gridDim.z;
    unsigned sum, cnt, mine, sp = 0u;
    for (;;) {
        sum = 0u; cnt = 0u; mine = 0u;
#pragma unroll
        for (unsigned j = 0; j < 16; ++j) { const unsigned c = xb_ld(&bar[XB_XCNT(j)]); sum += c; cnt += (c > 0u) ? 1u : 0u; mine = (j == x) ? c : mine; }
        if (sum == G) break;
        __builtin_amdgcn_s_sleep(1);
        if ((++sp & 255u) == 0u) { if (xb_ld(&bar[XB_TMO])) break; if (sp > XB_SPIN_CAP) { atomicAdd(&bar[XB_TMO], 1u); break; } }
    }
    nloc = mine > 0u ? mine : 1u; nx = cnt > 0u ? cnt : 1u;
}
DI void xcd_barrier(const XcdBarrier& b) {
    asm volatile("s_waitcnt vmcnt(0)" ::: "memory");
    __syncthreads();
    if (threadIdx.x == 0) {
        unsigned* bar = b.bar;
        __builtin_amdgcn_s_waitcnt(0);
        unsigned nloc = b.st[0], nx = b.st[1];
        if (nloc == 0u) { xcd_barrier_complete(bar, b.x, nloc, nx); b.st[0] = nloc; b.st[1] = nx; }
        const unsigned old = xb_add(&bar[XB_XSUB(b.x)], 1u);
        const unsigned gen = old / nloc;
        if (old + 1u == (gen + 1u) * nloc) {
            __builtin_amdgcn_fence(__ATOMIC_RELEASE, "agent");
            asm volatile("s_waitcnt vmcnt(0)" ::: "memory");
            const unsigned og = xb_add(&bar[XB_TOP], 1u);
            const unsigned tg = og / nx;
            if (og + 1u == (tg + 1u) * nx) xb_add(&bar[XB_TOPGEN], 1u);
            else XB_SPIN(xb_ld(&bar[XB_TOPGEN]) == tg, bar);
            __builtin_amdgcn_fence(__ATOMIC_ACQUIRE, "agent");
            xb_add(&bar[XB_XGEN(b.x)], 1u);
            asm volatile("s_waitcnt vmcnt(0)" ::: "memory");
        } else {
            XB_SPIN(xb_ld(&bar[XB_XGEN(b.x)]) == gen, bar);
            __builtin_amdgcn_fence(__ATOMIC_ACQUIRE, "agent");
            asm volatile("s_waitcnt vmcnt(0)" ::: "memory");
        }
    }
    __syncthreads();
}

struct Args {
    const float* in[18];
    float* out;
    unsigned char* ws;
    int ph_lo, ph_hi;
};

DI int perm13(int f, int which) { return (f >> 7) * 256 + ((f >> 5) & 3) * 64 + which * 32 + (f & 31); }
template <bool DEEP = false>
DI void transpose_item(const float* W, int ldw, bf16_t* WT, int ldt, int k0, int n0, int mode, LAS float* scr, int lane) {
    if (DEEP) {
        float wv[64];
#pragma unroll
        for (int i = 0; i < 64; ++i) wv[i] = __builtin_nontemporal_load(W + (size_t)(k0 + i) * ldw + n0 + lane);
#pragma unroll
        for (int i = 0; i < 64; ++i) scr[i * 65 + lane] = wv[i];
    } else {
#pragma unroll 16
        for (int i = 0; i < 64; ++i) scr[i * 65 + lane] = __builtin_nontemporal_load(W + (size_t)(k0 + i) * ldw + n0 + lane);
    }
    LDS_WAIT(); asm volatile("" ::: "memory");
    const int c = lane & 7;
#pragma unroll
    for (int j = 0; j < 8; ++j) {
        const int n = (lane >> 3) + 8 * j; const LAS float* s = scr + (8 * c) * 65 + n;
        u32x4 o; o.x = pk2(s[0 * 65], s[1 * 65]); o.y = pk2(s[2 * 65], s[3 * 65]); o.z = pk2(s[4 * 65], s[5 * 65]); o.w = pk2(s[6 * 65], s[7 * 65]);
        const int nn = n0 + n; const int row = (mode == 0) ? nn : perm13(nn, mode - 1);
        *(u32x4*)(WT + (size_t)row * ldt + k0 + 8 * c) = o;
    }
    LDS_WAIT(); asm volatile("" ::: "memory");
}

struct NormP {
    const float* src; bf16_t* X; const bf16_t* Y; bf16_t* H; float* outf; const float* g;
    const bf16_t* wimg; const float* bg; const float* be;
    unsigned* cnt; unsigned* list; float* listw;
    float* G;
};
template <int MODE, bool XB>
DI void norm_phase(const NormP& p, LAS unsigned char* lds, int tid, int wid, int lane) {
    constexpr int RB_LDB = 4112;
    LAS unsigned char* rb_hi = lds;
    LAS float* part = (LAS float*)(lds + 8 * RB_LDB);
    LAS float* logit = part + 8 * 8 * 48;
    LAS int* pex = (LAS int*)(logit + 512); LAS unsigned* pen = (LAS unsigned*)(pex + 512); LAS float* pwt = (LAS float*)(pen + 512);
    int itn = 0;
    constexpr bool PROJ = (MODE == 1 || MODE == 2);
    const float* xin = p.src;
    const bf16_t* xbn = (MODE <= 1) ? (const bf16_t*)p.src : (const bf16_t*)p.X;
    f32x4 v[8]; u32x2 xb[8], ya[8], yb[8];
    int it = blockIdx.x;
#define NP_LOADV(itx) do { const size_t ro_ = (size_t)((itx) * 8 + wid) * D; _Pragma("unroll") for (int j = 0; j < 8; ++j) { if (XB) xb[j] = *(const u32x2*)(xbn + ro_ + 4 * lane + 256 * j); else v[j] = __builtin_nontemporal_load((const f32x4*)(xin + ro_ + 4 * lane + 256 * j)); } } while (0)
#define NP_LOADY(itx) do { const size_t ro_ = (size_t)((itx) * 8 + wid) * D; _Pragma("unroll") for (int j = 0; j < 8; ++j) { const int c = 4 * lane + 256 * j; \
        if (MODE >= 1) ya[j] = *(const u32x2*)(p.Y + ro_ + c); if (MODE >= 2) yb[j] = *(const u32x2*)(p.Y + (size_t)T * D + ro_ + c); } } while (0)
#define NP_LOAD(itx) do { NP_LOADV(itx); NP_LOADY(itx); } while (0)
    if (it < T / 8) NP_LOAD(it);
    for (; it < T / 8; it += gridDim.x, ++itn) {
        const int row = it * 8 + wid;
        const size_t ro = (size_t)row * D;
        f32x4 gv[8];
#pragma unroll
        for (int j = 0; j < 8; ++j) gv[j] = *(const f32x4*)(p.g + 4 * lane + 256 * j);
        float ss = 0.f;
#pragma unroll
        for (int j = 0; j < 8; ++j) {
            f32x4 x;
            if (XB) { const u32x2 q = xb[j]; x.x = bf2f(q.x & 0xffff); x.y = bf2f(q.x >> 16); x.z = bf2f(q.y & 0xffff); x.w = bf2f(q.y >> 16); } else x = v[j];
            if (MODE >= 1) {
                const u32x2 a = ya[j];
                x.x += bf2f(a.x & 0xffff); x.y += bf2f(a.x >> 16); x.z += bf2f(a.y & 0xffff); x.w += bf2f(a.y >> 16);
                if (MODE >= 2) { const u32x2 b = yb[j]; x.x += bf2f(b.x & 0xffff); x.y += bf2f(b.x >> 16); x.z += bf2f(b.y & 0xffff); x.w += bf2f(b.y >> 16); }
                if (MODE <= 2) { u32x2 o; o.x = pk2(x.x, x.y); o.y = pk2(x.z, x.w); *(u32x2*)(p.X + ro + 4 * lane + 256 * j) = o; }
            }
            v[j] = x;
            ss += (x.x * x.x + x.y * x.y) + (x.z * x.z + x.w * x.w);
        }
        const float rstd = 1.0f / sqrtf(wave_sum(ss) * (1.0f / D) + EPS);
#pragma unroll
        for (int j = 0; j < 8; ++j) {
            const int c = 4 * lane + 256 * j;
            const f32x4 gg = gv[j];
            f32x4 y; y.x = v[j].x * rstd * gg.x; y.y = v[j].y * rstd * gg.y; y.z = v[j].z * rstd * gg.z; y.w = v[j].w * rstd * gg.w;
            if (MODE == 3) *(f32x4*)(p.outf + ro + c) = y;
            else { u32x2 o; o.x = pk2(y.x, y.y); o.y = pk2(y.z, y.w); *(u32x2*)(p.H + ro + c) = o; }
            if (PROJ) *(LAS u32x2*)(rb_hi + wid * RB_LDB + c * 2) = (u32x2){pk2(y.x, y.y), pk2(y.z, y.w)};
        }
        const bool more = it + (int)gridDim.x < T / 8;
        if (!PROJ && more) NP_LOAD(it + gridDim.x);
        if (PROJ) {
            __syncthreads();
            {
                constexpr int NT = (MODE == 1) ? 3 : 1;
                f32x4 pacc[NT];
#pragma unroll
                for (int nt = 0; nt < NT; ++nt) pacc[nt] = (f32x4){0.f, 0.f, 0.f, 0.f};
                const LAS unsigned char* ahi = rb_hi + (lane & 7) * RB_LDB + (lane >> 4) * 16 + wid * 512;
                const bf16_t* wim = p.wimg + (size_t)lane * 8 + (size_t)(8 * wid) * NT * 512;
                bf16x8 w0[4][NT], w1[4][NT];
#define NP_LDW(dst, g) do { _Pragma("unroll") for (int kk = 0; kk < 4; ++kk) _Pragma("unroll") for (int nt = 0; nt < NT; ++nt) dst[kk][nt] = *(const bf16x8*)(wim + (size_t)((4 * (g) + kk) * NT + nt) * 512); } while (0)
#define NP_MM(src, g) do { _Pragma("unroll") for (int kk = 0; kk < 4; ++kk) { const bf16x8 xh = *(const LAS bf16x8*)(ahi + (4 * (g) + kk) * 64); \
        _Pragma("unroll") for (int nt = 0; nt < NT; ++nt) pacc[nt] = MFMA16(xh, src[kk][nt], pacc[nt]); } } while (0)
#define NP_PIN __builtin_amdgcn_sched_barrier(0)
                NP_LDW(w0, 0); NP_LDW(w1, 1); NP_PIN;
                if (more) NP_LOADV(it + gridDim.x);
                NP_PIN; NP_MM(w0, 0); NP_MM(w1, 1); NP_PIN;
#undef NP_PIN
#undef NP_LDW
#undef NP_MM
                if (more) NP_LOADY(it + gridDim.x);
                if (lane < 32) {
#pragma unroll
                    for (int nt = 0; nt < NT; ++nt)
#pragma unroll
                        for (int r = 0; r < 4; ++r) part[(wid * 8 + 4 * (lane >> 4) + r) * 48 + 16 * nt + (lane & 15)] = pacc[nt][r];
                }
            }
            __syncthreads();
            {
                float sl = 0.f;
                if (lane < 48) {
#pragma unroll
                    for (int w = 0; w < 8; ++w) sl += part[(w * 8 + wid) * 48 + lane];
                }
                if (MODE == 2) { if (lane < 16) p.G[(size_t)row * 16 + lane] = sl; }
                else {
                    if (lane < 36) sl += (lane < 4) ? p.bg[lane] : p.be[lane - 4];
                    const float NEG = -3.0e38f;
                    const float gl = (lane < 4) ? sl : NEG;
                    float gm = fmaxf(gl, dpp_f(gl, 0xB1)); gm = fmaxf(gm, dpp_f(gm, 0x4E));
                    gm = __shfl(gm, 0);
                    const int gs = __ffsll((long long)__ballot(lane < 4 && sl == gm)) - 1;
                    float ge = (lane < 4) ? __expf(sl - gm) : 0.f;
                    ge += dpp_f(ge, 0xB1); ge += dpp_f(ge, 0x4E);
                    const float psel = 1.0f / __shfl(ge, 0);
                    const int eb = 4 + 8 * gs;
                    const bool inr = lane >= eb && lane < eb + 8;
                    const float v0 = wave_max(inr ? sl : NEG);
                    const int l0 = __ffsll((long long)__ballot(inr && sl == v0)) - 1;
                    const float v1 = wave_max((inr && lane != l0) ? sl : NEG);
                    const int l1 = __ffsll((long long)__ballot(inr && lane != l0 && sl == v1)) - 1;
                    if (lane == 0) {
                        const float e10 = __expf(v1 - v0); const float w0 = psel / (1.0f + e10), w1 = psel * e10 / (1.0f + e10);
                        const int e0 = gs * 8 + (l0 - eb), e1 = gs * 8 + (l1 - eb);
                        const int sl0 = itn * 16 + wid * 2;
                        pex[sl0] = e0; pen[sl0] = (unsigned)row * 2u; pwt[sl0] = w0;
                        pex[sl0 + 1] = e1; pen[sl0 + 1] = (unsigned)row * 2u + 1u; pwt[sl0 + 1] = w1;
                    }
                }
            }
        }
    }
#undef NP_LOAD
#undef NP_LOADV
#undef NP_LOADY
    if (MODE == 1) {
        __syncthreads();
        if (wid == 0) {
            const int np = itn * 16;
            for (int c0 = 0; c0 < np; c0 += 64) {
                const bool have = c0 + lane < np;
                const int ei = have ? pex[c0 + lane] : -1;
                int cnt_e = 0, rank = 0;
#pragma unroll 4
                for (int e = 0; e < NE; ++e) {
                    const unsigned long long m = __ballot(ei == e);
                    if (lane == e) cnt_e = __popcll(m);
                    if (ei == e) rank = __popcll(m & ((1ull << lane) - 1ull));
                }
                unsigned base = 0u;
                if (lane < NE && cnt_e > 0) base = atomicAdd(p.cnt + lane, (unsigned)cnt_e);
                const unsigned mybase = (unsigned)__shfl((int)base, ei < 0 ? 0 : ei);
                if (have) { const size_t pos = (size_t)ei * T + mybase + rank; p.list[pos] = pen[c0 + lane]; p.listw[pos] = pwt[c0 + lane]; }
            }
        }
        __syncthreads();
    }
}

DI int lds_byte(int r, int c) { const int st = (r >> 4) * 2 + (c >> 5), rr = r & 15, cc = c & 31, ob = rr * 64 + cc * 2; return st * 1024 + (ob ^ (((ob >> 9) & 1) << 5)); }
DI void stage_rc(int b, int& R, int& C) { const int st = b / 1024, sb = b % 1024, swz = sb ^ (((sb >> 9) & 1) << 5); R = (st >> 1) * 16 + swz / 64; C = (st & 1) * 32 + (swz % 64) / 2; }

namespace pg8 {
constexpr int BM = 256, BK = 64, HALF = 128, HTB = HALF * BK * 2, NXCD = 8, WGM = 8, KD = 2048;
DI int perm32(int rho) { const int n = rho >> 4, i = rho & 15; return 8 * (i >> 2) + 4 * n + (i & 3); }
struct Unit { int pm, pn, job; };
struct JobRec { const bf16_t* A; const bf16_t* Bt; bf16_t* o0; bf16_t* o1; int M, N, ld, split; float scale0; int pad[5]; };
constexpr int JOBS_OFF = 139264;
DI void put_job(LAS unsigned char* lds, int j, const bf16_t* A, const bf16_t* Bt, int M, int N, bf16_t* o0, bf16_t* o1, int ld, int split, float scale0) {
    LAS JobRec* r = (LAS JobRec*)(lds + JOBS_OFF) + j;
    r->A = A; r->Bt = Bt; r->o0 = o0; r->o1 = o1; r->M = M; r->N = N; r->ld = ld; r->split = split; r->scale0 = scale0;
}
struct Sched {
    const LAS JobRec* tab; int n0, n1, n2, G, c;
    DI void init(LAS unsigned char* lds, int njobs, int G_, int c_) {
        tab = (const LAS JobRec*)(lds + JOBS_OFF);
        n0 = (tab[0].M / BM) * (tab[0].N / BM); n1 = njobs > 1 ? (tab[1].M / BM) * (tab[1].N / BM) : 0; n2 = njobs > 2 ? (tab[2].M / BM) * (tab[2].N / BM) : 0; G = G_; c = c_; }
    DI bool next(int i, Unit& u) const {
        int L = i * G + c, nwg;
        if (L < n0) { u.job = 0; nwg = n0; }
        else if (L < n0 + n1) { L -= n0; u.job = 1; nwg = n1; }
        else if (L < n0 + n1 + n2) { L -= n0 + n1; u.job = 2; nwg = n2; }
        else return false;
        const int nM = tab[u.job].M / BM, nN = tab[u.job].N / BM;
        int wgid = L; { const int q = nwg / NXCD, r = nwg % NXCD, xcd = wgid % NXCD, off = wgid / NXCD; wgid = (xcd < r ? xcd * (q + 1) : r * (q + 1) + (xcd - r) * q) + off; }
        const int nig = WGM * nN, gid = wgid / nig, fm = gid * WGM, gsz = (nM - fm) < WGM ? (nM - fm) : WGM;
        u.pm = fm + ((wgid % nig) % gsz); u.pn = (wgid % nig) / gsz; return true;
    }
    DI const char* aptr(const Unit& u) const { return (const char*)tab[u.job].A + (size_t)u.pm * (2 * HALF * KD * 2); }
    DI const char* bptr(const Unit& u) const { return (const char*)tab[u.job].Bt + (size_t)u.pn * (2 * HALF * KD * 2); }
};
struct EpiBf16 {
    static constexpr bool PERM = true;
    const LAS JobRec* tab;
    DI void operator()(const f32x4 (&acc)[2][2][4][2], const Unit& u, int wr, int wc, int fr, int fq) const {
        const LAS JobRec* jr = tab + u.job;
        const int ldo = jr->ld, split = jr->split;
        float sc = jr->scale0;
        int colt = u.pn * BM; bf16_t* base = jr->o0;
        if (colt >= split) { colt -= split; base = jr->o1; sc = 1.0f; }
        const int row0 = u.pm * BM + wr * 64 + fr, col0 = colt + wc * 64 + 8 * fq;
#pragma unroll
        for (int ai = 0; ai < 2; ++ai)
#pragma unroll
            for (int m = 0; m < 4; ++m) { bf16_t* rowp = base + (size_t)(row0 + ai * HALF + m * 16) * ldo + col0;
#pragma unroll
                for (int bj = 0; bj < 2; ++bj) { const f32x4 v0 = acc[ai][bj][m][0], v1 = acc[ai][bj][m][1];
                    u32x4 w; w.x = pk2(v0.x * sc, v0.y * sc); w.y = pk2(v0.z * sc, v0.w * sc); w.z = pk2(v1.x * sc, v1.y * sc); w.w = pk2(v1.z * sc, v1.w * sc);
                    *(u32x4*)(rowp + bj * 32) = w; } }
    }
};
struct EpiResF32 {
    static constexpr bool PERM = false;
    const float* base; float* out; int ld;
    DI void operator()(const f32x4 (&acc)[2][2][4][2], const Unit& u, int wr, int wc, int fr, int fq) const {
        const int row0 = u.pm * BM + wr * 64 + fr, col0 = u.pn * BM + wc * 32 + 4 * fq;
#pragma unroll
        for (int ai = 0; ai < 2; ++ai)
#pragma unroll
            for (int m = 0; m < 4; ++m) { const size_t ro = (size_t)(row0 + ai * HALF + m * 16) * ld + col0;
#pragma unroll
                for (int bj = 0; bj < 2; ++bj)
#pragma unroll
                    for (int n = 0; n < 2; ++n) { const f32x4 b = *(const f32x4*)(base + ro + bj * HALF + n * 16); const f32x4 a = acc[ai][bj][m][n];
                        f32x4 o; o.x = a.x + b.x; o.y = a.y + b.y; o.z = a.z + b.z; o.w = a.w + b.w; *(f32x4*)(out + ro + bj * HALF + n * 16) = o; } }
    }
};
struct EpiNull {
    static constexpr bool PERM = false;
    DI void operator()(const f32x4 (&acc)[2][2][4][2], const Unit&, int, int, int, int) const {
#pragma unroll
        for (int ai = 0; ai < 2; ++ai)
#pragma unroll
            for (int bj = 0; bj < 2; ++bj)
#pragma unroll
                for (int m = 0; m < 4; ++m)
#pragma unroll
                    for (int n = 0; n < 2; ++n) asm volatile("" :: "v"(acc[ai][bj][m][n]));
    }
};
template <class Epi>
DI void gemm_phase(LAS unsigned char* lds, const Sched& S, const Epi& E) {
    const int tid = threadIdx.x, wid = __builtin_amdgcn_readfirstlane(tid >> 6), lane = tid & 63, wr = wid >> 2, wc = wid & 3, fr = lane & 15, fq = lane >> 4;
    constexpr int K = KD, nt = K / BK;
    unsigned voffA[2], voffB[2][2];
#pragma unroll
    for (int i = 0; i < 2; ++i) { int R, C; stage_rc(tid * 16 + i * 8192, R, C);
        voffA[i] = (unsigned)(R * K + C) * 2u;
#pragma unroll
        for (int h = 0; h < 2; ++h) { const int Rb = Epi::PERM ? (64 * (R >> 5) + 32 * h + perm32(R & 31)) : (128 * h + R); voffB[h][i] = (unsigned)(Rb * K + C) * 2u; } }
    constexpr size_t kstep = (size_t)(BK * 2);
    constexpr size_t hstep = (size_t)HALF * K * 2;
    const unsigned ldsw = (unsigned)wid * 1024u;
    const int aoff = lds_byte(wr * 64 + fr, fq * 8), boff = lds_byte(wc * 32 + fr, fq * 8);
#define PG8_SA(b, h) (((b) * 2 + (h)) * HTB)
#define PG8_SB(b, h) ((4 + (b) * 2 + (h)) * HTB)
#define PG8_STAGE(bufoff, gbase, voff) do { _Pragma("unroll") for (int _i = 0; _i < 2; ++_i) \
        __builtin_amdgcn_global_load_lds((const GAS unsigned*)((const char*)(gbase) + (voff)[_i]), (LAS unsigned*)(lds + (bufoff) + ldsw + _i * 8192), 16, 0, 0); } while (0)
#define PG8_LDA(dst, b, h) do { _Pragma("unroll") for (int m = 0; m < 4; ++m) _Pragma("unroll") for (int k = 0; k < 2; ++k) dst[m][k] = *(const LAS bf16x8*)(lds + PG8_SA(b, h) + aoff + m * 2048 + k * 1024); } while (0)
#define PG8_LDB(dst, b, h) do { _Pragma("unroll") for (int n = 0; n < 2; ++n) _Pragma("unroll") for (int k = 0; k < 2; ++k) dst[n][k] = *(const LAS bf16x8*)(lds + PG8_SB(b, h) + boff + n * 2048 + k * 1024); } while (0)
#define PG8_MMA(ai, bj, At, Bt) do { __builtin_amdgcn_s_setprio(1); _Pragma("unroll") for (int m = 0; m < 4; ++m) _Pragma("unroll") for (int n = 0; n < 2; ++n) _Pragma("unroll") for (int k = 0; k < 2; ++k) \
        acc[ai][bj][m][n] = __builtin_amdgcn_mfma_f32_16x16x32_bf16(Bt[n][k], At[m][k], acc[ai][bj][m][n], 0, 0, 0); __builtin_amdgcn_s_setprio(0); } while (0)
#define PG8_WAIT_V(n) asm volatile("s_waitcnt vmcnt(" #n ")" ::: "memory")
#define PG8_WAIT_L(n) asm volatile("s_waitcnt lgkmcnt(" #n ")" ::: "memory")
#define PG8_BAR __builtin_amdgcn_s_barrier()
#define PG8_SCHED __builtin_amdgcn_sched_barrier(0)
    Unit cur, nxt; int ui = 0;
    if (!S.next(0, cur)) return;
    f32x4 acc[2][2][4][2];
#pragma unroll
    for (int a = 0; a < 2; ++a)
#pragma unroll
        for (int b = 0; b < 2; ++b)
#pragma unroll
            for (int m = 0; m < 4; ++m)
#pragma unroll
                for (int n = 0; n < 2; ++n) acc[a][b][m][n] = (f32x4){0.f, 0.f, 0.f, 0.f};
    bf16x8 At[4][2], B0[2][2], B1[2][2];
    const char* cA = S.aptr(cur); const char* cB = S.bptr(cur);
    PG8_STAGE(PG8_SB(0, 0), cB, voffB[0]); PG8_STAGE(PG8_SA(0, 0), cA, voffA); PG8_STAGE(PG8_SB(0, 1), cB, voffB[1]); PG8_STAGE(PG8_SA(0, 1), cA + hstep, voffA);
    if (wr == 1) PG8_BAR;
    PG8_WAIT_V(4); PG8_BAR;
    PG8_STAGE(PG8_SB(1, 0), cB + kstep, voffB[0]); PG8_STAGE(PG8_SA(1, 0), cA + kstep, voffA); PG8_STAGE(PG8_SB(1, 1), cB + kstep, voffB[1]);
    PG8_WAIT_V(6); PG8_BAR;
    for (;;) {
        const bool has_next = S.next(ui + 1, nxt);
        const char* nA = has_next ? S.aptr(nxt) : cA; const char* nB = has_next ? S.bptr(nxt) : cB;
        for (int t = 0; t < nt; t += 2) {
            const bool last = (t == nt - 2);
            const char* a1 = cA + (size_t)(t + 1) * kstep;
            const char* a2 = last ? nA : cA + (size_t)(t + 2) * kstep; const char* b2 = last ? nB : cB + (size_t)(t + 2) * kstep;
            const char* a3 = a2 + kstep; const char* b3 = b2 + kstep;
            PG8_LDB(B0, 0, 0); PG8_SCHED; PG8_LDA(At, 0, 0); PG8_STAGE(PG8_SA(1, 1), a1 + hstep, voffA);
            PG8_WAIT_L(8); PG8_BAR; PG8_WAIT_L(0); PG8_MMA(0, 0, At, B0); PG8_BAR; PG8_SCHED;
            PG8_LDB(B1, 0, 1); PG8_STAGE(PG8_SB(0, 0), b2, voffB[0]);
            PG8_BAR; PG8_WAIT_L(0); PG8_MMA(0, 1, At, B1); PG8_BAR;
            PG8_LDA(At, 0, 1); PG8_STAGE(PG8_SA(0, 0), a2, voffA);
            PG8_BAR; PG8_WAIT_L(0); PG8_MMA(1, 0, At, B0); PG8_BAR; PG8_SCHED;
            PG8_STAGE(PG8_SB(0, 1), b2, voffB[1]);
            PG8_WAIT_V(6); PG8_BAR; PG8_MMA(1, 1, At, B1); PG8_BAR;
            PG8_LDB(B0, 1, 0); PG8_SCHED; PG8_LDA(At, 1, 0); PG8_STAGE(PG8_SA(0, 1), a2 + hstep, voffA);
            PG8_WAIT_L(8); PG8_BAR; PG8_WAIT_L(0); PG8_MMA(0, 0, At, B0); PG8_BAR; PG8_SCHED;
            PG8_LDB(B1, 1, 1); PG8_STAGE(PG8_SB(1, 0), b3, voffB[0]);
            PG8_BAR; PG8_WAIT_L(0); PG8_MMA(0, 1, At, B1); PG8_BAR;
            PG8_LDA(At, 1, 1); PG8_STAGE(PG8_SA(1, 0), a3, voffA);
            PG8_BAR; PG8_WAIT_L(0); PG8_MMA(1, 0, At, B0); PG8_BAR; PG8_SCHED;
            PG8_STAGE(PG8_SB(1, 1), b3, voffB[1]);
            PG8_WAIT_V(6); PG8_BAR; PG8_MMA(1, 1, At, B1); PG8_BAR;
        }
        E(acc, cur, wr, wc, fr, fq);
        if (!has_next) break;
#pragma unroll
        for (int a = 0; a < 2; ++a)
#pragma unroll
            for (int b = 0; b < 2; ++b)
#pragma unroll
                for (int m = 0; m < 4; ++m)
#pragma unroll
                    for (int n = 0; n < 2; ++n) acc[a][b][m][n] = (f32x4){0.f, 0.f, 0.f, 0.f};
        cur = nxt; cA = nA; cB = nB; ++ui;
    }
    PG8_WAIT_V(0);
    if (wr == 0) PG8_BAR;
    PG8_BAR;
#undef PG8_SA
#undef PG8_SB
#undef PG8_STAGE
#undef PG8_LDA
#undef PG8_LDB
#undef PG8_MMA
#undef PG8_WAIT_V
#undef PG8_WAIT_L
#undef PG8_BAR
#undef PG8_SCHED
}

struct MUnit { int e, rt, pn, cnt, sbase; };
constexpr int MTAB_OFF = JOBS_OFF + 256;
DI void moe_table256(const unsigned* cntg, LAS unsigned char* lds, int tid) {
    LAS int* ctl = (LAS int*)(lds + MTAB_OFF);
    if (tid < 64) {
        const int c = (tid < NE) ? (int)__hip_atomic_load(cntg + tid, __ATOMIC_RELAXED, __HIP_MEMORY_SCOPE_AGENT) : 0;
        const int n = (c + 255) / 256;
        int pb = c, pt = n;
#pragma unroll
        for (int o = 1; o < 32; o <<= 1) { const int vb = __shfl_up(pb, o), vt = __shfl_up(pt, o); if (tid >= o) { pb += vb; pt += vt; } }
        if (tid < NE) { ctl[tid] = c; ctl[32 + tid] = pb - c; ctl[64 + tid] = pt - n; for (int i = 0; i < n && pt - n + i < 128; ++i) ctl[128 + pt - n + i] = tid; }
        if (tid == NE - 1) ctl[64 + NE] = pt;
    }
    __syncthreads();
}
template <int NPN>
struct MSched {
    const LAS int* ctl; int G, c, total;
    DI void init(LAS unsigned char* lds, int G_, int c_, bool xcd_group = false) { ctl = (const LAS int*)(lds + MTAB_OFF); G = G_; total = ctl[64 + NE] * NPN;
        c = (xcd_group && (G_ % 8 == 0)) ? (c_ % 8) * (G_ / 8) + c_ / 8 : c_; }
    DI bool next(int i, MUnit& u) const {
        const int L = i * G + c; if (L >= total) return false;
        const int rtg = L / NPN; u.pn = L % NPN;
        const int e = ctl[128 + rtg];
        u.e = e; u.rt = rtg - ctl[64 + e]; u.cnt = ctl[e]; u.sbase = ctl[32 + e]; return true;
    }
};
struct MOps1 {
    const bf16_t* H; const bf16_t* W; const unsigned* list;
    DI const char* abase(const MUnit&) const { return (const char*)H; }
    DI void aoffs(const MUnit& u, int R0, int C0, int R1, int C1, unsigned (&o)[2][2]) const {
#pragma unroll
        for (int h = 0; h < 2; ++h) {
            const int ra = u.rt * 256 + h * 128 + R0, rb = u.rt * 256 + h * 128 + R1;
            const unsigned ta = list[(size_t)u.e * T + (ra < u.cnt ? ra : u.cnt - 1)] >> 1, tb = list[(size_t)u.e * T + (rb < u.cnt ? rb : u.cnt - 1)] >> 1;
            o[h][0] = (ta * (unsigned)D + (unsigned)C0) * 2u; o[h][1] = (tb * (unsigned)D + (unsigned)C1) * 2u;
        }
    }
    DI const char* bptr(const MUnit& u) const { return (const char*)(W + ((size_t)u.e * 512 + u.pn * 256) * D); }
};
struct MOps2 {
    const bf16_t* hid; const bf16_t* W;
    DI const char* abase(const MUnit& u) const { return (const char*)(hid + (size_t)(u.sbase + u.rt * 256) * FF); }
    DI void aoffs(const MUnit&, int R0, int C0, int R1, int C1, unsigned (&o)[2][2]) const {
#pragma unroll
        for (int h = 0; h < 2; ++h) { o[h][0] = (unsigned)((h * 128 + R0) * FF + C0) * 2u; o[h][1] = (unsigned)((h * 128 + R1) * FF + C1) * 2u; }
    }
    DI const char* bptr(const MUnit& u) const { return (const char*)(W + ((size_t)u.e * D + u.pn * 256) * FF); }
};
constexpr int MROW_OFF = 131072;
struct EpiSwiglu {
    bf16_t* hid; const float* listw;
    DI void prep(const MUnit& u, LAS unsigned char* lds, int par, int tid) const {
        if (tid < 256) { const int r = u.rt * 256 + tid;
            __builtin_amdgcn_global_load_lds((const GAS unsigned*)(listw + (size_t)u.e * T + (r < u.cnt ? r : u.cnt - 1)), (LAS unsigned*)(lds + MROW_OFF + par * 1024 + (tid >> 6) * 256), 4, 0, 0); }
    }
    DI void operator()(const f32x4 (&acc)[2][2][4][2], const MUnit& u, int wr, int wc, int fr, int fq, const LAS unsigned char* lds, int par) const {
#pragma unroll
        for (int ai = 0; ai < 2; ++ai)
#pragma unroll
            for (int m = 0; m < 4; ++m) {
                const int r = u.rt * 256 + ai * HALF + wr * 64 + m * 16 + fr;
                if (r < u.cnt) {
                    const float gw = ((const LAS float*)(lds + MROW_OFF))[par * 256 + ai * HALF + wr * 64 + m * 16 + fr];
                    unsigned o[4];
#pragma unroll
                    for (int n = 0; n < 2; ++n) { const f32x4 g = acc[ai][0][m][n], uu = acc[ai][1][m][n]; float hv[4];
#pragma unroll
                        for (int j = 0; j < 4; ++j) hv[j] = g[j] / (1.0f + __expf(-g[j])) * uu[j] * gw;
                        o[2 * n] = pk2(hv[0], hv[1]); o[2 * n + 1] = pk2(hv[2], hv[3]); }
                    *(u32x4*)(hid + (size_t)(u.sbase + r) * FF + u.pn * 128 + wc * 32 + 8 * fq) = (u32x4){o[0], o[1], o[2], o[3]};
                }
            }
    }
};
struct EpiScatter {
    bf16_t* Y; const unsigned* list;
    DI void prep(const MUnit& u, LAS unsigned char* lds, int par, int tid) const {
        if (tid < 256) { const int r = u.rt * 256 + tid;
            __builtin_amdgcn_global_load_lds((const GAS unsigned*)(list + (size_t)u.e * T + (r < u.cnt ? r : u.cnt - 1)), (LAS unsigned*)(lds + MROW_OFF + par * 1024 + (tid >> 6) * 256), 4, 0, 0); }
    }
    DI void operator()(const f32x4 (&acc)[2][2][4][2], const MUnit& u, int wr, int wc, int fr, int fq, const LAS unsigned char* lds, int par) const {
#pragma unroll
        for (int ai = 0; ai < 2; ++ai)
#pragma unroll
            for (int m = 0; m < 4; ++m) {
                const int r = u.rt * 256 + ai * HALF + wr * 64 + m * 16 + fr;
                if (r < u.cnt) {
                    const unsigned ent = ((const LAS unsigned*)(lds + MROW_OFF))[par * 256 + ai * HALF + wr * 64 + m * 16 + fr];
                    bf16_t* yrow = Y + ((size_t)(ent & 1u) * T + (ent >> 1)) * D + u.pn * 256 + wc * 64 + 8 * fq;
#pragma unroll
                    for (int bj = 0; bj < 2; ++bj) { const f32x4 v0 = acc[ai][bj][m][0], v1 = acc[ai][bj][m][1];
                        __builtin_nontemporal_store(((u32x4){pk2(v0.x, v0.y), pk2(v0.z, v0.w), pk2(v1.x, v1.y), pk2(v1.z, v1.w)}), (u32x4*)(yrow + bj * 32)); }
                }
            }
    }
};
struct EpiMNull {
    DI void prep(const MUnit&, LAS unsigned char*, int, int) const {}
    DI void operator()(const f32x4 (&acc)[2][2][4][2], const MUnit&, int, int, int, int, const LAS unsigned char*, int) const {
#pragma unroll
        for (int ai = 0; ai < 2; ++ai)
#pragma unroll
            for (int bj = 0; bj < 2; ++bj)
#pragma unroll
                for (int m = 0; m < 4; ++m)
#pragma unroll
                    for (int n = 0; n < 2; ++n) asm volatile("" :: "v"(acc[ai][bj][m][n]));
    }
};
template <int K, class Sched, class Ops, class Epi>
DI void gemm_phase_m(LAS unsigned char* lds, const Sched& S, const Ops& P, const Epi& E) {
    const int tid = threadIdx.x, wid = __builtin_amdgcn_readfirstlane(tid >> 6), lane = tid & 63, wr = wid >> 2, wc = wid & 3, fr = lane & 15, fq = lane >> 4;
    constexpr int nt = K / BK;
    int R0, C0, R1, C1; stage_rc(tid * 16, R0, C0); stage_rc(tid * 16 + 8192, R1, C1);
    unsigned voffB[2][2];
#pragma unroll
    for (int h = 0; h < 2; ++h) { voffB[h][0] = (unsigned)((64 * (R0 >> 5) + 32 * h + perm32(R0 & 31)) * K + C0) * 2u; voffB[h][1] = (unsigned)((64 * (R1 >> 5) + 32 * h + perm32(R1 & 31)) * K + C1) * 2u; }
    constexpr size_t kstep = (size_t)(BK * 2);
    constexpr size_t hstep = (size_t)HALF * K * 2;
    const unsigned ldsw = (unsigned)wid * 1024u;
    const int aoff = lds_byte(wr * 64 + fr, fq * 8), boff = lds_byte(wc * 32 + fr, fq * 8);
#define PG8_SA(b, h) (((b) * 2 + (h)) * HTB)
#define PG8_SB(b, h) ((4 + (b) * 2 + (h)) * HTB)
#define PG8_STAGEB(bufoff, gbase, h) do { _Pragma("unroll") for (int _i = 0; _i < 2; ++_i) \
        __builtin_amdgcn_global_load_lds((const GAS unsigned*)((const char*)(gbase) + voffB[h][_i]), (LAS unsigned*)(lds + (bufoff) + ldsw + _i * 8192), 16, 0, 0); } while (0)
#define PG8_STAGEA(bufoff, bb, pp, h, koff) do { _Pragma("unroll") for (int _i = 0; _i < 2; ++_i) \
        __builtin_amdgcn_global_load_lds((const GAS unsigned*)((bb) + (koff) + (pp)[h][_i]), (LAS unsigned*)(lds + (bufoff) + ldsw + _i * 8192), 16, 0, 0); } while (0)
#define PG8_LDA(dst, b, h) do { _Pragma("unroll") for (int m = 0; m < 4; ++m) _Pragma("unroll") for (int k = 0; k < 2; ++k) dst[m][k] = *(const LAS bf16x8*)(lds + PG8_SA(b, h) + aoff + m * 2048 + k * 1024); } while (0)
#define PG8_LDB(dst, b, h) do { _Pragma("unroll") for (int n = 0; n < 2; ++n) _Pragma("unroll") for (int k = 0; k < 2; ++k) dst[n][k] = *(const LAS bf16x8*)(lds + PG8_SB(b, h) + boff + n * 2048 + k * 1024); } while (0)
#define PG8_MMA(ai, bj, At, Bt) do { __builtin_amdgcn_s_setprio(1); _Pragma("unroll") for (int m = 0; m < 4; ++m) _Pragma("unroll") for (int n = 0; n < 2; ++n) _Pragma("unroll") for (int k = 0; k < 2; ++k) \
        acc[ai][bj][m][n] = __builtin_amdgcn_mfma_f32_16x16x32_bf16(Bt[n][k], At[m][k], acc[ai][bj][m][n], 0, 0, 0); __builtin_amdgcn_s_setprio(0); } while (0)
#define PG8_WAIT_V(n) asm volatile("s_waitcnt vmcnt(" #n ")" ::: "memory")
#define PG8_WAIT_L(n) asm volatile("s_waitcnt lgkmcnt(" #n ")" ::: "memory")
#define PG8_BAR __builtin_amdgcn_s_barrier()
#define PG8_SCHED __builtin_amdgcn_sched_barrier(0)
    MUnit cur, nxt; int ui = 0;
    if (!S.next(0, cur)) return;
    f32x4 acc[2][2][4][2];
#pragma unroll
    for (int a = 0; a < 2; ++a)
#pragma unroll
        for (int b = 0; b < 2; ++b)
#pragma unroll
            for (int m = 0; m < 4; ++m)
#pragma unroll
                for (int n = 0; n < 2; ++n) acc[a][b][m][n] = (f32x4){0.f, 0.f, 0.f, 0.f};
    bf16x8 At[4][2], B0[2][2], B1[2][2];
    unsigned pA[2][2], qA[2][2];
    P.aoffs(cur, R0, C0, R1, C1, pA);
    const char* cAb = P.abase(cur);
    E.prep(cur, lds, 0, tid);
    const char* cB = P.bptr(cur);
    PG8_STAGEB(PG8_SB(0, 0), cB, 0); PG8_STAGEA(PG8_SA(0, 0), cAb, pA, 0, 0); PG8_STAGEB(PG8_SB(0, 1), cB, 1); PG8_STAGEA(PG8_SA(0, 1), cAb, pA, 1, 0);
    if (wr == 1) PG8_BAR;
    PG8_WAIT_V(4); PG8_BAR;
    PG8_STAGEB(PG8_SB(1, 0), cB + kstep, 0); PG8_STAGEA(PG8_SA(1, 0), cAb, pA, 0, kstep); PG8_STAGEB(PG8_SB(1, 1), cB + kstep, 1);
    PG8_WAIT_V(6); PG8_BAR;
    for (;;) {
        const bool has_next = S.next(ui + 1, nxt);
        const char* nB = cB; const char* nAb = cAb;
#pragma unroll
        for (int h = 0; h < 2; ++h) { qA[h][0] = pA[h][0]; qA[h][1] = pA[h][1]; }
        if (has_next) { P.aoffs(nxt, R0, C0, R1, C1, qA); nAb = P.abase(nxt); nB = P.bptr(nxt); E.prep(nxt, lds, (ui + 1) % 3, tid); }
#pragma unroll 1
        for (int t = 0; t < nt; t += 2) {
            const bool last = (t == nt - 2);
            const size_t k1 = (size_t)(t + 1) * kstep;
            const size_t k2 = last ? 0 : (size_t)(t + 2) * kstep, k3 = k2 + kstep;
            const char* b2 = last ? nB : cB + k2; const char* b3 = b2 + kstep;
            const char* a2 = last ? nAb : cAb;
            unsigned o2[2][2];
#pragma unroll
            for (int h = 0; h < 2; ++h) { o2[h][0] = last ? qA[h][0] : pA[h][0]; o2[h][1] = last ? qA[h][1] : pA[h][1]; }
            PG8_LDB(B0, 0, 0); PG8_SCHED; PG8_LDA(At, 0, 0); PG8_STAGEA(PG8_SA(1, 1), cAb, pA, 1, k1);
            PG8_WAIT_L(8); PG8_BAR; PG8_WAIT_L(0); PG8_MMA(0, 0, At, B0); PG8_BAR; PG8_SCHED;
            PG8_LDB(B1, 0, 1); PG8_STAGEB(PG8_SB(0, 0), b2, 0);
            PG8_BAR; PG8_WAIT_L(0); PG8_MMA(0, 1, At, B1); PG8_BAR;
            PG8_LDA(At, 0, 1); PG8_STAGEA(PG8_SA(0, 0), a2, o2, 0, k2);
            PG8_BAR; PG8_WAIT_L(0); PG8_MMA(1, 0, At, B0); PG8_BAR; PG8_SCHED;
            PG8_STAGEB(PG8_SB(0, 1), b2, 1);
            PG8_WAIT_V(6); PG8_BAR; PG8_MMA(1, 1, At, B1); PG8_BAR;
            PG8_LDB(B0, 1, 0); PG8_SCHED; PG8_LDA(At, 1, 0); PG8_STAGEA(PG8_SA(0, 1), a2, o2, 1, k2);
            PG8_WAIT_L(8); PG8_BAR; PG8_WAIT_L(0); PG8_MMA(0, 0, At, B0); PG8_BAR; PG8_SCHED;
            PG8_LDB(B1, 1, 1); PG8_STAGEB(PG8_SB(1, 0), b3, 0);
            PG8_BAR; PG8_WAIT_L(0); PG8_MMA(0, 1, At, B1); PG8_BAR;
            PG8_LDA(At, 1, 1); PG8_STAGEA(PG8_SA(1, 0), a2, o2, 0, k3);
            PG8_BAR; PG8_WAIT_L(0); PG8_MMA(1, 0, At, B0); PG8_BAR; PG8_SCHED;
            PG8_STAGEB(PG8_SB(1, 1), b3, 1);
            PG8_WAIT_V(6); PG8_BAR; PG8_MMA(1, 1, At, B1); PG8_BAR;
        }
        E(acc, cur, wr, wc, fr, fq, lds, ui % 3);
        if (!has_next) break;
#pragma unroll
        for (int a = 0; a < 2; ++a)
#pragma unroll
            for (int b = 0; b < 2; ++b)
#pragma unroll
                for (int m = 0; m < 4; ++m)
#pragma unroll
                    for (int n = 0; n < 2; ++n) acc[a][b][m][n] = (f32x4){0.f, 0.f, 0.f, 0.f};
        cur = nxt; cB = nB; cAb = nAb; ++ui;
#pragma unroll
        for (int h = 0; h < 2; ++h) { pA[h][0] = qA[h][0]; pA[h][1] = qA[h][1]; }
    }
    PG8_WAIT_V(0);
    if (wr == 0) PG8_BAR;
    PG8_BAR;
#undef PG8_SA
#undef PG8_SB
#undef PG8_STAGEA
#undef PG8_STAGEB
#undef PG8_LDA
#undef PG8_LDB
#undef PG8_MMA
#undef PG8_WAIT_V
#undef PG8_WAIT_L
#undef PG8_BAR
#undef PG8_SCHED
}
}

constexpr int AT_K0 = 0, AT_V0 = 17408, AT_KVB = 35840, AT_FL = 71680, AT_QS = 71936;
template <int ABL = 0>
DI void attn_phase(const bf16_t* Qb, const bf16_t* Kb, const bf16_t* Vt, bf16_t* O, LAS unsigned char* lds, int tid, int wid, int lane) {
    const int fr = lane & 15, fq = lane >> 4;
    LAS int* flags = (LAS int*)(lds + AT_FL);
    for (int bx = blockIdx.x; bx < 512; bx += gridDim.x) {
        const int rnd = bx >> 8, pos = bx & 255;
        const int qb = (rnd & 1) ? 2 * (pos >> 6) : 2 * (pos >> 6) + 1;
        const int bh = pos & 63, b = bh >> 4, h = bh & 15;
        const int t0 = qb * 256;
        __syncthreads();
        const int kr0 = tid >> 4, kc = tid & 15, vr0 = tid >> 3, vc = tid & 7;
        const bf16_t* kg = Kb + (size_t)(b * SEQ + kr0) * D + h * 128 + kc * 8;
        const bf16_t* vg = Vt + (size_t)(h * 128 + vr0) * T + b * SEQ + vc * 8;
        u32x4 pk0, pk1, pv0, pv1;
        int s0 = t0 + 192;
        pk0 = *(const u32x4*)(kg + (size_t)s0 * D); pk1 = *(const u32x4*)(kg + (size_t)(s0 + 32) * D);
        pv0 = *(const u32x4*)(vg + s0); pv1 = *(const u32x4*)(vg + (size_t)64 * T + s0);
#pragma unroll
        for (int c8 = 0; c8 < 8; ++c8) {
            const int c = tid + 512 * c8, row = c >> 4, c16 = c & 15;
            *(LAS u32x4*)(lds + AT_QS + row * 272 + c16 * 16) = *(const u32x4*)(Qb + (size_t)(b * SEQ + t0 + row) * D + h * 128 + c16 * 8);
        }
        {
            LAS unsigned char* kb_ = lds + AT_K0; LAS unsigned char* vb_ = lds + AT_V0;
            *(LAS u32x4*)(kb_ + kr0 * 272 + kc * 16) = pk0; *(LAS u32x4*)(kb_ + (kr0 + 32) * 272 + kc * 16) = pk1;
            *(LAS u32x4*)(vb_ + vr0 * 144 + vc * 16) = pv0; *(LAS u32x4*)(vb_ + (vr0 + 64) * 144 + vc * 16) = pv1;
            const int s1 = s0 - 64;
            pk0 = *(const u32x4*)(kg + (size_t)s1 * D); pk1 = *(const u32x4*)(kg + (size_t)(s1 + 32) * D); pv0 = *(const u32x4*)(vg + s1); pv1 = *(const u32x4*)(vg + (size_t)64 * T + s1);
        }
        __syncthreads();
        f32x4 oacc[2][8];
#pragma unroll
        for (int r = 0; r < 2; ++r)
#pragma unroll
            for (int n = 0; n < 8; ++n) oacc[r][n] = (f32x4){0.f, 0.f, 0.f, 0.f};
        float Rrun[2] = {1.f, 1.f};
        bool wave_alive = true;
        int it = 0;
        for (;; ++it, s0 -= 64) {
            int zz = 0; asm volatile("" : "+v"(zz));
            const LAS unsigned char* kb_ = lds + zz + AT_K0 + (it & 1) * AT_KVB; const LAS unsigned char* vb_ = lds + zz + AT_V0 + (it & 1) * AT_KVB;
            const bool wave_on = (s0 < t0 + 32 * wid + 31) && wave_alive;
            if (wave_on) {
            f32x4 sacc[2][4];
#pragma unroll
            for (int r = 0; r < 2; ++r)
#pragma unroll
                for (int n = 0; n < 4; ++n) sacc[r][n] = (f32x4){0.f, 0.f, 0.f, 0.f};
            if constexpr ((ABL & 8) != 0) {
#pragma unroll
                for (int r = 0; r < 2; ++r)
#pragma unroll
                    for (int n = 0; n < 4; ++n) sacc[r][n] = (f32x4){0.1f * (float)(fr + n), -0.2f * (float)fq, 0.05f * (float)it, 0.3f};
            } else
#pragma unroll
            for (int ks = 0; ks < 4; ++ks) {
                const bf16x8 qa0 = *(const LAS bf16x8*)(lds + zz + AT_QS + (32 * wid + fr) * 272 + (ks * 32 + fq * 8) * 2);
                const bf16x8 qa1 = *(const LAS bf16x8*)(lds + zz + AT_QS + (32 * wid + 16 + fr) * 272 + (ks * 32 + fq * 8) * 2);
#pragma unroll
                for (int n = 0; n < 4; ++n) {
                    const bf16x8 kf = *(const LAS bf16x8*)(kb_ + (16 * n + fr) * 272 + (ks * 32 + fq * 8) * 2);
                    sacc[0][n] = MFMA16(kf, qa0, sacc[0][n]);
                    sacc[1][n] = MFMA16(kf, qa1, sacc[1][n]);
                }
            }
            unsigned ap[2][4][2];
            const int sb = s0 + 4 * fq;
            const bool need_mask = (s0 + 63 >= t0 + 32 * wid);
#pragma unroll
            for (int r = 0; r < 2; ++r) {
                const int tq = t0 + 32 * wid + 16 * r + fr;
                float apart[4][4], gprod[4];
                if constexpr ((ABL & 2) != 0) {
#pragma unroll
                    for (int n = 0; n < 4; ++n) { gprod[n] = 0.25f;
#pragma unroll
                        for (int j = 0; j < 4; ++j) apart[n][j] = sacc[r][n][j]; }
                } else if (need_mask) {
#pragma unroll
                    for (int n = 0; n < 4; ++n) {
                        float run = 1.f;
#pragma unroll
                        for (int j = 3; j >= 0; --j) {
                            const float zv = ((sb + 16 * n + j) < tq) ? sacc[r][n][j] : -200.f;
                            const float om = __builtin_amdgcn_rcpf(1.0f + __builtin_amdgcn_exp2f(zv));
                            const float rn = run * om;
                            apart[n][j] = run - rn;
                            run = rn;
                        }
                        gprod[n] = run;
                    }
                } else {
#pragma unroll
                    for (int n = 0; n < 4; ++n) {
                        float run = 1.f;
#pragma unroll
                        for (int j = 3; j >= 0; --j) {
                            const float om = __builtin_amdgcn_rcpf(1.0f + __builtin_amdgcn_exp2f(sacc[r][n][j]));
                            const float rn = run * om;
                            apart[n][j] = run - rn;
                            run = rn;
                        }
                        gprod[n] = run;
                    }
                }
                float offs[4]; float acc_after = 1.f;
#pragma unroll
                for (int n = 3; n >= 0; --n) {
                    const float bq = __shfl_xor(gprod[n], 16); const float s01 = gprod[n] * bq; const float oth = __shfl_xor(s01, 32);
                    offs[n] = Rrun[r] * acc_after * (((fq & 1) == 0) ? bq : 1.f) * ((fq < 2) ? oth : 1.f);
                    acc_after *= s01 * oth;
                }
                Rrun[r] *= acc_after;
#pragma unroll
                for (int n = 0; n < 4; ++n) { ap[r][n][0] = pk2(apart[n][0] * offs[n], apart[n][1] * offs[n]); ap[r][n][1] = pk2(apart[n][2] * offs[n], apart[n][3] * offs[n]); }
            }
#define AT_LDVF(dst, g) do { _Pragma("unroll") for (int i_ = 0; i_ < 4; ++i_) { const int n_ = 4 * ((g) & 1) + i_, u_ = (g) >> 1; \
                const s16x4 vlo = *(const LAS s16x4*)(vb_ + (16 * n_ + fr) * 144 + (32 * u_ + 4 * fq) * 2); const s16x4 vhi = *(const LAS s16x4*)(vb_ + (16 * n_ + fr) * 144 + (32 * u_ + 16 + 4 * fq) * 2); \
                dst[i_] = __builtin_shufflevector(vlo, vhi, 0, 1, 2, 3, 4, 5, 6, 7); } } while (0)
#define AT_MMAG(src, g) do { const int u_ = (g) >> 1; \
                const bf16x8 aa0 = __builtin_bit_cast(bf16x8, ((u32x4){ap[0][2 * u_][0], ap[0][2 * u_][1], ap[0][2 * u_ + 1][0], ap[0][2 * u_ + 1][1]})); \
                const bf16x8 aa1 = __builtin_bit_cast(bf16x8, ((u32x4){ap[1][2 * u_][0], ap[1][2 * u_][1], ap[1][2 * u_ + 1][0], ap[1][2 * u_ + 1][1]})); \
                _Pragma("unroll") for (int i_ = 0; i_ < 4; ++i_) { const int n_ = 4 * ((g) & 1) + i_; \
                    oacc[0][n_] = MFMA16(src[i_], aa0, oacc[0][n_]); oacc[1][n_] = MFMA16(src[i_], aa1, oacc[1][n_]); } } while (0)
            if constexpr ((ABL & 4) != 0) {
#pragma unroll
                for (int r = 0; r < 2; ++r)
#pragma unroll
                    for (int n = 0; n < 4; ++n) { oacc[r][n].x += __uint_as_float(ap[r][n][0]); oacc[r][n].y += __uint_as_float(ap[r][n][1]); }
            } else {
                bf16x8 vA[4], vB[4];
                AT_LDVF(vA, 0); AT_LDVF(vB, 1);
                __builtin_amdgcn_sched_barrier(0);
                AT_MMAG(vA, 0);
                __builtin_amdgcn_sched_barrier(0);
                AT_LDVF(vA, 2);
                __builtin_amdgcn_sched_barrier(0);
                AT_MMAG(vB, 1);
                __builtin_amdgcn_sched_barrier(0);
                AT_LDVF(vB, 3);
                __builtin_amdgcn_sched_barrier(0);
                AT_MMAG(vA, 2);
                __builtin_amdgcn_sched_barrier(0);
                AT_MMAG(vB, 3);
            }
#undef AT_LDVF
#undef AT_MMAG
            }
            const int sn1 = s0 - 64, sn2 = s0 - 128;
            wave_alive = (ABL & 1) ? true : (bool)__any(fmaxf(Rrun[0], Rrun[1]) > 0.f);
            if (lane == 0) flags[(it & 1) * 8 + wid] = wave_alive ? 1 : 0;
            if (sn1 >= 0) {
                LAS unsigned char* kn = lds + AT_K0 + ((it + 1) & 1) * AT_KVB; LAS unsigned char* vn = lds + AT_V0 + ((it + 1) & 1) * AT_KVB;
                *(LAS u32x4*)(kn + kr0 * 272 + kc * 16) = pk0; *(LAS u32x4*)(kn + (kr0 + 32) * 272 + kc * 16) = pk1;
                *(LAS u32x4*)(vn + vr0 * 144 + vc * 16) = pv0; *(LAS u32x4*)(vn + (vr0 + 64) * 144 + vc * 16) = pv1;
                if (sn2 >= 0) { pk0 = *(const u32x4*)(kg + (size_t)sn2 * D); pk1 = *(const u32x4*)(kg + (size_t)(sn2 + 32) * D); pv0 = *(const u32x4*)(vg + sn2); pv1 = *(const u32x4*)(vg + (size_t)64 * T + sn2); }
            }
            __syncthreads();
            if (sn1 < 0) break;
            int any_alive = 0;
#pragma unroll
            for (int w = 0; w < 8; ++w) any_alive |= flags[(it & 1) * 8 + w];
            if (!any_alive) break;
        }
#pragma unroll
        for (int r = 0; r < 2; ++r) {
            bf16_t* orow = O + (size_t)(b * SEQ + t0 + 32 * wid + 16 * r + fr) * D + h * 128 + 4 * fq;
#pragma unroll
            for (int n = 0; n < 8; ++n) { u32x2 o; o.x = pk2(oacc[r][n].x, oacc[r][n].y); o.y = pk2(oacc[r][n].z, oacc[r][n].w); *(u32x2*)(orow + 16 * n) = o; }
        }
    }
}

constexpr int ML_QS = 0, ML_KS = 17408, ML_KD = 34816, ML_VT = 53248, ML_WS = 90112, ML_HB = 99328, ML_SC = 133120;
DI float ml_tab(LAS float* tab, float gi, float gf, float mprev, int lane) {
    const float flog = fminf(gf, 0.f) - __logf(1.0f + __expf(-fabsf(gf)));
    float bb = flog;
#pragma unroll
    for (int o = 1; o < 64; o <<= 1) { const float v = __shfl_up(bb, o); if (lane >= o) bb += v; }
    const float a = gi - bb;
    float pm = a;
#pragma unroll
    for (int o = 1; o < 64; o <<= 1) { const float v = __shfl_up(pm, o); if (lane >= o) pm = fmaxf(pm, v); }
    const float amax = __shfl(pm, 63), bL = __shfl(bb, 63);
    const float Mx = fmaxf(mprev, amax);
    tab[lane] = a; tab[64 + lane] = bb; tab[128 + lane] = fmaxf(pm, mprev);
    if (lane == 0) { tab[192] = mprev; tab[193] = Mx; }
    return bL + Mx;
}
constexpr int MLA_KD = 0, MLA_SC = 69632;
DI void mlstm_local(const bf16_t* K1, const bf16_t* VT, const float* G, const float* b_i, const float* b_f, bf16_t* KV, float* NJ, float* SUM,
                    LAS unsigned char* lds, int tid, int wid, int lane) {
    const int fr = lane & 15, fq = lane >> 4;
    LAS float* sa = (LAS float*)(lds + MLA_SC); LAS float* swsum = sa + 256; LAS float* swmax = sa + 264;
    for (int unit0 = blockIdx.x; unit0 < 256; unit0 += gridDim.x) {
        const int unit = (gridDim.x == 256) ? (unit0 & 7) * 32 + (unit0 >> 3) : unit0;
        const int J = unit & 7, bh = unit >> 3, b = bh >> 3, h = bh & 7;
        if (J == 7) continue;
        const int tok0 = b * SEQ + J * 256;
        __syncthreads();
        float a = 0.f, bb = 0.f;
        if (tid < 256) {
            const size_t g0 = (size_t)(tok0 + tid) * 16;
            const float gi = G[g0 + h] + b_i[h], gf = G[g0 + 8 + h] + b_f[h];
            const float flog = fminf(gf, 0.f) - __logf(1.0f + __expf(-fabsf(gf)));
            bb = flog;
#pragma unroll
            for (int o = 1; o < 64; o <<= 1) { const float v = __shfl_up(bb, o); if (lane >= o) bb += v; }
            if (lane == 63) swsum[wid] = bb;
        }
        __syncthreads();
        if (tid < 256) {
            float off = 0.f;
            for (int w = 0; w < 4; ++w) off += (w < wid) ? swsum[w] : 0.f;
            bb += off;
            const size_t g0 = (size_t)(tok0 + tid) * 16;
            a = (G[g0 + h] + b_i[h]) - bb;
            float mx = a;
#pragma unroll
            for (int o = 1; o < 64; o <<= 1) mx = fmaxf(mx, __shfl_xor(mx, o));
            if (lane == 0) swmax[wid] = mx;
            sa[tid] = a;
        }
        __syncthreads();
        const float amax = fmaxf(fmaxf(swmax[0], swmax[1]), fmaxf(swmax[2], swmax[3]));
        if (tid == 255) { SUM[unit * 2] = amax; SUM[unit * 2 + 1] = bb; }
        bf16x8 vfa[8][2];
#pragma unroll
        for (int ks = 0; ks < 8; ++ks)
#pragma unroll
            for (int et = 0; et < 2; ++et) vfa[ks][et] = *(const bf16x8*)(VT + (size_t)(h * 256 + 32 * wid + 16 * et + fr) * T + tok0 + ks * 32 + fq * 8);
#pragma unroll 2
        for (int c8i = 0; c8i < 8; ++c8i) {
            const int ch = tid + 512 * c8i, sp = ch & 255, c16 = ch >> 8;
            const u32x4 v = *(const u32x4*)(K1 + (size_t)(tok0 + sp) * 1024 + h * 128 + c16 * 8);
            const float dsc = __expf(sa[sp] - amax);
            const unsigned w[4] = {v.x, v.y, v.z, v.w};
            LAS bf16_t* dst = (LAS bf16_t*)(lds + MLA_KD + (c16 * 8) * 528 + sp * 2);
#pragma unroll
            for (int q = 0; q < 4; ++q) { dst[(2 * q) * 264] = (bf16_t)f2bf(bf2f(w[q] & 0xffff) * dsc); dst[(2 * q + 1) * 264] = (bf16_t)f2bf(bf2f(w[q] >> 16) * dsc); }
        }
        __syncthreads();
        f32x4 C[8][2];
#pragma unroll
        for (int dt = 0; dt < 8; ++dt)
#pragma unroll
            for (int et = 0; et < 2; ++et) C[dt][et] = (f32x4){0.f, 0.f, 0.f, 0.f};
#pragma unroll
        for (int ks = 0; ks < 8; ++ks) {
#pragma unroll
            for (int dt = 0; dt < 8; ++dt) {
                const bf16x8 kf = *(const LAS bf16x8*)(lds + MLA_KD + (16 * dt + fr) * 528 + (ks * 32 + fq * 8) * 2);
#pragma unroll
                for (int et = 0; et < 2; ++et) C[dt][et] = MFMA16(kf, vfa[ks][et], C[dt][et]);
            }
        }
        bf16_t* kv = KV + (size_t)unit * 32768;
#pragma unroll
        for (int dt = 0; dt < 8; ++dt)
#pragma unroll
            for (int et = 0; et < 2; ++et) { u32x2 o; o.x = pk2(C[dt][et].x, C[dt][et].y); o.y = pk2(C[dt][et].z, C[dt][et].w); *(u32x2*)(kv + (size_t)(32 * wid + 16 * et + fr) * 128 + 16 * dt + 4 * fq) = o; }
        {
            const int dl = tid >> 2, sl = tid & 3;
            float p = 0.f;
#pragma unroll
            for (int i = 0; i < 8; ++i) {
                const u32x4 kq = *(const LAS u32x4*)(lds + MLA_KD + dl * 528 + sl * 128 + i * 16);
                p += (bf2f(kq.x & 0xffff) + bf2f(kq.x >> 16)) + (bf2f(kq.y & 0xffff) + bf2f(kq.y >> 16)) + (bf2f(kq.z & 0xffff) + bf2f(kq.z >> 16)) + (bf2f(kq.w & 0xffff) + bf2f(kq.w >> 16));
            }
            p += __shfl_xor(p, 1); p += __shfl_xor(p, 2);
            if (sl == 0) NJ[unit * 128 + dl] = p;
        }
    }
}
template <int skip>
DI void mlstm_phase(const bf16_t* Q1, const bf16_t* K1, const bf16_t* VT, const bf16_t* OG, const float* G, const float* b_i, const float* b_f,
                    const float* g_head, bf16_t* HS, const bf16_t* KV, const float* NJ, const float* SUM, LAS unsigned char* lds, int tid, int wid, int lane, int nsteps = 4) {
    const int fr = lane & 15, fq = lane >> 4;
    LAS float* sc = (LAS float*)(lds + ML_SC); LAS float* sssq = sc + 1024; LAS float* srs = sc + 1536; LAS float* sden = sc + 1792; LAS float* sn = sc + 1856; LAS float* sgh = sc + 2112; LAS float* scf = sc + 2368;
    LAS bf16_t* hb = (LAS bf16_t*)(lds + ML_HB);
    for (int unit0 = blockIdx.x; unit0 < 256; unit0 += gridDim.x) {
        const int unit = (gridDim.x == 256) ? (unit0 & 7) * 32 + (unit0 >> 3) : unit0;
        const int J = unit & 7, bh = unit >> 3, b = bh >> 3, h = bh & 7;
        const int c0 = 4 * J, c1 = c0 + nsteps;
        __syncthreads();
        if (wid < 4) {
            LAS float* tab = sc + wid * 256;
            const size_t g0 = (size_t)(b * SEQ + (c0 + wid) * 64 + lane) * 16;
            const float gi = G[g0 + h] + b_i[h], gf = G[g0 + 8 + h] + b_f[h];
            const float flog = fminf(gf, 0.f) - __logf(1.0f + __expf(-fabsf(gf)));
            float bb = flog;
#pragma unroll
            for (int o = 1; o < 64; o <<= 1) { const float v = __shfl_up(bb, o); if (lane >= o) bb += v; }
            const float a = gi - bb;
            float pm = a;
#pragma unroll
            for (int o = 1; o < 64; o <<= 1) { const float v = __shfl_up(pm, o); if (lane >= o) pm = fmaxf(pm, v); }
            tab[lane] = a; tab[64 + lane] = bb; tab[128 + lane] = pm;
            if (lane == 63) { tab[192] = pm; tab[193] = bb; }
        }
        if (tid >= 448 && tid < 462) scf[8 + tid - 448] = SUM[bh * 16 + tid - 448];
        __syncthreads();
        if (tid == 0) {
            float cf[7]; float m0 = 0.f;
#pragma unroll
            for (int jp = 0; jp < 7; ++jp) {
                cf[jp] = 0.f;
                if (jp < J) {
                    const float am = scf[8 + 2 * jp], bl = scf[9 + 2 * jp];
                    const float M63 = fmaxf(m0, am), csj = __expf(m0 - M63);
#pragma unroll
                    for (int i = 0; i < 7; ++i) if (i < jp) cf[i] *= csj;
                    cf[jp] = __expf(am - M63);
                    m0 = bl + M63;
                }
            }
#pragma unroll
            for (int jp = 0; jp < 7; ++jp) scf[jp] = cf[jp];
            scf[7] = m0;
        }
        __syncthreads();
        const float m0 = scf[7];
        f32x4 C[8][2];
#pragma unroll
        for (int dt = 0; dt < 8; ++dt)
#pragma unroll
            for (int et = 0; et < 2; ++et) C[dt][et] = (f32x4){0.f, 0.f, 0.f, 0.f};
        float n0 = 0.f;
#pragma unroll 1
        for (int jp = 0; jp < J; ++jp) {
            const bf16_t* kv = KV + (size_t)(bh * 8 + jp) * 32768; const float cf = scf[jp];
#pragma unroll
            for (int dt = 0; dt < 8; ++dt)
#pragma unroll
                for (int et = 0; et < 2; ++et) { const u32x2 v = *(const u32x2*)(kv + (size_t)(32 * wid + 16 * et + fr) * 128 + 16 * dt + 4 * fq);
                    C[dt][et].x += cf * bf2f(v.x & 0xffff); C[dt][et].y += cf * bf2f(v.x >> 16); C[dt][et].z += cf * bf2f(v.y & 0xffff); C[dt][et].w += cf * bf2f(v.y >> 16); }
            if (tid < 128) n0 += cf * NJ[(bh * 8 + jp) * 128 + tid];
        }
        if (tid < 128) sn[tid] = n0;
        if (tid >= 256) sgh[tid - 256] = g_head[h * 256 + tid - 256];
        __syncthreads();
        if (tid == 0) { float m = m0; for (int cc = 0; cc < 4; ++cc) { LAS float* tab = sc + cc * 256; const float M63 = fmaxf(m, tab[192]); tab[194] = m; tab[195] = M63; m = tab[193] + M63; } }
        __syncthreads();
        u32x4 rq[2], rk[2], rt[2], rv[4];
#define ML_LOAD(cc) do { const int tk_ = b * SEQ + (cc) * 64; _Pragma("unroll") for (int c2 = 0; c2 < 2; ++c2) { const int ch = tid + 512 * c2; \
            rq[c2] = *(const u32x4*)(Q1 + (size_t)(tk_ + (ch >> 4)) * 1024 + h * 128 + (ch & 15) * 8); rk[c2] = *(const u32x4*)(K1 + (size_t)(tk_ + (ch >> 4)) * 1024 + h * 128 + (ch & 15) * 8); \
            rt[c2] = *(const u32x4*)(K1 + (size_t)(tk_ + (ch & 63)) * 1024 + h * 128 + (ch >> 6) * 8); } \
        _Pragma("unroll") for (int c4 = 0; c4 < 4; ++c4) { const int ch = tid + 512 * c4; rv[c4] = *(const u32x4*)(VT + (size_t)(h * 256 + (ch >> 3)) * T + tk_ + (ch & 7) * 8); } } while (0)
#define ML_STORE(cc) do { const LAS float* tb_ = sc + ((cc) - c0) * 256; const float M63_ = tb_[195]; _Pragma("unroll") for (int c2 = 0; c2 < 2; ++c2) { const int ch = tid + 512 * c2; \
            *(LAS u32x4*)(lds + ML_QS + (ch >> 4) * 272 + (ch & 15) * 16) = rq[c2]; *(LAS u32x4*)(lds + ML_KS + (ch >> 4) * 272 + (ch & 15) * 16) = rk[c2]; \
            const int sp = ch & 63, c16 = ch >> 6; const float dsc = __expf(tb_[sp] - M63_); const unsigned w_[4] = {rt[c2].x, rt[c2].y, rt[c2].z, rt[c2].w}; \
            LAS bf16_t* dst = (LAS bf16_t*)(lds + ML_KD + (c16 * 8) * 144 + sp * 2); \
            _Pragma("unroll") for (int q = 0; q < 4; ++q) { dst[(2 * q) * 72] = (bf16_t)f2bf(bf2f(w_[q] & 0xffff) * dsc); dst[(2 * q + 1) * 72] = (bf16_t)f2bf(bf2f(w_[q] >> 16) * dsc); } } \
        _Pragma("unroll") for (int c4 = 0; c4 < 4; ++c4) { const int ch = tid + 512 * c4; *(LAS u32x4*)(lds + ML_VT + (ch >> 3) * 144 + (ch & 7) * 16) = rv[c4]; } } while (0)
        if (c0 < c1) { ML_LOAD(c0); ML_STORE(c0); }
#pragma unroll 1
        for (int c = c0; c < c1; ++c) {
            int zz = 0; asm volatile("" : "+v"(zz));
            LAS unsigned char* const L = lds + zz; LAS float* const scz = (LAS float*)(L + ML_SC);
            LAS float* const sssq = scz + 1024; LAS float* const srs = scz + 1536; LAS float* const sden = scz + 1792; LAS float* const sn = scz + 1856; LAS float* const sgh = scz + 2112; LAS bf16_t* const hb = (LAS bf16_t*)(L + ML_HB);
            const int tok0 = b * SEQ + c * 64;
            const LAS float* tab = scz + (c - c0) * 256;
            LAS float* sncur = sn + ((c - c0) & 1) * 128; LAS float* snnxt = sn + (((c - c0) & 1) ^ 1) * 128;
            __syncthreads();
            const float mprev = tab[194], M63 = tab[195];
            if (!(skip & 1)) {
                const int tb = wid >> 1;
#pragma unroll
                for (int a2 = 0; a2 < 2; ++a2) {
                    const int sa_t = 2 * (wid & 1) + a2;
                    u32x2 o = (u32x2){0u, 0u}; float rsum = 0.f;
                    if (sa_t <= tb) {
                        f32x4 acc = (f32x4){0.f, 0.f, 0.f, 0.f};
#pragma unroll
                        for (int ks = 0; ks < 4; ++ks) {
                            const bf16x8 kf = *(const LAS bf16x8*)(L + ML_KS + (16 * sa_t + fr) * 272 + (ks * 32 + fq * 8) * 2);
                            const bf16x8 qf = *(const LAS bf16x8*)(L + ML_QS + (16 * tb + fr) * 272 + (ks * 32 + fq * 8) * 2);
                            acc = MFMA16(kf, qf, acc);
                        }
                        const int tl = 16 * tb + fr; const float Mt = fmaxf(tab[128 + tl], mprev);
                        float wv[4];
#pragma unroll
                        for (int j = 0; j < 4; ++j) { const int sl = 16 * sa_t + 4 * fq + j; wv[j] = (sl <= tl) ? acc[j] * __expf(tab[sl] - Mt) : 0.f; }
                        o.x = pk2(wv[0], wv[1]); o.y = pk2(wv[2], wv[3]);
                        rsum = (wv[0] + wv[1]) + (wv[2] + wv[3]);
                        rsum += __shfl_xor(rsum, 16); rsum += __shfl_xor(rsum, 32);
                    }
                    *(LAS u32x2*)(L + ML_WS + (16 * tb + fr) * 144 + (16 * sa_t + 4 * fq) * 2) = o;
                    if (fq == 0) srs[sa_t * 64 + 16 * tb + fr] = rsum;
                }
            }
            __syncthreads();
            if (!(skip & 2)) {
                const int tl = tid >> 3, sl = tid & 7;
                const u32x4 qa = *(const LAS u32x4*)(L + ML_QS + tl * 272 + sl * 32), qb = *(const LAS u32x4*)(L + ML_QS + tl * 272 + sl * 32 + 16);
                const unsigned qw[8] = {qa.x, qa.y, qa.z, qa.w, qb.x, qb.y, qb.z, qb.w};
                float p = 0.f;
#pragma unroll
                for (int k = 0; k < 8; ++k) p += bf2f(qw[k] & 0xffff) * sncur[sl * 16 + 2 * k] + bf2f(qw[k] >> 16) * sncur[sl * 16 + 2 * k + 1];
                p += __shfl_xor(p, 1); p += __shfl_xor(p, 2); p += __shfl_xor(p, 4);
                if (sl == 0) sden[tl] = __expf(mprev - fmaxf(tab[128 + tl], mprev)) * p + (srs[tl] + srs[64 + tl]) + (srs[128 + tl] + srs[192 + tl]);
            }
#pragma unroll 1
            for (int tt = 0; tt < ((skip & 4) ? 0 : 4); ++tt) {
                f32x4 num[2];
#pragma unroll
                for (int et = 0; et < 2; ++et) num[et] = (f32x4){0.f, 0.f, 0.f, 0.f};
#pragma unroll
                for (int u = 0; u < 4; ++u) {
                    const s16x4 qlo = *(const LAS s16x4*)(L + ML_QS + (16 * tt + fr) * 272 + (32 * u + 4 * fq) * 2);
                    const s16x4 qhi = *(const LAS s16x4*)(L + ML_QS + (16 * tt + fr) * 272 + (32 * u + 16 + 4 * fq) * 2);
                    const bf16x8 qf = __builtin_shufflevector(qlo, qhi, 0, 1, 2, 3, 4, 5, 6, 7);
#pragma unroll
                    for (int et = 0; et < 2; ++et) {
                        const f32x4 c0v = C[2 * u][et], c1v = C[2 * u + 1][et];
                        u32x4 pb; pb.x = pk2(c0v.x, c0v.y); pb.y = pk2(c0v.z, c0v.w); pb.z = pk2(c1v.x, c1v.y); pb.w = pk2(c1v.z, c1v.w);
                        num[et] = MFMA16(qf, __builtin_bit_cast(bf16x8, pb), num[et]);
                    }
                }
                float scv[4];
#pragma unroll
                for (int j = 0; j < 4; ++j) scv[j] = __expf(mprev - fmaxf(tab[128 + 16 * tt + 4 * fq + j], mprev));
#pragma unroll
                for (int et = 0; et < 2; ++et) { num[et].x *= scv[0]; num[et].y *= scv[1]; num[et].z *= scv[2]; num[et].w *= scv[3]; }
                const int nks = (tt < 2) ? 1 : 2;
                for (int ks = 0; ks < nks; ++ks) {
                    const bf16x8 wf = *(const LAS bf16x8*)(L + ML_WS + (16 * tt + fr) * 144 + (ks * 32 + fq * 8) * 2);
#pragma unroll
                    for (int et = 0; et < 2; ++et) {
                        const bf16x8 vf = *(const LAS bf16x8*)(L + ML_VT + (32 * wid + 16 * et + fr) * 144 + (ks * 32 + fq * 8) * 2);
                        num[et] = MFMA16(wf, vf, num[et]);
                    }
                }
#pragma unroll
                for (int j = 0; j < 4; ++j) {
                    const int tl = 16 * tt + 4 * fq + j;
                    const float h0 = num[0][j], h1 = num[1][j];
                    hb[tl * 264 + 32 * wid + fr] = (bf16_t)f2bf(h0);
                    hb[tl * 264 + 32 * wid + 16 + fr] = (bf16_t)f2bf(h1);
                    float s = h0 * h0 + h1 * h1;
                    s += dpp_f(s, 0xB1); s += dpp_f(s, 0x4E); s += dpp_f(s, 0x141); s += dpp_f(s, 0x140);
                    if (fr == 0) sssq[wid * 64 + tl] = s;
                }
            }
            const float cs = __expf(mprev - M63);
            if (!(skip & 8)) {
#pragma unroll
                for (int dt = 0; dt < 8; ++dt)
#pragma unroll
                    for (int et = 0; et < 2; ++et) { C[dt][et].x *= cs; C[dt][et].y *= cs; C[dt][et].z *= cs; C[dt][et].w *= cs; }
#pragma unroll
                for (int ks = 0; ks < 2; ++ks) {
                    bf16x8 vf[2];
#pragma unroll
                    for (int et = 0; et < 2; ++et) vf[et] = *(const LAS bf16x8*)(L + ML_VT + (32 * wid + 16 * et + fr) * 144 + (ks * 32 + fq * 8) * 2);
#pragma unroll
                    for (int dt = 0; dt < 8; ++dt) {
                        const bf16x8 kf = *(const LAS bf16x8*)(L + ML_KD + (16 * dt + fr) * 144 + (ks * 32 + fq * 8) * 2);
#pragma unroll
                        for (int et = 0; et < 2; ++et) C[dt][et] = MFMA16(kf, vf[et], C[dt][et]);
                    }
                }
            }
            {
                const int dl = tid >> 2, sl = tid & 3;
                const u32x4 ka = *(const LAS u32x4*)(L + ML_KD + dl * 144 + sl * 32), kb = *(const LAS u32x4*)(L + ML_KD + dl * 144 + sl * 32 + 16);
                const unsigned kw[8] = {ka.x, ka.y, ka.z, ka.w, kb.x, kb.y, kb.z, kb.w};
                float p = 0.f;
#pragma unroll
                for (int k = 0; k < 8; ++k) p += bf2f(kw[k] & 0xffff) + bf2f(kw[k] >> 16);
                p += __shfl_xor(p, 1); p += __shfl_xor(p, 2);
                if (sl == 0) snnxt[dl] = cs * sncur[dl] + p;
            }
            __syncthreads();
            if (skip & 16) { if (c + 1 < c1) ML_LOAD(c + 1); } else {
                const int tl = tid >> 3, part = tid & 7;
                u32x4 ovq[4];
#pragma unroll
                for (int q = 0; q < 4; ++q) ovq[q] = *(const u32x4*)(OG + (size_t)(tok0 + tl) * D + h * 256 + (part + 8 * q) * 8);
                if (c + 1 < c1) ML_LOAD(c + 1);
                float tot = 0.f;
#pragma unroll
                for (int w = 0; w < 8; ++w) tot += sssq[w * 64 + tl];
                const float dd = 1.0f / fmaxf(fabsf(sden[tl]), __expf(-(tab[64 + tl] + fmaxf(tab[128 + tl], mprev))));
                const float rinv = dd / sqrtf(tot * dd * dd * (1.0f / 256.0f) + EPS);
#pragma unroll
                for (int q = 0; q < 4; ++q) {
                    const int e0 = (part + 8 * q) * 8;
                    const u32x4 hv = *(const LAS u32x4*)(L + ML_HB + tl * 528 + e0 * 2);
                    const size_t idx = (size_t)(tok0 + tl) * D + h * 256 + e0;
                    const u32x4 ov = ovq[q];
                    const f32x4 g0 = *(const LAS f32x4*)(sgh + e0), g1 = *(const LAS f32x4*)(sgh + e0 + 4);
                    const unsigned hw[4] = {hv.x, hv.y, hv.z, hv.w}, ow[4] = {ov.x, ov.y, ov.z, ov.w};
                    const float gg[8] = {g0.x, g0.y, g0.z, g0.w, g1.x, g1.y, g1.z, g1.w};
                    unsigned r[4];
#pragma unroll
                    for (int k = 0; k < 4; ++k) {
                        const float ha = bf2f(hw[k] & 0xffff), hbv = bf2f(hw[k] >> 16), oa = bf2f(ow[k] & 0xffff), ob = bf2f(ow[k] >> 16);
                        r[k] = pk2(ha * rinv * gg[2 * k] * __builtin_amdgcn_rcpf(1.0f + __expf(-oa)), hbv * rinv * gg[2 * k + 1] * __builtin_amdgcn_rcpf(1.0f + __expf(-ob)));
                    }
                    *(u32x4*)(HS + idx) = (u32x4){r[0], r[1], r[2], r[3]};
                }
            }
            if (c + 1 < c1) ML_STORE(c + 1);
        }
#undef ML_LOAD
#undef ML_STORE
    }
}

constexpr int W13_PRE = 2048;
#define P10_Q(J) ((J) == 0 ? 6 : (J) == 1 ? 5 : (J) <= 3 ? 4 : (J) == 4 ? 3 : (J) == 5 ? 2 : 0)
#define P10_PRE(J) ((J) == 0 ? 0 : (J) == 1 ? 6 : (J) == 2 ? 11 : (J) == 3 ? 15 : (J) == 4 ? 19 : (J) == 5 ? 22 : 24)
constexpr int W13_P10 = 24 * 256;
template <bool DEEP>
DI void convert_moe_layer(int l, bool do13, bool do2, int gw, int NGW, int lo13, int hi13, const float* w1, const float* w3, const float* w2, bf16_t* W13, bf16_t* W2, LAS unsigned char* lds, int wid, int lane) {
    LAS float* scr = (LAS float*)(lds + wid * 16640);
    constexpr int I_W1 = 32 * 32 * 4, I_W2 = 32 * 4 * 32;
    if (do2) for (int it = gw; it < I_W2; it += NGW) {
        const int le = l * NE + it / 128, q = it % 128;
        transpose_item<DEEP>(w2 + (size_t)le * FF * D, D, W2 + (size_t)le * D * FF, FF, 64 * (q / 32), 64 * (q % 32), 0, scr, lane); }
    if (do13) for (int it = lo13 + gw; it < (hi13 < 2 * I_W1 ? hi13 : 2 * I_W1); it += NGW) {
        const int which = it / I_W1, r = it % I_W1, le = l * NE + r / 128, q = r % 128;
        transpose_item<DEEP>((which ? w3 : w1) + (size_t)le * D * FF, FF, W13 + (size_t)le * 512 * D, D, 64 * (q / 4), 64 * (q % 4), 1 + which, scr, lane); }
}

__global__ void __launch_bounds__(NTHREADS, 2) fwd_kernel(Args args) {
    extern __shared__ __attribute__((aligned(16))) unsigned char lds_raw[];
    LAS unsigned char* lds = (LAS unsigned char*)lds_raw;
    const int tid = threadIdx.x, lane = tid & 63, wid = __builtin_amdgcn_readfirstlane(tid >> 6);
    unsigned char* ws = args.ws;
    unsigned* ctl = (unsigned*)(ws + WS_CTL);
    volatile LAS unsigned* misc = (volatile LAS unsigned*)(lds + LDS_BYTES - 256);
    if (tid < 16) misc[tid] = 0u;
    __syncthreads();
    XcdBarrier bar; bar.bar = ctl + CW_BAR; bar.x = 0; bar.st = misc;
    const int lo = args.ph_lo, hi = args.ph_hi;
    if (PROBE_A >= 0 && blockIdx.x == 0 && tid == 0) misc[16] = (unsigned)__builtin_amdgcn_s_memrealtime();
    if (hi - lo > 1) bar = xcd_barrier_post(ctl + CW_BAR, misc);
#ifndef PHMASK
#define PHMASK 0xffff
#endif
#define IN(k) (((PHMASK >> (k)) & 1) && lo <= (k) && (k) < hi)
#ifndef XBAR
#define XBAR 0
#endif
#define SEAM(k) do { if (IN(k) && IN((k) + 1)) { xcd_barrier(bar); if ((k) == 5) for (int xb_ = 0; xb_ < XBAR; ++xb_) xcd_barrier(bar); } if (PROBE_A >= 0 && blockIdx.x == 0 && tid == 0) misc[16 + (k) + 1] = (unsigned)__builtin_amdgcn_s_memrealtime(); } while (0)

#define PH(k, ...) { __VA_ARGS__ } if ((REPEAT_MASK >> (k)) & 1) { xcd_barrier(bar); { __VA_ARGS__ } }
#define LZ(z) int z = 0; asm volatile("" : "+s"(z))
#define INP(k) (args.in[k] + z)
#define WSP(type, off) ((type*)(ws + (off) + z))
#define ACT(type, off) ((type*)(ws + WS_ACT + (off) + z))

    PH(0, if (IN(0)) {
        LZ(z);
        const float* sb_w_in = INP(4); const float* sb_w_out = INP(5); const float* ml_w_in = INP(6); const float* ml_w_out = INP(10);
        const float* moe_w1 = INP(15); const float* moe_w3 = INP(16); const float* moe_w2 = INP(17);
        bf16_t* Wsbin = WSP(bf16_t, WS_WSBIN); bf16_t* Wsbout = WSP(bf16_t, WS_WSBOUT); bf16_t* Wmlin = WSP(bf16_t, WS_WMLIN); bf16_t* Wmlout = WSP(bf16_t, WS_WMLOUT);
        bf16_t* W13 = WSP(bf16_t, WS_W13); bf16_t* W2 = WSP(bf16_t, WS_W2);
        LAS float* scr = (LAS float*)(lds + wid * 16640);
        const int gw = blockIdx.x * 8 + wid, NGW = gridDim.x * 8;
        constexpr int I_SBIN = 32 * 96, I_SBOUT = 32 * 32, I_MLIN = 32 * 96, I_MLOUT = 32 * 32;
        constexpr int NITEMS = I_SBIN + I_SBOUT + I_MLIN + I_MLOUT;
        for (int it0 = gw; it0 < NITEMS; it0 += NGW) {
            int r = NITEMS - 1 - it0;
            if (r < I_SBIN) { transpose_item(sb_w_in, 6144, Wsbin, D, 64 * (r / 96), 64 * (r % 96), 0, scr, lane); continue; } r -= I_SBIN;
            if (r < I_SBOUT) { transpose_item(sb_w_out, D, Wsbout, D, 64 * (r / 32), 64 * (r % 32), 0, scr, lane); continue; } r -= I_SBOUT;
            if (r < I_MLIN) { transpose_item(ml_w_in, ML_IN, Wmlin, D, 64 * (r / 96), 64 * (r % 96), 0, scr, lane); continue; } r -= I_MLIN;
            transpose_item(ml_w_out, D, Wmlout, D, 64 * (r / 32), 64 * (r % 32), 0, scr, lane);
        }
        {
            const float* wg = INP(11); const float* we = INP(13); const float* wml = INP(6);
            bf16_t* wr = WSP(bf16_t, WS_WR); bf16_t* wgi = WSP(bf16_t, WS_WG);
            const int gt = blockIdx.x * NTHREADS + tid, NGT = gridDim.x * NTHREADS;
            for (int idx = gt; idx < 2 * 98304 + 32768; idx += NGT) {
                if (idx < 2 * 98304) {
                    const int l = idx / 98304, r = idx % 98304, j = r & 7, ln = (r >> 3) & 63, q = r >> 9, nt = q % 3, ks = q / 3;
                    const int k = 32 * ks + 8 * (ln >> 4) + j, n = 16 * nt + (ln & 15);
                    const float w = (n < 4) ? wg[(size_t)l * D * 4 + k * 4 + n] : ((n < 36) ? we[(size_t)l * D * 32 + k * 32 + (n - 4)] : 0.f);
                    wr[(size_t)l * (WR_BYTES / 2) + r] = (bf16_t)f2bf(w);
                } else {
                    const int r = idx - 2 * 98304, j = r & 7, ln = (r >> 3) & 63, ks = r >> 9;
                    const int k = 32 * ks + 8 * (ln >> 4) + j, n = ln & 15;
                    wgi[r] = (bf16_t)f2bf(wml[(size_t)k * ML_IN + 6144 + n]);
                }
            }
        }
        __syncthreads();
        NormP p{}; p.src = INP(0); p.H = WSP(bf16_t, WS_H); p.g = INP(1);
        norm_phase<0, false>(p, lds, tid, wid, lane);
    })
    SEAM(0);
    PH(1, if (IN(1)) {
        LZ(z);
        bf16_t* H = WSP(bf16_t, WS_H); bf16_t* Wsbin = WSP(bf16_t, WS_WSBIN);
        if (tid == 0) {
            pg8::put_job(lds, 0, H, Wsbin, T, 4096, ACT(bf16_t, A_Q), ACT(bf16_t, A_K), D, 2048, 0.12751743074602467f);
            pg8::put_job(lds, 1, Wsbin + (size_t)4096 * D, H, D, T, ACT(bf16_t, A_VT), ACT(bf16_t, A_VT), T, 1 << 30, 1.0f);
        }
        __syncthreads();
        pg8::Sched S; S.init(lds, 2, gridDim.x, blockIdx.x);
        pg8::EpiBf16 E{S.tab};
        pg8::gemm_phase(lds, S, E);
    })
    SEAM(1);
    PH(2, if (IN(2)) { LZ(z); attn_phase(ACT(bf16_t, A_Q), ACT(bf16_t, A_K), ACT(bf16_t, A_VT), ACT(bf16_t, A_O), lds, tid, wid, lane); })
#if defined(ATT_PROBE)
    if (IN(2)) { xcd_barrier(bar); LZ(z); attn_phase<ATT_PROBE>(ACT(bf16_t, A_Q), ACT(bf16_t, A_K), ACT(bf16_t, A_VT), WSP(bf16_t, WS_H), lds, tid, wid, lane); }
#endif
    SEAM(2);
    PH(3, if (IN(3)) { LZ(z);
        if (tid == 0) pg8::put_job(lds, 0, ACT(bf16_t, A_O), WSP(bf16_t, WS_WSBOUT), T, D, ACT(bf16_t, A_Z0), ACT(bf16_t, A_Z0), D, 1 << 30, 1.0f);
        __syncthreads();
        pg8::Sched S; S.init(lds, 1, gridDim.x, blockIdx.x);
        pg8::EpiBf16 E{S.tab}; pg8::gemm_phase(lds, S, E); })
    SEAM(3);
#if defined(OUTPROJ_PROBE)
    {
        LZ(z);
        if (tid == 0) pg8::put_job(lds, 0, ACT(bf16_t, A_O), WSP(bf16_t, WS_WSBOUT), T, D, nullptr, nullptr, D, 0, 1.0f);
        __syncthreads();
        pg8::Sched S; S.init(lds, 1, gridDim.x, blockIdx.x);
#if OUTPROJ_PROBE == 1
        pg8::EpiNull E; pg8::gemm_phase(lds, S, E);
#else
        pg8::EpiResF32 E{INP(0), ACT(float, A_Q), D}; pg8::gemm_phase(lds, S, E);
#endif
        xcd_barrier(bar);
    }
#endif
#define MOE_PHASES(l, pb) \
    PH(pb, if (IN(pb)) { LZ(z); convert_moe_layer<false>(l, true, false, blockIdx.x * 8 + wid, gridDim.x * 8, (l) ? W13_PRE + (gridDim.x == 256 ? W13_P10 : 0) : 0, 1 << 30, INP(15), INP(16), INP(17), WSP(bf16_t, WS_W13), WSP(bf16_t, WS_W2), lds, wid, lane); __syncthreads(); NormP p{}; p.src = (l) ? (const float*)WSP(bf16_t, WS_X) : INP(0); p.Y = (l) ? ACT(bf16_t, A_Z1) : ACT(bf16_t, A_Z0); p.X = WSP(bf16_t, WS_X); p.H = WSP(bf16_t, WS_H); p.g = INP(2) + (l) * D; p.wimg = WSP(bf16_t, WS_WR + (l) * WR_BYTES); p.bg = INP(12) + (l) * 4; \
        p.be = INP(14) + (l) * 32; p.cnt = ctl + CW_CNT + 64 * (l) + z; p.list = ACT(unsigned, A_LIST); p.listw = ACT(float, A_LISTW); \
        if (l) norm_phase<1, true>(p, lds, tid, wid, lane); else norm_phase<1, false>(p, lds, tid, wid, lane); }) \
    SEAM(pb); \
    PH((pb) + 1, if (IN((pb) + 1)) { LZ(z); pg8::moe_table256(ctl + CW_CNT + 64 * (l) + z, lds, tid); \
        pg8::MSched<2> S; S.init(lds, gridDim.x, blockIdx.x, true); \
        { const int nun = S.total; const int idle = (int)gridDim.x - nun;        \
          if (idle > 0) { if (S.c >= nun) { convert_moe_layer<true>(l, false, true, (S.c - nun) * 8 + wid, idle * 8, 0, 0, INP(15), INP(16), INP(17), WSP(bf16_t, WS_W13), WSP(bf16_t, WS_W2), lds, wid, lane); \
              if ((l) == 0) convert_moe_layer<true>(1, true, false, (S.c - nun) * 8 + wid, idle * 8, 0, W13_PRE, INP(15), INP(16), INP(17), WSP(bf16_t, WS_W13), WSP(bf16_t, WS_W2), lds, wid, lane); } } \
          else { convert_moe_layer<false>(l, false, true, blockIdx.x * 8 + wid, gridDim.x * 8, 0, 0, INP(15), INP(16), INP(17), WSP(bf16_t, WS_W13), WSP(bf16_t, WS_W2), lds, wid, lane); \
                 if ((l) == 0) convert_moe_layer<false>(1, true, false, blockIdx.x * 8 + wid, gridDim.x * 8, 0, W13_PRE, INP(15), INP(16), INP(17), WSP(bf16_t, WS_W13), WSP(bf16_t, WS_W2), lds, wid, lane); __syncthreads(); } } \
        pg8::MOps1 P{WSP(bf16_t, WS_H), WSP(bf16_t, WS_W13) + (size_t)(l) * NE * 512 * D, ACT(unsigned, A_LIST)}; \
        pg8::EpiSwiglu E{ACT(bf16_t, A_HID), ACT(float, A_LISTW)}; \
        pg8::gemm_phase_m<2048>(lds, S, P, E); }) \
    SEAM((pb) + 1); \
    PH((pb) + 2, if (IN((pb) + 2)) { LZ(z); pg8::moe_table256(ctl + CW_CNT + 64 * (l) + z, lds, tid); \
        pg8::MSched<8> S; S.init(lds, gridDim.x, blockIdx.x, true); \
        pg8::MOps2 P{ACT(bf16_t, A_HID), WSP(bf16_t, WS_W2) + (size_t)(l) * NE * D * FF}; \
        pg8::EpiScatter E{ACT(bf16_t, A_Y), ACT(unsigned, A_LIST)}; \
        pg8::gemm_phase_m<256>(lds, S, P, E); }) \
    SEAM((pb) + 2);
    MOE_PHASES(0, 4)
#if defined(MOE2_PROBE)
    {
        xcd_barrier(bar); LZ(z); pg8::moe_table256(ctl + CW_CNT + z, lds, tid);
        pg8::MSched<8> S; S.init(lds, gridDim.x, blockIdx.x);
        pg8::MOps2 P{ACT(bf16_t, A_HID), WSP(bf16_t, WS_W2)};
#if MOE2_PROBE == 1
        pg8::EpiMNull E; pg8::gemm_phase_m<256>(lds, S, P, E);
#else
        pg8::EpiScatter E{ACT(bf16_t, A_Y), ACT(unsigned, A_LIST)}; pg8::gemm_phase_m<256>(lds, S, P, E);
#endif
        xcd_barrier(bar);
    }
#endif
#if defined(ROUTER2X)
    { xcd_barrier(bar); LZ(z); NormP p{}; p.src = INP(0); p.Y = ACT(bf16_t, A_Z0); p.X = ACT(bf16_t, 96 * MiB); p.H = ACT(bf16_t, A_O); p.g = INP(2); p.wimg = WSP(bf16_t, WS_WR); p.bg = INP(12); p.be = INP(14);
      p.cnt = ctl + CW_CNT + 64 * 2 + z; p.list = ACT(unsigned, 128 * MiB); p.listw = ACT(float, 130 * MiB); norm_phase<1, false>(p, lds, tid, wid, lane); xcd_barrier(bar); }
#endif
    PH(7, if (IN(7)) { LZ(z); NormP p{}; p.X = WSP(bf16_t, WS_X); p.Y = ACT(bf16_t, A_Y); p.H = WSP(bf16_t, WS_H); p.g = INP(1) + D; p.wimg = WSP(bf16_t, WS_WG); p.G = ACT(float, A_G); norm_phase<2, true>(p, lds, tid, wid, lane); })
    SEAM(7);
    PH(8, if (IN(8)) {
        LZ(z);
        bf16_t* H = WSP(bf16_t, WS_H); bf16_t* Wmlin = WSP(bf16_t, WS_WMLIN);
        if (tid == 0) {
            pg8::put_job(lds, 0, H, Wmlin, T, 2048, ACT(bf16_t, A_Q1), ACT(bf16_t, A_K1), 1024, 1024, 0.08838834764831845f);
            pg8::put_job(lds, 1, H, Wmlin + (size_t)4096 * D, T, 2048, ACT(bf16_t, A_OG), ACT(bf16_t, A_OG), D, 1 << 30, 1.0f);
            pg8::put_job(lds, 2, Wmlin + (size_t)2048 * D, H, 2048, T, ACT(bf16_t, A_VT1), ACT(bf16_t, A_VT1), T, 1 << 30, 1.0f);
        }
        __syncthreads();
        pg8::Sched S; S.init(lds, 3, gridDim.x, blockIdx.x);
        pg8::EpiBf16 E{S.tab};
        pg8::gemm_phase(lds, S, E);
    })
    SEAM(8);
    PH(9, if (IN(9)) { LZ(z); mlstm_local(ACT(bf16_t, A_K1), ACT(bf16_t, A_VT1), ACT(float, A_G), INP(7), INP(8), WSP(bf16_t, WS_H), ACT(float, A_NJ), ACT(float, A_SUM), lds, tid, wid, lane); })
    SEAM(9);
    PH(10, if (IN(10)) { LZ(z); mlstm_phase<0>(ACT(bf16_t, A_Q1), ACT(bf16_t, A_K1), ACT(bf16_t, A_VT1), ACT(bf16_t, A_OG), ACT(float, A_G), INP(7), INP(8), INP(9), ACT(bf16_t, A_HS),
        WSP(bf16_t, WS_H), ACT(float, A_NJ), ACT(float, A_SUM), lds, tid, wid, lane);
        if (gridDim.x == 256) {
            const int J = (blockIdx.x >> 3) & 7, q = P10_Q(J), pre = P10_PRE(J);
            if (q) { __syncthreads(); convert_moe_layer<true>(1, true, false, ((blockIdx.x & 7) * 4 + (blockIdx.x >> 6)) * 8 + wid, 256, W13_PRE + pre * 256, W13_PRE + (pre + q) * 256, INP(15), INP(16), INP(17), WSP(bf16_t, WS_W13), WSP(bf16_t, WS_W2), lds, wid, lane); } } })
    SEAM(10);
#if defined(ML_PROBE)
    {
        LZ(z); mlstm_phase<ML_PROBE>(ACT(bf16_t, A_Q1), ACT(bf16_t, A_K1), ACT(bf16_t, A_VT1), ACT(bf16_t, A_OG), ACT(float, A_G), INP(7), INP(8), INP(9), (bf16_t*)(args.out + z),
            WSP(bf16_t, WS_H), ACT(float, A_NJ), ACT(float, A_SUM), lds, tid, wid, lane, 4); xcd_barrier(bar); }
#endif
    PH(11, if (IN(11)) { LZ(z);
        if (tid == 0) pg8::put_job(lds, 0, ACT(bf16_t, A_HS), WSP(bf16_t, WS_WMLOUT), T, D, ACT(bf16_t, A_Z1), ACT(bf16_t, A_Z1), D, 1 << 30, 1.0f);
        __syncthreads();
        pg8::Sched S; S.init(lds, 1, gridDim.x, blockIdx.x);
        pg8::EpiBf16 E{S.tab}; pg8::gemm_phase(lds, S, E); })
    SEAM(11);
    MOE_PHASES(1, 12)
    PH(15, if (IN(15)) { LZ(z); NormP p{}; p.X = WSP(bf16_t, WS_X); p.Y = ACT(bf16_t, A_Y); p.outf = args.out + z; p.g = INP(3); norm_phase<3, true>(p, lds, tid, wid, lane); })
    if (PROBE_A >= 0 && blockIdx.x == 0 && tid == 0) {
        misc[16 + 16] = (unsigned)__builtin_amdgcn_s_memrealtime();
        const float tA = (float)(misc[16 + PROBE_A + 1] - misc[16 + PROBE_A]) * 0.01f, tB = (PROBE_B >= 0) ? (float)(misc[16 + PROBE_B + 1] - misc[16 + PROBE_B]) * 0.01f : 0.f;
        args.out[0] = (1.0f + tA * 0.02f) * __builtin_powf(10.0f, __builtin_rintf(tB * 0.1f));
    }
#undef IN
#undef SEAM
}

extern "C" void kernel_launch(void* const* d_in, const int* in_sizes, int n_in, void* d_out, int out_size, void* d_ws, size_t ws_size, hipStream_t stream) {
    static int grid = 0;
    if (grid == 0) {
        if (n_in != 18 || out_size != T * D || ws_size < WS_END) { fprintf(stderr, "kernel_launch: unexpected shapes (n_in %d out %d ws %zu need %zu)\n", n_in, out_size, ws_size, (size_t)WS_END); grid = -1; return; }
        int dev = 0, cus = 0, per_cu = 0;
        if (hipGetDevice(&dev) != hipSuccess || hipDeviceGetAttribute(&cus, hipDeviceAttributeMultiprocessorCount, dev) != hipSuccess) { grid = -1; return; }
        if (hipFuncSetAttribute((const void*)fwd_kernel, hipFuncAttributeMaxDynamicSharedMemorySize, LDS_BYTES) != hipSuccess) { fprintf(stderr, "kernel_launch: hipFuncSetAttribute failed\n"); grid = -1; return; }
        if (hipOccupancyMaxActiveBlocksPerMultiprocessor(&per_cu, (const void*)fwd_kernel, NTHREADS, LDS_BYTES) != hipSuccess || per_cu < 1) { fprintf(stderr, "kernel_launch: occupancy query says %d\n", per_cu); per_cu = 1; }
        (void)hipGetLastError();
        grid = cus;
    }
    if (grid < 0) return;
    (void)hipMemsetAsync((char*)d_ws + WS_CTL, 0, CTL_BYTES, stream);
    Args a{};
    for (int i = 0; i < 18; ++i) a.in[i] = (const float*)d_in[i];
    a.out = (float*)d_out; a.ws = (unsigned char*)d_ws;
#if MK_MULTI
    for (int ph = 0; ph < NPHASE; ++ph) { a.ph_lo = ph; a.ph_hi = ph + 1; hipLaunchKernelGGL(fwd_kernel, dim3(grid), dim3(NTHREADS), LDS_BYTES, stream, a); }
#else
    a.ph_lo = 0; a.ph_hi = NPHASE;
    void* kargs[] = {&a};
    hipError_t e = hipLaunchCooperativeKernel((const void*)fwd_kernel, dim3(grid), dim3(NTHREADS), kargs, LDS_BYTES, stream);
    if (e != hipSuccess) fprintf(stderr, "kernel_launch: cooperative launch failed: %s\n", hipGetErrorString(e));
#endif
}
```
